# Optimizing an MI355X kernel written in HIP

```python
import math
import jax, jax.numpy as jnp
from jax import lax
import numpy as np

D_MODEL = 1024
BATCH = 4
SEQ = 4096
DEPTH = 1

D_MIX = D_MODEL
W_SSM = (3 * D_MIX) // 8
W_CONV = (3 * D_MIX) // 8
W_MEM = D_MIX // 4
SSM_GROUP = 16
SSM_GROUPS = W_SSM // SSM_GROUP
SSM_STATE = 64
CONV_WIDTH = 3
MEM_HEADS = 4
MEM_HEAD_DIM = W_MEM // MEM_HEADS
N_MEM = 256
NORM_EPS = 1e-6
DT_MIN = 1e-3
DT_MAX = 1e-1
IN_SPLITS = [W_SSM, W_SSM, W_CONV, W_CONV, W_CONV, W_CONV, W_MEM, W_MEM]
D_IN = sum(IN_SPLITS)

kernel_name = "hymba_s5_shortconv_memxattn_layer"


def _rmsnorm(x, g):
    xf = x.astype(jnp.float32)
    y = xf * lax.rsqrt(jnp.mean(xf * xf, axis=-1, keepdims=True) + NORM_EPS)
    return (y * g.astype(jnp.float32)).astype(x.dtype)


def _s5_group(u, lam_re, lam_im, b_re, b_im, c_re, c_im, d, log_dt, w_glu, b_glu):
    bsz, seqlen, _ = u.shape
    f32 = jnp.float32
    uf = u.astype(f32)
    ug = uf.reshape(bsz, seqlen, SSM_GROUPS, SSM_GROUP)
    lam = lax.complex(lam_re.astype(f32), lam_im.astype(f32))
    dt = jnp.exp(log_dt.astype(f32))[:, None]
    lam_bar = jnp.exp(lam * dt)
    b_bar = ((lam_bar - 1.0) / lam)[..., None] * lax.complex(b_re.astype(f32), b_im.astype(f32))
    bu = lax.complex(jnp.einsum('blgh,gph->blgp', ug, jnp.real(b_bar)),
                     jnp.einsum('blgh,gph->blgp', ug, jnp.imag(b_bar)))
    a = jnp.broadcast_to(lam_bar, bu.shape)

    def combine(left, right):
        a_l, b_l = left
        a_r, b_r = right
        return a_l * a_r, a_r * b_l + b_r

    _, s = lax.associative_scan(combine, (a, bu), axis=1)
    y = (jnp.einsum('blgp,ghp->blgh', jnp.real(s), c_re.astype(f32))
         - jnp.einsum('blgp,ghp->blgh', jnp.imag(s), c_im.astype(f32)))
    y = y.reshape(bsz, seqlen, W_SSM) + d.astype(f32) * uf
    g = jax.nn.gelu(y)
    out = g * jax.nn.sigmoid(g @ w_glu.astype(f32) + b_glu.astype(f32))
    return out.astype(u.dtype)


def _short_conv_group(x_in, gate_b, gate_c, conv_w, conv_b):
    u = gate_c * x_in
    up = jnp.pad(u, ((0, 0), (CONV_WIDTH - 1, 0), (0, 0)))
    seqlen = x_in.shape[1]
    y = conv_b + sum(conv_w[k] * up[:, k:k + seqlen] for k in range(CONV_WIDTH))
    return gate_b * y


def _memory_xattn_group(q, mem_n, w_mem_kv):
    bsz, seqlen, _ = q.shape
    kv = mem_n @ w_mem_kv
    k, v = jnp.split(kv, 2, axis=-1)
    qh = q.reshape(bsz, seqlen, MEM_HEADS, MEM_HEAD_DIM)
    kh = k.reshape(bsz, N_MEM, MEM_HEADS, MEM_HEAD_DIM)
    vh = v.reshape(bsz, N_MEM, MEM_HEADS, MEM_HEAD_DIM)
    scores = jnp.einsum('blhd,bmhd->bhlm', qh, kh).astype(jnp.float32) / math.sqrt(MEM_HEAD_DIM)
    p = jax.nn.softmax(scores, axis=-1).astype(q.dtype)
    o = jnp.einsum('bhlm,bmhd->blhd', p, vh)
    return o.reshape(bsz, seqlen, W_MEM)


def setup_inputs(seed: int = 0) -> dict:
    key = jax.random.key(seed)
    ks = jax.random.split(key, 24)
    f32 = jnp.float32
    n = lambda k, shape, scale: scale * jax.random.normal(k, shape, f32)
    x = jax.random.normal(ks[0], (BATCH, SEQ, D_MODEL), f32)
    mem = jax.random.normal(ks[1], (BATCH, N_MEM, D_MODEL), f32)
    norm_g = 1.0 + n(ks[2], (DEPTH, D_MODEL), 0.02)
    w_in = n(ks[3], (DEPTH, D_MODEL, D_IN), D_MODEL ** -0.5)
    idx = jnp.arange(SSM_STATE, dtype=f32)
    ssm_lam_re = -0.5 + n(ks[4], (DEPTH, SSM_GROUPS, SSM_STATE), 0.01)
    ssm_lam_im = math.pi * idx + n(ks[5], (DEPTH, SSM_GROUPS, SSM_STATE), 0.01)
    ssm_b_re = n(ks[6], (DEPTH, SSM_GROUPS, SSM_STATE, SSM_GROUP), (2 * SSM_GROUP) ** -0.5)
    ssm_b_im = n(ks[7], (DEPTH, SSM_GROUPS, SSM_STATE, SSM_GROUP), (2 * SSM_GROUP) ** -0.5)
    ssm_c_re = n(ks[8], (DEPTH, SSM_GROUPS, SSM_GROUP, SSM_STATE), (2 * SSM_STATE) ** -0.5)
    ssm_c_im = n(ks[9], (DEPTH, SSM_GROUPS, SSM_GROUP, SSM_STATE), (2 * SSM_STATE) ** -0.5)
    ssm_d = n(ks[10], (DEPTH, W_SSM), 1.0)
    ssm_log_dt = jax.random.uniform(ks[11], (DEPTH, SSM_GROUPS), f32,
                                    math.log(DT_MIN), math.log(DT_MAX))
    w_glu = n(ks[12], (DEPTH, W_SSM, W_SSM), W_SSM ** -0.5)
    b_glu = n(ks[13], (DEPTH, W_SSM), 0.02)
    conv_w = n(ks[14], (DEPTH, CONV_WIDTH, W_CONV), CONV_WIDTH ** -0.5)
    conv_b = n(ks[15], (DEPTH, W_CONV), 0.02)
    mem_norm_g = 1.0 + n(ks[16], (DEPTH, D_MODEL), 0.02)
    w_mem_kv = n(ks[17], (DEPTH, D_MODEL, 2 * W_MEM), D_MODEL ** -0.5)
    w_out = n(ks[18], (DEPTH, D_MIX, D_MODEL), D_MIX ** -0.5)
    final_norm_g = 1.0 + n(ks[19], (D_MODEL,), 0.02)
    return {"x": x, "mem": mem, "norm_g": norm_g, "w_in": w_in,
            "ssm_lam_re": ssm_lam_re, "ssm_lam_im": ssm_lam_im,
            "ssm_b_re": ssm_b_re, "ssm_b_im": ssm_b_im,
            "ssm_c_re": ssm_c_re, "ssm_c_im": ssm_c_im,
            "ssm_d": ssm_d, "ssm_log_dt": ssm_log_dt,
            "w_glu": w_glu, "b_glu": b_glu,
            "conv_w": conv_w, "conv_b": conv_b,
            "mem_norm_g": mem_norm_g, "w_mem_kv": w_mem_kv,
            "w_out": w_out, "final_norm_g": final_norm_g}


def reference(x, mem, norm_g, w_in, ssm_lam_re, ssm_lam_im, ssm_b_re, ssm_b_im,
              ssm_c_re, ssm_c_im, ssm_d, ssm_log_dt, w_glu, b_glu, conv_w, conv_b,
              mem_norm_g, w_mem_kv, w_out, final_norm_g):
    split_idx = list(np.cumsum(IN_SPLITS)[:-1])
    h = x
    for l in range(DEPTH):
        hn = _rmsnorm(h, norm_g[l])
        proj = hn @ w_in[l]
        (a_in, a_gate, c_in, c_b, c_c, c_gate, q, q_gate) = jnp.split(proj, split_idx, axis=-1)
        y_ssm = _s5_group(a_in, ssm_lam_re[l], ssm_lam_im[l], ssm_b_re[l], ssm_b_im[l],
                          ssm_c_re[l], ssm_c_im[l], ssm_d[l], ssm_log_dt[l],
                          w_glu[l], b_glu[l]) * jax.nn.silu(a_gate)
        y_conv = _short_conv_group(c_in, c_b, c_c, conv_w[l], conv_b[l]) * jax.nn.silu(c_gate)
        mem_n = _rmsnorm(mem, mem_norm_g[l])
        y_mem = _memory_xattn_group(q, mem_n, w_mem_kv[l]) * jax.nn.silu(q_gate)
        y = jnp.concatenate([y_ssm, y_conv, y_mem], axis=-1)
        h = h + y @ w_out[l]
    return _rmsnorm(h, final_norm_g)
```

```cpp
#include <hip/hip_runtime.h>
#include <hip/hip_cooperative_groups.h>
#include <cstdio>
#include <cstdint>
namespace cg = cooperative_groups;

#define LAS __attribute__((address_space(3)))
typedef unsigned short bf16_t;
typedef unsigned v4u __attribute__((ext_vector_type(4)));
typedef float f32x4 __attribute__((ext_vector_type(4)));

constexpr int NB = 4, SEQ = 4096, DM = 1024, NTOK = NB * SEQ, DIN = 2816, WSSM = 384, NG = 24, GH = 16, NP = 64, NMEM = 256;
constexpr int C_AIN = 0, C_AGATE = 384, C_CIN = 768, C_CB = 1152, C_CC = 1536, C_CGATE = 1920, C_Q = 2304, C_QGATE = 2560;
constexpr float NORM_EPS = 1e-6f;

constexpr size_t MiB = 1u << 20;
constexpr size_t WS_CTL = 0;
constexpr size_t WS_XB = 1 * MiB;
constexpr size_t WS_WINT = 33 * MiB;
constexpr size_t WS_WKVT = 39 * MiB;
constexpr size_t WS_WOUTT = 40 * MiB;
constexpr size_t WS_WGLUT = 42 * MiB;
constexpr size_t WS_MEMN = 43 * MiB;
constexpr size_t WS_KV = 45 * MiB;
constexpr size_t WS_LAMB = 46 * MiB;
constexpr size_t WS_BBAR = 46 * MiB + 65536;
constexpr size_t WS_GB = 47 * MiB;
constexpr size_t WS_PROJ = 59 * MiB;
constexpr size_t WS_YCAT = 147 * MiB;
constexpr size_t WS_AY = 179 * MiB;
constexpr size_t WS_WS = 203 * MiB;
constexpr size_t WS_WY = 206 * MiB;
constexpr size_t WS_LAMT = 212 * MiB;
constexpr size_t WS_LAM512 = 212 * MiB + 65536;
constexpr size_t WS_XCH = 213 * MiB;
constexpr size_t WS_END = 214 * MiB;
constexpr size_t CTL_PANEL = 16384;
constexpr size_t CTL_BYTES = 32768;

constexpr int LDS_BYTES = 147456;

struct Args {
    const float* in[20];
    float* out;
    unsigned char* ws;
};

__device__ __forceinline__ unsigned f2bf(float f) { unsigned u = __builtin_bit_cast(unsigned, f); return (u + 0x7fffu + ((u >> 16) & 1u)) >> 16; }
__device__ __forceinline__ unsigned pk2(float lo, float hi) { return f2bf(lo) | (f2bf(hi) << 16); }
__device__ __forceinline__ float bf2f(unsigned short b) { return __builtin_bit_cast(float, ((unsigned)b) << 16); }
__device__ __forceinline__ float bflo(unsigned w) { return __builtin_bit_cast(float, w << 16); }
__device__ __forceinline__ float bfhi(unsigned w) { return __builtin_bit_cast(float, w & 0xffff0000u); }
__device__ __forceinline__ float wave_sum(float v) {
#pragma unroll
    for (int o = 1; o < 64; o <<= 1) v += __shfl_xor(v, o);
    return v;
}
__device__ __forceinline__ float silu_f(float v) { return v * __builtin_amdgcn_rcpf(1.0f + __builtin_amdgcn_exp2f(-1.4426950408889634f * v)); }
__device__ __forceinline__ float sigmoid_f(float v) { return __builtin_amdgcn_rcpf(1.0f + __builtin_amdgcn_exp2f(-1.4426950408889634f * v)); }
__device__ __forceinline__ float gelu_tanh(float v) { const float w = __builtin_fmaf(v * v, -0.10294324f, -2.3022082f); return v * __builtin_amdgcn_rcpf(1.0f + __builtin_amdgcn_exp2f(v * w)); }
#define LDS_WAIT() asm volatile("s_waitcnt lgkmcnt(0)" ::: "memory")
__device__ __forceinline__ int otid() { int t = threadIdx.x; asm volatile("" : "+v"(t)); return t; }

#define XB_TMO      128
#define XB_XCNT(j)  (256  + 64 * (j))
#define XB_XSUB(j)  (1280 + 64 * (j))
#define XB_XGEN(j)  (2304 + 64 * (j))
#define XB_TOP      3328
#define XB_TOPGEN   3392
#define XCD_BAR_WORDS 3456
#define XB_SPIN_CAP (1u << 18)

__device__ __forceinline__ unsigned xb_ld(unsigned* p)              { return __hip_atomic_load(p, __ATOMIC_RELAXED, __HIP_MEMORY_SCOPE_AGENT); }
__device__ __forceinline__ unsigned xb_add(unsigned* p, unsigned v) { return __hip_atomic_fetch_add(p, v, __ATOMIC_RELAXED, __HIP_MEMORY_SCOPE_AGENT); }
__device__ __forceinline__ unsigned xb_xcc_id() { return (unsigned)__builtin_amdgcn_s_getreg((3 << 11) | 20) & 0xFu; }
#define XB_SPIN(cond, bar) do { unsigned _sp = 0; while (cond) { __builtin_amdgcn_s_sleep(1); \
    if ((++_sp & 255u) == 0u) { if (xb_ld(&(bar)[XB_TMO])) break; if (_sp > XB_SPIN_CAP) { atomicAdd(&(bar)[XB_TMO], 1u); break; } } } } while (0)

struct XcdBarrier {
    unsigned* bar; unsigned x;
    volatile LAS unsigned* st;
};

__device__ __forceinline__ XcdBarrier xcd_barrier_post(unsigned* bar, volatile LAS unsigned* st) {
    XcdBarrier b; b.bar = bar; b.x = xb_xcc_id(); b.st = st;
    if (threadIdx.x == 0) (void)xb_add(&bar[XB_XCNT(b.x)], 1u);
    return b;
}
__device__ __forceinline__ void xcd_barrier_complete(unsigned* bar, unsigned x, unsigned& nloc, unsigned& nx) {
    const unsigned G = gridDim.x * gridDim.y * gridDim.z;
    unsigned sum, cnt, mine, sp = 0u;
    for (;;) {
        sum = 0u; cnt = 0u; mine = 0u;
#pragma unroll
        for (unsigned j = 0; j < 16; ++j) { const unsigned c = xb_ld(&bar[XB_XCNT(j)]); sum += c; cnt += (c > 0u) ? 1u : 0u; mine = (j == x) ? c : mine; }
        if (sum == G) break;
        __builtin_amdgcn_s_sleep(1);
        if ((++sp & 255u) == 0u) { if (xb_ld(&bar[XB_TMO])) break; if (sp > XB_SPIN_CAP) { atomicAdd(&bar[XB_TMO], 1u); break; } }
    }
    nloc = mine > 0u ? mine : 1u; nx = cnt > 0u ? cnt : 1u;
}

__device__ __forceinline__ void xcd_barrier(const XcdBarrier& b) {
    asm volatile("s_waitcnt vmcnt(0)" ::: "memory");
    __syncthreads();
    if (threadIdx.x == 0) {
        unsigned* bar = b.bar;
        __builtin_amdgcn_s_waitcnt(0);
        unsigned nloc = b.st[0], nx = b.st[1];
        if (nloc == 0u) { xcd_barrier_complete(bar, b.x, nloc, nx); b.st[0] = nloc; b.st[1] = nx; }
        const unsigned old = xb_add(&bar[XB_XSUB(b.x)], 1u);
        const unsigned gen = old / nloc;
        if (old + 1u == (gen + 1u) * nloc) {
            __builtin_amdgcn_fence(__ATOMIC_RELEASE, "agent");
            asm volatile("s_waitcnt vmcnt(0)" ::: "memory");
            const unsigned og = xb_add(&bar[XB_TOP], 1u);
            const unsigned tg = og / nx;
            if (og + 1u == (tg + 1u) * nx) xb_add(&bar[XB_TOPGEN], 1u);
            else XB_SPIN(xb_ld(&bar[XB_TOPGEN]) == tg, bar);
            __builtin_amdgcn_fence(__ATOMIC_ACQUIRE, "agent");
            xb_add(&bar[XB_XGEN(b.x)], 1u);
            asm volatile("s_waitcnt vmcnt(0)" ::: "memory");
        } else {
            XB_SPIN(xb_ld(&bar[XB_XGEN(b.x)]) == gen, bar);
            __builtin_amdgcn_fence(__ATOMIC_ACQUIRE, "agent");
            asm volatile("s_waitcnt vmcnt(0)" ::: "memory");
        }
    }
    __syncthreads();
}

__device__ __forceinline__ void rms_row_to_bf16(const float* xrow, bf16_t* orow, const float* gain, int lane) {
    const f32x4* xr = (const f32x4*)xrow + lane;
    f32x4 v[4]; float s = 0.f;
#pragma unroll
    for (int j = 0; j < 4; ++j) { v[j] = xr[64 * j]; s += (v[j].x * v[j].x + v[j].y * v[j].y) + (v[j].z * v[j].z + v[j].w * v[j].w); }
    const float rstd = 1.0f / sqrtf(wave_sum(s) * (1.0f / DM) + NORM_EPS);
    unsigned long long* o8 = (unsigned long long*)orow + lane;
#pragma unroll
    for (int j = 0; j < 4; ++j) {
        f32x4 g = gain ? ((const f32x4*)gain)[lane + 64 * j] : (f32x4){1.f, 1.f, 1.f, 1.f};
        o8[64 * j] = (unsigned long long)pk2(v[j].x * rstd * g.x, v[j].y * rstd * g.y) | ((unsigned long long)pk2(v[j].z * rstd * g.z, v[j].w * rstd * g.w) << 32);
    }
}
__device__ __forceinline__ void transpose_item(const float* W, int K, int N, bf16_t* WT, const float* ks, LAS float* scr, int item, int lane) {
    const int nblk = N / 32, kb = item / nblk, nb = item % nblk, k0 = 64 * kb, n0 = 32 * nb;
#pragma unroll 8
    for (int i = 0; i < 32; ++i) { const int kk = 2 * i + (lane >> 5); float w = W[(size_t)(k0 + kk) * N + n0 + (lane & 31)]; if (ks) w *= ks[k0 + kk]; scr[kk * 33 + (lane & 31)] = w; }
    LDS_WAIT();
    const int c = lane & 7;
#pragma unroll
    for (int j = 0; j < 4; ++j) { const int n = (lane >> 3) + 8 * j; const LAS float* s = scr + (8 * c) * 33 + n;
        v4u o; o.x = pk2(s[0 * 33], s[1 * 33]); o.y = pk2(s[2 * 33], s[3 * 33]); o.z = pk2(s[4 * 33], s[5 * 33]); o.w = pk2(s[6 * 33], s[7 * 33]);
        *(v4u*)(WT + (size_t)(n0 + n) * K + k0 + 8 * c) = o; }
    LDS_WAIT();
}


__device__ __forceinline__ void s5_tables(const Args& a, LAS unsigned char* lds, int tid) {
    const int bid = blockIdx.x; if (bid >= 192) return;
    const int g = bid % NG, q = bid / NG;
    const float* lam_re = a.in[4]; const float* lam_im = a.in[5]; const float* b_re = a.in[6]; const float* b_im = a.in[7]; const float* c_re = a.in[8]; const float* c_im = a.in[9]; const float* log_dt = a.in[11];
    LAS float* LPr = (LAS float*)(lds + 69632); LAS float* LPi = LPr + 17 * 64; LAS float* BBr = LPi + 17 * 64; LAS float* BBi = BBr + 1024;
    LAS float* Cr = BBi + 1024; LAS float* Ci = Cr + 1024; LAS float* KT = Ci + 1024;
    if (tid < 64) {
        const int p = tid, i = g * NP + p;
        const double dt = exp((double)log_dt[g]);
        const double lr = lam_re[i], li = lam_im[i];
        const double er = exp(lr * dt), ang = li * dt;
        const double lbr = er * cos(ang), lbi = er * sin(ang);
        const double nr = lbr - 1.0, ni = lbi, den = lr * lr + li * li;
        const double qr = (nr * lr + ni * li) / den, qi = (ni * lr - nr * li) / den;
        for (int h = 0; h < GH; ++h) { const double br = b_re[i * GH + h], bi = b_im[i * GH + h];
            BBr[p * 16 + h] = (float)(qr * br - qi * bi); BBi[p * 16 + h] = (float)(qr * bi + qi * br); }
        double pr = 1.0, pi = 0.0;
        for (int t = 0; t < 16; ++t) { LPr[t * 64 + p] = (float)pr; LPi[t * 64 + p] = (float)pi; const double nr2 = pr * lbr - pi * lbi, ni2 = pr * lbi + pi * lbr; pr = nr2; pi = ni2; }
        LPr[16 * 64 + p] = (float)pr; LPi[16 * 64 + p] = (float)pi;
        double tr = pr, ti = pi;
        if (q == 0) { float* LAMT = (float*)(a.ws + WS_LAMT); LAMT[2 * i] = (float)tr; LAMT[2 * i + 1] = (float)ti; }
        for (int k = 0; k < 5; ++k) { const double nr2 = tr * tr - ti * ti, ni2 = 2.0 * tr * ti; tr = nr2; ti = ni2; }
        if (q == 0) { float* L512 = (float*)(a.ws + WS_LAM512); L512[2 * i] = (float)tr; L512[2 * i + 1] = (float)ti; }
    }
    for (int i = tid; i < 1024; i += 512) { Cr[i] = c_re[g * 1024 + i]; Ci[i] = c_im[g * 1024 + i]; }
    __syncthreads();
    { const int tau = tid >> 5, hol = (tid >> 4) & 1, hi = tid & 15, ho = 2 * q + hol; float sacc = 0.f;
#pragma unroll 4
      for (int p = 0; p < 64; ++p) { const float lpr = LPr[tau * 64 + p], lpi = LPi[tau * 64 + p], br = BBr[p * 16 + hi], bi = BBi[p * 16 + hi];
          const float wr_ = lpr * br - lpi * bi, wi_ = lpr * bi + lpi * br; sacc += Cr[ho * 64 + p] * wr_ - Ci[ho * 64 + p] * wi_; }
      KT[tid] = sacc; }
    __syncthreads();
    bf16_t* WSb = (bf16_t*)(a.ws + WS_WS); bf16_t* WYb = (bf16_t*)(a.ws + WS_WY);
#pragma unroll
    for (int kk = 0; kk < 2; ++kk) { const int ch = tid + 512 * kk, n = 32 * q + (ch >> 5), k0 = (ch & 31) * 8, p = n & 63, isim = (n >> 6) & 1;
        float v[8];
#pragma unroll
        for (int j = 0; j < 8; ++j) { const int k = k0 + j, t = k >> 4, h = k & 15, tau = 15 - t; const float lpr = LPr[tau * 64 + p], lpi = LPi[tau * 64 + p], br = BBr[p * 16 + h], bi = BBi[p * 16 + h];
            const float val = isim ? (lpr * bi + lpi * br) : (lpr * br - lpi * bi); v[j] = n < 128 ? val : 0.f; }
        v4u o; o.x = pk2(v[0], v[1]); o.y = pk2(v[2], v[3]); o.z = pk2(v[4], v[5]); o.w = pk2(v[6], v[7]);
        *(v4u*)(WSb + ((size_t)(g * 256 + n)) * 256 + k0) = o; }
#pragma unroll
    for (int kk = 0; kk < 4; ++kk) { const int ch = tid + 512 * kk, rr = ch >> 6, to = rr >> 1, hol = rr & 1, ho = 2 * q + hol, n = to * 16 + ho, k0 = (ch & 63) * 8;
        float v[8];
#pragma unroll
        for (int j = 0; j < 8; ++j) { const int k = k0 + j; float val;
            if (k < 256) { const int ti = k >> 4, hi = k & 15; val = ti <= to ? KT[((to - ti) * 2 + hol) * 16 + hi] : 0.f; }
            else { const int jj = (k - 256) & 127, p = jj & 63, isim = jj >> 6; const float lpr = LPr[(to + 1) * 64 + p], lpi = LPi[(to + 1) * 64 + p], cr = Cr[ho * 64 + p], ci = Ci[ho * 64 + p];
                val = isim ? -(cr * lpi + ci * lpr) : (cr * lpr - ci * lpi); }
            v[j] = val; }
        v4u o; o.x = pk2(v[0], v[1]); o.y = pk2(v[2], v[3]); o.z = pk2(v[4], v[5]); o.w = pk2(v[6], v[7]);
        *(v4u*)(WYb + ((size_t)(g * 256 + n)) * 512 + k0) = o; }
}

__device__ __forceinline__ void rms_rows2_to_bf16(const float* x0, const float* x1, bf16_t* o0, bf16_t* o1, const float* gain, int lane) {
    const f32x4* xr0 = (const f32x4*)x0 + lane; const f32x4* xr1 = (const f32x4*)x1 + lane;
    f32x4 v[4], w[4]; float s0 = 0.f, s1 = 0.f;
#pragma unroll
    for (int j = 0; j < 4; ++j) { v[j] = xr0[64 * j]; w[j] = xr1[64 * j]; }
#pragma unroll
    for (int j = 0; j < 4; ++j) { s0 += (v[j].x * v[j].x + v[j].y * v[j].y) + (v[j].z * v[j].z + v[j].w * v[j].w); s1 += (w[j].x * w[j].x + w[j].y * w[j].y) + (w[j].z * w[j].z + w[j].w * w[j].w); }
#pragma unroll
    for (int o = 1; o < 64; o <<= 1) { s0 += __shfl_xor(s0, o); s1 += __shfl_xor(s1, o); }
    const float r0 = 1.0f / sqrtf(s0 * (1.0f / DM) + NORM_EPS), r1 = 1.0f / sqrtf(s1 * (1.0f / DM) + NORM_EPS);
    unsigned long long* p0 = (unsigned long long*)o0 + lane; unsigned long long* p1 = (unsigned long long*)o1 + lane;
#pragma unroll
    for (int j = 0; j < 4; ++j) {
        const f32x4 g = gain ? ((const f32x4*)gain)[lane + 64 * j] : (f32x4){1.f, 1.f, 1.f, 1.f};
        p0[64 * j] = (unsigned long long)pk2(v[j].x * r0 * g.x, v[j].y * r0 * g.y) | ((unsigned long long)pk2(v[j].z * r0 * g.z, v[j].w * r0 * g.w) << 32);
        p1[64 * j] = (unsigned long long)pk2(w[j].x * r1 * g.x, w[j].y * r1 * g.y) | ((unsigned long long)pk2(w[j].z * r1 * g.z, w[j].w * r1 * g.w) << 32);
    }
}
__device__ __forceinline__ void transpose_item4(const float* W, int K, int N, bf16_t* WT, const float* ks, LAS float* scr, int item, int lane) {
    const int nblk = N / 32, kb = item / nblk, nb = item % nblk, k0 = 64 * kb, n0 = 32 * nb;
    f32x4 w[8];
#pragma unroll
    for (int i = 0; i < 8; ++i) { const int kk = 8 * i + (lane >> 3); w[i] = *(const f32x4*)(W + (size_t)(k0 + kk) * N + n0 + 4 * (lane & 7)); }
#pragma unroll
    for (int i = 0; i < 8; ++i) { const int kk = 8 * i + (lane >> 3); const float sc = ks ? ks[k0 + kk] : 1.0f; LAS float* d = scr + kk * 33 + 4 * (lane & 7);
        d[0] = w[i].x * sc; d[1] = w[i].y * sc; d[2] = w[i].z * sc; d[3] = w[i].w * sc; }
    LDS_WAIT();
    const int c = lane & 7;
#pragma unroll
    for (int j = 0; j < 4; ++j) { const int n = (lane >> 3) + 8 * j; const LAS float* sp = scr + (8 * c) * 33 + n;
        v4u o; o.x = pk2(sp[0 * 33], sp[1 * 33]); o.y = pk2(sp[2 * 33], sp[3 * 33]); o.z = pk2(sp[4 * 33], sp[5 * 33]); o.w = pk2(sp[6 * 33], sp[7 * 33]);
        *(v4u*)(WT + (size_t)(n0 + n) * K + k0 + 8 * c) = o; }
    LDS_WAIT();
}

__device__ __forceinline__ void phase0(const Args& a, LAS unsigned char* lds) {
    const int tid = otid(), lane = tid & 63, wave = tid >> 6;
    const int gw = blockIdx.x * 8 + wave, NGW = gridDim.x * 8;
    s5_tables(a, lds, tid);
    const float* x = a.in[0]; const float* mem = a.in[1]; const float* norm_g = a.in[2]; const float* w_in = a.in[3];
    const float* w_glu = a.in[12]; const float* mem_norm_g = a.in[16]; const float* w_mem_kv = a.in[17]; const float* w_out = a.in[18];
    bf16_t* XB = (bf16_t*)(a.ws + WS_XB); bf16_t* MEMN = (bf16_t*)(a.ws + WS_MEMN);
    bf16_t* WINT = (bf16_t*)(a.ws + WS_WINT); bf16_t* WKVT = (bf16_t*)(a.ws + WS_WKVT); bf16_t* WOUTT = (bf16_t*)(a.ws + WS_WOUTT); bf16_t* WGLUT = (bf16_t*)(a.ws + WS_WGLUT);
    for (int r2 = gw; r2 < (NTOK + NB * NMEM) / 2; r2 += NGW) { const int r = 2 * r2;
        if (r < NTOK) rms_rows2_to_bf16(x + (size_t)r * DM, x + (size_t)(r + 1) * DM, XB + (size_t)r * DM, XB + (size_t)(r + 1) * DM, nullptr, lane);
        else { const int m = r - NTOK; rms_rows2_to_bf16(mem + (size_t)m * DM, mem + (size_t)(m + 1) * DM, MEMN + (size_t)m * DM, MEMN + (size_t)(m + 1) * DM, mem_norm_g, lane); }
    }
    LAS float* scr = (LAS float*)(lds + wave * 8448);
    constexpr int I_IN = (DM / 64) * (DIN / 32), I_KV = (DM / 64) * (512 / 32), I_OUT = (DM / 64) * (DM / 32), I_GLU = (WSSM / 64) * (WSSM / 32);
    for (int it = gw; it < I_IN + I_KV + I_OUT + I_GLU; it += NGW) {
        int r = it;
        if (r < I_IN) { transpose_item4(w_in, DM, DIN, WINT, norm_g, scr, r, lane); continue; } r -= I_IN;
        if (r < I_KV) { transpose_item4(w_mem_kv, DM, 512, WKVT, nullptr, scr, r, lane); continue; } r -= I_KV;
        if (r < I_OUT) { transpose_item4(w_out, DM, DM, WOUTT, nullptr, scr, r, lane); continue; } r -= I_OUT;
        transpose_item4(w_glu, WSSM, WSSM, WGLUT, nullptr, scr, r, lane);
    }
    const int gt = blockIdx.x * 512 + tid, NT = gridDim.x * 512;
    for (int i = gt; i < 128 * 384 / 2; i += NT) ((unsigned*)(WGLUT + 384 * 384))[i] = 0u;
}

template <class Epi>
__device__ __forceinline__ void gemm_naive(const bf16_t* A, int lda, const bf16_t* Bt, int ldb, int M, int N, int K, LAS unsigned char* lds, int tile0, int ntile_total, const Epi& epi) {
    LAS float* As = (LAS float*)lds;
    LAS float* Bs = As + 32 * 132;
    const int tid = threadIdx.x, ty = tid >> 4, tx = tid & 15;
    const int ntn = N / 64, nt = (M / 128) * ntn;
    (void)ntile_total;
    for (int tile = blockIdx.x - tile0; tile < nt; tile += gridDim.x) {
        if (tile < 0) continue;
        const int tm = tile / ntn, tn = tile % ntn;
        float acc[4][4];
#pragma unroll
        for (int i = 0; i < 4; ++i)
#pragma unroll
            for (int j = 0; j < 4; ++j) acc[i][j] = 0.f;
        for (int k0 = 0; k0 < K; k0 += 32) {
            __syncthreads();
            { const int r = tid >> 2, kc = (tid & 3) * 8; const v4u v = *(const v4u*)(A + (size_t)(tm * 128 + r) * lda + k0 + kc);
              As[(kc + 0) * 132 + r] = bflo(v.x); As[(kc + 1) * 132 + r] = bfhi(v.x); As[(kc + 2) * 132 + r] = bflo(v.y); As[(kc + 3) * 132 + r] = bfhi(v.y);
              As[(kc + 4) * 132 + r] = bflo(v.z); As[(kc + 5) * 132 + r] = bfhi(v.z); As[(kc + 6) * 132 + r] = bflo(v.w); As[(kc + 7) * 132 + r] = bfhi(v.w); }
            if (tid < 256) { const int r = tid >> 2, kc = (tid & 3) * 8; const v4u v = *(const v4u*)(Bt + (size_t)(tn * 64 + r) * ldb + k0 + kc);
              Bs[(kc + 0) * 68 + r] = bflo(v.x); Bs[(kc + 1) * 68 + r] = bfhi(v.x); Bs[(kc + 2) * 68 + r] = bflo(v.y); Bs[(kc + 3) * 68 + r] = bfhi(v.y);
              Bs[(kc + 4) * 68 + r] = bflo(v.z); Bs[(kc + 5) * 68 + r] = bfhi(v.z); Bs[(kc + 6) * 68 + r] = bflo(v.w); Bs[(kc + 7) * 68 + r] = bfhi(v.w); }
            __syncthreads();
#pragma unroll 8
            for (int k = 0; k < 32; ++k) {
                const f32x4 av = *(const LAS f32x4*)(As + k * 132 + ty * 4), bv = *(const LAS f32x4*)(Bs + k * 68 + tx * 4);
#pragma unroll
                for (int i = 0; i < 4; ++i)
#pragma unroll
                    for (int j = 0; j < 4; ++j) acc[i][j] += av[i] * bv[j];
            }
        }
#pragma unroll
        for (int i = 0; i < 4; ++i)
#pragma unroll
            for (int j = 0; j < 4; ++j) epi(tm * 128 + ty * 4 + i, tn * 64 + tx * 4 + j, acc[i][j]);
    }
}

struct EpiStoreBf16 { bf16_t* O; int ldo; __device__ __forceinline__ void operator()(int r, int c, float v) const { O[(size_t)r * ldo + c] = (bf16_t)f2bf(v); } };
struct EpiGlu { const bf16_t* GB; const bf16_t* PROJ; const float* b_glu; bf16_t* YCAT;
    __device__ __forceinline__ void operator()(int r, int c, float v) const {
        const float g = bf2f(GB[(size_t)r * WSSM + c]); const float gate = bf2f(PROJ[(size_t)r * DIN + C_AGATE + c]);
        YCAT[(size_t)r * DM + c] = (bf16_t)f2bf(g * sigmoid_f(v + b_glu[c]) * silu_f(gate)); } };
struct EpiOut { const float* x; float* out; __device__ __forceinline__ void operator()(int r, int c, float v) const { out[(size_t)r * DM + c] = x[(size_t)r * DM + c] + v; } };


namespace pg8 {
typedef short bf16x8 __attribute__((ext_vector_type(8)));
typedef unsigned u32x4 __attribute__((ext_vector_type(4)));
constexpr int BM = 256, BK = 64, HALF = 128, HTB = HALF * BK * 2, STAGE_BYTES = 8 * HTB, NXCD = 8, WGM = 8;
__host__ __device__ __forceinline__ int lds_byte(int r, int c) { const int st = (r >> 4) * 2 + (c >> 5), rr = r & 15, cc = c & 31, ob = rr * 64 + cc * 2; return st * 1024 + (ob ^ (((ob >> 9) & 1) << 5)); }
__host__ __device__ __forceinline__ void stage_rc(int b, int& R, int& C) { const int st = b / 1024, sb = b % 1024, swz = sb ^ (((sb >> 9) & 1) << 5); R = (st >> 1) * 16 + swz / 64; C = (st & 1) * 32 + (swz % 64) / 2; }
__host__ __device__ __forceinline__ int perm32(int rho) { const int n = rho >> 4, i = rho & 15; return 8 * (i >> 2) + 4 * n + (i & 3); }
struct Unit { int pm, pn, z; };
struct Gemm { const bf16_t* A; const bf16_t* Bt; int lda, ldb, K; size_t sAz, sBz; };
struct Order {
    int nM, nN, per, total, G, c;
    __device__ void init(int nM_, int nN_, int nZ_, int G_, int c_) { nM = nM_; nN = nN_; per = nM_ * nN_; total = per * nZ_; G = G_; c = c_; }
    __device__ bool next(int i, Unit& u) const {
        const long L = (long)i * G + c; if (L >= total) return false;
        u.z = (int)(L / per); int wgid = (int)(L % per); const int nwg = per;
        { const int q = nwg / NXCD, r = nwg % NXCD, xcd = wgid % NXCD, off = wgid / NXCD; wgid = (xcd < r ? xcd * (q + 1) : r * (q + 1) + (xcd - r) * q) + off; }
        const int nig = WGM * nN, gid = wgid / nig, fm = gid * WGM, gsz = (nM - fm) < WGM ? (nM - fm) : WGM;
        u.pm = fm + ((wgid % nig) % gsz); u.pn = (wgid % nig) / gsz; return true;
    }
};
__device__ __forceinline__ unsigned cvt_pk_bf16(float lo, float hi) { unsigned r; asm volatile("v_cvt_pk_bf16_f32 %0, %1, %2" : "=v"(r) : "v"(lo), "v"(hi)); return r; }

template <class Epi>
__device__ __forceinline__ void gemm_phase(LAS unsigned char* lds, const Gemm g, const Order& S, const Epi& E) {
    int tid = threadIdx.x; asm volatile("" : "+v"(tid));
    const int wid = __builtin_amdgcn_readfirstlane(tid >> 6), lane = tid & 63, wr = wid >> 2, wc = wid & 3, fr = lane & 15, fq = lane >> 4;
    int K = g.K; asm volatile("" : "+s"(K));
    const int nt = K / BK;
    unsigned voffA[2], voffB[2];
#pragma unroll
    for (int i = 0; i < 2; ++i) { int R, C; stage_rc(tid * 16 + i * 8192, R, C); const int Rb = Epi::PERM ? ((R & ~31) + perm32(R & 31)) : R;
        voffA[i] = (unsigned)(R * g.lda + C) * 2u; voffB[i] = (unsigned)(Rb * g.ldb + C) * 2u; }
    const size_t kstep = (size_t)(BK * 2);
    const size_t hstepA = (size_t)HALF * g.lda * 2, hstepB = (size_t)HALF * g.ldb * 2;
    const size_t tstepA = 2 * hstepA, tstepB = 2 * hstepB;
    const unsigned ldsw = (unsigned)wid * 1024u;
    const int aoff = lds_byte(wr * 64 + fr, fq * 8), boff = lds_byte(wc * 32 + fr, fq * 8);
#define PG8_SA(b, h) (((b) * 2 + (h)) * HTB)
#define PG8_SB(b, h) ((4 + (b) * 2 + (h)) * HTB)
#define PG8_STAGE(bufoff, gbase, voff) do { _Pragma("unroll") for (int _i = 0; _i < 2; ++_i) \
        __builtin_amdgcn_global_load_lds((const unsigned*)((const char*)(gbase) + (voff)[_i]), (LAS unsigned*)(lds + (bufoff) + ldsw + _i * 8192), 16, 0, 0); } while (0)
#define PG8_LDA(dst, b, h) do { _Pragma("unroll") for (int m = 0; m < 4; ++m) _Pragma("unroll") for (int k = 0; k < 2; ++k) dst[m][k] = *(const LAS bf16x8*)(lds + PG8_SA(b, h) + aoff + m * 2048 + k * 1024); } while (0)
#define PG8_LDB(dst, b, h) do { _Pragma("unroll") for (int n = 0; n < 2; ++n) _Pragma("unroll") for (int k = 0; k < 2; ++k) dst[n][k] = *(const LAS bf16x8*)(lds + PG8_SB(b, h) + boff + n * 2048 + k * 1024); } while (0)
#define PG8_MMA(ai, bj, At, Bt) do { __builtin_amdgcn_s_setprio(1); _Pragma("unroll") for (int m = 0; m < 4; ++m) _Pragma("unroll") for (int n = 0; n < 2; ++n) _Pragma("unroll") for (int k = 0; k < 2; ++k) \
        acc[ai][bj][m][n] = __builtin_amdgcn_mfma_f32_16x16x32_bf16(Bt[n][k], At[m][k], acc[ai][bj][m][n], 0, 0, 0); __builtin_amdgcn_s_setprio(0); } while (0)
#define PG8_WAIT_V(n) asm volatile("s_waitcnt vmcnt(" #n ")" ::: "memory")
#define PG8_WAIT_L(n) asm volatile("s_waitcnt lgkmcnt(" #n ")" ::: "memory")
#define PG8_BAR __builtin_amdgcn_s_barrier()
#define PG8_SCHED __builtin_amdgcn_sched_barrier(0)
    Unit cur, nxt; int ui = 0;
    if (!S.next(0, cur)) return;
    f32x4 acc[2][2][4][2];
#pragma unroll
    for (int a = 0; a < 2; ++a)
#pragma unroll
        for (int b = 0; b < 2; ++b)
#pragma unroll
            for (int m = 0; m < 4; ++m)
#pragma unroll
                for (int n = 0; n < 2; ++n) acc[a][b][m][n] = (f32x4){0.f, 0.f, 0.f, 0.f};
    bf16x8 At[4][2], B0[2][2], B1[2][2];
    const char* cA = (const char*)(g.A + (size_t)cur.z * g.sAz) + (size_t)cur.pm * tstepA; const char* cB = (const char*)(g.Bt + (size_t)cur.z * g.sBz) + (size_t)cur.pn * tstepB;
    PG8_STAGE(PG8_SB(0, 0), cB, voffB); PG8_STAGE(PG8_SA(0, 0), cA, voffA); PG8_STAGE(PG8_SB(0, 1), cB + hstepB, voffB); PG8_STAGE(PG8_SA(0, 1), cA + hstepA, voffA);
    if (wr == 1) PG8_BAR;
    PG8_WAIT_V(4); PG8_BAR;
    PG8_STAGE(PG8_SB(1, 0), cB + kstep, voffB); PG8_STAGE(PG8_SA(1, 0), cA + kstep, voffA); PG8_STAGE(PG8_SB(1, 1), cB + hstepB + kstep, voffB);
    PG8_WAIT_V(6); PG8_BAR;
    for (;;) {
        const bool has_next = S.next(ui + 1, nxt);
        const char* nA = has_next ? (const char*)(g.A + (size_t)nxt.z * g.sAz) + (size_t)nxt.pm * tstepA : cA; const char* nB = has_next ? (const char*)(g.Bt + (size_t)nxt.z * g.sBz) + (size_t)nxt.pn * tstepB : cB;
        for (int t = 0; t < nt; t += 2) {
            const bool last = (t == nt - 2);
            const char* a1 = cA + (size_t)(t + 1) * kstep;
            const char* a2 = last ? nA : cA + (size_t)(t + 2) * kstep; const char* b2 = last ? nB : cB + (size_t)(t + 2) * kstep;
            const char* a3 = a2 + kstep; const char* b3 = b2 + kstep;
            PG8_LDB(B0, 0, 0); PG8_SCHED; PG8_LDA(At, 0, 0); PG8_STAGE(PG8_SA(1, 1), a1 + hstepA, voffA);
            PG8_WAIT_L(8); PG8_BAR; PG8_WAIT_L(0); PG8_MMA(0, 0, At, B0); PG8_BAR; PG8_SCHED;
            PG8_LDB(B1, 0, 1); PG8_STAGE(PG8_SB(0, 0), b2, voffB);
            PG8_BAR; PG8_WAIT_L(0); PG8_MMA(0, 1, At, B1); PG8_BAR;
            PG8_LDA(At, 0, 1); PG8_STAGE(PG8_SA(0, 0), a2, voffA);
            PG8_BAR; PG8_WAIT_L(0); PG8_MMA(1, 0, At, B0); PG8_BAR; PG8_SCHED;
            PG8_STAGE(PG8_SB(0, 1), b2 + hstepB, voffB);
            PG8_WAIT_V(6); PG8_BAR; PG8_MMA(1, 1, At, B1); PG8_BAR;
            PG8_LDB(B0, 1, 0); PG8_SCHED; PG8_LDA(At, 1, 0); PG8_STAGE(PG8_SA(0, 1), a2 + hstepA, voffA);
            PG8_WAIT_L(8); PG8_BAR; PG8_WAIT_L(0); PG8_MMA(0, 0, At, B0); PG8_BAR; PG8_SCHED;
            PG8_LDB(B1, 1, 1); PG8_STAGE(PG8_SB(1, 0), b3, voffB);
            PG8_BAR; PG8_WAIT_L(0); PG8_MMA(0, 1, At, B1); PG8_BAR;
            PG8_LDA(At, 1, 1); PG8_STAGE(PG8_SA(1, 0), a3, voffA);
            PG8_BAR; PG8_WAIT_L(0); PG8_MMA(1, 0, At, B0); PG8_BAR; PG8_SCHED;
            PG8_STAGE(PG8_SB(1, 1), b3 + hstepB, voffB);
            PG8_WAIT_V(6); PG8_BAR; PG8_MMA(1, 1, At, B1); PG8_BAR;
        }
        if constexpr (!Epi::AFTER_DRAIN) { E(acc, cur, wr, wc, fr, fq); }
        if (!has_next) break;
#pragma unroll
        for (int a = 0; a < 2; ++a)
#pragma unroll
            for (int b = 0; b < 2; ++b)
#pragma unroll
                for (int m = 0; m < 4; ++m)
#pragma unroll
                    for (int n = 0; n < 2; ++n) acc[a][b][m][n] = (f32x4){0.f, 0.f, 0.f, 0.f};
        cur = nxt; cA = nA; cB = nB; ++ui;
    }
    PG8_WAIT_V(0);
    if (wr == 0) PG8_BAR;
    PG8_BAR;
    if constexpr (Epi::AFTER_DRAIN) { E.fused(acc, cur, wr, wc, fr, fq, lds, wid, lane); }
#undef PG8_SA
#undef PG8_SB
#undef PG8_STAGE
#undef PG8_LDA
#undef PG8_LDB
#undef PG8_MMA
#undef PG8_WAIT_V
#undef PG8_WAIT_L
#undef PG8_BAR
#undef PG8_SCHED
}

struct EpiBf16Store {
    static constexpr bool PERM = true, AFTER_DRAIN = false;
    bf16_t* O; int ldc;
    __device__ __forceinline__ void operator()(const f32x4 (&acc)[2][2][4][2], const Unit& u, int wr, int wc, int fr, int fq) const {
        const int row0 = u.pm * BM + wr * 64 + fr, col0 = u.pn * BM + wc * 32 + 8 * fq;
#pragma unroll
        for (int ai = 0; ai < 2; ++ai)
#pragma unroll
            for (int m = 0; m < 4; ++m) { bf16_t* rowp = O + (size_t)(row0 + ai * HALF + m * 16) * ldc + col0;
#pragma unroll
                for (int bj = 0; bj < 2; ++bj) { const f32x4 v0 = acc[ai][bj][m][0], v1 = acc[ai][bj][m][1];
                    u32x4 w; w.x = cvt_pk_bf16(v0[0], v0[1]); w.y = cvt_pk_bf16(v0[2], v0[3]); w.z = cvt_pk_bf16(v1[0], v1[1]); w.w = cvt_pk_bf16(v1[2], v1[3]);
                    *(u32x4*)(rowp + bj * HALF) = w; } }
    }
};

struct EpiProjAY {
    static constexpr bool PERM = true, AFTER_DRAIN = false;
    bf16_t* PROJ; bf16_t* AY;
    __device__ __forceinline__ void operator()(const f32x4 (&acc)[2][2][4][2], const Unit& u, int wr, int wc, int fr, int fq) const {
        const int rowb = u.pm * BM + wr * 64, col0 = u.pn * BM + wc * 32 + 8 * fq;
#pragma unroll
        for (int bj = 0; bj < 2; ++bj) { const int col = col0 + bj * HALF; const bool ay = col < WSSM;
#pragma unroll
            for (int ai = 0; ai < 2; ++ai)
#pragma unroll
                for (int m = 0; m < 4; ++m) { const int rb = rowb + ai * HALF + m * 16;
                    bf16_t* dst = ay ? AY + ((size_t)((col >> 4) * 1024 + (rb >> 4)) * 512 + fr * 16 + (col & 15)) : PROJ + (size_t)(rb + fr) * DIN + col;
                    const f32x4 v0 = acc[ai][bj][m][0], v1 = acc[ai][bj][m][1];
                    u32x4 w; w.x = cvt_pk_bf16(v0[0], v0[1]); w.y = cvt_pk_bf16(v0[2], v0[3]); w.z = cvt_pk_bf16(v1[0], v1[1]); w.w = cvt_pk_bf16(v1[2], v1[3]);
                    *(u32x4*)dst = w; } }
    }
};
struct EpiSend {
    static constexpr bool PERM = false, AFTER_DRAIN = true;
    bf16_t* AY; const float* LAMT; const float* LAM512;
    __device__ __forceinline__ void fused(const f32x4 (&acc)[2][2][4][2], const Unit& u, int wr, int wc, int fr, int fq, LAS unsigned char* lds, int wid, int lane) const {
        LAS float* S = (LAS float*)lds;
        LAS float* E = (LAS float*)(lds + 131072);
#pragma unroll
        for (int ai = 0; ai < 2; ++ai)
#pragma unroll
            for (int m = 0; m < 4; ++m)
#pragma unroll
                for (int n = 0; n < 2; ++n) { const int r = ai * HALF + wr * 64 + m * 16 + fr, c = wc * 32 + n * 16 + 4 * fq; *(LAS f32x4*)(S + r * 128 + c) = acc[ai][0][m][n]; }
        __syncthreads();
        const int g = u.z, b = u.pm, p = lane, seg = wid;
        const float tr = LAMT[(g * NP + p) * 2], ti = LAMT[(g * NP + p) * 2 + 1], hr = LAM512[(g * NP + p) * 2], hi = LAM512[(g * NP + p) * 2 + 1];
        float sr = 0.f, si = 0.f;
        for (int i = 0; i < 32; ++i) { const int row = seg * 32 + i; const float xr = S[row * 128 + p], xi = S[row * 128 + 64 + p];
            const float nr = tr * sr - ti * si + xr, ni = tr * si + ti * sr + xi; sr = nr; si = ni; }
        E[seg * 128 + p] = sr; E[seg * 128 + 64 + p] = si;
        __syncthreads();
        sr = 0.f; si = 0.f;
        for (int s2 = 0; s2 < seg; ++s2) { const float xr = E[s2 * 128 + p], xi = E[s2 * 128 + 64 + p]; const float nr = hr * sr - hi * si + xr, ni = hr * si + hi * sr + xi; sr = nr; si = ni; }
        bf16_t* base = AY + ((size_t)(g * 1024 + b * 256 + seg * 32)) * 512 + 256 + p;
        for (int i = 0; i < 32; ++i) { const int row = seg * 32 + i;
            bf16_t* o = base + (size_t)i * 512;
            o[0] = (bf16_t)f2bf(sr); o[64] = (bf16_t)f2bf(si);
            const float xr = S[row * 128 + p], xi = S[row * 128 + 64 + p];
            const float nr = tr * sr - ti * si + xr, ni = tr * si + ti * sr + xi; sr = nr; si = ni; }
    }
};
struct EpiY {
    static constexpr bool PERM = true, AFTER_DRAIN = false;
    const bf16_t* AY; const float* ssm_d; bf16_t* GB;
    __device__ __forceinline__ void operator()(const f32x4 (&acc)[2][2][4][2], const Unit& u, int wr, int wc, int fr, int fq) const {
        const int g = u.z, b = u.pm;
#pragma unroll
        for (int bj = 0; bj < 2; ++bj) { const int col = bj * HALF + wc * 32 + 8 * fq, t = col >> 4, h0 = col & 15;
            const f32x4 d0 = *(const f32x4*)(ssm_d + g * GH + h0), d1 = *(const f32x4*)(ssm_d + g * GH + h0 + 4);
            u32x4 u8[2][4];
#pragma unroll
            for (int ai = 0; ai < 2; ++ai)
#pragma unroll
                for (int m = 0; m < 4; ++m) { const int crow = ai * HALF + wr * 64 + m * 16 + fr; u8[ai][m] = *(const u32x4*)(AY + ((size_t)(g * 1024 + b * 256 + crow)) * 512 + col); }
#pragma unroll
            for (int ai = 0; ai < 2; ++ai)
#pragma unroll
                for (int m = 0; m < 4; ++m) { const int crow = ai * HALF + wr * 64 + m * 16 + fr;
                    const u32x4 uu = u8[ai][m]; const f32x4 v0 = acc[ai][bj][m][0], v1 = acc[ai][bj][m][1];
                    u32x4 w;
                    w.x = cvt_pk_bf16(gelu_tanh(v0[0] + d0[0] * bflo(uu.x)), gelu_tanh(v0[1] + d0[1] * bfhi(uu.x)));
                    w.y = cvt_pk_bf16(gelu_tanh(v0[2] + d0[2] * bflo(uu.y)), gelu_tanh(v0[3] + d0[3] * bfhi(uu.y)));
                    w.z = cvt_pk_bf16(gelu_tanh(v1[0] + d1[0] * bflo(uu.z)), gelu_tanh(v1[1] + d1[1] * bfhi(uu.z)));
                    w.w = cvt_pk_bf16(gelu_tanh(v1[2] + d1[2] * bflo(uu.w)), gelu_tanh(v1[3] + d1[3] * bfhi(uu.w)));
                    *(u32x4*)(GB + ((size_t)(b * SEQ + crow * 16 + t)) * WSSM + g * GH + h0) = w; }
            asm volatile("" ::: "memory"); }
    }
};
struct EpiGluP {
    static constexpr bool PERM = true, AFTER_DRAIN = false;
    const bf16_t* GB; const bf16_t* PROJ; const float* b_glu; bf16_t* YCAT;
    __device__ __forceinline__ void operator()(const f32x4 (&acc)[2][2][4][2], const Unit& u, int wr, int wc, int fr, int fq) const {
        const int row0 = u.pm * BM + wr * 64 + fr, col0 = u.pn * BM + wc * 32 + 8 * fq;
#pragma unroll
        for (int bj = 0; bj < 2; ++bj) { const int col = col0 + bj * HALF; if (col >= WSSM) continue;
            const f32x4 b0 = *(const f32x4*)(b_glu + col), b1 = *(const f32x4*)(b_glu + col + 4);
#pragma unroll
            for (int ai = 0; ai < 2; ++ai) {
                u32x4 g8[4], a8[4];
#pragma unroll
                for (int m = 0; m < 4; ++m) { const size_t row = (size_t)(row0 + ai * HALF + m * 16); g8[m] = *(const u32x4*)(GB + row * WSSM + col); a8[m] = *(const u32x4*)(PROJ + row * DIN + C_AGATE + col); }
#pragma unroll
                for (int m = 0; m < 4; ++m) { const size_t row = (size_t)(row0 + ai * HALF + m * 16);
                    const f32x4 v0 = acc[ai][bj][m][0] + b0, v1 = acc[ai][bj][m][1] + b1;
                    u32x4 w;
                    w.x = cvt_pk_bf16(bflo(g8[m].x) * sigmoid_f(v0[0]) * silu_f(bflo(a8[m].x)), bfhi(g8[m].x) * sigmoid_f(v0[1]) * silu_f(bfhi(a8[m].x)));
                    w.y = cvt_pk_bf16(bflo(g8[m].y) * sigmoid_f(v0[2]) * silu_f(bflo(a8[m].y)), bfhi(g8[m].y) * sigmoid_f(v0[3]) * silu_f(bfhi(a8[m].y)));
                    w.z = cvt_pk_bf16(bflo(g8[m].z) * sigmoid_f(v1[0]) * silu_f(bflo(a8[m].z)), bfhi(g8[m].z) * sigmoid_f(v1[1]) * silu_f(bfhi(a8[m].z)));
                    w.w = cvt_pk_bf16(bflo(g8[m].w) * sigmoid_f(v1[2]) * silu_f(bflo(a8[m].w)), bfhi(g8[m].w) * sigmoid_f(v1[3]) * silu_f(bfhi(a8[m].w)));
                    *(u32x4*)(YCAT + row * DM + col) = w; }
                asm volatile("" ::: "memory"); } }
    }
};
struct EpiResF32 {
    static constexpr bool PERM = false, AFTER_DRAIN = false;
    const float* x; float* out;
    __device__ __forceinline__ void operator()(const f32x4 (&acc)[2][2][4][2], const Unit& u, int wr, int wc, int fr, int fq) const {
        const int row0 = u.pm * BM + wr * 64 + fr, col0 = u.pn * BM + wc * 32 + 4 * fq;
#pragma unroll
        for (int ai = 0; ai < 2; ++ai)
#pragma unroll
            for (int m = 0; m < 4; ++m) { const size_t off = (size_t)(row0 + ai * HALF + m * 16) * DM + col0;
#pragma unroll
                for (int bj = 0; bj < 2; ++bj)
#pragma unroll
                    for (int n = 0; n < 2; ++n) { const f32x4 xv = *(const f32x4*)(x + off + bj * HALF + n * 16); *(f32x4*)(out + off + bj * HALF + n * 16) = xv + acc[ai][bj][m][n]; }
                asm volatile("" ::: "memory"); }
    }
};

struct EpiOutNorm {
    static constexpr bool PERM = false, AFTER_DRAIN = true;
    const float* x; const float* fg; float* out; float* xch; unsigned* cnt;
    __device__ __forceinline__ void fused(f32x4 (&acc)[2][2][4][2], const Unit& u, int wr, int wc, int fr, int fq, LAS unsigned char* lds, int wid, int lane) const {
        LAS float* P = (LAS float*)lds;
        LAS float* S = (LAS float*)(lds + 8192);
        const int row0 = u.pm * BM + wr * 64 + fr, col0 = u.pn * BM + wc * 32 + 4 * fq;
#pragma unroll
        for (int ai = 0; ai < 2; ++ai) {
            f32x4 xv[4][2][2];
#pragma unroll
            for (int m = 0; m < 4; ++m) { const size_t off = (size_t)(row0 + ai * HALF + m * 16) * DM + col0;
#pragma unroll
                for (int bj = 0; bj < 2; ++bj)
#pragma unroll
                    for (int n = 0; n < 2; ++n) xv[m][bj][n] = *(const f32x4*)(x + off + bj * HALF + n * 16); }
#pragma unroll
            for (int m = 0; m < 4; ++m) { float sq = 0.f;
#pragma unroll
                for (int bj = 0; bj < 2; ++bj)
#pragma unroll
                    for (int n = 0; n < 2; ++n) { const f32x4 hv = acc[ai][bj][m][n] + xv[m][bj][n]; acc[ai][bj][m][n] = hv; sq += (hv[0] * hv[0] + hv[1] * hv[1]) + (hv[2] * hv[2] + hv[3] * hv[3]); }
                sq += __shfl_xor(sq, 16); sq += __shfl_xor(sq, 32);
                if (fq == 0) P[(ai * HALF + wr * 64 + m * 16 + fr) * 4 + wc] = sq; }
            asm volatile("" ::: "memory"); }
        asm volatile("s_waitcnt lgkmcnt(0)" ::: "memory"); __builtin_amdgcn_s_barrier(); asm volatile("" ::: "memory");
        const int row = wid * 32 + (lane & 31);
        if (lane < 32) { const f32x4 pv = *(const LAS f32x4*)(P + row * 4); const float t = (pv[0] + pv[1]) + (pv[2] + pv[3]);
            __hip_atomic_store(xch + ((size_t)(u.pm * BM + row) * 4 + u.pn), t, __ATOMIC_RELAXED, __HIP_MEMORY_SCOPE_AGENT); }
        asm volatile("s_waitcnt vmcnt(0)" ::: "memory");
        if (lane == 0) __hip_atomic_fetch_add(cnt + 64 * u.pm, 1u, __ATOMIC_RELAXED, __HIP_MEMORY_SCOPE_AGENT);
        if (wid == 0) { unsigned sp = 0;
            while ((unsigned)__builtin_amdgcn_readfirstlane(__hip_atomic_load(cnt + 64 * u.pm, __ATOMIC_RELAXED, __HIP_MEMORY_SCOPE_AGENT)) < 32u) { __builtin_amdgcn_s_sleep(2); if (++sp > (1u << 22)) break; }
            __builtin_amdgcn_fence(__ATOMIC_ACQUIRE, "agent"); }
        asm volatile("s_waitcnt vmcnt(0) lgkmcnt(0)" ::: "memory"); __builtin_amdgcn_s_barrier(); asm volatile("" ::: "memory");
        if (lane < 32) { const float* slot = xch + (size_t)(u.pm * BM + row) * 4; float t = 0.f;
#pragma unroll
            for (int q = 0; q < 4; ++q) t += __hip_atomic_load(slot + q, __ATOMIC_RELAXED, __HIP_MEMORY_SCOPE_AGENT);
            S[row] = 1.0f / sqrtf(t * (1.0f / DM) + NORM_EPS); }
        asm volatile("s_waitcnt lgkmcnt(0)" ::: "memory"); __builtin_amdgcn_s_barrier(); asm volatile("" ::: "memory");
        f32x4 gv[2][2];
#pragma unroll
        for (int bj = 0; bj < 2; ++bj)
#pragma unroll
            for (int n = 0; n < 2; ++n) gv[bj][n] = *(const f32x4*)(fg + col0 + bj * HALF + n * 16);
#pragma unroll
        for (int ai = 0; ai < 2; ++ai)
#pragma unroll
            for (int m = 0; m < 4; ++m) { const int r = ai * HALF + wr * 64 + m * 16 + fr; const float rs = S[r]; const size_t off = (size_t)(u.pm * BM + r) * DM + col0;
#pragma unroll
                for (int bj = 0; bj < 2; ++bj)
#pragma unroll
                    for (int n = 0; n < 2; ++n) *(f32x4*)(out + off + bj * HALF + n * 16) = acc[ai][bj][m][n] * rs * gv[bj][n]; }
    }
};
}

__device__ __forceinline__ void s5_naive(const Args& a, int b, int g, int lane) {
    const bf16_t* PROJ = (const bf16_t*)(a.ws + WS_PROJ); bf16_t* GB = (bf16_t*)(a.ws + WS_GB);
    const float* LAMB = (const float*)(a.ws + WS_LAMB); const float* BBAR = (const float*)(a.ws + WS_BBAR);
    const float* c_re = a.in[8]; const float* c_im = a.in[9]; const float* ssm_d = a.in[10];
    const int p = lane, h = lane & 15, pg = lane >> 4;
    const float lr = LAMB[(g * NP + p) * 2], li = LAMB[(g * NP + p) * 2 + 1];
    float bre[16], bim[16], cre[16], cim[16];
#pragma unroll
    for (int j = 0; j < 16; ++j) { bre[j] = BBAR[((g * NP + p) * GH + j) * 2]; bim[j] = BBAR[((g * NP + p) * GH + j) * 2 + 1];
        cre[j] = c_re[(g * GH + h) * NP + pg * 16 + j]; cim[j] = c_im[(g * GH + h) * NP + pg * 16 + j]; }
    const float dd = ssm_d[g * GH + h];
    float sr = 0.f, si = 0.f;
    for (int t = 0; t < SEQ; ++t) {
        const bf16_t* up = PROJ + (size_t)(b * SEQ + t) * DIN + C_AIN + g * GH;
        const v4u u0 = *(const v4u*)up, u1 = *(const v4u*)(up + 8);
        float u[16];
        u[0] = bflo(u0.x); u[1] = bfhi(u0.x); u[2] = bflo(u0.y); u[3] = bfhi(u0.y); u[4] = bflo(u0.z); u[5] = bfhi(u0.z); u[6] = bflo(u0.w); u[7] = bfhi(u0.w);
        u[8] = bflo(u1.x); u[9] = bfhi(u1.x); u[10] = bflo(u1.y); u[11] = bfhi(u1.y); u[12] = bflo(u1.z); u[13] = bfhi(u1.z); u[14] = bflo(u1.w); u[15] = bfhi(u1.w);
        const float uh = bf2f(up[h]);
        float bur = 0.f, bui = 0.f;
#pragma unroll
        for (int j = 0; j < 16; ++j) { bur += bre[j] * u[j]; bui += bim[j] * u[j]; }
        const float nsr = lr * sr - li * si + bur, nsi = lr * si + li * sr + bui;
        sr = nsr; si = nsi;
        float part = 0.f;
#pragma unroll
        for (int j = 0; j < 16; ++j) { const float xr = __shfl(sr, pg * 16 + j), xi = __shfl(si, pg * 16 + j); part += cre[j] * xr - cim[j] * xi; }
        part += __shfl_xor(part, 16); part += __shfl_xor(part, 32);
        const float y = part + dd * uh;
        if (lane < 16) GB[(size_t)(b * SEQ + t) * WSSM + g * GH + h] = (bf16_t)f2bf(gelu_tanh(y));
    }
}

__device__ __forceinline__ void conv_naive(const Args& a, int vb, int nvb) {
    const bf16_t* PROJ = (const bf16_t*)(a.ws + WS_PROJ); bf16_t* YCAT = (bf16_t*)(a.ws + WS_YCAT);
    const float* conv_w = a.in[14]; const float* conv_b = a.in[15];
    const int gt = vb * 512 + otid(), NT = nvb * 512;
    for (int idx = gt; idx < NTOK * WSSM; idx += NT) {
        const int tok = idx / WSSM, c = idx % WSSM, t = tok % SEQ;
        const bf16_t* row = PROJ + (size_t)tok * DIN;
        float acc = conv_b[c];
#pragma unroll
        for (int k = 0; k < 3; ++k) { const int tt = t - 2 + k; if (tt >= 0) { const bf16_t* r2 = PROJ + (size_t)(tok - 2 + k) * DIN; acc += conv_w[k * WSSM + c] * (bf2f(r2[C_CC + c]) * bf2f(r2[C_CIN + c])); } }
        const float y = bf2f(row[C_CB + c]) * acc * silu_f(bf2f(row[C_CGATE + c]));
        YCAT[(size_t)tok * DM + WSSM + c] = (bf16_t)f2bf(y);
    }
}
__device__ __forceinline__ void attn_naive(const Args& a, int vb, int nvb) {
    const bf16_t* PROJ = (const bf16_t*)(a.ws + WS_PROJ); bf16_t* YCAT = (bf16_t*)(a.ws + WS_YCAT); const bf16_t* KV = (const bf16_t*)(a.ws + WS_KV);
    const int gt = vb * 512 + otid(), NT = nvb * 512;
    for (int item = gt; item < NB * 4 * SEQ; item += NT) {
        const int t = item % SEQ, hh = (item / SEQ) % 4, b = item / (4 * SEQ), tok = b * SEQ + t;
        const v4u* qp = (const v4u*)(PROJ + (size_t)tok * DIN + C_Q + hh * 64);
        float q[64], o[64];
#pragma unroll
        for (int i = 0; i < 8; ++i) { const v4u v = qp[i]; q[8 * i] = bflo(v.x); q[8 * i + 1] = bfhi(v.x); q[8 * i + 2] = bflo(v.y); q[8 * i + 3] = bfhi(v.y); q[8 * i + 4] = bflo(v.z); q[8 * i + 5] = bfhi(v.z); q[8 * i + 6] = bflo(v.w); q[8 * i + 7] = bfhi(v.w); }
#pragma unroll
        for (int d = 0; d < 64; ++d) o[d] = 0.f;
        float m = -1e30f, l = 0.f;
        for (int mm = 0; mm < NMEM; ++mm) {
            const v4u* kp = (const v4u*)(KV + (size_t)(b * NMEM + mm) * 512 + hh * 64);
            const v4u* vp = (const v4u*)(KV + (size_t)(b * NMEM + mm) * 512 + 256 + hh * 64);
            float s = 0.f;
#pragma unroll
            for (int i = 0; i < 8; ++i) { const v4u v = kp[i];
                s += q[8 * i] * bflo(v.x) + q[8 * i + 1] * bfhi(v.x) + q[8 * i + 2] * bflo(v.y) + q[8 * i + 3] * bfhi(v.y) + q[8 * i + 4] * bflo(v.z) + q[8 * i + 5] * bfhi(v.z) + q[8 * i + 6] * bflo(v.w) + q[8 * i + 7] * bfhi(v.w); }
            s *= 0.125f;
            const float mn = fmaxf(m, s), sc = __expf(m - mn), pp = __expf(s - mn);
            l = l * sc + pp; m = mn;
#pragma unroll
            for (int i = 0; i < 8; ++i) { const v4u v = vp[i];
                o[8 * i] = o[8 * i] * sc + pp * bflo(v.x); o[8 * i + 1] = o[8 * i + 1] * sc + pp * bfhi(v.x); o[8 * i + 2] = o[8 * i + 2] * sc + pp * bflo(v.y); o[8 * i + 3] = o[8 * i + 3] * sc + pp * bfhi(v.y);
                o[8 * i + 4] = o[8 * i + 4] * sc + pp * bflo(v.z); o[8 * i + 5] = o[8 * i + 5] * sc + pp * bfhi(v.z); o[8 * i + 6] = o[8 * i + 6] * sc + pp * bflo(v.w); o[8 * i + 7] = o[8 * i + 7] * sc + pp * bfhi(v.w); }
        }
        const float inv = 1.0f / l;
        const v4u* gp = (const v4u*)(PROJ + (size_t)tok * DIN + C_QGATE + hh * 64);
        v4u* op = (v4u*)(YCAT + (size_t)tok * DM + 768 + hh * 64);
#pragma unroll
        for (int i = 0; i < 8; ++i) { const v4u gv = gp[i]; v4u w;
            w.x = pk2(o[8 * i] * inv * silu_f(bflo(gv.x)), o[8 * i + 1] * inv * silu_f(bfhi(gv.x)));
            w.y = pk2(o[8 * i + 2] * inv * silu_f(bflo(gv.y)), o[8 * i + 3] * inv * silu_f(bfhi(gv.y)));
            w.z = pk2(o[8 * i + 4] * inv * silu_f(bflo(gv.z)), o[8 * i + 5] * inv * silu_f(bfhi(gv.z)));
            w.w = pk2(o[8 * i + 6] * inv * silu_f(bflo(gv.w)), o[8 * i + 7] * inv * silu_f(bfhi(gv.w)));
            op[i] = w; }
    }
}

typedef short bf16x8_t __attribute__((ext_vector_type(8)));
typedef short s16x4_t __attribute__((ext_vector_type(4)));
typedef float f32x16 __attribute__((ext_vector_type(16)));
typedef __bf16 bf2_t __attribute__((ext_vector_type(2)));
typedef float f2_t __attribute__((ext_vector_type(2)));
typedef unsigned u32x2_t __attribute__((ext_vector_type(2)));
__device__ __forceinline__ unsigned cvt2(float lo, float hi) { const f2_t v = {lo, hi}; return __builtin_bit_cast(unsigned, __builtin_convertvector(v, bf2_t)); }
__device__ __forceinline__ void attn_mfma(const Args& a, LAS unsigned char* lds, int vb, int nvb) {
    const int nj = nvb / 16; if (nj < 1 || vb >= nj * 16) return;
    const int tid = otid(), lane = tid & 63, wave = tid >> 6, r = lane & 31, h = lane >> 5;
    const int bh = vb % 16, j = vb / 16, b = bh >> 2, head = bh & 3;
    const bf16_t* PROJ = (const bf16_t*)(a.ws + WS_PROJ); bf16_t* YCAT = (bf16_t*)(a.ws + WS_YCAT); const bf16_t* KV = (const bf16_t*)(a.ws + WS_KV);
    LAS unsigned char* Kl = lds;
    LAS unsigned char* Vl = lds + 36864;
    for (int c = tid; c < 2048; c += 512) { const int key = c >> 3, dch = c & 7;
        const bf16_t* src = KV + (size_t)(b * NMEM + key) * 512 + head * 64 + dch * 8;
        const v4u kv = *(const v4u*)src, vv = *(const v4u*)(src + 256);
        *(LAS v4u*)(Kl + key * 144 + dch * 16) = kv;
        LAS bf16_t* vd = (LAS bf16_t*)(Vl + (dch * 8) * 520 + key * 2);
        vd[0 * 260] = (bf16_t)(vv.x & 0xffff); vd[1 * 260] = (bf16_t)(vv.x >> 16); vd[2 * 260] = (bf16_t)(vv.y & 0xffff); vd[3 * 260] = (bf16_t)(vv.y >> 16);
        vd[4 * 260] = (bf16_t)(vv.z & 0xffff); vd[5 * 260] = (bf16_t)(vv.z >> 16); vd[6 * 260] = (bf16_t)(vv.w & 0xffff); vd[7 * 260] = (bf16_t)(vv.w >> 16); }
    __syncthreads();
    for (int tile = j * 8 + wave; tile < SEQ / 32; tile += nj * 8) {
        const size_t tok = (size_t)b * SEQ + tile * 32 + r;
        bf16x8_t qf[4];
#pragma unroll
        for (int s4 = 0; s4 < 4; ++s4) qf[s4] = *(const bf16x8_t*)(PROJ + tok * DIN + C_Q + head * 64 + 16 * s4 + 8 * h);
        const float sc = 0.125f * 1.4426950408889634f;
        float mx = -3.0e38f, l = 0.f;
        f32x16 o0, o1;
#pragma unroll
        for (int i = 0; i < 16; ++i) { o0[i] = 0.f; o1[i] = 0.f; }
#pragma unroll 2
        for (int kt = 0; kt < 8; ++kt) {
            f32x16 st;
#pragma unroll
            for (int i = 0; i < 16; ++i) st[i] = 0.f;
#pragma unroll
            for (int s4 = 0; s4 < 4; ++s4) { const bf16x8_t kf = *(const LAS bf16x8_t*)(Kl + (kt * 32 + r) * 144 + (16 * s4 + 8 * h) * 2);
                st = __builtin_amdgcn_mfma_f32_32x32x16_bf16(kf, qf[s4], st, 0, 0, 0); }
            float tm = st[0];
#pragma unroll
            for (int i = 1; i < 16; ++i) tm = fmaxf(tm, st[i]);
            tm = fmaxf(tm, __shfl_xor(tm, 32));
            const float mn = fmaxf(mx, tm), alpha = __builtin_amdgcn_exp2f((mx - mn) * sc), mb = mn * sc;
            mx = mn; l *= alpha;
#pragma unroll
            for (int i = 0; i < 16; ++i) { o0[i] *= alpha; o1[i] *= alpha; }
#pragma unroll
            for (int i = 0; i < 16; ++i) { const float p = __builtin_amdgcn_exp2f(st[i] * sc - mb); st[i] = p; l += p; }
#pragma unroll
            for (int s2 = 0; s2 < 2; ++s2) {
                v4u pw; pw.x = cvt2(st[8 * s2 + 0], st[8 * s2 + 1]); pw.y = cvt2(st[8 * s2 + 2], st[8 * s2 + 3]);
                pw.z = cvt2(st[8 * s2 + 4], st[8 * s2 + 5]); pw.w = cvt2(st[8 * s2 + 6], st[8 * s2 + 7]);
                const bf16x8_t pf = __builtin_bit_cast(bf16x8_t, pw);
                const int koff = (kt * 32 + 16 * s2 + 4 * h) * 2;
                { const s16x4_t lo = *(const LAS s16x4_t*)(Vl + r * 520 + koff), hi = *(const LAS s16x4_t*)(Vl + r * 520 + koff + 16);
                  const bf16x8_t vf = __builtin_shufflevector(lo, hi, 0, 1, 2, 3, 4, 5, 6, 7); o0 = __builtin_amdgcn_mfma_f32_32x32x16_bf16(vf, pf, o0, 0, 0, 0); }
                { const s16x4_t lo = *(const LAS s16x4_t*)(Vl + (32 + r) * 520 + koff), hi = *(const LAS s16x4_t*)(Vl + (32 + r) * 520 + koff + 16);
                  const bf16x8_t vf = __builtin_shufflevector(lo, hi, 0, 1, 2, 3, 4, 5, 6, 7); o1 = __builtin_amdgcn_mfma_f32_32x32x16_bf16(vf, pf, o1, 0, 0, 0); }
            }
        }
        l += __shfl_xor(l, 32);
        const float inv = 1.0f / l;
        const bf16_t* gp = PROJ + tok * DIN + C_QGATE + head * 64; bf16_t* op = YCAT + tok * DM + 768 + head * 64;
#pragma unroll
        for (int q4 = 0; q4 < 4; ++q4) {
            { const int d = 8 * q4 + 4 * h; const u32x2_t gv = *(const u32x2_t*)(gp + d); u32x2_t w;
              w.x = cvt2(o0[4 * q4 + 0] * inv * silu_f(bflo(gv.x)), o0[4 * q4 + 1] * inv * silu_f(bfhi(gv.x))); w.y = cvt2(o0[4 * q4 + 2] * inv * silu_f(bflo(gv.y)), o0[4 * q4 + 3] * inv * silu_f(bfhi(gv.y)));
              *(u32x2_t*)(op + d) = w; }
            { const int d = 32 + 8 * q4 + 4 * h; const u32x2_t gv = *(const u32x2_t*)(gp + d); u32x2_t w;
              w.x = cvt2(o1[4 * q4 + 0] * inv * silu_f(bflo(gv.x)), o1[4 * q4 + 1] * inv * silu_f(bfhi(gv.x))); w.y = cvt2(o1[4 * q4 + 2] * inv * silu_f(bflo(gv.y)), o1[4 * q4 + 3] * inv * silu_f(bfhi(gv.y)));
              *(u32x2_t*)(op + d) = w; }
        }
    }
}
__device__ __forceinline__ void conv_vec(const Args& a, int vb, int nvb) {
    const bf16_t* PROJ = (const bf16_t*)(a.ws + WS_PROJ); bf16_t* YCAT = (bf16_t*)(a.ws + WS_YCAT);
    const float* conv_w = a.in[14]; const float* conv_b = a.in[15];
    const int gt = vb * 512 + otid(), NT = nvb * 512;
    for (int it = gt; it < NTOK * 48; it += NT) {
        const int tok = it / 48, c0 = (it % 48) * 8, t = tok % SEQ;
        const bf16_t* row = PROJ + (size_t)tok * DIN;
        float acc[8];
        { const f32x4 b0 = *(const f32x4*)(conv_b + c0), b1 = *(const f32x4*)(conv_b + c0 + 4); acc[0] = b0.x; acc[1] = b0.y; acc[2] = b0.z; acc[3] = b0.w; acc[4] = b1.x; acc[5] = b1.y; acc[6] = b1.z; acc[7] = b1.w; }
#pragma unroll
        for (int k = 0; k < 3; ++k) { if (t - 2 + k >= 0) { const bf16_t* r2 = row - (size_t)(2 - k) * DIN;
            const v4u cc = *(const v4u*)(r2 + C_CC + c0), ci = *(const v4u*)(r2 + C_CIN + c0);
            const f32x4 w0 = *(const f32x4*)(conv_w + k * WSSM + c0), w1 = *(const f32x4*)(conv_w + k * WSSM + c0 + 4);
            acc[0] += w0.x * (bflo(cc.x) * bflo(ci.x)); acc[1] += w0.y * (bfhi(cc.x) * bfhi(ci.x)); acc[2] += w0.z * (bflo(cc.y) * bflo(ci.y)); acc[3] += w0.w * (bfhi(cc.y) * bfhi(ci.y));
            acc[4] += w1.x * (bflo(cc.z) * bflo(ci.z)); acc[5] += w1.y * (bfhi(cc.z) * bfhi(ci.z)); acc[6] += w1.z * (bflo(cc.w) * bflo(ci.w)); acc[7] += w1.w * (bfhi(cc.w) * bfhi(ci.w)); } }
        const v4u cb = *(const v4u*)(row + C_CB + c0), cg = *(const v4u*)(row + C_CGATE + c0);
        v4u w;
        w.x = cvt2(bflo(cb.x) * acc[0] * silu_f(bflo(cg.x)), bfhi(cb.x) * acc[1] * silu_f(bfhi(cg.x)));
        w.y = cvt2(bflo(cb.y) * acc[2] * silu_f(bflo(cg.y)), bfhi(cb.y) * acc[3] * silu_f(bfhi(cg.y)));
        w.z = cvt2(bflo(cb.z) * acc[4] * silu_f(bflo(cg.z)), bfhi(cb.z) * acc[5] * silu_f(bfhi(cg.z)));
        w.w = cvt2(bflo(cb.w) * acc[6] * silu_f(bflo(cg.w)), bfhi(cb.w) * acc[7] * silu_f(bfhi(cg.w)));
        *(v4u*)(YCAT + (size_t)tok * DM + WSSM + c0) = w;
    }
}
__device__ __forceinline__ void final_norm(const Args& a) {
    const int tid = otid(), lane = tid & 63, gw = blockIdx.x * 8 + (tid >> 6), NGW = gridDim.x * 8;
    const float* fg = a.in[19];
    for (int r = gw; r < NTOK; r += NGW) {
        f32x4* xr = (f32x4*)(a.out + (size_t)r * DM) + lane;
        f32x4 v[4]; float s = 0.f;
#pragma unroll
        for (int j = 0; j < 4; ++j) { v[j] = xr[64 * j]; s += (v[j].x * v[j].x + v[j].y * v[j].y) + (v[j].z * v[j].z + v[j].w * v[j].w); }
        const float rstd = 1.0f / sqrtf(wave_sum(s) * (1.0f / DM) + NORM_EPS);
#pragma unroll
        for (int j = 0; j < 4; ++j) { const f32x4 g = ((const f32x4*)fg)[lane + 64 * j]; xr[64 * j] = v[j] * rstd * g; }
    }
}

__global__ void __launch_bounds__(512, 2) mega(Args a) {
    extern __shared__ __attribute__((aligned(16))) unsigned char smem_raw[];
    LAS unsigned char* lds = (LAS unsigned char*)smem_raw;
    cg::grid_group grid = cg::this_grid();
    volatile LAS unsigned* xst = (volatile LAS unsigned*)(lds + 139264);
    if (threadIdx.x == 0) { xst[0] = 0u; xst[1] = 0u; }
    __syncthreads();
    const XcdBarrier xbar = xcd_barrier_post((unsigned*)(a.ws + WS_CTL), xst);
    const int bid = blockIdx.x, G = gridDim.x;
    bf16_t* XB = (bf16_t*)(a.ws + WS_XB); bf16_t* MEMN = (bf16_t*)(a.ws + WS_MEMN);
    bf16_t* WINT = (bf16_t*)(a.ws + WS_WINT); bf16_t* WKVT = (bf16_t*)(a.ws + WS_WKVT); bf16_t* WOUTT = (bf16_t*)(a.ws + WS_WOUTT); bf16_t* WGLUT = (bf16_t*)(a.ws + WS_WGLUT);
    bf16_t* PROJ = (bf16_t*)(a.ws + WS_PROJ); bf16_t* KV = (bf16_t*)(a.ws + WS_KV); bf16_t* GB = (bf16_t*)(a.ws + WS_GB); bf16_t* YCAT = (bf16_t*)(a.ws + WS_YCAT);
    bf16_t* AY = (bf16_t*)(a.ws + WS_AY); bf16_t* WSb = (bf16_t*)(a.ws + WS_WS); bf16_t* WYb = (bf16_t*)(a.ws + WS_WY);

#ifndef PROBE_DUP
#define PROBE_DUP -1
#endif
#define REPS(k) for (int rep_ = 0; rep_ < ((PROBE_DUP == (k)) ? 2 : 1); ++rep_)
#ifndef PROBE_SUB
#define PROBE_SUB -1
#endif
    if (a.out == nullptr) grid.sync();
    REPS(0) { phase0(a, lds);
    xcd_barrier(xbar); }
    REPS(1) {
    { pg8::Order S; S.init(NTOK / 256, DIN / 256, 1, G, bid);
      pg8::gemm_phase(lds, pg8::Gemm{XB, WINT, DM, DM, DM, 0, 0}, S, pg8::EpiProjAY{PROJ, AY}); }
    { pg8::Order S; S.init(NB * NMEM / 256, 512 / 256, 1, G, (bid + G - ((NTOK / 256) * (DIN / 256)) % G) % G);
      pg8::gemm_phase(lds, pg8::Gemm{MEMN, WKVT, DM, DM, DM, 0, 0}, S, pg8::EpiBf16Store{KV, 512}); }
    xcd_barrier(xbar); }
    REPS(2) {
    if (bid < NB * NG) { pg8::Order S; S.init(NB, 1, NG, G, bid);
      pg8::gemm_phase(lds, pg8::Gemm{AY, WSb, 512, 256, 256, (size_t)1024 * 512, (size_t)256 * 256}, S, pg8::EpiSend{AY, (const float*)(a.ws + WS_LAMT), (const float*)(a.ws + WS_LAM512)});
      asm volatile("s_waitcnt vmcnt(0)" ::: "memory"); __syncthreads();
      pg8::gemm_phase(lds, pg8::Gemm{AY, WYb, 512, 512, 384, (size_t)1024 * 512, (size_t)256 * 512}, S, pg8::EpiY{AY, a.in[10], GB}); }
    else { attn_mfma(a, lds, bid - NB * NG, G - NB * NG); if (PROBE_SUB == 0) { __syncthreads(); attn_mfma(a, lds, bid - NB * NG, G - NB * NG); } }
    xcd_barrier(xbar); }
    REPS(4) {
    { pg8::Order S; S.init(NTOK / 256, 2, 1, G, bid);
      pg8::gemm_phase(lds, pg8::Gemm{GB, WGLUT, WSSM, WSSM, WSSM, 0, 0}, S, pg8::EpiGluP{GB, PROJ, a.in[13], YCAT}); }
    if (bid >= 128) conv_vec(a, bid - 128, G - 128);
    xcd_barrier(xbar); }
    REPS(5) {
    { pg8::Order S; S.init(NTOK / 256, DM / 256, 1, G, bid);
      pg8::gemm_phase(lds, pg8::Gemm{YCAT, WOUTT, DM, DM, DM, 0, 0}, S, pg8::EpiOutNorm{a.in[0], a.in[19], a.out, (float*)(a.ws + WS_XCH), (unsigned*)(a.ws + WS_CTL + CTL_PANEL)}); }
    }
}

extern "C" void kernel_launch(void* const* d_in, const int* in_sizes, int n_in, void* d_out, int out_size, void* d_ws, size_t ws_size, hipStream_t stream) {
    static int grid = 0;
    if (grid == 0) {
        if (n_in != 20 || out_size != NTOK * DM || ws_size < WS_END) { fprintf(stderr, "kernel_launch: unexpected shapes n_in %d out %d ws %zu\n", n_in, out_size, ws_size); grid = -1; return; }
        int dev = 0, cus = 0, per_cu = 0;
        hipGetDevice(&dev);
        hipDeviceGetAttribute(&cus, hipDeviceAttributeMultiprocessorCount, dev);
        if (hipFuncSetAttribute((const void*)mega, hipFuncAttributeMaxDynamicSharedMemorySize, LDS_BYTES) != hipSuccess) { fprintf(stderr, "kernel_launch: hipFuncSetAttribute failed\n"); grid = -1; return; }
        if (hipOccupancyMaxActiveBlocksPerMultiprocessor(&per_cu, (const void*)mega, 512, LDS_BYTES) != hipSuccess || per_cu < 1) { fprintf(stderr, "kernel_launch: occupancy query says %d\n", per_cu); per_cu = 1; }
        (void)hipGetLastError();
        grid = cus;
        if (grid < NB * NG) { fprintf(stderr, "kernel_launch: grid %d too small\n", grid); grid = -1; return; }
    }
    if (grid < 0) return;
    if (hipMemsetAsync((char*)d_ws + WS_CTL, 0, CTL_BYTES, stream) != hipSuccess) { fprintf(stderr, "kernel_launch: memset failed\n"); return; }
    Args a{};
    for (int i = 0; i < 20; ++i) a.in[i] = (const float*)d_in[i];
    a.out = (float*)d_out; a.ws = (unsigned char*)d_ws;
    void* args[] = {&a};
    hipError_t e = hipLaunchCooperativeKernel((const void*)mega, dim3(grid), dim3(512), args, LDS_BYTES, stream);
    if (e != hipSuccess) fprintf(stderr, "cooperative launch failed: %s (grid %d)\n", hipGetErrorString(e), grid);
}
```

```cpp
#include <hip/hip_runtime.h>
#include <hip/hip_cooperative_groups.h>
#include <cstdio>
#include <cstdint>
namespace cg = cooperative_groups;

#define LAS __attribute__((address_space(3)))
typedef unsigned short bf16_t;
typedef unsigned v4u __attribute__((ext_vector_type(4)));
typedef float f32x4 __attribute__((ext_vector_type(4)));

constexpr int NB = 4, SEQ = 4096, DM = 1024, NTOK = NB * SEQ, DIN = 2816, WSSM = 384, NG = 24, GH = 16, NP = 64, NMEM = 256;
constexpr int C_AIN = 0, C_AGATE = 384, C_CIN = 768, C_CB = 1152, C_CC = 1536, C_CGATE = 1920, C_Q = 2304, C_QGATE = 2560;
constexpr float NORM_EPS = 1e-6f;

constexpr size_t MiB = 1u << 20;
constexpr size_t WS_CTL = 0;
constexpr size_t WS_XB = 1 * MiB;
constexpr size_t WS_WINT = 33 * MiB;
constexpr size_t WS_WKVT = 39 * MiB;
constexpr size_t WS_WOUTT = 40 * MiB;
constexpr size_t WS_WGLUT = 42 * MiB;
constexpr size_t WS_MEMN = 43 * MiB;
constexpr size_t WS_KV = 45 * MiB;
constexpr size_t WS_LAMB = 46 * MiB;
constexpr size_t WS_BBAR = 46 * MiB + 65536;
constexpr size_t WS_GB = 47 * MiB;
constexpr size_t WS_PROJ = 59 * MiB;
constexpr size_t WS_YCAT = 147 * MiB;
constexpr size_t WS_AY = 179 * MiB;
constexpr size_t WS_WS = 203 * MiB;
constexpr size_t WS_WY = 206 * MiB;
constexpr size_t WS_LAMT = 212 * MiB;
constexpr size_t WS_LAM512 = 212 * MiB + 65536;
constexpr size_t WS_XCH = 213 * MiB;
constexpr size_t WS_END = 214 * MiB;
constexpr size_t CTL_PANEL = 16384;
constexpr size_t CTL_BYTES = 32768;

constexpr int LDS_BYTES = 147456;

struct Args {
    const float* in[20];
    float* out;
    unsigned char* ws;
};

__device__ __forceinline__ unsigned f2bf(float f) { unsigned u = __builtin_bit_cast(unsigned, f); return (u + 0x7fffu + ((u >> 16) & 1u)) >> 16; }
__device__ __forceinline__ unsigned pk2(float lo, float hi) { return f2bf(lo) | (f2bf(hi) << 16); }
__device__ __forceinline__ float bf2f(unsigned short b) { return __builtin_bit_cast(float, ((unsigned)b) << 16); }
__device__ __forceinline__ float bflo(unsigned w) { return __builtin_bit_cast(float, w << 16); }
__device__ __forceinline__ float bfhi(unsigned w) { return __builtin_bit_cast(float, w & 0xffff0000u); }
__device__ __forceinline__ float wave_sum(float v) {
#pragma unroll
    for (int o = 1; o < 64; o <<= 1) v += __shfl_xor(v, o);
    return v;
}
__device__ __forceinline__ float silu_f(float v) { return v * __builtin_amdgcn_rcpf(1.0f + __builtin_amdgcn_exp2f(-1.4426950408889634f * v)); }
__device__ __forceinline__ float sigmoid_f(float v) { return __builtin_amdgcn_rcpf(1.0f + __builtin_amdgcn_exp2f(-1.4426950408889634f * v)); }
__device__ __forceinline__ float gelu_tanh(float v) { const float w = __builtin_fmaf(v * v, -0.10294324f, -2.3022082f); return v * __builtin_amdgcn_rcpf(1.0f + __builtin_amdgcn_exp2f(v * w)); }
#define LDS_WAIT() asm volatile("s_waitcnt lgkmcnt(0)" ::: "memory")
__device__ __forceinline__ int otid() { int t = threadIdx.x; asm volatile("" : "+v"(t)); return t; }

#define XB_TMO      128
#define XB_XCNT(j)  (256  + 64 * (j))
#define XB_XSUB(j)  (1280 + 64 * (j))
#define XB_XGEN(j)  (2304 + 64 * (j))
#define XB_TOP      3328
#define XB_TOPGEN   3392
#define XCD_BAR_WORDS 3456
#define XB_SPIN_CAP (1u << 18)

__device__ __forceinline__ unsigned xb_ld(unsigned* p)              { return __hip_atomic_load(p, __ATOMIC_RELAXED, __HIP_MEMORY_SCOPE_AGENT); }
__device__ __forceinline__ unsigned xb_add(unsigned* p, unsigned v) { return __hip_atomic_fetch_add(p, v, __ATOMIC_RELAXED, __HIP_MEMORY_SCOPE_AGENT); }
__device__ __forceinline__ unsigned xb_xcc_id() { return (unsigned)__builtin_amdgcn_s_getreg((3 << 11) | 20) & 0xFu; }
#define XB_SPIN(cond, bar) do { unsigned _sp = 0; while (cond) { __builtin_amdgcn_s_sleep(1); \
    if ((++_sp & 255u) == 0u) { if (xb_ld(&(bar)[XB_TMO])) break; if (_sp > XB_SPIN_CAP) { atomicAdd(&(bar)[XB_TMO], 1u); break; } } } } while (0)

struct XcdBarrier {
    unsigned* bar; unsigned x;
    volatile LAS unsigned* st;
};

__device__ __forceinline__ XcdBarrier xcd_barrier_post(unsigned* bar, volatile LAS unsigned* st) {
    XcdBarrier b; b.bar = bar; b.x = xb_xcc_id(); b.st = st;
    if (threadIdx.x == 0) (void)xb_add(&bar[XB_XCNT(b.x)], 1u);
    return b;
}
__device__ __forceinline__ void xcd_barrier_complete(unsigned* bar, unsigned x, unsigned& nloc, unsigned& nx) {
    const unsigned G = gridDim.x * gridDim.y * gridDim.z;
    unsigned sum, cnt, mine, sp = 0u;
    for (;;) {
        sum = 0u; cnt = 0u; mine = 0u;
#pragma unroll
        for (unsigned j = 0; j < 16; ++j) { const unsigned c = xb_ld(&bar[XB_XCNT(j)]); sum += c; cnt += (c > 0u) ? 1u : 0u; mine = (j == x) ? c : mine; }
        if (sum == G) break;
        __builtin_amdgcn_s_sleep(1);
        if ((++sp & 255u) == 0u) { if (xb_ld(&bar[XB_TMO])) break; if (sp > XB_SPIN_CAP) { atomicAdd(&bar[XB_TMO], 1u); break; } }
    }
    nloc = mine > 0u ? mine : 1u; nx = cnt > 0u ? cnt : 1u;
}

__device__ __forceinline__ void xcd_barrier(const XcdBarrier& b) {
    asm volatile("s_waitcnt vmcnt(0)" ::: "memory");
    __syncthreads();
    if (threadIdx.x == 0) {
        unsigned* bar = b.bar;
        __builtin_amdgcn_s_waitcnt(0);
        unsigned nloc = b.st[0], nx = b.st[1];
        if (nloc == 0u) { xcd_barrier_complete(bar, b.x, nloc, nx); b.st[0] = nloc; b.st[1] = nx; }
        const unsigned old = xb_add(&bar[XB_XSUB(b.x)], 1u);
        const unsigned gen = old / nloc;
        if (old + 1u == (gen + 1u) * nloc) {
            __builtin_amdgcn_fence(__ATOMIC_RELEASE, "agent");
            asm volatile("s_waitcnt vmcnt(0)" ::: "memory");
            const unsigned og = xb_add(&bar[XB_TOP], 1u);
            const unsigned tg = og / nx;
            if (og + 1u == (tg + 1u) * nx) xb_add(&bar[XB_TOPGEN], 1u);
            else XB_SPIN(xb_ld(&bar[XB_TOPGEN]) == tg, bar);
            __builtin_amdgcn_fence(__ATOMIC_ACQUIRE, "agent");
            xb_add(&bar[XB_XGEN(b.x)], 1u);
            asm volatile("s_waitcnt vmcnt(0)" ::: "memory");
        } else {
            XB_SPIN(xb_ld(&bar[XB_XGEN(b.x)]) == gen, bar);
            __builtin_amdgcn_fence(__ATOMIC_ACQUIRE, "agent");
            asm volatile("s_waitcnt vmcnt(0)" ::: "memory");
        }
    }
    __syncthreads();
}

__device__ __forceinline__ void rms_row_to_bf16(const float* xrow, bf16_t* orow, const float* gain, int lane) {
    const f32x4* xr = (const f32x4*)xrow + lane;
    f32x4 v[4]; float s = 0.f;
#pragma unroll
    for (int j = 0; j < 4; ++j) { v[j] = xr[64 * j]; s += (v[j].x * v[j].x + v[j].y * v[j].y) + (v[j].z * v[j].z + v[j].w * v[j].w); }
    const float rstd = 1.0f / sqrtf(wave_sum(s) * (1.0f / DM) + NORM_EPS);
    unsigned long long* o8 = (unsigned long long*)orow + lane;
#pragma unroll
    for (int j = 0; j < 4; ++j) {
        f32x4 g = gain ? ((const f32x4*)gain)[lane + 64 * j] : (f32x4){1.f, 1.f, 1.f, 1.f};
        o8[64 * j] = (unsigned long long)pk2(v[j].x * rstd * g.x, v[j].y * rstd * g.y) | ((unsigned long long)pk2(v[j].z * rstd * g.z, v[j].w * rstd * g.w) << 32);
    }
}
__device__ __forceinline__ void transpose_item(const float* W, int K, int N, bf16_t* WT, const float* ks, LAS float* scr, int item, int lane) {
    const int nblk = N / 32, kb = item / nblk, nb = item % nblk, k0 = 64 * kb, n0 = 32 * nb;
#pragma unroll 8
    for (int i = 0; i < 32; ++i) { const int kk = 2 * i + (lane >> 5); float w = W[(size_t)(k0 + kk) * N + n0 + (lane & 31)]; if (ks) w *= ks[k0 + kk]; scr[kk * 33 + (lane & 31)] = w; }
    LDS_WAIT();
    const int c = lane & 7;
#pragma unroll
    for (int j = 0; j < 4; ++j) { const int n = (lane >> 3) + 8 * j; const LAS float* s = scr + (8 * c) * 33 + n;
        v4u o; o.x = pk2(s[0 * 33], s[1 * 33]); o.y = pk2(s[2 * 33], s[3 * 33]); o.z = pk2(s[4 * 33], s[5 * 33]); o.w = pk2(s[6 * 33], s[7 * 33]);
        *(v4u*)(WT + (size_t)(n0 + n) * K + k0 + 8 * c) = o; }
    LDS_WAIT();
}


__device__ __forceinline__ void s5_tables(const Args& a, LAS unsigned char* lds, int tid) {
    const int bid = blockIdx.x; if (bid >= 192) return;
    const int g = bid % NG, q = bid / NG;
    const float* lam_re = a.in[4]; const float* lam_im = a.in[5]; const float* b_re = a.in[6]; const float* b_im = a.in[7]; const float* c_re = a.in[8]; const float* c_im = a.in[9]; const float* log_dt = a.in[11];
    LAS float* LPr = (LAS float*)(lds + 69632); LAS float* LPi = LPr + 17 * 64; LAS float* BBr = LPi + 17 * 64; LAS float* BBi = BBr + 1024;
    LAS float* Cr = BBi + 1024; LAS float* Ci = Cr + 1024; LAS float* KT = Ci + 1024;
    if (tid < 64) {
        const int p = tid, i = g * NP + p;
        const double dt = exp((double)log_dt[g]);
        const double lr = lam_re[i], li = lam_im[i];
        const double er = exp(lr * dt), ang = li * dt;
        const double lbr = er * cos(ang), lbi = er * sin(ang);
        const double nr = lbr - 1.0, ni = lbi, den = lr * lr + li * li;
        const double qr = (nr * lr + ni * li) / den, qi = (ni * lr - nr * li) / den;
        for (int h = 0; h < GH; ++h) { const double br = b_re[i * GH + h], bi = b_im[i * GH + h];
            BBr[p * 16 + h] = (float)(qr * br - qi * bi); BBi[p * 16 + h] = (float)(qr * bi + qi * br); }
        double pr = 1.0, pi = 0.0;
        for (int t = 0; t < 16; ++t) { LPr[t * 64 + p] = (float)pr; LPi[t * 64 + p] = (float)pi; const double nr2 = pr * lbr - pi * lbi, ni2 = pr * lbi + pi * lbr; pr = nr2; pi = ni2; }
        LPr[16 * 64 + p] = (float)pr; LPi[16 * 64 + p] = (float)pi;
        double tr = pr, ti = pi;
        if (q == 0) { float* LAMT = (float*)(a.ws + WS_LAMT); LAMT[2 * i] = (float)tr; LAMT[2 * i + 1] = (float)ti; }
        for (int k = 0; k < 5; ++k) { const double nr2 = tr * tr - ti * ti, ni2 = 2.0 * tr * ti; tr = nr2; ti = ni2; }
        if (q == 0) { float* L512 = (float*)(a.ws + WS_LAM512); L512[2 * i] = (float)tr; L512[2 * i + 1] = (float)ti; }
    }
    for (int i = tid; i < 1024; i += 512) { Cr[i] = c_re[g * 1024 + i]; Ci[i] = c_im[g * 1024 + i]; }
    __syncthreads();
    { const int tau = tid >> 5, hol = (tid >> 4) & 1, hi = tid & 15, ho = 2 * q + hol; float sacc = 0.f;
#pragma unroll 4
      for (int p = 0; p < 64; ++p) { const float lpr = LPr[tau * 64 + p], lpi = LPi[tau * 64 + p], br = BBr[p * 16 + hi], bi = BBi[p * 16 + hi];
          const float wr_ = lpr * br - lpi * bi, wi_ = lpr * bi + lpi * br; sacc += Cr[ho * 64 + p] * wr_ - Ci[ho * 64 + p] * wi_; }
      KT[tid] = sacc; }
    __syncthreads();
    bf16_t* WSb = (bf16_t*)(a.ws + WS_WS); bf16_t* WYb = (bf16_t*)(a.ws + WS_WY);
#pragma unroll
    for (int kk = 0; kk < 2; ++kk) { const int ch = tid + 512 * kk, n = 32 * q + (ch >> 5), k0 = (ch & 31) * 8, p = n & 63, isim = (n >> 6) & 1;
        float v[8];
#pragma unroll
        for (int j = 0; j < 8; ++j) { const int k = k0 + j, t = k >> 4, h = k & 15, tau = 15 - t; const float lpr = LPr[tau * 64 + p], lpi = LPi[tau * 64 + p], br = BBr[p * 16 + h], bi = BBi[p * 16 + h];
            const float val = isim ? (lpr * bi + lpi * br) : (lpr * br - lpi * bi); v[j] = n < 128 ? val : 0.f; }
        v4u o; o.x = pk2(v[0], v[1]); o.y = pk2(v[2], v[3]); o.z = pk2(v[4], v[5]); o.w = pk2(v[6], v[7]);
        *(v4u*)(WSb + ((size_t)(g * 256 + n)) * 256 + k0) = o; }
#pragma unroll
    for (int kk = 0; kk < 4; ++kk) { const int ch = tid + 512 * kk, rr = ch >> 6, to = rr >> 1, hol = rr & 1, ho = 2 * q + hol, n = to * 16 + ho, k0 = (ch & 63) * 8;
        float v[8];
#pragma unroll
        for (int j = 0; j < 8; ++j) { const int k = k0 + j; float val;
            if (k < 256) { const int ti = k >> 4, hi = k & 15; val = ti <= to ? KT[((to - ti) * 2 + hol) * 16 + hi] : 0.f; }
            else { const int jj = (k - 256) & 127, p = jj & 63, isim = jj >> 6; const float lpr = LPr[(to + 1) * 64 + p], lpi = LPi[(to + 1) * 64 + p], cr = Cr[ho * 64 + p], ci = Ci[ho * 64 + p];
                val = isim ? -(cr * lpi + ci * lpr) : (cr * lpr - ci * lpi); }
            v[j] = val; }
        v4u o; o.x = pk2(v[0], v[1]); o.y = pk2(v[2], v[3]); o.z = pk2(v[4], v[5]); o.w = pk2(v[6], v[7]);
        *(v4u*)(WYb + ((size_t)(g * 256 + n)) * 512 + k0) = o; }
}

__device__ __forceinline__ void rms_rows2_to_bf16(const float* x0, const float* x1, bf16_t* o0, bf16_t* o1, const float* gain, int lane) {
    const f32x4* xr0 = (const f32x4*)x0 + lane; const f32x4* xr1 = (const f32x4*)x1 + lane;
    f32x4 v[4], w[4]; float s0 = 0.f, s1 = 0.f;
#pragma unroll
    for (int j = 0; j < 4; ++j) { v[j] = xr0[64 * j]; w[j] = xr1[64 * j]; }
#pragma unroll
    for (int j = 0; j < 4; ++j) { s0 += (v[j].x * v[j].x + v[j].y * v[j].y) + (v[j].z * v[j].z + v[j].w * v[j].w); s1 += (w[j].x * w[j].x + w[j].y * w[j].y) + (w[j].z * w[j].z + w[j].w * w[j].w); }
#pragma unroll
    for (int o = 1; o < 64; o <<= 1) { s0 += __shfl_xor(s0, o); s1 += __shfl_xor(s1, o); }
    const float r0 = 1.0f / sqrtf(s0 * (1.0f / DM) + NORM_EPS), r1 = 1.0f / sqrtf(s1 * (1.0f / DM) + NORM_EPS);
    unsigned long long* p0 = (unsigned long long*)o0 + lane; unsigned long long* p1 = (unsigned long long*)o1 + lane;
#pragma unroll
    for (int j = 0; j < 4; ++j) {
        const f32x4 g = gain ? ((const f32x4*)gain)[lane + 64 * j] : (f32x4){1.f, 1.f, 1.f, 1.f};
        p0[64 * j] = (unsigned long long)pk2(v[j].x * r0 * g.x, v[j].y * r0 * g.y) | ((unsigned long long)pk2(v[j].z * r0 * g.z, v[j].w * r0 * g.w) << 32);
        p1[64 * j] = (unsigned long long)pk2(w[j].x * r1 * g.x, w[j].y * r1 * g.y) | ((unsigned long long)pk2(w[j].z * r1 * g.z, w[j].w * r1 * g.w) << 32);
    }
}
__device__ __forceinline__ void transpose_item4(const float* W, int K, int N, bf16_t* WT, const float* ks, LAS float* scr, int item, int lane) {
    const int nblk = N / 32, kb = item / nblk, nb = item % nblk, k0 = 64 * kb, n0 = 32 * nb;
    f32x4 w[8];
#pragma unroll
    for (int i = 0; i < 8; ++i) { const int kk = 8 * i + (lane >> 3); w[i] = *(const f32x4*)(W + (size_t)(k0 + kk) * N + n0 + 4 * (lane & 7)); }
#pragma unroll
    for (int i = 0; i < 8; ++i) { const int kk = 8 * i + (lane >> 3); const float sc = ks ? ks[k0 + kk] : 1.0f; LAS float* d = scr + kk * 33 + 4 * (lane & 7);
        d[0] = w[i].x * sc; d[1] = w[i].y * sc; d[2] = w[i].z * sc; d[3] = w[i].w * sc; }
    LDS_WAIT();
    const int c = lane & 7;
#pragma unroll
    for (int j = 0; j < 4; ++j) { const int n = (lane >> 3) + 8 * j; const LAS float* sp = scr + (8 * c) * 33 + n;
        v4u o; o.x = pk2(sp[0 * 33], sp[1 * 33]); o.y = pk2(sp[2 * 33], sp[3 * 33]); o.z = pk2(sp[4 * 33], sp[5 * 33]); o.w = pk2(sp[6 * 33], sp[7 * 33]);
        *(v4u*)(WT + (size_t)(n0 + n) * K + k0 + 8 * c) = o; }
    LDS_WAIT();
}

__device__ __forceinline__ void phase0(const Args& a, LAS unsigned char* lds) {
    const int tid = otid(), lane = tid & 63, wave = tid >> 6;
    const int gw = blockIdx.x * 8 + wave, NGW = gridDim.x * 8;
    s5_tables(a, lds, tid);
    const float* x = a.in[0]; const float* mem = a.in[1]; const float* norm_g = a.in[2]; const float* w_in = a.in[3];
    const float* w_glu = a.in[12]; const float* mem_norm_g = a.in[16]; const float* w_mem_kv = a.in[17]; const float* w_out = a.in[18];
    bf16_t* XB = (bf16_t*)(a.ws + WS_XB); bf16_t* MEMN = (bf16_t*)(a.ws + WS_MEMN);
    bf16_t* WINT = (bf16_t*)(a.ws + WS_WINT); bf16_t* WKVT = (bf16_t*)(a.ws + WS_WKVT); bf16_t* WOUTT = (bf16_t*)(a.ws + WS_WOUTT); bf16_t* WGLUT = (bf16_t*)(a.ws + WS_WGLUT);
    for (int r2 = gw; r2 < (NTOK + NB * NMEM) / 2; r2 += NGW) { const int r = 2 * r2;
        if (r < NTOK) rms_rows2_to_bf16(x + (size_t)r * DM, x + (size_t)(r + 1) * DM, XB + (size_t)r * DM, XB + (size_t)(r + 1) * DM, nullptr, lane);
        else { const int m = r - NTOK; rms_rows2_to_bf16(mem + (size_t)m * DM, mem + (size_t)(m + 1) * DM, MEMN + (size_t)m * DM, MEMN + (size_t)(m + 1) * DM, mem_norm_g, lane); }
    }
    LAS float* scr = (LAS float*)(lds + wave * 8448);
    constexpr int I_IN = (DM / 64) * (DIN / 32), I_KV = (DM / 64) * (512 / 32), I_OUT = (DM / 64) * (DM / 32), I_GLU = (WSSM / 64) * (WSSM / 32);
    for (int it = gw; it < I_IN + I_KV + I_OUT + I_GLU; it += NGW) {
        int r = it;
        if (r < I_IN) { transpose_item4(w_in, DM, DIN, WINT, norm_g, scr, r, lane); continue; } r -= I_IN;
        if (r < I_KV) { transpose_item4(w_mem_kv, DM, 512, WKVT, nullptr, scr, r, lane); continue; } r -= I_KV;
        if (r < I_OUT) { transpose_item4(w_out, DM, DM, WOUTT, nullptr, scr, r, lane); continue; } r -= I_OUT;
        transpose_item4(w_glu, WSSM, WSSM, WGLUT, nullptr, scr, r, lane);
    }
    const int gt = blockIdx.x * 512 + tid, NT = gridDim.x * 512;
    for (int i = gt; i < 128 * 384 / 2; i += NT) ((unsigned*)(WGLUT + 384 * 384))[i] = 0u;
}

template <class Epi>
__device__ __forceinline__ void gemm_naive(const bf16_t* A, int lda, const bf16_t* Bt, int ldb, int M, int N, int K, LAS unsigned char* lds, int tile0, int ntile_total, const Epi& epi) {
    LAS float* As = (LAS float*)lds;
    LAS float* Bs = As + 32 * 132;
    const int tid = threadIdx.x, ty = tid >> 4, tx = tid & 15;
    const int ntn = N / 64, nt = (M / 128) * ntn;
    (void)ntile_total;
    for (int tile = blockIdx.x - tile0; tile < nt; tile += gridDim.x) {
        if (tile < 0) continue;
        const int tm = tile / ntn, tn = tile % ntn;
        float acc[4][4];
#pragma unroll
        for (int i = 0; i < 4; ++i)
#pragma unroll
            for (int j = 0; j < 4; ++j) acc[i][j] = 0.f;
        for (int k0 = 0; k0 < K; k0 += 32) {
            __syncthreads();
            { const int r = tid >> 2, kc = (tid & 3) * 8; const v4u v = *(const v4u*)(A + (size_t)(tm * 128 + r) * lda + k0 + kc);
              As[(kc + 0) * 132 + r] = bflo(v.x); As[(kc + 1) * 132 + r] = bfhi(v.x); As[(kc + 2) * 132 + r] = bflo(v.y); As[(kc + 3) * 132 + r] = bfhi(v.y);
              As[(kc + 4) * 132 + r] = bflo(v.z); As[(kc + 5) * 132 + r] = bfhi(v.z); As[(kc + 6) * 132 + r] = bflo(v.w); As[(kc + 7) * 132 + r] = bfhi(v.w); }
            if (tid < 256) { const int r = tid >> 2, kc = (tid & 3) * 8; const v4u v = *(const v4u*)(Bt + (size_t)(tn * 64 + r) * ldb + k0 + kc);
              Bs[(kc + 0) * 68 + r] = bflo(v.x); Bs[(kc + 1) * 68 + r] = bfhi(v.x); Bs[(kc + 2) * 68 + r] = bflo(v.y); Bs[(kc + 3) * 68 + r] = bfhi(v.y);
              Bs[(kc + 4) * 68 + r] = bflo(v.z); Bs[(kc + 5) * 68 + r] = bfhi(v.z); Bs[(kc + 6) * 68 + r] = bflo(v.w); Bs[(kc + 7) * 68 + r] = bfhi(v.w); }
            __syncthreads();
#pragma unroll 8
            for (int k = 0; k < 32; ++k) {
                const f32x4 av = *(const LAS f32x4*)(As + k * 132 + ty * 4), bv = *(const LAS f32x4*)(Bs + k * 68 + tx * 4);
#pragma unroll
                for (int i = 0; i < 4; ++i)
#pragma unroll
                    for (int j = 0; j < 4; ++j) acc[i][j] += av[i] * bv[j];
            }
        }
#pragma unroll
        for (int i = 0; i < 4; ++i)
#pragma unroll
            for (int j = 0; j < 4; ++j) epi(tm * 128 + ty * 4 + i, tn * 64 + tx * 4 + j, acc[i][j]);
    }
}

struct EpiStoreBf16 { bf16_t* O; int ldo; __device__ __forceinline__ void operator()(int r, int c, float v) const { O[(size_t)r * ldo + c] = (bf16_t)f2bf(v); } };
struct EpiGlu { const bf16_t* GB; const bf16_t* PROJ; const float* b_glu; bf16_t* YCAT;
    __device__ __forceinline__ void operator()(int r, int c, float v) const {
        const float g = bf2f(GB[(size_t)r * WSSM + c]); const float gate = bf2f(PROJ[(size_t)r * DIN + C_AGATE + c]);
        YCAT[(size_t)r * DM + c] = (bf16_t)f2bf(g * sigmoid_f(v + b_glu[c]) * silu_f(gate)); } };
struct EpiOut { const float* x; float* out; __device__ __forceinline__ void operator()(int r, int c, float v) const { out[(size_t)r * DM + c] = x[(size_t)r * DM + c] + v; } };


namespace pg8 {
typedef short bf16x8 __attribute__((ext_vector_type(8)));
typedef unsigned u32x4 __attribute__((ext_vector_type(4)));
constexpr int BM = 256, BK = 64, HALF = 128, HTB = HALF * BK * 2, STAGE_BYTES = 8 * HTB, NXCD = 8, WGM = 8;
__host__ __device__ __forceinline__ int lds_byte(int r, int c) { const int st = (r >> 4) * 2 + (c >> 5), rr = r & 15, cc = c & 31, ob = rr * 64 + cc * 2; return st * 1024 + (ob ^ (((ob >> 9) & 1) << 5)); }
__host__ __device__ __forceinline__ void stage_rc(int b, int& R, int& C) { const int st = b / 1024, sb = b % 1024, swz = sb ^ (((sb >> 9) & 1) << 5); R = (st >> 1) * 16 + swz / 64; C = (st & 1) * 32 + (swz % 64) / 2; }
__host__ __device__ __forceinline__ int perm32(int rho) { const int n = rho >> 4, i = rho & 15; return 8 * (i >> 2) + 4 * n + (i & 3); }
struct Unit { int pm, pn, z; };
struct Gemm { const bf16_t* A; const bf16_t* Bt; int lda, ldb, K; size_t sAz, sBz; };
struct Order {
    int nM, nN, per, total, G, c;
    __device__ void init(int nM_, int nN_, int nZ_, int G_, int c_) { nM = nM_; nN = nN_; per = nM_ * nN_; total = per * nZ_; G = G_; c = c_; }
    __device__ bool next(int i, Unit& u) const {
        const long L = (long)i * G + c; if (L >= total) return false;
        u.z = (int)(L / per); int wgid = (int)(L % per); const int nwg = per;
        { const int q = nwg / NXCD, r = nwg % NXCD, xcd = wgid % NXCD, off = wgid / NXCD; wgid = (xcd < r ? xcd * (q + 1) : r * (q + 1) + (xcd - r) * q) + off; }
        const int nig = WGM * nN, gid = wgid / nig, fm = gid * WGM, gsz = (nM - fm) < WGM ? (nM - fm) : WGM;
        u.pm = fm + ((wgid % nig) % gsz); u.pn = (wgid % nig) / gsz; return true;
    }
};
__device__ __forceinline__ unsigned cvt_pk_bf16(float lo, float hi) { unsigned r; asm volatile("v_cvt_pk_bf16_f32 %0, %1, %2" : "=v"(r) : "v"(lo), "v"(hi)); return r; }

template <class Epi>
__device__ __forceinline__ void gemm_phase(LAS unsigned char* lds, const Gemm g, const Order& S, const Epi& E) {
    int tid = threadIdx.x; asm volatile("" : "+v"(tid));
    const int wid = __builtin_amdgcn_readfirstlane(tid >> 6), lane = tid & 63, wr = wid >> 2, wc = wid & 3, fr = lane & 15, fq = lane >> 4;
    int K = g.K; asm volatile("" : "+s"(K));
    const int nt = K / BK;
    unsigned voffA[2], voffB[2];
#pragma unroll
    for (int i = 0; i < 2; ++i) { int R, C; stage_rc(tid * 16 + i * 8192, R, C); const int Rb = Epi::PERM ? ((R & ~31) + perm32(R & 31)) : R;
        voffA[i] = (unsigned)(R * g.lda + C) * 2u; voffB[i] = (unsigned)(Rb * g.ldb + C) * 2u; }
    const size_t kstep = (size_t)(BK * 2);
    const size_t hstepA = (size_t)HALF * g.lda * 2, hstepB = (size_t)HALF * g.ldb * 2;
    const size_t tstepA = 2 * hstepA, tstepB = 2 * hstepB;
    const unsigned ldsw = (unsigned)wid * 1024u;
    const int aoff = lds_byte(wr * 64 + fr, fq * 8), boff = lds_byte(wc * 32 + fr, fq * 8);
#define PG8_SA(b, h) (((b) * 2 + (h)) * HTB)
#define PG8_SB(b, h) ((4 + (b) * 2 + (h)) * HTB)
#define PG8_STAGE(bufoff, gbase, voff) do { _Pragma("unroll") for (int _i = 0; _i < 2; ++_i) \
        __builtin_amdgcn_global_load_lds((const unsigned*)((const char*)(gbase) + (voff)[_i]), (LAS unsigned*)(lds + (bufoff) + ldsw + _i * 8192), 16, 0, 0); } while (0)
#define PG8_LDA(dst, b, h) do { _Pragma("unroll") for (int m = 0; m < 4; ++m) _Pragma("unroll") for (int k = 0; k < 2; ++k) dst[m][k] = *(const LAS bf16x8*)(lds + PG8_SA(b, h) + aoff + m * 2048 + k * 1024); } while (0)
#define PG8_LDB(dst, b, h) do { _Pragma("unroll") for (int n = 0; n < 2; ++n) _Pragma("unroll") for (int k = 0; k < 2; ++k) dst[n][k] = *(const LAS bf16x8*)(lds + PG8_SB(b, h) + boff + n * 2048 + k * 1024); } while (0)
#define PG8_MMA(ai, bj, At, Bt) do { __builtin_amdgcn_s_setprio(1); _Pragma("unroll") for (int m = 0; m < 4; ++m) _Pragma("unroll") for (int n = 0; n < 2; ++n) _Pragma("unroll") for (int k = 0; k < 2; ++k) \
        acc[ai][bj][m][n] = __builtin_amdgcn_mfma_f32_16x16x32_bf16(Bt[n][k], At[m][k], acc[ai][bj][m][n], 0, 0, 0); __builtin_amdgcn_s_setprio(0); } while (0)
#define PG8_WAIT_V(n) asm volatile("s_waitcnt vmcnt(" #n ")" ::: "memory")
#define PG8_WAIT_L(n) asm volatile("s_waitcnt lgkmcnt(" #n ")" ::: "memory")
#define PG8_BAR __builtin_amdgcn_s_barrier()
#define PG8_SCHED __builtin_amdgcn_sched_barrier(0)
    Unit cur, nxt; int ui = 0;
    if (!S.next(0, cur)) return;
    f32x4 acc[2][2][4][2];
#pragma unroll
    for (int a = 0; a < 2; ++a)
#pragma unroll
        for (int b = 0; b < 2; ++b)
#pragma unroll
            for (int m = 0; m < 4; ++m)
#pragma unroll
                for (int n = 0; n < 2; ++n) acc[a][b][m][n] = (f32x4){0.f, 0.f, 0.f, 0.f};
    bf16x8 At[4][2], B0[2][2], B1[2][2];
    const char* cA = (const char*)(g.A + (size_t)cur.z * g.sAz) + (size_t)cur.pm * tstepA; const char* cB = (const char*)(g.Bt + (size_t)cur.z * g.sBz) + (size_t)cur.pn * tstepB;
    PG8_STAGE(PG8_SB(0, 0), cB, voffB); PG8_STAGE(PG8_SA(0, 0), cA, voffA); PG8_STAGE(PG8_SB(0, 1), cB + hstepB, voffB); PG8_STAGE(PG8_SA(0, 1), cA + hstepA, voffA);
    if (wr == 1) PG8_BAR;
    PG8_WAIT_V(4); PG8_BAR;
    PG8_STAGE(PG8_SB(1, 0), cB + kstep, voffB); PG8_STAGE(PG8_SA(1, 0), cA + kstep, voffA); PG8_STAGE(PG8_SB(1, 1), cB + hstepB + kstep, voffB);
    PG8_WAIT_V(6); PG8_BAR;
    for (;;) {
        const bool has_next = S.next(ui + 1, nxt);
        const char* nA = has_next ? (const char*)(g.A + (size_t)nxt.z * g.sAz) + (size_t)nxt.pm * tstepA : cA; const char* nB = has_next ? (const char*)(g.Bt + (size_t)nxt.z * g.sBz) + (size_t)nxt.pn * tstepB : cB;
        for (int t = 0; t < nt; t += 2) {
            const bool last = (t == nt - 2);
            const char* a1 = cA + (size_t)(t + 1) * kstep;
            const char* a2 = last ? nA : cA + (size_t)(t + 2) * kstep; const char* b2 = last ? nB : cB + (size_t)(t + 2) * kstep;
            const char* a3 = a2 + kstep; const char* b3 = b2 + kstep;
            PG8_LDB(B0, 0, 0); PG8_SCHED; PG8_LDA(At, 0, 0); PG8_STAGE(PG8_SA(1, 1), a1 + hstepA, voffA);
            PG8_WAIT_L(8); PG8_BAR; PG8_WAIT_L(0); PG8_MMA(0, 0, At, B0); PG8_BAR; PG8_SCHED;
            PG8_LDB(B1, 0, 1); PG8_STAGE(PG8_SB(0, 0), b2, voffB);
            PG8_BAR; PG8_WAIT_L(0); PG8_MMA(0, 1, At, B1); PG8_BAR;
            PG8_LDA(At, 0, 1); PG8_STAGE(PG8_SA(0, 0), a2, voffA);
            PG8_BAR; PG8_WAIT_L(0); PG8_MMA(1, 0, At, B0); PG8_BAR; PG8_SCHED;
            PG8_STAGE(PG8_SB(0, 1), b2 + hstepB, voffB);
            PG8_WAIT_V(6); PG8_BAR; PG8_MMA(1, 1, At, B1); PG8_BAR;
            PG8_LDB(B0, 1, 0); PG8_SCHED; PG8_LDA(At, 1, 0); PG8_STAGE(PG8_SA(0, 1), a2 + hstepA, voffA);
            PG8_WAIT_L(8); PG8_BAR; PG8_WAIT_L(0); PG8_MMA(0, 0, At, B0); PG8_BAR; PG8_SCHED;
            PG8_LDB(B1, 1, 1); PG8_STAGE(PG8_SB(1, 0), b3, voffB);
            PG8_BAR; PG8_WAIT_L(0); PG8_MMA(0, 1, At, B1); PG8_BAR;
            PG8_LDA(At, 1, 1); PG8_STAGE(PG8_SA(1, 0), a3, voffA);
            PG8_BAR; PG8_WAIT_L(0); PG8_MMA(1, 0, At, B0); PG8_BAR; PG8_SCHED;
            PG8_STAGE(PG8_SB(1, 1), b3 + hstepB, voffB);
            PG8_WAIT_V(6); PG8_BAR; PG8_MMA(1, 1, At, B1); PG8_BAR;
        }
        if constexpr (!Epi::AFTER_DRAIN) { E(acc, cur, wr, wc, fr, fq); }
        if (!has_next) break;
#pragma unroll
        for (int a = 0; a < 2; ++a)
#pragma unroll
            for (int b = 0; b < 2; ++b)
#pragma unroll
                for (int m = 0; m < 4; ++m)
#pragma unroll
                    for (int n = 0; n < 2; ++n) acc[a][b][m][n] = (f32x4){0.f, 0.f, 0.f, 0.f};
        cur = nxt; cA = nA; cB = nB; ++ui;
    }
    PG8_WAIT_V(0);
    if (wr == 0) PG8_BAR;
    PG8_BAR;
    if constexpr (Epi::AFTER_DRAIN) { E.fused(acc, cur, wr, wc, fr, fq, lds, wid, lane); }
#undef PG8_SA
#undef PG8_SB
#undef PG8_STAGE
#undef PG8_LDA
#undef PG8_LDB
#undef PG8_MMA
#undef PG8_WAIT_V
#undef PG8_WAIT_L
#undef PG8_BAR
#undef PG8_SCHED
}

struct EpiBf16Store {
    static constexpr bool PERM = true, AFTER_DRAIN = false;
    bf16_t* O; int ldc;
    __device__ __forceinline__ void operator()(const f32x4 (&acc)[2][2][4][2], const Unit& u, int wr, int wc, int fr, int fq) const {
        const int row0 = u.pm * BM + wr * 64 + fr, col0 = u.pn * BM + wc * 32 + 8 * fq;
#pragma unroll
        for (int ai = 0; ai < 2; ++ai)
#pragma unroll
            for (int m = 0; m < 4; ++m) { bf16_t* rowp = O + (size_t)(row0 + ai * HALF + m * 16) * ldc + col0;
#pragma unroll
                for (int bj = 0; bj < 2; ++bj) { const f32x4 v0 = acc[ai][bj][m][0], v1 = acc[ai][bj][m][1];
                    u32x4 w; w.x = cvt_pk_bf16(v0[0], v0[1]); w.y = cvt_pk_bf16(v0[2], v0[3]); w.z = cvt_pk_bf16(v1[0], v1[1]); w.w = cvt_pk_bf16(v1[2], v1[3]);
                    *(u32x4*)(rowp + bj * HALF) = w; } }
    }
};

struct EpiProjAY {
    static constexpr bool PERM = true, AFTER_DRAIN = false;
    bf16_t* PROJ; bf16_t* AY;
    __device__ __forceinline__ void operator()(const f32x4 (&acc)[2][2][4][2], const Unit& u, int wr, int wc, int fr, int fq) const {
        const int rowb = u.pm * BM + wr * 64, col0 = u.pn * BM + wc * 32 + 8 * fq;
#pragma unroll
        for (int bj = 0; bj < 2; ++bj) { const int col = col0 + bj * HALF; const bool ay = col < WSSM;
#pragma unroll
            for (int ai = 0; ai < 2; ++ai)
#pragma unroll
                for (int m = 0; m < 4; ++m) { const int rb = rowb + ai * HALF + m * 16;
                    bf16_t* dst = ay ? AY + ((size_t)((col >> 4) * 1024 + (rb >> 4)) * 512 + fr * 16 + (col & 15)) : PROJ + (size_t)(rb + fr) * DIN + col;
                    const f32x4 v0 = acc[ai][bj][m][0], v1 = acc[ai][bj][m][1];
                    u32x4 w; w.x = cvt_pk_bf16(v0[0], v0[1]); w.y = cvt_pk_bf16(v0[2], v0[3]); w.z = cvt_pk_bf16(v1[0], v1[1]); w.w = cvt_pk_bf16(v1[2], v1[3]);
                    *(u32x4*)dst = w; } }
    }
};
struct EpiSend {
    static constexpr bool PERM = false, AFTER_DRAIN = true;
    bf16_t* AY; const float* LAMT; const float* LAM512;
    __device__ __forceinline__ void fused(const f32x4 (&acc)[2][2][4][2], const Unit& u, int wr, int wc, int fr, int fq, LAS unsigned char* lds, int wid, int lane) const {
        LAS float* S = (LAS float*)lds;
        LAS float* E = (LAS float*)(lds + 131072);
#pragma unroll
        for (int ai = 0; ai < 2; ++ai)
#pragma unroll
            for (int m = 0; m < 4; ++m)
#pragma unroll
                for (int n = 0; n < 2; ++n) { const int r = ai * HALF + wr * 64 + m * 16 + fr, c = wc * 32 + n * 16 + 4 * fq; *(LAS f32x4*)(S + r * 128 + c) = acc[ai][0][m][n]; }
        __syncthreads();
        const int g = u.z, b = u.pm, p = lane, seg = wid;
        const float tr = LAMT[(g * NP + p) * 2], ti = LAMT[(g * NP + p) * 2 + 1], hr = LAM512[(g * NP + p) * 2], hi = LAM512[(g * NP + p) * 2 + 1];
        float sr = 0.f, si = 0.f;
        for (int i = 0; i < 32; ++i) { const int row = seg * 32 + i; const float xr = S[row * 128 + p], xi = S[row * 128 + 64 + p];
            const float nr = tr * sr - ti * si + xr, ni = tr * si + ti * sr + xi; sr = nr; si = ni; }
        E[seg * 128 + p] = sr; E[seg * 128 + 64 + p] = si;
        __syncthreads();
        sr = 0.f; si = 0.f;
        for (int s2 = 0; s2 < seg; ++s2) { const float xr = E[s2 * 128 + p], xi = E[s2 * 128 + 64 + p]; const float nr = hr * sr - hi * si + xr, ni = hr * si + hi * sr + xi; sr = nr; si = ni; }
        bf16_t* base = AY + ((size_t)(g * 1024 + b * 256 + seg * 32)) * 512 + 256 + p;
        for (int i = 0; i < 32; ++i) { const int row = seg * 32 + i;
            bf16_t* o = base + (size_t)i * 512;
            o[0] = (bf16_t)f2bf(sr); o[64] = (bf16_t)f2bf(si);
            const float xr = S[row * 128 + p], xi = S[row * 128 + 64 + p];
            const float nr = tr * sr - ti * si + xr, ni = tr * si + ti * sr + xi; sr = nr; si = ni; }
    }
};
struct EpiY {
    static constexpr bool PERM = true, AFTER_DRAIN = false;
    const bf16_t* AY; const float* ssm_d; bf16_t* GB;
    __device__ __forceinline__ void operator()(const f32x4 (&acc)[2][2][4][2], const Unit& u, int wr, int wc, int fr, int fq) const {
        const int g = u.z, b = u.pm;
#pragma unroll
        for (int bj = 0; bj < 2; ++bj) { const int col = bj * HALF + wc * 32 + 8 * fq, t = col >> 4, h0 = col & 15;
            const f32x4 d0 = *(const f32x4*)(ssm_d + g * GH + h0), d1 = *(const f32x4*)(ssm_d + g * GH + h0 + 4);
            u32x4 u8[2][4];
#pragma unroll
            for (int ai = 0; ai < 2; ++ai)
#pragma unroll
                for (int m = 0; m < 4; ++m) { const int crow = ai * HALF + wr * 64 + m * 16 + fr; u8[ai][m] = *(const u32x4*)(AY + ((size_t)(g * 1024 + b * 256 + crow)) * 512 + col); }
#pragma unroll
            for (int ai = 0; ai < 2; ++ai)
#pragma unroll
                for (int m = 0; m < 4; ++m) { const int crow = ai * HALF + wr * 64 + m * 16 + fr;
                    const u32x4 uu = u8[ai][m]; const f32x4 v0 = acc[ai][bj][m][0], v1 = acc[ai][bj][m][1];
                    u32x4 w;
                    w.x = cvt_pk_bf16(gelu_tanh(v0[0] + d0[0] * bflo(uu.x)), gelu_tanh(v0[1] + d0[1] * bfhi(uu.x)));
                    w.y = cvt_pk_bf16(gelu_tanh(v0[2] + d0[2] * bflo(uu.y)), gelu_tanh(v0[3] + d0[3] * bfhi(uu.y)));
                    w.z = cvt_pk_bf16(gelu_tanh(v1[0] + d1[0] * bflo(uu.z)), gelu_tanh(v1[1] + d1[1] * bfhi(uu.z)));
                    w.w = cvt_pk_bf16(gelu_tanh(v1[2] + d1[2] * bflo(uu.w)), gelu_tanh(v1[3] + d1[3] * bfhi(uu.w)));
                    *(u32x4*)(GB + ((size_t)(b * SEQ + crow * 16 + t)) * WSSM + g * GH + h0) = w; }
            asm volatile("" ::: "memory"); }
    }
};
struct EpiGluP {
    static constexpr bool PERM = true, AFTER_DRAIN = false;
    const bf16_t* GB; const bf16_t* PROJ; const float* b_glu; bf16_t* YCAT;
    __device__ __forceinline__ void operator()(const f32x4 (&acc)[2][2][4][2], const Unit& u, int wr, int wc, int fr, int fq) const {
        const int row0 = u.pm * BM + wr * 64 + fr, col0 = u.pn * BM + wc * 32 + 8 * fq;
#pragma unroll
        for (int bj = 0; bj < 2; ++bj) { const int col = col0 + bj * HALF; if (col >= WSSM) continue;
            const f32x4 b0 = *(const f32x4*)(b_glu + col), b1 = *(const f32x4*)(b_glu + col + 4);
#pragma unroll
            for (int ai = 0; ai < 2; ++ai) { if (ai != u.z) continue;
                u32x4 g8[4], a8[4];
#pragma unroll
                for (int m = 0; m < 4; ++m) { const size_t row = (size_t)(row0 + ai * HALF + m * 16); g8[m] = *(const u32x4*)(GB + row * WSSM + col); a8[m] = *(const u32x4*)(PROJ + row * DIN + C_AGATE + col); }
#pragma unroll
                for (int m = 0; m < 4; ++m) { const size_t row = (size_t)(row0 + ai * HALF + m * 16);
                    const f32x4 v0 = acc[ai][bj][m][0] + b0, v1 = acc[ai][bj][m][1] + b1;
                    u32x4 w;
                    w.x = cvt_pk_bf16(bflo(g8[m].x) * sigmoid_f(v0[0]) * silu_f(bflo(a8[m].x)), bfhi(g8[m].x) * sigmoid_f(v0[1]) * silu_f(bfhi(a8[m].x)));
                    w.y = cvt_pk_bf16(bflo(g8[m].y) * sigmoid_f(v0[2]) * silu_f(bflo(a8[m].y)), bfhi(g8[m].y) * sigmoid_f(v0[3]) * silu_f(bfhi(a8[m].y)));
                    w.z = cvt_pk_bf16(bflo(g8[m].z) * sigmoid_f(v1[0]) * silu_f(bflo(a8[m].z)), bfhi(g8[m].z) * sigmoid_f(v1[1]) * silu_f(bfhi(a8[m].z)));
                    w.w = cvt_pk_bf16(bflo(g8[m].w) * sigmoid_f(v1[2]) * silu_f(bflo(a8[m].w)), bfhi(g8[m].w) * sigmoid_f(v1[3]) * silu_f(bfhi(a8[m].w)));
                    *(u32x4*)(YCAT + row * DM + col) = w; }
                asm volatile("" ::: "memory"); } }
    }
};
struct EpiResF32 {
    static constexpr bool PERM = false, AFTER_DRAIN = false;
    const float* x; float* out;
    __device__ __forceinline__ void operator()(const f32x4 (&acc)[2][2][4][2], const Unit& u, int wr, int wc, int fr, int fq) const {
        const int row0 = u.pm * BM + wr * 64 + fr, col0 = u.pn * BM + wc * 32 + 4 * fq;
#pragma unroll
        for (int ai = 0; ai < 2; ++ai)
#pragma unroll
            for (int m = 0; m < 4; ++m) { const size_t off = (size_t)(row0 + ai * HALF + m * 16) * DM + col0;
#pragma unroll
                for (int bj = 0; bj < 2; ++bj)
#pragma unroll
                    for (int n = 0; n < 2; ++n) { const f32x4 xv = *(const f32x4*)(x + off + bj * HALF + n * 16); *(f32x4*)(out + off + bj * HALF + n * 16) = xv + acc[ai][bj][m][n]; }
                asm volatile("" ::: "memory"); }
    }
};

struct EpiOutNorm {
    static constexpr bool PERM = false, AFTER_DRAIN = true;
    const float* x; const float* fg; float* out; float* xch; unsigned* cnt;
    __device__ __forceinline__ void fused(f32x4 (&acc)[2][2][4][2], const Unit& u, int wr, int wc, int fr, int fq, LAS unsigned char* lds, int wid, int lane) const {
        LAS float* P = (LAS float*)lds;
        LAS float* S = (LAS float*)(lds + 8192);
        const int row0 = u.pm * BM + wr * 64 + fr, col0 = u.pn * BM + wc * 32 + 4 * fq;
#pragma unroll
        for (int ai = 0; ai < 2; ++ai) {
            f32x4 xv[4][2][2];
#pragma unroll
            for (int m = 0; m < 4; ++m) { const size_t off = (size_t)(row0 + ai * HALF + m * 16) * DM + col0;
#pragma unroll
                for (int bj = 0; bj < 2; ++bj)
#pragma unroll
                    for (int n = 0; n < 2; ++n) xv[m][bj][n] = *(const f32x4*)(x + off + bj * HALF + n * 16); }
#pragma unroll
            for (int m = 0; m < 4; ++m) { float sq = 0.f;
#pragma unroll
                for (int bj = 0; bj < 2; ++bj)
#pragma unroll
                    for (int n = 0; n < 2; ++n) { const f32x4 hv = acc[ai][bj][m][n] + xv[m][bj][n]; acc[ai][bj][m][n] = hv; sq += (hv[0] * hv[0] + hv[1] * hv[1]) + (hv[2] * hv[2] + hv[3] * hv[3]); }
                sq += __shfl_xor(sq, 16); sq += __shfl_xor(sq, 32);
                if (fq == 0) P[(ai * HALF + wr * 64 + m * 16 + fr) * 4 + wc] = sq; }
            asm volatile("" ::: "memory"); }
        asm volatile("s_waitcnt lgkmcnt(0)" ::: "memory"); __builtin_amdgcn_s_barrier(); asm volatile("" ::: "memory");
        const int row = wid * 32 + (lane & 31);
        if (lane < 32) { const f32x4 pv = *(const LAS f32x4*)(P + row * 4); const float t = (pv[0] + pv[1]) + (pv[2] + pv[3]);
            __hip_atomic_store(xch + ((size_t)(u.pm * BM + row) * 4 + u.pn), t, __ATOMIC_RELAXED, __HIP_MEMORY_SCOPE_AGENT); }
        asm volatile("s_waitcnt vmcnt(0)" ::: "memory");
        if (lane == 0) __hip_atomic_fetch_add(cnt + 64 * u.pm, 1u, __ATOMIC_RELAXED, __HIP_MEMORY_SCOPE_AGENT);
        if (wid == 0) { unsigned sp = 0;
            while ((unsigned)__builtin_amdgcn_readfirstlane(__hip_atomic_load(cnt + 64 * u.pm, __ATOMIC_RELAXED, __HIP_MEMORY_SCOPE_AGENT)) < 32u) { __builtin_amdgcn_s_sleep(2); if (++sp > (1u << 22)) break; }
            __builtin_amdgcn_fence(__ATOMIC_ACQUIRE, "agent"); }
        asm volatile("s_waitcnt vmcnt(0) lgkmcnt(0)" ::: "memory"); __builtin_amdgcn_s_barrier(); asm volatile("" ::: "memory");
        if (lane < 32) { const float* slot = xch + (size_t)(u.pm * BM + row) * 4; float t = 0.f;
#pragma unroll
            for (int q = 0; q < 4; ++q) t += __hip_atomic_load(slot + q, __ATOMIC_RELAXED, __HIP_MEMORY_SCOPE_AGENT);
            S[row] = 1.0f / sqrtf(t * (1.0f / DM) + NORM_EPS); }
        asm volatile("s_waitcnt lgkmcnt(0)" ::: "memory"); __builtin_amdgcn_s_barrier(); asm volatile("" ::: "memory");
        f32x4 gv[2][2];
#pragma unroll
        for (int bj = 0; bj < 2; ++bj)
#pragma unroll
            for (int n = 0; n < 2; ++n) gv[bj][n] = *(const f32x4*)(fg + col0 + bj * HALF + n * 16);
#pragma unroll
        for (int ai = 0; ai < 2; ++ai)
#pragma unroll
            for (int m = 0; m < 4; ++m) { const int r = ai * HALF + wr * 64 + m * 16 + fr; const float rs = S[r]; const size_t off = (size_t)(u.pm * BM + r) * DM + col0;
#pragma unroll
                for (int bj = 0; bj < 2; ++bj)
#pragma unroll
                    for (int n = 0; n < 2; ++n) *(f32x4*)(out + off + bj * HALF + n * 16) = acc[ai][bj][m][n] * rs * gv[bj][n]; }
    }
};
}

__device__ __forceinline__ void s5_naive(const Args& a, int b, int g, int lane) {
    const bf16_t* PROJ = (const bf16_t*)(a.ws + WS_PROJ); bf16_t* GB = (bf16_t*)(a.ws + WS_GB);
    const float* LAMB = (const float*)(a.ws + WS_LAMB); const float* BBAR = (const float*)(a.ws + WS_BBAR);
    const float* c_re = a.in[8]; const float* c_im = a.in[9]; const float* ssm_d = a.in[10];
    const int p = lane, h = lane & 15, pg = lane >> 4;
    const float lr = LAMB[(g * NP + p) * 2], li = LAMB[(g * NP + p) * 2 + 1];
    float bre[16], bim[16], cre[16], cim[16];
#pragma unroll
    for (int j = 0; j < 16; ++j) { bre[j] = BBAR[((g * NP + p) * GH + j) * 2]; bim[j] = BBAR[((g * NP + p) * GH + j) * 2 + 1];
        cre[j] = c_re[(g * GH + h) * NP + pg * 16 + j]; cim[j] = c_im[(g * GH + h) * NP + pg * 16 + j]; }
    const float dd = ssm_d[g * GH + h];
    float sr = 0.f, si = 0.f;
    for (int t = 0; t < SEQ; ++t) {
        const bf16_t* up = PROJ + (size_t)(b * SEQ + t) * DIN + C_AIN + g * GH;
        const v4u u0 = *(const v4u*)up, u1 = *(const v4u*)(up + 8);
        float u[16];
        u[0] = bflo(u0.x); u[1] = bfhi(u0.x); u[2] = bflo(u0.y); u[3] = bfhi(u0.y); u[4] = bflo(u0.z); u[5] = bfhi(u0.z); u[6] = bflo(u0.w); u[7] = bfhi(u0.w);
        u[8] = bflo(u1.x); u[9] = bfhi(u1.x); u[10] = bflo(u1.y); u[11] = bfhi(u1.y); u[12] = bflo(u1.z); u[13] = bfhi(u1.z); u[14] = bflo(u1.w); u[15] = bfhi(u1.w);
        const float uh = bf2f(up[h]);
        float bur = 0.f, bui = 0.f;
#pragma unroll
        for (int j = 0; j < 16; ++j) { bur += bre[j] * u[j]; bui += bim[j] * u[j]; }
        const float nsr = lr * sr - li * si + bur, nsi = lr * si + li * sr + bui;
        sr = nsr; si = nsi;
        float part = 0.f;
#pragma unroll
        for (int j = 0; j < 16; ++j) { const float xr = __shfl(sr, pg * 16 + j), xi = __shfl(si, pg * 16 + j); part += cre[j] * xr - cim[j] * xi; }
        part += __shfl_xor(part, 16); part += __shfl_xor(part, 32);
        const float y = part + dd * uh;
        if (lane < 16) GB[(size_t)(b * SEQ + t) * WSSM + g * GH + h] = (bf16_t)f2bf(gelu_tanh(y));
    }
}

__device__ __forceinline__ void conv_naive(const Args& a, int vb, int nvb) {
    const bf16_t* PROJ = (const bf16_t*)(a.ws + WS_PROJ); bf16_t* YCAT = (bf16_t*)(a.ws + WS_YCAT);
    const float* conv_w = a.in[14]; const float* conv_b = a.in[15];
    const int gt = vb * 512 + otid(), NT = nvb * 512;
    for (int idx = gt; idx < NTOK * WSSM; idx += NT) {
        const int tok = idx / WSSM, c = idx % WSSM, t = tok % SEQ;
        const bf16_t* row = PROJ + (size_t)tok * DIN;
        float acc = conv_b[c];
#pragma unroll
        for (int k = 0; k < 3; ++k) { const int tt = t - 2 + k; if (tt >= 0) { const bf16_t* r2 = PROJ + (size_t)(tok - 2 + k) * DIN; acc += conv_w[k * WSSM + c] * (bf2f(r2[C_CC + c]) * bf2f(r2[C_CIN + c])); } }
        const float y = bf2f(row[C_CB + c]) * acc * silu_f(bf2f(row[C_CGATE + c]));
        YCAT[(size_t)tok * DM + WSSM + c] = (bf16_t)f2bf(y);
    }
}
__device__ __forceinline__ void attn_naive(const Args& a, int vb, int nvb) {
    const bf16_t* PROJ = (const bf16_t*)(a.ws + WS_PROJ); bf16_t* YCAT = (bf16_t*)(a.ws + WS_YCAT); const bf16_t* KV = (const bf16_t*)(a.ws + WS_KV);
    const int gt = vb * 512 + otid(), NT = nvb * 512;
    for (int item = gt; item < NB * 4 * SEQ; item += NT) {
        const int t = item % SEQ, hh = (item / SEQ) % 4, b = item / (4 * SEQ), tok = b * SEQ + t;
        const v4u* qp = (const v4u*)(PROJ + (size_t)tok * DIN + C_Q + hh * 64);
        float q[64], o[64];
#pragma unroll
        for (int i = 0; i < 8; ++i) { const v4u v = qp[i]; q[8 * i] = bflo(v.x); q[8 * i + 1] = bfhi(v.x); q[8 * i + 2] = bflo(v.y); q[8 * i + 3] = bfhi(v.y); q[8 * i + 4] = bflo(v.z); q[8 * i + 5] = bfhi(v.z); q[8 * i + 6] = bflo(v.w); q[8 * i + 7] = bfhi(v.w); }
#pragma unroll
        for (int d = 0; d < 64; ++d) o[d] = 0.f;
        float m = -1e30f, l = 0.f;
        for (int mm = 0; mm < NMEM; ++mm) {
            const v4u* kp = (const v4u*)(KV + (size_t)(b * NMEM + mm) * 512 + hh * 64);
            const v4u* vp = (const v4u*)(KV + (size_t)(b * NMEM + mm) * 512 + 256 + hh * 64);
            float s = 0.f;
#pragma unroll
            for (int i = 0; i < 8; ++i) { const v4u v = kp[i];
                s += q[8 * i] * bflo(v.x) + q[8 * i + 1] * bfhi(v.x) + q[8 * i + 2] * bflo(v.y) + q[8 * i + 3] * bfhi(v.y) + q[8 * i + 4] * bflo(v.z) + q[8 * i + 5] * bfhi(v.z) + q[8 * i + 6] * bflo(v.w) + q[8 * i + 7] * bfhi(v.w); }
            s *= 0.125f;
            const float mn = fmaxf(m, s), sc = __expf(m - mn), pp = __expf(s - mn);
            l = l * sc + pp; m = mn;
#pragma unroll
            for (int i = 0; i < 8; ++i) { const v4u v = vp[i];
                o[8 * i] = o[8 * i] * sc + pp * bflo(v.x); o[8 * i + 1] = o[8 * i + 1] * sc + pp * bfhi(v.x); o[8 * i + 2] = o[8 * i + 2] * sc + pp * bflo(v.y); o[8 * i + 3] = o[8 * i + 3] * sc + pp * bfhi(v.y);
                o[8 * i + 4] = o[8 * i + 4] * sc + pp * bflo(v.z); o[8 * i + 5] = o[8 * i + 5] * sc + pp * bfhi(v.z); o[8 * i + 6] = o[8 * i + 6] * sc + pp * bflo(v.w); o[8 * i + 7] = o[8 * i + 7] * sc + pp * bfhi(v.w); }
        }
        const float inv = 1.0f / l;
        const v4u* gp = (const v4u*)(PROJ + (size_t)tok * DIN + C_QGATE + hh * 64);
        v4u* op = (v4u*)(YCAT + (size_t)tok * DM + 768 + hh * 64);
#pragma unroll
        for (int i = 0; i < 8; ++i) { const v4u gv = gp[i]; v4u w;
            w.x = pk2(o[8 * i] * inv * silu_f(bflo(gv.x)), o[8 * i + 1] * inv * silu_f(bfhi(gv.x)));
            w.y = pk2(o[8 * i + 2] * inv * silu_f(bflo(gv.y)), o[8 * i + 3] * inv * silu_f(bfhi(gv.y)));
            w.z = pk2(o[8 * i + 4] * inv * silu_f(bflo(gv.z)), o[8 * i + 5] * inv * silu_f(bfhi(gv.z)));
            w.w = pk2(o[8 * i + 6] * inv * silu_f(bflo(gv.w)), o[8 * i + 7] * inv * silu_f(bfhi(gv.w)));
            op[i] = w; }
    }
}

typedef short bf16x8_t __attribute__((ext_vector_type(8)));
typedef short s16x4_t __attribute__((ext_vector_type(4)));
typedef float f32x16 __attribute__((ext_vector_type(16)));
typedef __bf16 bf2_t __attribute__((ext_vector_type(2)));
typedef float f2_t __attribute__((ext_vector_type(2)));
typedef unsigned u32x2_t __attribute__((ext_vector_type(2)));
__device__ __forceinline__ unsigned cvt2(float lo, float hi) { const f2_t v = {lo, hi}; return __builtin_bit_cast(unsigned, __builtin_convertvector(v, bf2_t)); }
__device__ __forceinline__ void attn_mfma(const Args& a, LAS unsigned char* lds, int vb, int nvb) {
    const int nj = nvb / 16; if (nj < 1 || vb >= nj * 16) return;
    const int tid = otid(), lane = tid & 63, wave = tid >> 6, r = lane & 31, h = lane >> 5;
    const int bh = vb % 16, j = vb / 16, b = bh >> 2, head = bh & 3;
    const bf16_t* PROJ = (const bf16_t*)(a.ws + WS_PROJ); bf16_t* YCAT = (bf16_t*)(a.ws + WS_YCAT); const bf16_t* KV = (const bf16_t*)(a.ws + WS_KV);
    LAS unsigned char* Kl = lds;
    LAS unsigned char* Vl = lds + 36864;
    for (int c = tid; c < 2048; c += 512) { const int key = c >> 3, dch = c & 7;
        const bf16_t* src = KV + (size_t)(b * NMEM + key) * 512 + head * 64 + dch * 8;
        const v4u kv = *(const v4u*)src, vv = *(const v4u*)(src + 256);
        *(LAS v4u*)(Kl + key * 144 + dch * 16) = kv;
        LAS bf16_t* vd = (LAS bf16_t*)(Vl + (dch * 8) * 520 + key * 2);
        vd[0 * 260] = (bf16_t)(vv.x & 0xffff); vd[1 * 260] = (bf16_t)(vv.x >> 16); vd[2 * 260] = (bf16_t)(vv.y & 0xffff); vd[3 * 260] = (bf16_t)(vv.y >> 16);
        vd[4 * 260] = (bf16_t)(vv.z & 0xffff); vd[5 * 260] = (bf16_t)(vv.z >> 16); vd[6 * 260] = (bf16_t)(vv.w & 0xffff); vd[7 * 260] = (bf16_t)(vv.w >> 16); }
    __syncthreads();
    for (int tile = j * 8 + wave; tile < SEQ / 32; tile += nj * 8) {
        const size_t tok = (size_t)b * SEQ + tile * 32 + r;
        bf16x8_t qf[4];
#pragma unroll
        for (int s4 = 0; s4 < 4; ++s4) qf[s4] = *(const bf16x8_t*)(PROJ + tok * DIN + C_Q + head * 64 + 16 * s4 + 8 * h);
        const float sc = 0.125f * 1.4426950408889634f;
        float mx = -3.0e38f, l = 0.f;
        f32x16 o0, o1;
#pragma unroll
        for (int i = 0; i < 16; ++i) { o0[i] = 0.f; o1[i] = 0.f; }
#pragma unroll 2
        for (int kt = 0; kt < 8; ++kt) {
            f32x16 st;
#pragma unroll
            for (int i = 0; i < 16; ++i) st[i] = 0.f;
#pragma unroll
            for (int s4 = 0; s4 < 4; ++s4) { const bf16x8_t kf = *(const LAS bf16x8_t*)(Kl + (kt * 32 + r) * 144 + (16 * s4 + 8 * h) * 2);
                st = __builtin_amdgcn_mfma_f32_32x32x16_bf16(kf, qf[s4], st, 0, 0, 0); }
            float tm = st[0];
#pragma unroll
            for (int i = 1; i < 16; ++i) tm = fmaxf(tm, st[i]);
            tm = fmaxf(tm, __shfl_xor(tm, 32));
            const float mn = fmaxf(mx, tm), alpha = __builtin_amdgcn_exp2f((mx - mn) * sc), mb = mn * sc;
            mx = mn; l *= alpha;
#pragma unroll
            for (int i = 0; i < 16; ++i) { o0[i] *= alpha; o1[i] *= alpha; }
#pragma unroll
            for (int i = 0; i < 16; ++i) { const float p = __builtin_amdgcn_exp2f(st[i] * sc - mb); st[i] = p; l += p; }
#pragma unroll
            for (int s2 = 0; s2 < 2; ++s2) {
                v4u pw; pw.x = cvt2(st[8 * s2 + 0], st[8 * s2 + 1]); pw.y = cvt2(st[8 * s2 + 2], st[8 * s2 + 3]);
                pw.z = cvt2(st[8 * s2 + 4], st[8 * s2 + 5]); pw.w = cvt2(st[8 * s2 + 6], st[8 * s2 + 7]);
                const bf16x8_t pf = __builtin_bit_cast(bf16x8_t, pw);
                const int koff = (kt * 32 + 16 * s2 + 4 * h) * 2;
                { const s16x4_t lo = *(const LAS s16x4_t*)(Vl + r * 520 + koff), hi = *(const LAS s16x4_t*)(Vl + r * 520 + koff + 16);
                  const bf16x8_t vf = __builtin_shufflevector(lo, hi, 0, 1, 2, 3, 4, 5, 6, 7); o0 = __builtin_amdgcn_mfma_f32_32x32x16_bf16(vf, pf, o0, 0, 0, 0); }
                { const s16x4_t lo = *(const LAS s16x4_t*)(Vl + (32 + r) * 520 + koff), hi = *(const LAS s16x4_t*)(Vl + (32 + r) * 520 + koff + 16);
                  const bf16x8_t vf = __builtin_shufflevector(lo, hi, 0, 1, 2, 3, 4, 5, 6, 7); o1 = __builtin_amdgcn_mfma_f32_32x32x16_bf16(vf, pf, o1, 0, 0, 0); }
            }
        }
        l += __shfl_xor(l, 32);
        const float inv = 1.0f / l;
        const bf16_t* gp = PROJ + tok * DIN + C_QGATE + head * 64; bf16_t* op = YCAT + tok * DM + 768 + head * 64;
#pragma unroll
        for (int q4 = 0; q4 < 4; ++q4) {
            { const int d = 8 * q4 + 4 * h; const u32x2_t gv = *(const u32x2_t*)(gp + d); u32x2_t w;
              w.x = cvt2(o0[4 * q4 + 0] * inv * silu_f(bflo(gv.x)), o0[4 * q4 + 1] * inv * silu_f(bfhi(gv.x))); w.y = cvt2(o0[4 * q4 + 2] * inv * silu_f(bflo(gv.y)), o0[4 * q4 + 3] * inv * silu_f(bfhi(gv.y)));
              *(u32x2_t*)(op + d) = w; }
            { const int d = 32 + 8 * q4 + 4 * h; const u32x2_t gv = *(const u32x2_t*)(gp + d); u32x2_t w;
              w.x = cvt2(o1[4 * q4 + 0] * inv * silu_f(bflo(gv.x)), o1[4 * q4 + 1] * inv * silu_f(bfhi(gv.x))); w.y = cvt2(o1[4 * q4 + 2] * inv * silu_f(bflo(gv.y)), o1[4 * q4 + 3] * inv * silu_f(bfhi(gv.y)));
              *(u32x2_t*)(op + d) = w; }
        }
    }
}
__device__ __forceinline__ void conv_vec(const Args& a, int vb, int nvb) {
    const bf16_t* PROJ = (const bf16_t*)(a.ws + WS_PROJ); bf16_t* YCAT = (bf16_t*)(a.ws + WS_YCAT);
    const float* conv_w = a.in[14]; const float* conv_b = a.in[15];
    const int gt = vb * 512 + otid(), NT = nvb * 512;
    for (int it = gt; it < (NTOK / 4) * 48; it += NT) {
        const int tg = it / 48, c0 = (it % 48) * 8, tok0 = tg * 4, t0 = tok0 % SEQ;
        const bf16_t* row0 = PROJ + (size_t)tok0 * DIN;
        v4u cc[6], ci[6], cb[4], cg[4];
#pragma unroll
        for (int r = 0; r < 6; ++r) { const bool ok = (t0 + r - 2) >= 0; const bf16_t* rp = row0 + (ptrdiff_t)(r - 2) * DIN;
            cc[r] = ok ? *(const v4u*)(rp + C_CC + c0) : (v4u){0u, 0u, 0u, 0u}; ci[r] = ok ? *(const v4u*)(rp + C_CIN + c0) : (v4u){0u, 0u, 0u, 0u}; }
#pragma unroll
        for (int j = 0; j < 4; ++j) { cb[j] = *(const v4u*)(row0 + (size_t)j * DIN + C_CB + c0); cg[j] = *(const v4u*)(row0 + (size_t)j * DIN + C_CGATE + c0); }
        float w[3][8], bb[8];
#pragma unroll
        for (int k = 0; k < 3; ++k) { const f32x4 w0 = *(const f32x4*)(conv_w + k * WSSM + c0), w1 = *(const f32x4*)(conv_w + k * WSSM + c0 + 4);
            w[k][0] = w0.x; w[k][1] = w0.y; w[k][2] = w0.z; w[k][3] = w0.w; w[k][4] = w1.x; w[k][5] = w1.y; w[k][6] = w1.z; w[k][7] = w1.w; }
        { const f32x4 b0 = *(const f32x4*)(conv_b + c0), b1 = *(const f32x4*)(conv_b + c0 + 4); bb[0] = b0.x; bb[1] = b0.y; bb[2] = b0.z; bb[3] = b0.w; bb[4] = b1.x; bb[5] = b1.y; bb[6] = b1.z; bb[7] = b1.w; }
        float u[6][8];
#pragma unroll
        for (int r = 0; r < 6; ++r) { u[r][0] = bflo(cc[r].x) * bflo(ci[r].x); u[r][1] = bfhi(cc[r].x) * bfhi(ci[r].x); u[r][2] = bflo(cc[r].y) * bflo(ci[r].y); u[r][3] = bfhi(cc[r].y) * bfhi(ci[r].y);
            u[r][4] = bflo(cc[r].z) * bflo(ci[r].z); u[r][5] = bfhi(cc[r].z) * bfhi(ci[r].z); u[r][6] = bflo(cc[r].w) * bflo(ci[r].w); u[r][7] = bfhi(cc[r].w) * bfhi(ci[r].w); }
#pragma unroll
        for (int j = 0; j < 4; ++j) { float y[8];
#pragma unroll
            for (int e = 0; e < 8; ++e) y[e] = bb[e] + w[0][e] * u[j][e] + w[1][e] * u[j + 1][e] + w[2][e] * u[j + 2][e];
            v4u o;
            o.x = cvt2(bflo(cb[j].x) * y[0] * silu_f(bflo(cg[j].x)), bfhi(cb[j].x) * y[1] * silu_f(bfhi(cg[j].x)));
            o.y = cvt2(bflo(cb[j].y) * y[2] * silu_f(bflo(cg[j].y)), bfhi(cb[j].y) * y[3] * silu_f(bfhi(cg[j].y)));
            o.z = cvt2(bflo(cb[j].z) * y[4] * silu_f(bflo(cg[j].z)), bfhi(cb[j].z) * y[5] * silu_f(bfhi(cg[j].z)));
            o.w = cvt2(bflo(cb[j].w) * y[6] * silu_f(bflo(cg[j].w)), bfhi(cb[j].w) * y[7] * silu_f(bfhi(cg[j].w)));
            *(v4u*)(YCAT + (size_t)(tok0 + j) * DM + WSSM + c0) = o; }
    }
}
__device__ __forceinline__ void final_norm(const Args& a) {
    const int tid = otid(), lane = tid & 63, gw = blockIdx.x * 8 + (tid >> 6), NGW = gridDim.x * 8;
    const float* fg = a.in[19];
    for (int r = gw; r < NTOK; r += NGW) {
        f32x4* xr = (f32x4*)(a.out + (size_t)r * DM) + lane;
        f32x4 v[4]; float s = 0.f;
#pragma unroll
        for (int j = 0; j < 4; ++j) { v[j] = xr[64 * j]; s += (v[j].x * v[j].x + v[j].y * v[j].y) + (v[j].z * v[j].z + v[j].w * v[j].w); }
        const float rstd = 1.0f / sqrtf(wave_sum(s) * (1.0f / DM) + NORM_EPS);
#pragma unroll
        for (int j = 0; j < 4; ++j) { const f32x4 g = ((const f32x4*)fg)[lane + 64 * j]; xr[64 * j] = v[j] * rstd * g; }
    }
}

__global__ void __launch_bounds__(512, 2) mega(Args a) {
    extern __shared__ __attribute__((aligned(16))) unsigned char smem_raw[];
    LAS unsigned char* lds = (LAS unsigned char*)smem_raw;
    cg::grid_group grid = cg::this_grid();
    volatile LAS unsigned* xst = (volatile LAS unsigned*)(lds + 139264);
    if (threadIdx.x == 0) { xst[0] = 0u; xst[1] = 0u; }
    __syncthreads();
    const XcdBarrier xbar = xcd_barrier_post((unsigned*)(a.ws + WS_CTL), xst);
    const int bid = blockIdx.x, G = gridDim.x;
    bf16_t* XB = (bf16_t*)(a.ws + WS_XB); bf16_t* MEMN = (bf16_t*)(a.ws + WS_MEMN);
    bf16_t* WINT = (bf16_t*)(a.ws + WS_WINT); bf16_t* WKVT = (bf16_t*)(a.ws + WS_WKVT); bf16_t* WOUTT = (bf16_t*)(a.ws + WS_WOUTT); bf16_t* WGLUT = (bf16_t*)(a.ws + WS_WGLUT);
    bf16_t* PROJ = (bf16_t*)(a.ws + WS_PROJ); bf16_t* KV = (bf16_t*)(a.ws + WS_KV); bf16_t* GB = (bf16_t*)(a.ws + WS_GB); bf16_t* YCAT = (bf16_t*)(a.ws + WS_YCAT);
    bf16_t* AY = (bf16_t*)(a.ws + WS_AY); bf16_t* WSb = (bf16_t*)(a.ws + WS_WS); bf16_t* WYb = (bf16_t*)(a.ws + WS_WY);

#ifndef PROBE_DUP
#define PROBE_DUP -1
#endif
#define REPS(k) for (int rep_ = 0; rep_ < ((PROBE_DUP == (k)) ? 2 : 1); ++rep_)
#ifndef PROBE_SUB
#define PROBE_SUB -1
#endif
    if (a.out == nullptr) grid.sync();
    REPS(0) { phase0(a, lds);
    xcd_barrier(xbar); }
    REPS(1) {
    { pg8::Order S; S.init(NTOK / 256, DIN / 256, 1, G, bid);
      pg8::gemm_phase(lds, pg8::Gemm{XB, WINT, DM, DM, DM, 0, 0}, S, pg8::EpiProjAY{PROJ, AY}); }
    { pg8::Order S; S.init(NB * NMEM / 256, 512 / 256, 1, G, (bid + G - ((NTOK / 256) * (DIN / 256)) % G) % G);
      pg8::gemm_phase(lds, pg8::Gemm{MEMN, WKVT, DM, DM, DM, 0, 0}, S, pg8::EpiBf16Store{KV, 512}); }
    xcd_barrier(xbar); }
    REPS(2) {
    if (bid < NB * NG) { pg8::Order S; S.init(NB, 1, NG, G, bid);
      pg8::gemm_phase(lds, pg8::Gemm{AY, WSb, 512, 256, 256, (size_t)1024 * 512, (size_t)256 * 256}, S, pg8::EpiSend{AY, (const float*)(a.ws + WS_LAMT), (const float*)(a.ws + WS_LAM512)});
      asm volatile("s_waitcnt vmcnt(0)" ::: "memory"); __syncthreads();
      pg8::gemm_phase(lds, pg8::Gemm{AY, WYb, 512, 512, 384, (size_t)1024 * 512, (size_t)256 * 512}, S, pg8::EpiY{AY, a.in[10], GB}); }
    else { attn_mfma(a, lds, bid - NB * NG, G - NB * NG); conv_vec(a, bid - NB * NG, G - NB * NG); }
    xcd_barrier(xbar); }
    REPS(4) {
    { pg8::Order S; S.init(NTOK / 256, 2, 2, G, bid);
      pg8::gemm_phase(lds, pg8::Gemm{GB, WGLUT, WSSM, WSSM, WSSM, 0, 0}, S, pg8::EpiGluP{GB, PROJ, a.in[13], YCAT}); }
    xcd_barrier(xbar); }
    REPS(5) {
    { pg8::Order S; S.init(NTOK / 256, DM / 256, 1, G, bid);
      pg8::gemm_phase(lds, pg8::Gemm{YCAT, WOUTT, DM, DM, DM, 0, 0}, S, pg8::EpiOutNorm{a.in[0], a.in[19], a.out, (float*)(a.ws + WS_XCH), (unsigned*)(a.ws + WS_CTL + CTL_PANEL)}); }
    }
}

extern "C" void kernel_launch(void* const* d_in, const int* in_sizes, int n_in, void* d_out, int out_size, void* d_ws, size_t ws_size, hipStream_t stream) {
    static int grid = 0;
    if (grid == 0) {
        if (n_in != 20 || out_size != NTOK * DM || ws_size < WS_END) { fprintf(stderr, "kernel_launch: unexpected shapes n_in %d out %d ws %zu\n", n_in, out_size, ws_size); grid = -1; return; }
        int dev = 0, cus = 0, per_cu = 0;
        hipGetDevice(&dev);
        hipDeviceGetAttribute(&cus, hipDeviceAttributeMultiprocessorCount, dev);
        if (hipFuncSetAttribute((const void*)mega, hipFuncAttributeMaxDynamicSharedMemorySize, LDS_BYTES) != hipSuccess) { fprintf(stderr, "kernel_launch: hipFuncSetAttribute failed\n"); grid = -1; return; }
        if (hipOccupancyMaxActiveBlocksPerMultiprocessor(&per_cu, (const void*)mega, 512, LDS_BYTES) != hipSuccess || per_cu < 1) { fprintf(stderr, "kernel_launch: occupancy query says %d\n", per_cu); per_cu = 1; }
        (void)hipGetLastError();
        grid = cus;
        if (grid < NB * NG) { fprintf(stderr, "kernel_launch: grid %d too small\n", grid); grid = -1; return; }
    }
    if (grid < 0) return;
    if (hipMemsetAsync((char*)d_ws + WS_CTL, 0, CTL_BYTES, stream) != hipSuccess) { fprintf(stderr, "kernel_launch: memset failed\n"); return; }
    Args a{};
    for (int i = 0; i < 20; ++i) a.in[i] = (const float*)d_in[i];
    a.out = (float*)d_out; a.ws = (unsigned char*)d_ws;
    void* args[] = {&a};
    hipError_t e = hipLaunchCooperativeKernel((const void*)mega, dim3(grid), dim3(512), args, LDS_BYTES, stream);
    if (e != hipSuccess) fprintf(stderr, "cooperative launch failed: %s (grid %d)\n", hipGetErrorString(e), grid);
}
```

```cpp
#include <hip/hip_runtime.h>
#include <hip/hip_cooperative_groups.h>
#include <cstdio>
#include <cstdint>
namespace cg = cooperative_groups;

#define LAS __attribute__((address_space(3)))
typedef unsigned short bf16_t;
typedef unsigned v4u __attribute__((ext_vector_type(4)));
typedef float f32x4 __attribute__((ext_vector_type(4)));

constexpr int NB = 4, SEQ = 4096, DM = 1024, NTOK = NB * SEQ, DIN = 2816, WSSM = 384, NG = 24, GH = 16, NP = 64, NMEM = 256;
constexpr int C_AIN = 0, C_AGATE = 384, C_CIN = 768, C_CB = 1152, C_CC = 1536, C_CGATE = 1920, C_Q = 2304, C_QGATE = 2560;
constexpr float NORM_EPS = 1e-6f;

constexpr size_t MiB = 1u << 20;
constexpr size_t WS_CTL = 0;
constexpr size_t WS_XB = 1 * MiB;
constexpr size_t WS_WINT = 33 * MiB;
constexpr size_t WS_WKVT = 39 * MiB;
constexpr size_t WS_WOUTT = 40 * MiB;
constexpr size_t WS_WGLUT = 42 * MiB;
constexpr size_t WS_MEMN = 43 * MiB;
constexpr size_t WS_KV = 45 * MiB;
constexpr size_t WS_LAMB = 46 * MiB;
constexpr size_t WS_BBAR = 46 * MiB + 65536;
constexpr size_t WS_GB = 47 * MiB;
constexpr size_t WS_PROJ = 59 * MiB;
constexpr size_t WS_YCAT = 147 * MiB;
constexpr size_t WS_AY = 179 * MiB;
constexpr size_t WS_WS = 203 * MiB;
constexpr size_t WS_WY = 206 * MiB;
constexpr size_t WS_LAMT = 212 * MiB;
constexpr size_t WS_LAM512 = 212 * MiB + 65536;
constexpr size_t WS_XCH = 213 * MiB;
constexpr size_t WS_END = 214 * MiB;
constexpr size_t CTL_PANEL = 16384;
constexpr size_t CTL_BYTES = 32768;
constexpr int CTL_EXIT_WORD = 3968, CTL_FLAG_WORD = 8192 + 64;
constexpr unsigned CTL_TOKEN = 0x600DF00Du, CTL_RESET = 0x0BADF00Du;

constexpr int LDS_BYTES = 147456;

struct Args {
    const float* in[20];
    float* out;
    unsigned char* ws;
};

__device__ __forceinline__ unsigned f2bf(float f) { unsigned u = __builtin_bit_cast(unsigned, f); return (u + 0x7fffu + ((u >> 16) & 1u)) >> 16; }
__device__ __forceinline__ unsigned pk2(float lo, float hi) { return f2bf(lo) | (f2bf(hi) << 16); }
__device__ __forceinline__ float bf2f(unsigned short b) { return __builtin_bit_cast(float, ((unsigned)b) << 16); }
__device__ __forceinline__ float bflo(unsigned w) { return __builtin_bit_cast(float, w << 16); }
__device__ __forceinline__ float bfhi(unsigned w) { return __builtin_bit_cast(float, w & 0xffff0000u); }
__device__ __forceinline__ float wave_sum(float v) {
#pragma unroll
    for (int o = 1; o < 64; o <<= 1) v += __shfl_xor(v, o);
    return v;
}
__device__ __forceinline__ float silu_f(float v) { return v * __builtin_amdgcn_rcpf(1.0f + __builtin_amdgcn_exp2f(-1.4426950408889634f * v)); }
__device__ __forceinline__ float sigmoid_f(float v) { return __builtin_amdgcn_rcpf(1.0f + __builtin_amdgcn_exp2f(-1.4426950408889634f * v)); }
__device__ __forceinline__ float gelu_tanh(float v) { const float w = __builtin_fmaf(v * v, -0.10294324f, -2.3022082f); return v * __builtin_amdgcn_rcpf(1.0f + __builtin_amdgcn_exp2f(v * w)); }
#define LDS_WAIT() asm volatile("s_waitcnt lgkmcnt(0)" ::: "memory")
__device__ __forceinline__ int otid() { int t = threadIdx.x; asm volatile("" : "+v"(t)); return t; }

#define XB_TMO      128
#define XB_XCNT(j)  (256  + 64 * (j))
#define XB_XSUB(j)  (1280 + 64 * (j))
#define XB_XGEN(j)  (2304 + 64 * (j))
#define XB_TOP      3328
#define XB_TOPGEN   3392
#define XCD_BAR_WORDS 3456
#define XB_SPIN_CAP (1u << 18)

__device__ __forceinline__ unsigned xb_ld(unsigned* p)              { return __hip_atomic_load(p, __ATOMIC_RELAXED, __HIP_MEMORY_SCOPE_AGENT); }
__device__ __forceinline__ unsigned xb_add(unsigned* p, unsigned v) { return __hip_atomic_fetch_add(p, v, __ATOMIC_RELAXED, __HIP_MEMORY_SCOPE_AGENT); }
__device__ __forceinline__ unsigned xb_xcc_id() { return (unsigned)__builtin_amdgcn_s_getreg((3 << 11) | 20) & 0xFu; }
#define XB_SPIN(cond, bar) do { unsigned _sp = 0; while (cond) { __builtin_amdgcn_s_sleep(1); \
    if ((++_sp & 255u) == 0u) { if (xb_ld(&(bar)[XB_TMO])) break; if (_sp > XB_SPIN_CAP) { atomicAdd(&(bar)[XB_TMO], 1u); break; } } } } while (0)

struct XcdBarrier {
    unsigned* bar; unsigned x;
    volatile LAS unsigned* st;
};

__device__ __forceinline__ XcdBarrier xcd_barrier_post(unsigned* bar, volatile LAS unsigned* st) {
    XcdBarrier b; b.bar = bar; b.x = xb_xcc_id(); b.st = st;
    if (threadIdx.x == 0) (void)xb_add(&bar[XB_XCNT(b.x)], 1u);
    return b;
}
__device__ __forceinline__ void xcd_barrier_complete(unsigned* bar, unsigned x, unsigned& nloc, unsigned& nx) {
    const unsigned G = gridDim.x * gridDim.y * gridDim.z;
    unsigned sum, cnt, mine, sp = 0u;
    for (;;) {
        sum = 0u; cnt = 0u; mine = 0u;
#pragma unroll
        for (unsigned j = 0; j < 16; ++j) { const unsigned c = xb_ld(&bar[XB_XCNT(j)]); sum += c; cnt += (c > 0u) ? 1u : 0u; mine = (j == x) ? c : mine; }
        if (sum == G) break;
        __builtin_amdgcn_s_sleep(1);
        if ((++sp & 255u) == 0u) { if (xb_ld(&bar[XB_TMO])) break; if (sp > XB_SPIN_CAP) { atomicAdd(&bar[XB_TMO], 1u); break; } }
    }
    nloc = mine > 0u ? mine : 1u; nx = cnt > 0u ? cnt : 1u;
}

__device__ __forceinline__ void xcd_barrier(const XcdBarrier& b) {
    asm volatile("s_waitcnt vmcnt(0)" ::: "memory");
    __syncthreads();
    if (threadIdx.x == 0) {
        unsigned* bar = b.bar;
        __builtin_amdgcn_s_waitcnt(0);
        unsigned nloc = b.st[0], nx = b.st[1];
        if (nloc == 0u) { xcd_barrier_complete(bar, b.x, nloc, nx); b.st[0] = nloc; b.st[1] = nx; }
        const unsigned old = xb_add(&bar[XB_XSUB(b.x)], 1u);
        const unsigned gen = old / nloc;
        if (old + 1u == (gen + 1u) * nloc) {
            __builtin_amdgcn_fence(__ATOMIC_RELEASE, "agent");
            asm volatile("s_waitcnt vmcnt(0)" ::: "memory");
            const unsigned og = xb_add(&bar[XB_TOP], 1u);
            const unsigned tg = og / nx;
            if (og + 1u == (tg + 1u) * nx) xb_add(&bar[XB_TOPGEN], 1u);
            else XB_SPIN(xb_ld(&bar[XB_TOPGEN]) == tg, bar);
            __builtin_amdgcn_fence(__ATOMIC_ACQUIRE, "agent");
            xb_add(&bar[XB_XGEN(b.x)], 1u);
            asm volatile("s_waitcnt vmcnt(0)" ::: "memory");
        } else {
            XB_SPIN(xb_ld(&bar[XB_XGEN(b.x)]) == gen, bar);
            __builtin_amdgcn_fence(__ATOMIC_ACQUIRE, "agent");
            asm volatile("s_waitcnt vmcnt(0)" ::: "memory");
        }
    }
    __syncthreads();
}

__device__ __forceinline__ void rms_row_to_bf16(const float* xrow, bf16_t* orow, const float* gain, int lane) {
    const f32x4* xr = (const f32x4*)xrow + lane;
    f32x4 v[4]; float s = 0.f;
#pragma unroll
    for (int j = 0; j < 4; ++j) { v[j] = xr[64 * j]; s += (v[j].x * v[j].x + v[j].y * v[j].y) + (v[j].z * v[j].z + v[j].w * v[j].w); }
    const float rstd = 1.0f / sqrtf(wave_sum(s) * (1.0f / DM) + NORM_EPS);
    unsigned long long* o8 = (unsigned long long*)orow + lane;
#pragma unroll
    for (int j = 0; j < 4; ++j) {
        f32x4 g = gain ? ((const f32x4*)gain)[lane + 64 * j] : (f32x4){1.f, 1.f, 1.f, 1.f};
        o8[64 * j] = (unsigned long long)pk2(v[j].x * rstd * g.x, v[j].y * rstd * g.y) | ((unsigned long long)pk2(v[j].z * rstd * g.z, v[j].w * rstd * g.w) << 32);
    }
}
__device__ __forceinline__ void transpose_item(const float* W, int K, int N, bf16_t* WT, const float* ks, LAS float* scr, int item, int lane) {
    const int nblk = N / 32, kb = item / nblk, nb = item % nblk, k0 = 64 * kb, n0 = 32 * nb;
#pragma unroll 8
    for (int i = 0; i < 32; ++i) { const int kk = 2 * i + (lane >> 5); float w = W[(size_t)(k0 + kk) * N + n0 + (lane & 31)]; if (ks) w *= ks[k0 + kk]; scr[kk * 33 + (lane & 31)] = w; }
    LDS_WAIT();
    const int c = lane & 7;
#pragma unroll
    for (int j = 0; j < 4; ++j) { const int n = (lane >> 3) + 8 * j; const LAS float* s = scr + (8 * c) * 33 + n;
        v4u o; o.x = pk2(s[0 * 33], s[1 * 33]); o.y = pk2(s[2 * 33], s[3 * 33]); o.z = pk2(s[4 * 33], s[5 * 33]); o.w = pk2(s[6 * 33], s[7 * 33]);
        *(v4u*)(WT + (size_t)(n0 + n) * K + k0 + 8 * c) = o; }
    LDS_WAIT();
}


__device__ __forceinline__ void s5_tables(const Args& a, LAS unsigned char* lds, int tid) {
    const int bid = blockIdx.x; if (bid >= 192) return;
    const int g = bid % NG, q = bid / NG;
    const float* lam_re = a.in[4]; const float* lam_im = a.in[5]; const float* b_re = a.in[6]; const float* b_im = a.in[7]; const float* c_re = a.in[8]; const float* c_im = a.in[9]; const float* log_dt = a.in[11];
    LAS float* LPr = (LAS float*)(lds + 69632); LAS float* LPi = LPr + 17 * 64; LAS float* BBr = LPi + 17 * 64; LAS float* BBi = BBr + 1024;
    LAS float* Cr = BBi + 1024; LAS float* Ci = Cr + 1024; LAS float* KT = Ci + 1024;
    if (tid < 64) {
        const int p = tid, i = g * NP + p;
        const double dt = exp((double)log_dt[g]);
        const double lr = lam_re[i], li = lam_im[i];
        const double er = exp(lr * dt), ang = li * dt;
        const double lbr = er * cos(ang), lbi = er * sin(ang);
        const double nr = lbr - 1.0, ni = lbi, den = lr * lr + li * li;
        const double qr = (nr * lr + ni * li) / den, qi = (ni * lr - nr * li) / den;
        for (int h = 0; h < GH; ++h) { const double br = b_re[i * GH + h], bi = b_im[i * GH + h];
            BBr[p * 16 + h] = (float)(qr * br - qi * bi); BBi[p * 16 + h] = (float)(qr * bi + qi * br); }
        double pr = 1.0, pi = 0.0;
        for (int t = 0; t < 16; ++t) { LPr[t * 64 + p] = (float)pr; LPi[t * 64 + p] = (float)pi; const double nr2 = pr * lbr - pi * lbi, ni2 = pr * lbi + pi * lbr; pr = nr2; pi = ni2; }
        LPr[16 * 64 + p] = (float)pr; LPi[16 * 64 + p] = (float)pi;
        double tr = pr, ti = pi;
        if (q == 0) { float* LAMT = (float*)(a.ws + WS_LAMT); LAMT[2 * i] = (float)tr; LAMT[2 * i + 1] = (float)ti; }
        for (int k = 0; k < 5; ++k) { const double nr2 = tr * tr - ti * ti, ni2 = 2.0 * tr * ti; tr = nr2; ti = ni2; }
        if (q == 0) { float* L512 = (float*)(a.ws + WS_LAM512); L512[2 * i] = (float)tr; L512[2 * i + 1] = (float)ti; }
    }
    for (int i = tid; i < 1024; i += 512) { Cr[i] = c_re[g * 1024 + i]; Ci[i] = c_im[g * 1024 + i]; }
    __syncthreads();
    { const int tau = tid >> 5, hol = (tid >> 4) & 1, hi = tid & 15, ho = 2 * q + hol; float sacc = 0.f;
#pragma unroll 4
      for (int p = 0; p < 64; ++p) { const float lpr = LPr[tau * 64 + p], lpi = LPi[tau * 64 + p], br = BBr[p * 16 + hi], bi = BBi[p * 16 + hi];
          const float wr_ = lpr * br - lpi * bi, wi_ = lpr * bi + lpi * br; sacc += Cr[ho * 64 + p] * wr_ - Ci[ho * 64 + p] * wi_; }
      KT[tid] = sacc; }
    __syncthreads();
    bf16_t* WSb = (bf16_t*)(a.ws + WS_WS); bf16_t* WYb = (bf16_t*)(a.ws + WS_WY);
#pragma unroll
    for (int kk = 0; kk < 2; ++kk) { const int ch = tid + 512 * kk, n = 32 * q + (ch >> 5), k0 = (ch & 31) * 8, p = n & 63, isim = (n >> 6) & 1;
        float v[8];
#pragma unroll
        for (int j = 0; j < 8; ++j) { const int k = k0 + j, t = k >> 4, h = k & 15, tau = 15 - t; const float lpr = LPr[tau * 64 + p], lpi = LPi[tau * 64 + p], br = BBr[p * 16 + h], bi = BBi[p * 16 + h];
            const float val = isim ? (lpr * bi + lpi * br) : (lpr * br - lpi * bi); v[j] = n < 128 ? val : 0.f; }
        v4u o; o.x = pk2(v[0], v[1]); o.y = pk2(v[2], v[3]); o.z = pk2(v[4], v[5]); o.w = pk2(v[6], v[7]);
        *(v4u*)(WSb + ((size_t)(g * 256 + n)) * 256 + k0) = o; }
#pragma unroll
    for (int kk = 0; kk < 4; ++kk) { const int ch = tid + 512 * kk, rr = ch >> 6, to = rr >> 1, hol = rr & 1, ho = 2 * q + hol, n = to * 16 + ho, k0 = (ch & 63) * 8;
        float v[8];
#pragma unroll
        for (int j = 0; j < 8; ++j) { const int k = k0 + j; float val;
            if (k < 256) { const int ti = k >> 4, hi = k & 15; val = ti <= to ? KT[((to - ti) * 2 + hol) * 16 + hi] : 0.f; }
            else { const int jj = (k - 256) & 127, p = jj & 63, isim = jj >> 6; const float lpr = LPr[(to + 1) * 64 + p], lpi = LPi[(to + 1) * 64 + p], cr = Cr[ho * 64 + p], ci = Ci[ho * 64 + p];
                val = isim ? -(cr * lpi + ci * lpr) : (cr * lpr - ci * lpi); }
            v[j] = val; }
        v4u o; o.x = pk2(v[0], v[1]); o.y = pk2(v[2], v[3]); o.z = pk2(v[4], v[5]); o.w = pk2(v[6], v[7]);
        *(v4u*)(WYb + ((size_t)(g * 256 + n)) * 512 + k0) = o; }
}

__device__ __forceinline__ void rms_rows2_to_bf16(const float* x0, const float* x1, bf16_t* o0, bf16_t* o1, const float* gain, int lane) {
    const f32x4* xr0 = (const f32x4*)x0 + lane; const f32x4* xr1 = (const f32x4*)x1 + lane;
    f32x4 v[4], w[4]; float s0 = 0.f, s1 = 0.f;
#pragma unroll
    for (int j = 0; j < 4; ++j) { v[j] = xr0[64 * j]; w[j] = xr1[64 * j]; }
#pragma unroll
    for (int j = 0; j < 4; ++j) { s0 += (v[j].x * v[j].x + v[j].y * v[j].y) + (v[j].z * v[j].z + v[j].w * v[j].w); s1 += (w[j].x * w[j].x + w[j].y * w[j].y) + (w[j].z * w[j].z + w[j].w * w[j].w); }
#pragma unroll
    for (int o = 1; o < 64; o <<= 1) { s0 += __shfl_xor(s0, o); s1 += __shfl_xor(s1, o); }
    const float r0 = 1.0f / sqrtf(s0 * (1.0f / DM) + NORM_EPS), r1 = 1.0f / sqrtf(s1 * (1.0f / DM) + NORM_EPS);
    unsigned long long* p0 = (unsigned long long*)o0 + lane; unsigned long long* p1 = (unsigned long long*)o1 + lane;
#pragma unroll
    for (int j = 0; j < 4; ++j) {
        const f32x4 g = gain ? ((const f32x4*)gain)[lane + 64 * j] : (f32x4){1.f, 1.f, 1.f, 1.f};
        p0[64 * j] = (unsigned long long)pk2(v[j].x * r0 * g.x, v[j].y * r0 * g.y) | ((unsigned long long)pk2(v[j].z * r0 * g.z, v[j].w * r0 * g.w) << 32);
        p1[64 * j] = (unsigned long long)pk2(w[j].x * r1 * g.x, w[j].y * r1 * g.y) | ((unsigned long long)pk2(w[j].z * r1 * g.z, w[j].w * r1 * g.w) << 32);
    }
}
__device__ __forceinline__ void transpose_item4(const float* W, int K, int N, bf16_t* WT, const float* ks, LAS float* scr, int item, int lane) {
    const int nblk = N / 32, kb = item / nblk, nb = item % nblk, k0 = 64 * kb, n0 = 32 * nb;
    f32x4 w[8];
#pragma unroll
    for (int i = 0; i < 8; ++i) { const int kk = 8 * i + (lane >> 3); w[i] = *(const f32x4*)(W + (size_t)(k0 + kk) * N + n0 + 4 * (lane & 7)); }
#pragma unroll
    for (int i = 0; i < 8; ++i) { const int kk = 8 * i + (lane >> 3); const float sc = ks ? ks[k0 + kk] : 1.0f; LAS float* d = scr + kk * 33 + 4 * (lane & 7);
        d[0] = w[i].x * sc; d[1] = w[i].y * sc; d[2] = w[i].z * sc; d[3] = w[i].w * sc; }
    LDS_WAIT();
    const int c = lane & 7;
#pragma unroll
    for (int j = 0; j < 4; ++j) { const int n = (lane >> 3) + 8 * j; const LAS float* sp = scr + (8 * c) * 33 + n;
        v4u o; o.x = pk2(sp[0 * 33], sp[1 * 33]); o.y = pk2(sp[2 * 33], sp[3 * 33]); o.z = pk2(sp[4 * 33], sp[5 * 33]); o.w = pk2(sp[6 * 33], sp[7 * 33]);
        *(v4u*)(WT + (size_t)(n0 + n) * K + k0 + 8 * c) = o; }
    LDS_WAIT();
}

__device__ __forceinline__ void phase0(const Args& a, LAS unsigned char* lds) {
    const int tid = otid(), lane = tid & 63, wave = tid >> 6;
    const int gw = blockIdx.x * 8 + wave, NGW = gridDim.x * 8;
    s5_tables(a, lds, tid);
    const float* x = a.in[0]; const float* mem = a.in[1]; const float* norm_g = a.in[2]; const float* w_in = a.in[3];
    const float* w_glu = a.in[12]; const float* mem_norm_g = a.in[16]; const float* w_mem_kv = a.in[17]; const float* w_out = a.in[18];
    bf16_t* XB = (bf16_t*)(a.ws + WS_XB); bf16_t* MEMN = (bf16_t*)(a.ws + WS_MEMN);
    bf16_t* WINT = (bf16_t*)(a.ws + WS_WINT); bf16_t* WKVT = (bf16_t*)(a.ws + WS_WKVT); bf16_t* WOUTT = (bf16_t*)(a.ws + WS_WOUTT); bf16_t* WGLUT = (bf16_t*)(a.ws + WS_WGLUT);
    for (int r2 = gw; r2 < (NTOK + NB * NMEM) / 2; r2 += NGW) { const int r = 2 * r2;
        if (r < NTOK) rms_rows2_to_bf16(x + (size_t)r * DM, x + (size_t)(r + 1) * DM, XB + (size_t)r * DM, XB + (size_t)(r + 1) * DM, nullptr, lane);
        else { const int m = r - NTOK; rms_rows2_to_bf16(mem + (size_t)m * DM, mem + (size_t)(m + 1) * DM, MEMN + (size_t)m * DM, MEMN + (size_t)(m + 1) * DM, mem_norm_g, lane); }
    }
    LAS float* scr = (LAS float*)(lds + wave * 8448);
    constexpr int I_IN = (DM / 64) * (DIN / 32), I_KV = (DM / 64) * (512 / 32), I_OUT = (DM / 64) * (DM / 32), I_GLU = (WSSM / 64) * (WSSM / 32);
    for (int it = gw; it < I_IN + I_KV + I_OUT + I_GLU; it += NGW) {
        int r = it;
        if (r < I_IN) { transpose_item4(w_in, DM, DIN, WINT, norm_g, scr, r, lane); continue; } r -= I_IN;
        if (r < I_KV) { transpose_item4(w_mem_kv, DM, 512, WKVT, nullptr, scr, r, lane); continue; } r -= I_KV;
        if (r < I_OUT) { transpose_item4(w_out, DM, DM, WOUTT, nullptr, scr, r, lane); continue; } r -= I_OUT;
        transpose_item4(w_glu, WSSM, WSSM, WGLUT, nullptr, scr, r, lane);
    }
    const int gt = blockIdx.x * 512 + tid, NT = gridDim.x * 512;
    for (int i = gt; i < 128 * 384 / 2; i += NT) ((unsigned*)(WGLUT + 384 * 384))[i] = 0u;
}

template <class Epi>
__device__ __forceinline__ void gemm_naive(const bf16_t* A, int lda, const bf16_t* Bt, int ldb, int M, int N, int K, LAS unsigned char* lds, int tile0, int ntile_total, const Epi& epi) {
    LAS float* As = (LAS float*)lds;
    LAS float* Bs = As + 32 * 132;
    const int tid = threadIdx.x, ty = tid >> 4, tx = tid & 15;
    const int ntn = N / 64, nt = (M / 128) * ntn;
    (void)ntile_total;
    for (int tile = blockIdx.x - tile0; tile < nt; tile += gridDim.x) {
        if (tile < 0) continue;
        const int tm = tile / ntn, tn = tile % ntn;
        float acc[4][4];
#pragma unroll
        for (int i = 0; i < 4; ++i)
#pragma unroll
            for (int j = 0; j < 4; ++j) acc[i][j] = 0.f;
        for (int k0 = 0; k0 < K; k0 += 32) {
            __syncthreads();
            { const int r = tid >> 2, kc = (tid & 3) * 8; const v4u v = *(const v4u*)(A + (size_t)(tm * 128 + r) * lda + k0 + kc);
              As[(kc + 0) * 132 + r] = bflo(v.x); As[(kc + 1) * 132 + r] = bfhi(v.x); As[(kc + 2) * 132 + r] = bflo(v.y); As[(kc + 3) * 132 + r] = bfhi(v.y);
              As[(kc + 4) * 132 + r] = bflo(v.z); As[(kc + 5) * 132 + r] = bfhi(v.z); As[(kc + 6) * 132 + r] = bflo(v.w); As[(kc + 7) * 132 + r] = bfhi(v.w); }
            if (tid < 256) { const int r = tid >> 2, kc = (tid & 3) * 8; const v4u v = *(const v4u*)(Bt + (size_t)(tn * 64 + r) * ldb + k0 + kc);
              Bs[(kc + 0) * 68 + r] = bflo(v.x); Bs[(kc + 1) * 68 + r] = bfhi(v.x); Bs[(kc + 2) * 68 + r] = bflo(v.y); Bs[(kc + 3) * 68 + r] = bfhi(v.y);
              Bs[(kc + 4) * 68 + r] = bflo(v.z); Bs[(kc + 5) * 68 + r] = bfhi(v.z); Bs[(kc + 6) * 68 + r] = bflo(v.w); Bs[(kc + 7) * 68 + r] = bfhi(v.w); }
            __syncthreads();
#pragma unroll 8
            for (int k = 0; k < 32; ++k) {
                const f32x4 av = *(const LAS f32x4*)(As + k * 132 + ty * 4), bv = *(const LAS f32x4*)(Bs + k * 68 + tx * 4);
#pragma unroll
                for (int i = 0; i < 4; ++i)
#pragma unroll
                    for (int j = 0; j < 4; ++j) acc[i][j] += av[i] * bv[j];
            }
        }
#pragma unroll
        for (int i = 0; i < 4; ++i)
#pragma unroll
            for (int j = 0; j < 4; ++j) epi(tm * 128 + ty * 4 + i, tn * 64 + tx * 4 + j, acc[i][j]);
    }
}

struct EpiStoreBf16 { bf16_t* O; int ldo; __device__ __forceinline__ void operator()(int r, int c, float v) const { O[(size_t)r * ldo + c] = (bf16_t)f2bf(v); } };
struct EpiGlu { const bf16_t* GB; const bf16_t* PROJ; const float* b_glu; bf16_t* YCAT;
    __device__ __forceinline__ void operator()(int r, int c, float v) const {
        const float g = bf2f(GB[(size_t)r * WSSM + c]); const float gate = bf2f(PROJ[(size_t)r * DIN + C_AGATE + c]);
        YCAT[(size_t)r * DM + c] = (bf16_t)f2bf(g * sigmoid_f(v + b_glu[c]) * silu_f(gate)); } };
struct EpiOut { const float* x; float* out; __device__ __forceinline__ void operator()(int r, int c, float v) const { out[(size_t)r * DM + c] = x[(size_t)r * DM + c] + v; } };


namespace pg8 {
typedef short bf16x8 __attribute__((ext_vector_type(8)));
typedef unsigned u32x4 __attribute__((ext_vector_type(4)));
constexpr int BM = 256, BK = 64, HALF = 128, HTB = HALF * BK * 2, STAGE_BYTES = 8 * HTB, NXCD = 8, WGM = 8;
__host__ __device__ __forceinline__ int lds_byte(int r, int c) { const int st = (r >> 4) * 2 + (c >> 5), rr = r & 15, cc = c & 31, ob = rr * 64 + cc * 2; return st * 1024 + (ob ^ (((ob >> 9) & 1) << 5)); }
__host__ __device__ __forceinline__ void stage_rc(int b, int& R, int& C) { const int st = b / 1024, sb = b % 1024, swz = sb ^ (((sb >> 9) & 1) << 5); R = (st >> 1) * 16 + swz / 64; C = (st & 1) * 32 + (swz % 64) / 2; }
__host__ __device__ __forceinline__ int perm32(int rho) { const int n = rho >> 4, i = rho & 15; return 8 * (i >> 2) + 4 * n + (i & 3); }
struct Unit { int pm, pn, z; };
struct Gemm { const bf16_t* A; const bf16_t* Bt; int lda, ldb, K; size_t sAz, sBz; };
struct Order {
    int nM, nN, per, total, G, c;
    __device__ void init(int nM_, int nN_, int nZ_, int G_, int c_) { nM = nM_; nN = nN_; per = nM_ * nN_; total = per * nZ_; G = G_; c = c_; }
    __device__ bool next(int i, Unit& u) const {
        const long L = (long)i * G + c; if (L >= total) return false;
        u.z = (int)(L / per); int wgid = (int)(L % per); const int nwg = per;
        { const int q = nwg / NXCD, r = nwg % NXCD, xcd = wgid % NXCD, off = wgid / NXCD; wgid = (xcd < r ? xcd * (q + 1) : r * (q + 1) + (xcd - r) * q) + off; }
        const int nig = WGM * nN, gid = wgid / nig, fm = gid * WGM, gsz = (nM - fm) < WGM ? (nM - fm) : WGM;
        u.pm = fm + ((wgid % nig) % gsz); u.pn = (wgid % nig) / gsz; return true;
    }
};
__device__ __forceinline__ unsigned cvt_pk_bf16(float lo, float hi) { unsigned r; asm volatile("v_cvt_pk_bf16_f32 %0, %1, %2" : "=v"(r) : "v"(lo), "v"(hi)); return r; }

template <class Epi>
__device__ __forceinline__ void gemm_phase(LAS unsigned char* lds, const Gemm g, const Order& S, const Epi& E) {
    int tid = threadIdx.x; asm volatile("" : "+v"(tid));
    const int wid = __builtin_amdgcn_readfirstlane(tid >> 6), lane = tid & 63, wr = wid >> 2, wc = wid & 3, fr = lane & 15, fq = lane >> 4;
    int K = g.K; asm volatile("" : "+s"(K));
    const int nt = K / BK;
    unsigned voffA[2], voffB[2];
#pragma unroll
    for (int i = 0; i < 2; ++i) { int R, C; stage_rc(tid * 16 + i * 8192, R, C); const int Rb = Epi::PERM ? ((R & ~31) + perm32(R & 31)) : R;
        voffA[i] = (unsigned)(R * g.lda + C) * 2u; voffB[i] = (unsigned)(Rb * g.ldb + C) * 2u; }
    const size_t kstep = (size_t)(BK * 2);
    const size_t hstepA = (size_t)HALF * g.lda * 2, hstepB = (size_t)HALF * g.ldb * 2;
    const size_t tstepA = 2 * hstepA, tstepB = 2 * hstepB;
    const unsigned ldsw = (unsigned)wid * 1024u;
    const int aoff = lds_byte(wr * 64 + fr, fq * 8), boff = lds_byte(wc * 32 + fr, fq * 8);
#define PG8_SA(b, h) (((b) * 2 + (h)) * HTB)
#define PG8_SB(b, h) ((4 + (b) * 2 + (h)) * HTB)
#define PG8_STAGE(bufoff, gbase, voff) do { _Pragma("unroll") for (int _i = 0; _i < 2; ++_i) \
        __builtin_amdgcn_global_load_lds((const unsigned*)((const char*)(gbase) + (voff)[_i]), (LAS unsigned*)(lds + (bufoff) + ldsw + _i * 8192), 16, 0, 0); } while (0)
#define PG8_LDA(dst, b, h) do { _Pragma("unroll") for (int m = 0; m < 4; ++m) _Pragma("unroll") for (int k = 0; k < 2; ++k) dst[m][k] = *(const LAS bf16x8*)(lds + PG8_SA(b, h) + aoff + m * 2048 + k * 1024); } while (0)
#define PG8_LDB(dst, b, h) do { _Pragma("unroll") for (int n = 0; n < 2; ++n) _Pragma("unroll") for (int k = 0; k < 2; ++k) dst[n][k] = *(const LAS bf16x8*)(lds + PG8_SB(b, h) + boff + n * 2048 + k * 1024); } while (0)
#define PG8_MMA(ai, bj, At, Bt) do { __builtin_amdgcn_s_setprio(1); _Pragma("unroll") for (int m = 0; m < 4; ++m) _Pragma("unroll") for (int n = 0; n < 2; ++n) _Pragma("unroll") for (int k = 0; k < 2; ++k) \
        acc[ai][bj][m][n] = __builtin_amdgcn_mfma_f32_16x16x32_bf16(Bt[n][k], At[m][k], acc[ai][bj][m][n], 0, 0, 0); __builtin_amdgcn_s_setprio(0); } while (0)
#define PG8_WAIT_V(n) asm volatile("s_waitcnt vmcnt(" #n ")" ::: "memory")
#define PG8_WAIT_L(n) asm volatile("s_waitcnt lgkmcnt(" #n ")" ::: "memory")
#define PG8_BAR __builtin_amdgcn_s_barrier()
#define PG8_SCHED __builtin_amdgcn_sched_barrier(0)
    Unit cur, nxt; int ui = 0;
    if (!S.next(0, cur)) return;
    f32x4 acc[2][2][4][2];
#pragma unroll
    for (int a = 0; a < 2; ++a)
#pragma unroll
        for (int b = 0; b < 2; ++b)
#pragma unroll
            for (int m = 0; m < 4; ++m)
#pragma unroll
                for (int n = 0; n < 2; ++n) acc[a][b][m][n] = (f32x4){0.f, 0.f, 0.f, 0.f};
    bf16x8 At[4][2], B0[2][2], B1[2][2];
    const char* cA = (const char*)(g.A + (size_t)cur.z * g.sAz) + (size_t)cur.pm * tstepA; const char* cB = (const char*)(g.Bt + (size_t)cur.z * g.sBz) + (size_t)cur.pn * tstepB;
    PG8_STAGE(PG8_SB(0, 0), cB, voffB); PG8_STAGE(PG8_SA(0, 0), cA, voffA); PG8_STAGE(PG8_SB(0, 1), cB + hstepB, voffB); PG8_STAGE(PG8_SA(0, 1), cA + hstepA, voffA);
    if (wr == 1) PG8_BAR;
    PG8_WAIT_V(4); PG8_BAR;
    PG8_STAGE(PG8_SB(1, 0), cB + kstep, voffB); PG8_STAGE(PG8_SA(1, 0), cA + kstep, voffA); PG8_STAGE(PG8_SB(1, 1), cB + hstepB + kstep, voffB);
    PG8_WAIT_V(6); PG8_BAR;
    for (;;) {
        const bool has_next = S.next(ui + 1, nxt);
        const char* nA = has_next ? (const char*)(g.A + (size_t)nxt.z * g.sAz) + (size_t)nxt.pm * tstepA : cA; const char* nB = has_next ? (const char*)(g.Bt + (size_t)nxt.z * g.sBz) + (size_t)nxt.pn * tstepB : cB;
        for (int t = 0; t < nt; t += 2) {
            const bool last = (t == nt - 2);
            const char* a1 = cA + (size_t)(t + 1) * kstep;
            const char* a2 = last ? nA : cA + (size_t)(t + 2) * kstep; const char* b2 = last ? nB : cB + (size_t)(t + 2) * kstep;
            const char* a3 = a2 + kstep; const char* b3 = b2 + kstep;
            PG8_LDB(B0, 0, 0); PG8_SCHED; PG8_LDA(At, 0, 0); PG8_STAGE(PG8_SA(1, 1), a1 + hstepA, voffA);
            PG8_WAIT_L(8); PG8_BAR; PG8_WAIT_L(0); PG8_MMA(0, 0, At, B0); PG8_BAR; PG8_SCHED;
            PG8_LDB(B1, 0, 1); PG8_STAGE(PG8_SB(0, 0), b2, voffB);
            PG8_BAR; PG8_WAIT_L(0); PG8_MMA(0, 1, At, B1); PG8_BAR;
            PG8_LDA(At, 0, 1); PG8_STAGE(PG8_SA(0, 0), a2, voffA);
            PG8_BAR; PG8_WAIT_L(0); PG8_MMA(1, 0, At, B0); PG8_BAR; PG8_SCHED;
            PG8_STAGE(PG8_SB(0, 1), b2 + hstepB, voffB);
            PG8_WAIT_V(6); PG8_BAR; PG8_MMA(1, 1, At, B1); PG8_BAR;
            PG8_LDB(B0, 1, 0); PG8_SCHED; PG8_LDA(At, 1, 0); PG8_STAGE(PG8_SA(0, 1), a2 + hstepA, voffA);
            PG8_WAIT_L(8); PG8_BAR; PG8_WAIT_L(0); PG8_MMA(0, 0, At, B0); PG8_BAR; PG8_SCHED;
            PG8_LDB(B1, 1, 1); PG8_STAGE(PG8_SB(1, 0), b3, voffB);
            PG8_BAR; PG8_WAIT_L(0); PG8_MMA(0, 1, At, B1); PG8_BAR;
            PG8_LDA(At, 1, 1); PG8_STAGE(PG8_SA(1, 0), a3, voffA);
            PG8_BAR; PG8_WAIT_L(0); PG8_MMA(1, 0, At, B0); PG8_BAR; PG8_SCHED;
            PG8_STAGE(PG8_SB(1, 1), b3 + hstepB, voffB);
            PG8_WAIT_V(6); PG8_BAR; PG8_MMA(1, 1, At, B1); PG8_BAR;
        }
        if constexpr (!Epi::AFTER_DRAIN) { E(acc, cur, wr, wc, fr, fq); }
        if (!has_next) break;
#pragma unroll
        for (int a = 0; a < 2; ++a)
#pragma unroll
            for (int b = 0; b < 2; ++b)
#pragma unroll
                for (int m = 0; m < 4; ++m)
#pragma unroll
                    for (int n = 0; n < 2; ++n) acc[a][b][m][n] = (f32x4){0.f, 0.f, 0.f, 0.f};
        cur = nxt; cA = nA; cB = nB; ++ui;
    }
    PG8_WAIT_V(0);
    if (wr == 0) PG8_BAR;
    PG8_BAR;
    if constexpr (Epi::AFTER_DRAIN) { E.fused(acc, cur, wr, wc, fr, fq, lds, wid, lane); }
#undef PG8_SA
#undef PG8_SB
#undef PG8_STAGE
#undef PG8_LDA
#undef PG8_LDB
#undef PG8_MMA
#undef PG8_WAIT_V
#undef PG8_WAIT_L
#undef PG8_BAR
#undef PG8_SCHED
}

struct EpiBf16Store {
    static constexpr bool PERM = true, AFTER_DRAIN = false;
    bf16_t* O; int ldc;
    __device__ __forceinline__ void operator()(const f32x4 (&acc)[2][2][4][2], const Unit& u, int wr, int wc, int fr, int fq) const {
        const int row0 = u.pm * BM + wr * 64 + fr, col0 = u.pn * BM + wc * 32 + 8 * fq;
#pragma unroll
        for (int ai = 0; ai < 2; ++ai)
#pragma unroll
            for (int m = 0; m < 4; ++m) { bf16_t* rowp = O + (size_t)(row0 + ai * HALF + m * 16) * ldc + col0;
#pragma unroll
                for (int bj = 0; bj < 2; ++bj) { const f32x4 v0 = acc[ai][bj][m][0], v1 = acc[ai][bj][m][1];
                    u32x4 w; w.x = cvt_pk_bf16(v0[0], v0[1]); w.y = cvt_pk_bf16(v0[2], v0[3]); w.z = cvt_pk_bf16(v1[0], v1[1]); w.w = cvt_pk_bf16(v1[2], v1[3]);
                    *(u32x4*)(rowp + bj * HALF) = w; } }
    }
};

struct EpiProjAY {
    static constexpr bool PERM = true, AFTER_DRAIN = false;
    bf16_t* PROJ; bf16_t* AY;
    __device__ __forceinline__ void operator()(const f32x4 (&acc)[2][2][4][2], const Unit& u, int wr, int wc, int fr, int fq) const {
        const int rowb = u.pm * BM + wr * 64, col0 = u.pn * BM + wc * 32 + 8 * fq;
#pragma unroll
        for (int bj = 0; bj < 2; ++bj) { const int col = col0 + bj * HALF; const bool ay = col < WSSM;
#pragma unroll
            for (int ai = 0; ai < 2; ++ai)
#pragma unroll
                for (int m = 0; m < 4; ++m) { const int rb = rowb + ai * HALF + m * 16;
                    bf16_t* dst = ay ? AY + ((size_t)((col >> 4) * 1024 + (rb >> 4)) * 512 + fr * 16 + (col & 15)) : PROJ + (size_t)(rb + fr) * DIN + col;
                    const f32x4 v0 = acc[ai][bj][m][0], v1 = acc[ai][bj][m][1];
                    u32x4 w; w.x = cvt_pk_bf16(v0[0], v0[1]); w.y = cvt_pk_bf16(v0[2], v0[3]); w.z = cvt_pk_bf16(v1[0], v1[1]); w.w = cvt_pk_bf16(v1[2], v1[3]);
                    *(u32x4*)dst = w; } }
    }
};
struct EpiSend {
    static constexpr bool PERM = false, AFTER_DRAIN = true;
    bf16_t* AY; const float* LAMT; const float* LAM512;
    __device__ __forceinline__ void fused(const f32x4 (&acc)[2][2][4][2], const Unit& u, int wr, int wc, int fr, int fq, LAS unsigned char* lds, int wid, int lane) const {
        LAS float* S = (LAS float*)lds;
        LAS float* E = (LAS float*)(lds + 131072);
#pragma unroll
        for (int ai = 0; ai < 2; ++ai)
#pragma unroll
            for (int m = 0; m < 4; ++m)
#pragma unroll
                for (int n = 0; n < 2; ++n) { const int r = ai * HALF + wr * 64 + m * 16 + fr, c = wc * 32 + n * 16 + 4 * fq; *(LAS f32x4*)(S + r * 128 + c) = acc[ai][0][m][n]; }
        __syncthreads();
        const int g = u.z, b = u.pm, p = lane, seg = wid;
        const float tr = LAMT[(g * NP + p) * 2], ti = LAMT[(g * NP + p) * 2 + 1], hr = LAM512[(g * NP + p) * 2], hi = LAM512[(g * NP + p) * 2 + 1];
        float sr = 0.f, si = 0.f;
        for (int i = 0; i < 32; ++i) { const int row = seg * 32 + i; const float xr = S[row * 128 + p], xi = S[row * 128 + 64 + p];
            const float nr = tr * sr - ti * si + xr, ni = tr * si + ti * sr + xi; sr = nr; si = ni; }
        E[seg * 128 + p] = sr; E[seg * 128 + 64 + p] = si;
        __syncthreads();
        sr = 0.f; si = 0.f;
        for (int s2 = 0; s2 < seg; ++s2) { const float xr = E[s2 * 128 + p], xi = E[s2 * 128 + 64 + p]; const float nr = hr * sr - hi * si + xr, ni = hr * si + hi * sr + xi; sr = nr; si = ni; }
        bf16_t* base = AY + ((size_t)(g * 1024 + b * 256 + seg * 32)) * 512 + 256 + p;
        for (int i = 0; i < 32; ++i) { const int row = seg * 32 + i;
            bf16_t* o = base + (size_t)i * 512;
            o[0] = (bf16_t)f2bf(sr); o[64] = (bf16_t)f2bf(si);
            const float xr = S[row * 128 + p], xi = S[row * 128 + 64 + p];
            const float nr = tr * sr - ti * si + xr, ni = tr * si + ti * sr + xi; sr = nr; si = ni; }
    }
};
struct EpiY {
    static constexpr bool PERM = true, AFTER_DRAIN = false;
    const bf16_t* AY; const float* ssm_d; bf16_t* GB;
    __device__ __forceinline__ void operator()(const f32x4 (&acc)[2][2][4][2], const Unit& u, int wr, int wc, int fr, int fq) const {
        const int g = u.z, b = u.pm;
#pragma unroll
        for (int bj = 0; bj < 2; ++bj) { const int col = bj * HALF + wc * 32 + 8 * fq, t = col >> 4, h0 = col & 15;
            const f32x4 d0 = *(const f32x4*)(ssm_d + g * GH + h0), d1 = *(const f32x4*)(ssm_d + g * GH + h0 + 4);
            u32x4 u8[2][4];
#pragma unroll
            for (int ai = 0; ai < 2; ++ai)
#pragma unroll
                for (int m = 0; m < 4; ++m) { const int crow = ai * HALF + wr * 64 + m * 16 + fr; u8[ai][m] = *(const u32x4*)(AY + ((size_t)(g * 1024 + b * 256 + crow)) * 512 + col); }
#pragma unroll
            for (int ai = 0; ai < 2; ++ai)
#pragma unroll
                for (int m = 0; m < 4; ++m) { const int crow = ai * HALF + wr * 64 + m * 16 + fr;
                    const u32x4 uu = u8[ai][m]; const f32x4 v0 = acc[ai][bj][m][0], v1 = acc[ai][bj][m][1];
                    u32x4 w;
                    w.x = cvt_pk_bf16(gelu_tanh(v0[0] + d0[0] * bflo(uu.x)), gelu_tanh(v0[1] + d0[1] * bfhi(uu.x)));
                    w.y = cvt_pk_bf16(gelu_tanh(v0[2] + d0[2] * bflo(uu.y)), gelu_tanh(v0[3] + d0[3] * bfhi(uu.y)));
                    w.z = cvt_pk_bf16(gelu_tanh(v1[0] + d1[0] * bflo(uu.z)), gelu_tanh(v1[1] + d1[1] * bfhi(uu.z)));
                    w.w = cvt_pk_bf16(gelu_tanh(v1[2] + d1[2] * bflo(uu.w)), gelu_tanh(v1[3] + d1[3] * bfhi(uu.w)));
                    *(u32x4*)(GB + ((size_t)(b * SEQ + crow * 16 + t)) * WSSM + g * GH + h0) = w; }
            asm volatile("" ::: "memory"); }
    }
};
struct EpiGluP {
    static constexpr bool PERM = true, AFTER_DRAIN = false;
    const bf16_t* GB; const bf16_t* PROJ; const float* b_glu; bf16_t* YCAT;
    __device__ __forceinline__ void operator()(const f32x4 (&acc)[2][2][4][2], const Unit& u, int wr, int wc, int fr, int fq) const {
        const int row0 = u.pm * BM + wr * 64 + fr, col0 = u.pn * BM + wc * 32 + 8 * fq;
#pragma unroll
        for (int bj = 0; bj < 2; ++bj) { const int col = col0 + bj * HALF; if (col >= WSSM) continue;
            const f32x4 b0 = *(const f32x4*)(b_glu + col), b1 = *(const f32x4*)(b_glu + col + 4);
#pragma unroll
            for (int ai = 0; ai < 2; ++ai) { if (ai != u.z) continue;
                u32x4 g8[4], a8[4];
#pragma unroll
                for (int m = 0; m < 4; ++m) { const size_t row = (size_t)(row0 + ai * HALF + m * 16); g8[m] = *(const u32x4*)(GB + row * WSSM + col); a8[m] = *(const u32x4*)(PROJ + row * DIN + C_AGATE + col); }
#pragma unroll
                for (int m = 0; m < 4; ++m) { const size_t row = (size_t)(row0 + ai * HALF + m * 16);
                    const f32x4 v0 = acc[ai][bj][m][0] + b0, v1 = acc[ai][bj][m][1] + b1;
                    u32x4 w;
                    w.x = cvt_pk_bf16(bflo(g8[m].x) * sigmoid_f(v0[0]) * silu_f(bflo(a8[m].x)), bfhi(g8[m].x) * sigmoid_f(v0[1]) * silu_f(bfhi(a8[m].x)));
                    w.y = cvt_pk_bf16(bflo(g8[m].y) * sigmoid_f(v0[2]) * silu_f(bflo(a8[m].y)), bfhi(g8[m].y) * sigmoid_f(v0[3]) * silu_f(bfhi(a8[m].y)));
                    w.z = cvt_pk_bf16(bflo(g8[m].z) * sigmoid_f(v1[0]) * silu_f(bflo(a8[m].z)), bfhi(g8[m].z) * sigmoid_f(v1[1]) * silu_f(bfhi(a8[m].z)));
                    w.w = cvt_pk_bf16(bflo(g8[m].w) * sigmoid_f(v1[2]) * silu_f(bflo(a8[m].w)), bfhi(g8[m].w) * sigmoid_f(v1[3]) * silu_f(bfhi(a8[m].w)));
                    *(u32x4*)(YCAT + row * DM + col) = w; }
                asm volatile("" ::: "memory"); } }
    }
};
struct EpiResF32 {
    static constexpr bool PERM = false, AFTER_DRAIN = false;
    const float* x; float* out;
    __device__ __forceinline__ void operator()(const f32x4 (&acc)[2][2][4][2], const Unit& u, int wr, int wc, int fr, int fq) const {
        const int row0 = u.pm * BM + wr * 64 + fr, col0 = u.pn * BM + wc * 32 + 4 * fq;
#pragma unroll
        for (int ai = 0; ai < 2; ++ai)
#pragma unroll
            for (int m = 0; m < 4; ++m) { const size_t off = (size_t)(row0 + ai * HALF + m * 16) * DM + col0;
#pragma unroll
                for (int bj = 0; bj < 2; ++bj)
#pragma unroll
                    for (int n = 0; n < 2; ++n) { const f32x4 xv = *(const f32x4*)(x + off + bj * HALF + n * 16); *(f32x4*)(out + off + bj * HALF + n * 16) = xv + acc[ai][bj][m][n]; }
                asm volatile("" ::: "memory"); }
    }
};

struct EpiOutNorm {
    static constexpr bool PERM = false, AFTER_DRAIN = true;
    const float* x; const float* fg; float* out; float* xch; unsigned* cnt;
    __device__ __forceinline__ void fused(f32x4 (&acc)[2][2][4][2], const Unit& u, int wr, int wc, int fr, int fq, LAS unsigned char* lds, int wid, int lane) const {
        LAS float* P = (LAS float*)lds;
        LAS float* S = (LAS float*)(lds + 8192);
        const int row0 = u.pm * BM + wr * 64 + fr, col0 = u.pn * BM + wc * 32 + 4 * fq;
#pragma unroll
        for (int ai = 0; ai < 2; ++ai) {
            f32x4 xv[4][2][2];
#pragma unroll
            for (int m = 0; m < 4; ++m) { const size_t off = (size_t)(row0 + ai * HALF + m * 16) * DM + col0;
#pragma unroll
                for (int bj = 0; bj < 2; ++bj)
#pragma unroll
                    for (int n = 0; n < 2; ++n) xv[m][bj][n] = *(const f32x4*)(x + off + bj * HALF + n * 16); }
#pragma unroll
            for (int m = 0; m < 4; ++m) { float sq = 0.f;
#pragma unroll
                for (int bj = 0; bj < 2; ++bj)
#pragma unroll
                    for (int n = 0; n < 2; ++n) { const f32x4 hv = acc[ai][bj][m][n] + xv[m][bj][n]; acc[ai][bj][m][n] = hv; sq += (hv[0] * hv[0] + hv[1] * hv[1]) + (hv[2] * hv[2] + hv[3] * hv[3]); }
                sq += __shfl_xor(sq, 16); sq += __shfl_xor(sq, 32);
                if (fq == 0) P[(ai * HALF + wr * 64 + m * 16 + fr) * 4 + wc] = sq; }
            asm volatile("" ::: "memory"); }
        asm volatile("s_waitcnt lgkmcnt(0)" ::: "memory"); __builtin_amdgcn_s_barrier(); asm volatile("" ::: "memory");
        const int row = wid * 32 + (lane & 31);
        if (lane < 32) { const f32x4 pv = *(const LAS f32x4*)(P + row * 4); const float t = (pv[0] + pv[1]) + (pv[2] + pv[3]);
            __hip_atomic_store(xch + ((size_t)(u.pm * BM + row) * 4 + u.pn), t, __ATOMIC_RELAXED, __HIP_MEMORY_SCOPE_AGENT); }
        asm volatile("s_waitcnt vmcnt(0)" ::: "memory");
        if (lane == 0) __hip_atomic_fetch_add(cnt + 64 * u.pm, 1u, __ATOMIC_RELAXED, __HIP_MEMORY_SCOPE_AGENT);
        if (wid == 0) { unsigned sp = 0;
            while ((unsigned)__builtin_amdgcn_readfirstlane(__hip_atomic_load(cnt + 64 * u.pm, __ATOMIC_RELAXED, __HIP_MEMORY_SCOPE_AGENT)) < 32u) { __builtin_amdgcn_s_sleep(2); if (++sp > (1u << 22)) break; }
            __builtin_amdgcn_fence(__ATOMIC_ACQUIRE, "agent"); }
        asm volatile("s_waitcnt vmcnt(0) lgkmcnt(0)" ::: "memory"); __builtin_amdgcn_s_barrier(); asm volatile("" ::: "memory");
        if (lane < 32) { const float* slot = xch + (size_t)(u.pm * BM + row) * 4; float t = 0.f;
#pragma unroll
            for (int q = 0; q < 4; ++q) t += __hip_atomic_load(slot + q, __ATOMIC_RELAXED, __HIP_MEMORY_SCOPE_AGENT);
            S[row] = 1.0f / sqrtf(t * (1.0f / DM) + NORM_EPS); }
        asm volatile("s_waitcnt lgkmcnt(0)" ::: "memory"); __builtin_amdgcn_s_barrier(); asm volatile("" ::: "memory");
        f32x4 gv[2][2];
#pragma unroll
        for (int bj = 0; bj < 2; ++bj)
#pragma unroll
            for (int n = 0; n < 2; ++n) gv[bj][n] = *(const f32x4*)(fg + col0 + bj * HALF + n * 16);
#pragma unroll
        for (int ai = 0; ai < 2; ++ai)
#pragma unroll
            for (int m = 0; m < 4; ++m) { const int r = ai * HALF + wr * 64 + m * 16 + fr; const float rs = S[r]; const size_t off = (size_t)(u.pm * BM + r) * DM + col0;
#pragma unroll
                for (int bj = 0; bj < 2; ++bj)
#pragma unroll
                    for (int n = 0; n < 2; ++n) *(f32x4*)(out + off + bj * HALF + n * 16) = acc[ai][bj][m][n] * rs * gv[bj][n]; }
    }
};
}

__device__ __forceinline__ void s5_naive(const Args& a, int b, int g, int lane) {
    const bf16_t* PROJ = (const bf16_t*)(a.ws + WS_PROJ); bf16_t* GB = (bf16_t*)(a.ws + WS_GB);
    const float* LAMB = (const float*)(a.ws + WS_LAMB); const float* BBAR = (const float*)(a.ws + WS_BBAR);
    const float* c_re = a.in[8]; const float* c_im = a.in[9]; const float* ssm_d = a.in[10];
    const int p = lane, h = lane & 15, pg = lane >> 4;
    const float lr = LAMB[(g * NP + p) * 2], li = LAMB[(g * NP + p) * 2 + 1];
    float bre[16], bim[16], cre[16], cim[16];
#pragma unroll
    for (int j = 0; j < 16; ++j) { bre[j] = BBAR[((g * NP + p) * GH + j) * 2]; bim[j] = BBAR[((g * NP + p) * GH + j) * 2 + 1];
        cre[j] = c_re[(g * GH + h) * NP + pg * 16 + j]; cim[j] = c_im[(g * GH + h) * NP + pg * 16 + j]; }
    const float dd = ssm_d[g * GH + h];
    float sr = 0.f, si = 0.f;
    for (int t = 0; t < SEQ; ++t) {
        const bf16_t* up = PROJ + (size_t)(b * SEQ + t) * DIN + C_AIN + g * GH;
        const v4u u0 = *(const v4u*)up, u1 = *(const v4u*)(up + 8);
        float u[16];
        u[0] = bflo(u0.x); u[1] = bfhi(u0.x); u[2] = bflo(u0.y); u[3] = bfhi(u0.y); u[4] = bflo(u0.z); u[5] = bfhi(u0.z); u[6] = bflo(u0.w); u[7] = bfhi(u0.w);
        u[8] = bflo(u1.x); u[9] = bfhi(u1.x); u[10] = bflo(u1.y); u[11] = bfhi(u1.y); u[12] = bflo(u1.z); u[13] = bfhi(u1.z); u[14] = bflo(u1.w); u[15] = bfhi(u1.w);
        const float uh = bf2f(up[h]);
        float bur = 0.f, bui = 0.f;
#pragma unroll
        for (int j = 0; j < 16; ++j) { bur += bre[j] * u[j]; bui += bim[j] * u[j]; }
        const float nsr = lr * sr - li * si + bur, nsi = lr * si + li * sr + bui;
        sr = nsr; si = nsi;
        float part = 0.f;
#pragma unroll
        for (int j = 0; j < 16; ++j) { const float xr = __shfl(sr, pg * 16 + j), xi = __shfl(si, pg * 16 + j); part += cre[j] * xr - cim[j] * xi; }
        part += __shfl_xor(part, 16); part += __shfl_xor(part, 32);
        const float y = part + dd * uh;
        if (lane < 16) GB[(size_t)(b * SEQ + t) * WSSM + g * GH + h] = (bf16_t)f2bf(gelu_tanh(y));
    }
}

__device__ __forceinline__ void conv_naive(const Args& a, int vb, int nvb) {
    const bf16_t* PROJ = (const bf16_t*)(a.ws + WS_PROJ); bf16_t* YCAT = (bf16_t*)(a.ws + WS_YCAT);
    const float* conv_w = a.in[14]; const float* conv_b = a.in[15];
    const int gt = vb * 512 + otid(), NT = nvb * 512;
    for (int idx = gt; idx < NTOK * WSSM; idx += NT) {
        const int tok = idx / WSSM, c = idx % WSSM, t = tok % SEQ;
        const bf16_t* row = PROJ + (size_t)tok * DIN;
        float acc = conv_b[c];
#pragma unroll
        for (int k = 0; k < 3; ++k) { const int tt = t - 2 + k; if (tt >= 0) { const bf16_t* r2 = PROJ + (size_t)(tok - 2 + k) * DIN; acc += conv_w[k * WSSM + c] * (bf2f(r2[C_CC + c]) * bf2f(r2[C_CIN + c])); } }
        const float y = bf2f(row[C_CB + c]) * acc * silu_f(bf2f(row[C_CGATE + c]));
        YCAT[(size_t)tok * DM + WSSM + c] = (bf16_t)f2bf(y);
    }
}
__device__ __forceinline__ void attn_naive(const Args& a, int vb, int nvb) {
    const bf16_t* PROJ = (const bf16_t*)(a.ws + WS_PROJ); bf16_t* YCAT = (bf16_t*)(a.ws + WS_YCAT); const bf16_t* KV = (const bf16_t*)(a.ws + WS_KV);
    const int gt = vb * 512 + otid(), NT = nvb * 512;
    for (int item = gt; item < NB * 4 * SEQ; item += NT) {
        const int t = item % SEQ, hh = (item / SEQ) % 4, b = item / (4 * SEQ), tok = b * SEQ + t;
        const v4u* qp = (const v4u*)(PROJ + (size_t)tok * DIN + C_Q + hh * 64);
        float q[64], o[64];
#pragma unroll
        for (int i = 0; i < 8; ++i) { const v4u v = qp[i]; q[8 * i] = bflo(v.x); q[8 * i + 1] = bfhi(v.x); q[8 * i + 2] = bflo(v.y); q[8 * i + 3] = bfhi(v.y); q[8 * i + 4] = bflo(v.z); q[8 * i + 5] = bfhi(v.z); q[8 * i + 6] = bflo(v.w); q[8 * i + 7] = bfhi(v.w); }
#pragma unroll
        for (int d = 0; d < 64; ++d) o[d] = 0.f;
        float m = -1e30f, l = 0.f;
        for (int mm = 0; mm < NMEM; ++mm) {
            const v4u* kp = (const v4u*)(KV + (size_t)(b * NMEM + mm) * 512 + hh * 64);
            const v4u* vp = (const v4u*)(KV + (size_t)(b * NMEM + mm) * 512 + 256 + hh * 64);
            float s = 0.f;
#pragma unroll
            for (int i = 0; i < 8; ++i) { const v4u v = kp[i];
                s += q[8 * i] * bflo(v.x) + q[8 * i + 1] * bfhi(v.x) + q[8 * i + 2] * bflo(v.y) + q[8 * i + 3] * bfhi(v.y) + q[8 * i + 4] * bflo(v.z) + q[8 * i + 5] * bfhi(v.z) + q[8 * i + 6] * bflo(v.w) + q[8 * i + 7] * bfhi(v.w); }
            s *= 0.125f;
            const float mn = fmaxf(m, s), sc = __expf(m - mn), pp = __expf(s - mn);
            l = l * sc + pp; m = mn;
#pragma unroll
            for (int i = 0; i < 8; ++i) { const v4u v = vp[i];
                o[8 * i] = o[8 * i] * sc + pp * bflo(v.x); o[8 * i + 1] = o[8 * i + 1] * sc + pp * bfhi(v.x); o[8 * i + 2] = o[8 * i + 2] * sc + pp * bflo(v.y); o[8 * i + 3] = o[8 * i + 3] * sc + pp * bfhi(v.y);
                o[8 * i + 4] = o[8 * i + 4] * sc + pp * bflo(v.z); o[8 * i + 5] = o[8 * i + 5] * sc + pp * bfhi(v.z); o[8 * i + 6] = o[8 * i + 6] * sc + pp * bflo(v.w); o[8 * i + 7] = o[8 * i + 7] * sc + pp * bfhi(v.w); }
        }
        const float inv = 1.0f / l;
        const v4u* gp = (const v4u*)(PROJ + (size_t)tok * DIN + C_QGATE + hh * 64);
        v4u* op = (v4u*)(YCAT + (size_t)tok * DM + 768 + hh * 64);
#pragma unroll
        for (int i = 0; i < 8; ++i) { const v4u gv = gp[i]; v4u w;
            w.x = pk2(o[8 * i] * inv * silu_f(bflo(gv.x)), o[8 * i + 1] * inv * silu_f(bfhi(gv.x)));
            w.y = pk2(o[8 * i + 2] * inv * silu_f(bflo(gv.y)), o[8 * i + 3] * inv * silu_f(bfhi(gv.y)));
            w.z = pk2(o[8 * i + 4] * inv * silu_f(bflo(gv.z)), o[8 * i + 5] * inv * silu_f(bfhi(gv.z)));
            w.w = pk2(o[8 * i + 6] * inv * silu_f(bflo(gv.w)), o[8 * i + 7] * inv * silu_f(bfhi(gv.w)));
            op[i] = w; }
    }
}

typedef short bf16x8_t __attribute__((ext_vector_type(8)));
typedef short s16x4_t __attribute__((ext_vector_type(4)));
typedef float f32x16 __attribute__((ext_vector_type(16)));
typedef __bf16 bf2_t __attribute__((ext_vector_type(2)));
typedef float f2_t __attribute__((ext_vector_type(2)));
typedef unsigned u32x2_t __attribute__((ext_vector_type(2)));
__device__ __forceinline__ unsigned cvt2(float lo, float hi) { const f2_t v = {lo, hi}; return __builtin_bit_cast(unsigned, __builtin_convertvector(v, bf2_t)); }
__device__ __forceinline__ void attn_mfma(const Args& a, LAS unsigned char* lds, int vb, int nvb) {
    const int nj = nvb / 16; if (nj < 1 || vb >= nj * 16) return;
    const int tid = otid(), lane = tid & 63, wave = tid >> 6, r = lane & 31, h = lane >> 5;
    const int bh = vb % 16, j = vb / 16, b = bh >> 2, head = bh & 3;
    const bf16_t* PROJ = (const bf16_t*)(a.ws + WS_PROJ); bf16_t* YCAT = (bf16_t*)(a.ws + WS_YCAT); const bf16_t* KV = (const bf16_t*)(a.ws + WS_KV);
    LAS unsigned char* Kl = lds;
    LAS unsigned char* Vl = lds + 36864;
    for (int c = tid; c < 2048; c += 512) { const int key = c >> 3, dch = c & 7;
        const bf16_t* src = KV + (size_t)(b * NMEM + key) * 512 + head * 64 + dch * 8;
        const v4u kv = *(const v4u*)src, vv = *(const v4u*)(src + 256);
        *(LAS v4u*)(Kl + key * 144 + dch * 16) = kv;
        LAS bf16_t* vd = (LAS bf16_t*)(Vl + (dch * 8) * 520 + key * 2);
        vd[0 * 260] = (bf16_t)(vv.x & 0xffff); vd[1 * 260] = (bf16_t)(vv.x >> 16); vd[2 * 260] = (bf16_t)(vv.y & 0xffff); vd[3 * 260] = (bf16_t)(vv.y >> 16);
        vd[4 * 260] = (bf16_t)(vv.z & 0xffff); vd[5 * 260] = (bf16_t)(vv.z >> 16); vd[6 * 260] = (bf16_t)(vv.w & 0xffff); vd[7 * 260] = (bf16_t)(vv.w >> 16); }
    __syncthreads();
    for (int tile = j * 8 + wave; tile < SEQ / 32; tile += nj * 8) {
        const size_t tok = (size_t)b * SEQ + tile * 32 + r;
        bf16x8_t qf[4];
#pragma unroll
        for (int s4 = 0; s4 < 4; ++s4) qf[s4] = *(const bf16x8_t*)(PROJ + tok * DIN + C_Q + head * 64 + 16 * s4 + 8 * h);
        const float sc = 0.125f * 1.4426950408889634f;
        float mx = -3.0e38f, l = 0.f;
        f32x16 o0, o1;
#pragma unroll
        for (int i = 0; i < 16; ++i) { o0[i] = 0.f; o1[i] = 0.f; }
#pragma unroll 2
        for (int kt = 0; kt < 8; ++kt) {
            f32x16 st;
#pragma unroll
            for (int i = 0; i < 16; ++i) st[i] = 0.f;
#pragma unroll
            for (int s4 = 0; s4 < 4; ++s4) { const bf16x8_t kf = *(const LAS bf16x8_t*)(Kl + (kt * 32 + r) * 144 + (16 * s4 + 8 * h) * 2);
                st = __builtin_amdgcn_mfma_f32_32x32x16_bf16(kf, qf[s4], st, 0, 0, 0); }
            float tm = st[0];
#pragma unroll
            for (int i = 1; i < 16; ++i) tm = fmaxf(tm, st[i]);
            tm = fmaxf(tm, __shfl_xor(tm, 32));
            const float mn = fmaxf(mx, tm), alpha = __builtin_amdgcn_exp2f((mx - mn) * sc), mb = mn * sc;
            mx = mn; l *= alpha;
#pragma unroll
            for (int i = 0; i < 16; ++i) { o0[i] *= alpha; o1[i] *= alpha; }
#pragma unroll
            for (int i = 0; i < 16; ++i) { const float p = __builtin_amdgcn_exp2f(st[i] * sc - mb); st[i] = p; l += p; }
#pragma unroll
            for (int s2 = 0; s2 < 2; ++s2) {
                v4u pw; pw.x = cvt2(st[8 * s2 + 0], st[8 * s2 + 1]); pw.y = cvt2(st[8 * s2 + 2], st[8 * s2 + 3]);
                pw.z = cvt2(st[8 * s2 + 4], st[8 * s2 + 5]); pw.w = cvt2(st[8 * s2 + 6], st[8 * s2 + 7]);
                const bf16x8_t pf = __builtin_bit_cast(bf16x8_t, pw);
                const int koff = (kt * 32 + 16 * s2 + 4 * h) * 2;
                { const s16x4_t lo = *(const LAS s16x4_t*)(Vl + r * 520 + koff), hi = *(const LAS s16x4_t*)(Vl + r * 520 + koff + 16);
                  const bf16x8_t vf = __builtin_shufflevector(lo, hi, 0, 1, 2, 3, 4, 5, 6, 7); o0 = __builtin_amdgcn_mfma_f32_32x32x16_bf16(vf, pf, o0, 0, 0, 0); }
                { const s16x4_t lo = *(const LAS s16x4_t*)(Vl + (32 + r) * 520 + koff), hi = *(const LAS s16x4_t*)(Vl + (32 + r) * 520 + koff + 16);
                  const bf16x8_t vf = __builtin_shufflevector(lo, hi, 0, 1, 2, 3, 4, 5, 6, 7); o1 = __builtin_amdgcn_mfma_f32_32x32x16_bf16(vf, pf, o1, 0, 0, 0); }
            }
        }
        l += __shfl_xor(l, 32);
        const float inv = 1.0f / l;
        const bf16_t* gp = PROJ + tok * DIN + C_QGATE + head * 64; bf16_t* op = YCAT + tok * DM + 768 + head * 64;
#pragma unroll
        for (int q4 = 0; q4 < 4; ++q4) {
            { const int d = 8 * q4 + 4 * h; const u32x2_t gv = *(const u32x2_t*)(gp + d); u32x2_t w;
              w.x = cvt2(o0[4 * q4 + 0] * inv * silu_f(bflo(gv.x)), o0[4 * q4 + 1] * inv * silu_f(bfhi(gv.x))); w.y = cvt2(o0[4 * q4 + 2] * inv * silu_f(bflo(gv.y)), o0[4 * q4 + 3] * inv * silu_f(bfhi(gv.y)));
              *(u32x2_t*)(op + d) = w; }
            { const int d = 32 + 8 * q4 + 4 * h; const u32x2_t gv = *(const u32x2_t*)(gp + d); u32x2_t w;
              w.x = cvt2(o1[4 * q4 + 0] * inv * silu_f(bflo(gv.x)), o1[4 * q4 + 1] * inv * silu_f(bfhi(gv.x))); w.y = cvt2(o1[4 * q4 + 2] * inv * silu_f(bflo(gv.y)), o1[4 * q4 + 3] * inv * silu_f(bfhi(gv.y)));
              *(u32x2_t*)(op + d) = w; }
        }
    }
}
__device__ __forceinline__ void conv_vec(const Args& a, int vb, int nvb) {
    const bf16_t* PROJ = (const bf16_t*)(a.ws + WS_PROJ); bf16_t* YCAT = (bf16_t*)(a.ws + WS_YCAT);
    const float* conv_w = a.in[14]; const float* conv_b = a.in[15];
    const int gt = vb * 512 + otid(), NT = nvb * 512;
    for (int it = gt; it < (NTOK / 4) * 48; it += NT) {
        const int tg = it / 48, c0 = (it % 48) * 8, tok0 = tg * 4, t0 = tok0 % SEQ;
        const bf16_t* row0 = PROJ + (size_t)tok0 * DIN;
        v4u cc[6], ci[6], cb[4], cg[4];
#pragma unroll
        for (int r = 0; r < 6; ++r) { const bool ok = (t0 + r - 2) >= 0; const bf16_t* rp = row0 + (ptrdiff_t)(r - 2) * DIN;
            cc[r] = ok ? *(const v4u*)(rp + C_CC + c0) : (v4u){0u, 0u, 0u, 0u}; ci[r] = ok ? *(const v4u*)(rp + C_CIN + c0) : (v4u){0u, 0u, 0u, 0u}; }
#pragma unroll
        for (int j = 0; j < 4; ++j) { cb[j] = *(const v4u*)(row0 + (size_t)j * DIN + C_CB + c0); cg[j] = *(const v4u*)(row0 + (size_t)j * DIN + C_CGATE + c0); }
        float w[3][8], bb[8];
#pragma unroll
        for (int k = 0; k < 3; ++k) { const f32x4 w0 = *(const f32x4*)(conv_w + k * WSSM + c0), w1 = *(const f32x4*)(conv_w + k * WSSM + c0 + 4);
            w[k][0] = w0.x; w[k][1] = w0.y; w[k][2] = w0.z; w[k][3] = w0.w; w[k][4] = w1.x; w[k][5] = w1.y; w[k][6] = w1.z; w[k][7] = w1.w; }
        { const f32x4 b0 = *(const f32x4*)(conv_b + c0), b1 = *(const f32x4*)(conv_b + c0 + 4); bb[0] = b0.x; bb[1] = b0.y; bb[2] = b0.z; bb[3] = b0.w; bb[4] = b1.x; bb[5] = b1.y; bb[6] = b1.z; bb[7] = b1.w; }
        float u[6][8];
#pragma unroll
        for (int r = 0; r < 6; ++r) { u[r][0] = bflo(cc[r].x) * bflo(ci[r].x); u[r][1] = bfhi(cc[r].x) * bfhi(ci[r].x); u[r][2] = bflo(cc[r].y) * bflo(ci[r].y); u[r][3] = bfhi(cc[r].y) * bfhi(ci[r].y);
            u[r][4] = bflo(cc[r].z) * bflo(ci[r].z); u[r][5] = bfhi(cc[r].z) * bfhi(ci[r].z); u[r][6] = bflo(cc[r].w) * bflo(ci[r].w); u[r][7] = bfhi(cc[r].w) * bfhi(ci[r].w); }
#pragma unroll
        for (int j = 0; j < 4; ++j) { float y[8];
#pragma unroll
            for (int e = 0; e < 8; ++e) y[e] = bb[e] + w[0][e] * u[j][e] + w[1][e] * u[j + 1][e] + w[2][e] * u[j + 2][e];
            v4u o;
            o.x = cvt2(bflo(cb[j].x) * y[0] * silu_f(bflo(cg[j].x)), bfhi(cb[j].x) * y[1] * silu_f(bfhi(cg[j].x)));
            o.y = cvt2(bflo(cb[j].y) * y[2] * silu_f(bflo(cg[j].y)), bfhi(cb[j].y) * y[3] * silu_f(bfhi(cg[j].y)));
            o.z = cvt2(bflo(cb[j].z) * y[4] * silu_f(bflo(cg[j].z)), bfhi(cb[j].z) * y[5] * silu_f(bfhi(cg[j].z)));
            o.w = cvt2(bflo(cb[j].w) * y[6] * silu_f(bflo(cg[j].w)), bfhi(cb[j].w) * y[7] * silu_f(bfhi(cg[j].w)));
            *(v4u*)(YCAT + (size_t)(tok0 + j) * DM + WSSM + c0) = o; }
    }
}
__device__ __forceinline__ void final_norm(const Args& a) {
    const int tid = otid(), lane = tid & 63, gw = blockIdx.x * 8 + (tid >> 6), NGW = gridDim.x * 8;
    const float* fg = a.in[19];
    for (int r = gw; r < NTOK; r += NGW) {
        f32x4* xr = (f32x4*)(a.out + (size_t)r * DM) + lane;
        f32x4 v[4]; float s = 0.f;
#pragma unroll
        for (int j = 0; j < 4; ++j) { v[j] = xr[64 * j]; s += (v[j].x * v[j].x + v[j].y * v[j].y) + (v[j].z * v[j].z + v[j].w * v[j].w); }
        const float rstd = 1.0f / sqrtf(wave_sum(s) * (1.0f / DM) + NORM_EPS);
#pragma unroll
        for (int j = 0; j < 4; ++j) { const f32x4 g = ((const f32x4*)fg)[lane + 64 * j]; xr[64 * j] = v[j] * rstd * g; }
    }
}

__global__ void __launch_bounds__(512, 2) mega(Args a) {
    extern __shared__ __attribute__((aligned(16))) unsigned char smem_raw[];
    LAS unsigned char* lds = (LAS unsigned char*)smem_raw;
    cg::grid_group grid = cg::this_grid();
    volatile LAS unsigned* xst = (volatile LAS unsigned*)(lds + 139264);
    if (threadIdx.x == 0) { xst[0] = 0u; xst[1] = 0u; }
    { unsigned* ctl = (unsigned*)(a.ws + WS_CTL); unsigned* flag = ctl + CTL_FLAG_WORD;
      if (blockIdx.x == 0) { for (int i = threadIdx.x; i < 8192; i += 512) __hip_atomic_store(ctl + i, 0u, __ATOMIC_RELAXED, __HIP_MEMORY_SCOPE_AGENT);
          asm volatile("s_waitcnt vmcnt(0)" ::: "memory"); __syncthreads();
          if (threadIdx.x == 0) { __builtin_amdgcn_fence(__ATOMIC_RELEASE, "agent"); __hip_atomic_store(flag, CTL_TOKEN, __ATOMIC_RELAXED, __HIP_MEMORY_SCOPE_AGENT); } }
      if (threadIdx.x == 0) { unsigned sp = 0; while (__hip_atomic_load(flag, __ATOMIC_RELAXED, __HIP_MEMORY_SCOPE_AGENT) != CTL_TOKEN) { __builtin_amdgcn_s_sleep(1); if (++sp > (1u << 22)) break; }
          __builtin_amdgcn_fence(__ATOMIC_ACQUIRE, "agent"); } }
    __syncthreads();
    const XcdBarrier xbar = xcd_barrier_post((unsigned*)(a.ws + WS_CTL), xst);
    const int bid = blockIdx.x, G = gridDim.x;
    bf16_t* XB = (bf16_t*)(a.ws + WS_XB); bf16_t* MEMN = (bf16_t*)(a.ws + WS_MEMN);
    bf16_t* WINT = (bf16_t*)(a.ws + WS_WINT); bf16_t* WKVT = (bf16_t*)(a.ws + WS_WKVT); bf16_t* WOUTT = (bf16_t*)(a.ws + WS_WOUTT); bf16_t* WGLUT = (bf16_t*)(a.ws + WS_WGLUT);
    bf16_t* PROJ = (bf16_t*)(a.ws + WS_PROJ); bf16_t* KV = (bf16_t*)(a.ws + WS_KV); bf16_t* GB = (bf16_t*)(a.ws + WS_GB); bf16_t* YCAT = (bf16_t*)(a.ws + WS_YCAT);
    bf16_t* AY = (bf16_t*)(a.ws + WS_AY); bf16_t* WSb = (bf16_t*)(a.ws + WS_WS); bf16_t* WYb = (bf16_t*)(a.ws + WS_WY);

#ifndef PROBE_DUP
#define PROBE_DUP -1
#endif
#define REPS(k) for (int rep_ = 0; rep_ < ((PROBE_DUP == (k)) ? 2 : 1); ++rep_)
#ifndef PROBE_SUB
#define PROBE_SUB -1
#endif
    if (a.out == nullptr) grid.sync();
    REPS(0) { phase0(a, lds);
    xcd_barrier(xbar); }
    REPS(1) {
    { pg8::Order S; S.init(NTOK / 256, DIN / 256, 1, G, bid);
      pg8::gemm_phase(lds, pg8::Gemm{XB, WINT, DM, DM, DM, 0, 0}, S, pg8::EpiProjAY{PROJ, AY}); }
    { pg8::Order S; S.init(NB * NMEM / 256, 512 / 256, 1, G, (bid + G - ((NTOK / 256) * (DIN / 256)) % G) % G);
      pg8::gemm_phase(lds, pg8::Gemm{MEMN, WKVT, DM, DM, DM, 0, 0}, S, pg8::EpiBf16Store{KV, 512}); }
    xcd_barrier(xbar); }
    REPS(2) {
    if (bid < NB * NG) { pg8::Order S; S.init(NB, 1, NG, G, bid);
      pg8::gemm_phase(lds, pg8::Gemm{AY, WSb, 512, 256, 256, (size_t)1024 * 512, (size_t)256 * 256}, S, pg8::EpiSend{AY, (const float*)(a.ws + WS_LAMT), (const float*)(a.ws + WS_LAM512)});
      asm volatile("s_waitcnt vmcnt(0)" ::: "memory"); __syncthreads();
      pg8::gemm_phase(lds, pg8::Gemm{AY, WYb, 512, 512, 384, (size_t)1024 * 512, (size_t)256 * 512}, S, pg8::EpiY{AY, a.in[10], GB}); }
    else { attn_mfma(a, lds, bid - NB * NG, G - NB * NG); conv_vec(a, bid - NB * NG, G - NB * NG); }
    xcd_barrier(xbar); }
    REPS(4) {
    { pg8::Order S; S.init(NTOK / 256, 2, 2, G, bid);
      pg8::gemm_phase(lds, pg8::Gemm{GB, WGLUT, WSSM, WSSM, WSSM, 0, 0}, S, pg8::EpiGluP{GB, PROJ, a.in[13], YCAT}); }
    xcd_barrier(xbar); }
    REPS(5) {
    { pg8::Order S; S.init(NTOK / 256, DM / 256, 1, G, bid);
      pg8::gemm_phase(lds, pg8::Gemm{YCAT, WOUTT, DM, DM, DM, 0, 0}, S, pg8::EpiOutNorm{a.in[0], a.in[19], a.out, (float*)(a.ws + WS_XCH), (unsigned*)(a.ws + WS_CTL + CTL_PANEL)}); }
    }
    __syncthreads();
    if (threadIdx.x == 0) { unsigned* ctl = (unsigned*)(a.ws + WS_CTL);
        const unsigned old_ = __hip_atomic_fetch_add(ctl + CTL_EXIT_WORD, 1u, __ATOMIC_RELAXED, __HIP_MEMORY_SCOPE_AGENT);
        if (old_ == (unsigned)G - 1u) __hip_atomic_store(ctl + CTL_FLAG_WORD, CTL_RESET, __ATOMIC_RELAXED, __HIP_MEMORY_SCOPE_AGENT); }
}

extern "C" void kernel_launch(void* const* d_in, const int* in_sizes, int n_in, void* d_out, int out_size, void* d_ws, size_t ws_size, hipStream_t stream) {
    static int grid = 0;
    if (grid == 0) {
        if (n_in != 20 || out_size != NTOK * DM || ws_size < WS_END) { fprintf(stderr, "kernel_launch: unexpected shapes n_in %d out %d ws %zu\n", n_in, out_size, ws_size); grid = -1; return; }
        int dev = 0, cus = 0, per_cu = 0;
        hipGetDevice(&dev);
        hipDeviceGetAttribute(&cus, hipDeviceAttributeMultiprocessorCount, dev);
        if (hipFuncSetAttribute((const void*)mega, hipFuncAttributeMaxDynamicSharedMemorySize, LDS_BYTES) != hipSuccess) { fprintf(stderr, "kernel_launch: hipFuncSetAttribute failed\n"); grid = -1; return; }
        if (hipOccupancyMaxActiveBlocksPerMultiprocessor(&per_cu, (const void*)mega, 512, LDS_BYTES) != hipSuccess || per_cu < 1) { fprintf(stderr, "kernel_launch: occupancy query says %d\n", per_cu); per_cu = 1; }
        (void)hipGetLastError();
        grid = cus;
        if (grid < NB * NG) { fprintf(stderr, "kernel_launch: grid %d too small\n", grid); grid = -1; return; }
    }
    if (grid < 0) return;
    Args a{};
    for (int i = 0; i < 20; ++i) a.in[i] = (const float*)d_in[i];
    a.out = (float*)d_out; a.ws = (unsigned char*)d_ws;
    void* args[] = {&a};
    hipError_t e = hipLaunchCooperativeKernel((const void*)mega, dim3(grid), dim3(512), args, LDS_BYTES, stream);
    if (e != hipSuccess) fprintf(stderr, "cooperative launch failed: %s (grid %d)\n", hipGetErrorString(e), grid);
}
```

```cpp
#include <hip/hip_runtime.h>
#include <hip/hip_cooperative_groups.h>
#include <cstdio>
#include <cstdint>
namespace cg = cooperative_groups;

#define LAS __attribute__((address_space(3)))
typedef unsigned short bf16_t;
typedef unsigned v4u __attribute__((ext_vector_type(4)));
typedef float f32x4 __attribute__((ext_vector_type(4)));

constexpr int NB = 4, SEQ = 4096, DM = 1024, NTOK = NB * SEQ, DIN = 2816, WSSM = 384, NG = 24, GH = 16, NP = 64, NMEM = 256;
constexpr int C_AIN = 0, C_AGATE = 384, C_CIN = 768, C_CB = 1152, C_CC = 1536, C_CGATE = 1920, C_Q = 2304, C_QGATE = 2560;
constexpr float NORM_EPS = 1e-6f;

constexpr size_t MiB = 1u << 20;
constexpr size_t WS_CTL = 0;
constexpr size_t WS_XB = 1 * MiB;
constexpr size_t WS_WINT = 33 * MiB;
constexpr size_t WS_WKVT = 39 * MiB;
constexpr size_t WS_WOUTT = 40 * MiB;
constexpr size_t WS_WGLUT = 42 * MiB;
constexpr size_t WS_MEMN = 43 * MiB;
constexpr size_t WS_KV = 45 * MiB;
constexpr size_t WS_LAMB = 46 * MiB;
constexpr size_t WS_BBAR = 46 * MiB + 65536;
constexpr size_t WS_GB = 47 * MiB;
constexpr size_t WS_PROJ = 59 * MiB;
constexpr size_t WS_YCAT = 147 * MiB;
constexpr size_t WS_AY = 179 * MiB;
constexpr size_t WS_WS = 203 * MiB;
constexpr size_t WS_WY = 206 * MiB;
constexpr size_t WS_LAMT = 212 * MiB;
constexpr size_t WS_LAM512 = 212 * MiB + 65536;
constexpr size_t WS_XCH = 213 * MiB;
constexpr size_t WS_END = 214 * MiB;
constexpr size_t CTL_PANEL = 16384;
constexpr size_t CTL_BYTES = 32768;
constexpr int CTL_EXIT_WORD = 3968, CTL_FLAG_WORD = 8192 + 64;
constexpr unsigned CTL_TOKEN = 0x600DF00Du, CTL_RESET = 0x0BADF00Du;

constexpr int LDS_BYTES = 147456;

struct Args {
    const float* in[20];
    float* out;
    unsigned char* ws;
};

__device__ __forceinline__ unsigned f2bf(float f) { unsigned u = __builtin_bit_cast(unsigned, f); return (u + 0x7fffu + ((u >> 16) & 1u)) >> 16; }
__device__ __forceinline__ unsigned pk2(float lo, float hi) { return f2bf(lo) | (f2bf(hi) << 16); }
__device__ __forceinline__ float bf2f(unsigned short b) { return __builtin_bit_cast(float, ((unsigned)b) << 16); }
__device__ __forceinline__ float bflo(unsigned w) { return __builtin_bit_cast(float, w << 16); }
__device__ __forceinline__ float bfhi(unsigned w) { return __builtin_bit_cast(float, w & 0xffff0000u); }
__device__ __forceinline__ float wave_sum(float v) {
#pragma unroll
    for (int o = 1; o < 64; o <<= 1) v += __shfl_xor(v, o);
    return v;
}
__device__ __forceinline__ float silu_f(float v) { return v * __builtin_amdgcn_rcpf(1.0f + __builtin_amdgcn_exp2f(-1.4426950408889634f * v)); }
__device__ __forceinline__ float sigmoid_f(float v) { return __builtin_amdgcn_rcpf(1.0f + __builtin_amdgcn_exp2f(-1.4426950408889634f * v)); }
__device__ __forceinline__ float gelu_tanh(float v) { const float w = __builtin_fmaf(v * v, -0.10294324f, -2.3022082f); return v * __builtin_amdgcn_rcpf(1.0f + __builtin_amdgcn_exp2f(v * w)); }
#define LDS_WAIT() asm volatile("s_waitcnt lgkmcnt(0)" ::: "memory")
__device__ __forceinline__ int otid() { int t = threadIdx.x; asm volatile("" : "+v"(t)); return t; }

#define XB_TMO      128
#define XB_XCNT(j)  (256  + 64 * (j))
#define XB_XSUB(j)  (1280 + 64 * (j))
#define XB_XGEN(j)  (2304 + 64 * (j))
#define XB_TOP      3328
#define XB_TOPGEN   3392
#define XCD_BAR_WORDS 3456
#define XB_SPIN_CAP (1u << 18)

__device__ __forceinline__ unsigned xb_ld(unsigned* p)              { return __hip_atomic_load(p, __ATOMIC_RELAXED, __HIP_MEMORY_SCOPE_AGENT); }
__device__ __forceinline__ unsigned xb_add(unsigned* p, unsigned v) { return __hip_atomic_fetch_add(p, v, __ATOMIC_RELAXED, __HIP_MEMORY_SCOPE_AGENT); }
__device__ __forceinline__ unsigned xb_xcc_id() { return (unsigned)__builtin_amdgcn_s_getreg((3 << 11) | 20) & 0xFu; }
#define XB_SPIN(cond, bar) do { unsigned _sp = 0; while (cond) { __builtin_amdgcn_s_sleep(1); \
    if ((++_sp & 255u) == 0u) { if (xb_ld(&(bar)[XB_TMO])) break; if (_sp > XB_SPIN_CAP) { atomicAdd(&(bar)[XB_TMO], 1u); break; } } } } while (0)

struct XcdBarrier {
    unsigned* bar; unsigned x;
    volatile LAS unsigned* st;
};

__device__ __forceinline__ XcdBarrier xcd_barrier_post(unsigned* bar, volatile LAS unsigned* st) {
    XcdBarrier b; b.bar = bar; b.x = xb_xcc_id(); b.st = st;
    if (threadIdx.x == 0) (void)xb_add(&bar[XB_XCNT(b.x)], 1u);
    return b;
}
__device__ __forceinline__ void xcd_barrier_complete(unsigned* bar, unsigned x, unsigned& nloc, unsigned& nx) {
    const unsigned G = gridDim.x * gridDim.y * gridDim.z;
    unsigned sum, cnt, mine, sp = 0u;
    for (;;) {
        sum = 0u; cnt = 0u; mine = 0u;
#pragma unroll
        for (unsigned j = 0; j < 16; ++j) { const unsigned c = xb_ld(&bar[XB_XCNT(j)]); sum += c; cnt += (c > 0u) ? 1u : 0u; mine = (j == x) ? c : mine; }
        if (sum == G) break;
        __builtin_amdgcn_s_sleep(1);
        if ((++sp & 255u) == 0u) { if (xb_ld(&bar[XB_TMO])) break; if (sp > XB_SPIN_CAP) { atomicAdd(&bar[XB_TMO], 1u); break; } }
    }
    nloc = mine > 0u ? mine : 1u; nx = cnt > 0u ? cnt : 1u;
}

__device__ __forceinline__ void xcd_barrier(const XcdBarrier& b) {
    asm volatile("s_waitcnt vmcnt(0)" ::: "memory");
    __syncthreads();
    if (threadIdx.x == 0) {
        unsigned* bar = b.bar;
        __builtin_amdgcn_s_waitcnt(0);
        unsigned nloc = b.st[0], nx = b.st[1];
        if (nloc == 0u) { xcd_barrier_complete(bar, b.x, nloc, nx); b.st[0] = nloc; b.st[1] = nx; }
        const unsigned old = xb_add(&bar[XB_XSUB(b.x)], 1u);
        const unsigned gen = old / nloc;
        if (old + 1u == (gen + 1u) * nloc) {
            __builtin_amdgcn_fence(__ATOMIC_RELEASE, "agent");
            asm volatile("s_waitcnt vmcnt(0)" ::: "memory");
            const unsigned og = xb_add(&bar[XB_TOP], 1u);
            const unsigned tg = og / nx;
            if (og + 1u == (tg + 1u) * nx) xb_add(&bar[XB_TOPGEN], 1u);
            else XB_SPIN(xb_ld(&bar[XB_TOPGEN]) == tg, bar);
            __builtin_amdgcn_fence(__ATOMIC_ACQUIRE, "agent");
            xb_add(&bar[XB_XGEN(b.x)], 1u);
            asm volatile("s_waitcnt vmcnt(0)" ::: "memory");
        } else {
            XB_SPIN(xb_ld(&bar[XB_XGEN(b.x)]) == gen, bar);
            __builtin_amdgcn_fence(__ATOMIC_ACQUIRE, "agent");
            asm volatile("s_waitcnt vmcnt(0)" ::: "memory");
        }
    }
    __syncthreads();
}

__device__ __forceinline__ void rms_row_to_bf16(const float* xrow, bf16_t* orow, const float* gain, int lane) {
    const f32x4* xr = (const f32x4*)xrow + lane;
    f32x4 v[4]; float s = 0.f;
#pragma unroll
    for (int j = 0; j < 4; ++j) { v[j] = xr[64 * j]; s += (v[j].x * v[j].x + v[j].y * v[j].y) + (v[j].z * v[j].z + v[j].w * v[j].w); }
    const float rstd = 1.0f / sqrtf(wave_sum(s) * (1.0f / DM) + NORM_EPS);
    unsigned long long* o8 = (unsigned long long*)orow + lane;
#pragma unroll
    for (int j = 0; j < 4; ++j) {
        f32x4 g = gain ? ((const f32x4*)gain)[lane + 64 * j] : (f32x4){1.f, 1.f, 1.f, 1.f};
        o8[64 * j] = (unsigned long long)pk2(v[j].x * rstd * g.x, v[j].y * rstd * g.y) | ((unsigned long long)pk2(v[j].z * rstd * g.z, v[j].w * rstd * g.w) << 32);
    }
}
__device__ __forceinline__ void transpose_item(const float* W, int K, int N, bf16_t* WT, const float* ks, LAS float* scr, int item, int lane) {
    const int nblk = N / 32, kb = item / nblk, nb = item % nblk, k0 = 64 * kb, n0 = 32 * nb;
#pragma unroll 8
    for (int i = 0; i < 32; ++i) { const int kk = 2 * i + (lane >> 5); float w = W[(size_t)(k0 + kk) * N + n0 + (lane & 31)]; if (ks) w *= ks[k0 + kk]; scr[kk * 33 + (lane & 31)] = w; }
    LDS_WAIT();
    const int c = lane & 7;
#pragma unroll
    for (int j = 0; j < 4; ++j) { const int n = (lane >> 3) + 8 * j; const LAS float* s = scr + (8 * c) * 33 + n;
        v4u o; o.x = pk2(s[0 * 33], s[1 * 33]); o.y = pk2(s[2 * 33], s[3 * 33]); o.z = pk2(s[4 * 33], s[5 * 33]); o.w = pk2(s[6 * 33], s[7 * 33]);
        *(v4u*)(WT + (size_t)(n0 + n) * K + k0 + 8 * c) = o; }
    LDS_WAIT();
}


__device__ __forceinline__ void s5_tables(const Args& a, LAS unsigned char* lds, int tid) {
    const int bid = blockIdx.x; if (bid >= 192) return;
    const int g = bid % NG, q = bid / NG;
    const float* lam_re = a.in[4]; const float* lam_im = a.in[5]; const float* b_re = a.in[6]; const float* b_im = a.in[7]; const float* c_re = a.in[8]; const float* c_im = a.in[9]; const float* log_dt = a.in[11];
    LAS float* LPr = (LAS float*)(lds + 69632); LAS float* LPi = LPr + 17 * 64; LAS float* BBr = LPi + 17 * 64; LAS float* BBi = BBr + 1024;
    LAS float* Cr = BBi + 1024; LAS float* Ci = Cr + 1024; LAS float* KT = Ci + 1024;
    if (tid < 64) {
        const int p = tid, i = g * NP + p;
        const double dt = exp((double)log_dt[g]);
        const double lr = lam_re[i], li = lam_im[i];
        const double er = exp(lr * dt), ang = li * dt;
        const double lbr = er * cos(ang), lbi = er * sin(ang);
        const double nr = lbr - 1.0, ni = lbi, den = lr * lr + li * li;
        const double qr = (nr * lr + ni * li) / den, qi = (ni * lr - nr * li) / den;
        for (int h = 0; h < GH; ++h) { const double br = b_re[i * GH + h], bi = b_im[i * GH + h];
            BBr[p * 16 + h] = (float)(qr * br - qi * bi); BBi[p * 16 + h] = (float)(qr * bi + qi * br); }
        double pr = 1.0, pi = 0.0;
        for (int t = 0; t < 16; ++t) { LPr[t * 64 + p] = (float)pr; LPi[t * 64 + p] = (float)pi; const double nr2 = pr * lbr - pi * lbi, ni2 = pr * lbi + pi * lbr; pr = nr2; pi = ni2; }
        LPr[16 * 64 + p] = (float)pr; LPi[16 * 64 + p] = (float)pi;
        double tr = pr, ti = pi;
        if (q == 0) { float* LAMT = (float*)(a.ws + WS_LAMT); LAMT[2 * i] = (float)tr; LAMT[2 * i + 1] = (float)ti; }
        for (int k = 0; k < 5; ++k) { const double nr2 = tr * tr - ti * ti, ni2 = 2.0 * tr * ti; tr = nr2; ti = ni2; }
        if (q == 0) { float* L512 = (float*)(a.ws + WS_LAM512); L512[2 * i] = (float)tr; L512[2 * i + 1] = (float)ti; }
    }
    for (int i = tid; i < 1024; i += 512) { Cr[i] = c_re[g * 1024 + i]; Ci[i] = c_im[g * 1024 + i]; }
    __syncthreads();
    { const int tau = tid >> 5, hol = (tid >> 4) & 1, hi = tid & 15, ho = 2 * q + hol; float sacc = 0.f;
#pragma unroll 4
      for (int p = 0; p < 64; ++p) { const float lpr = LPr[tau * 64 + p], lpi = LPi[tau * 64 + p], br = BBr[p * 16 + hi], bi = BBi[p * 16 + hi];
          const float wr_ = lpr * br - lpi * bi, wi_ = lpr * bi + lpi * br; sacc += Cr[ho * 64 + p] * wr_ - Ci[ho * 64 + p] * wi_; }
      KT[tid] = sacc; }
    __syncthreads();
    bf16_t* WSb = (bf16_t*)(a.ws + WS_WS); bf16_t* WYb = (bf16_t*)(a.ws + WS_WY);
#pragma unroll
    for (int kk = 0; kk < 2; ++kk) { const int ch = tid + 512 * kk, n = 32 * q + (ch >> 5), k0 = (ch & 31) * 8, p = n & 63, isim = (n >> 6) & 1;
        float v[8];
#pragma unroll
        for (int j = 0; j < 8; ++j) { const int k = k0 + j, t = k >> 4, h = k & 15, tau = 15 - t; const float lpr = LPr[tau * 64 + p], lpi = LPi[tau * 64 + p], br = BBr[p * 16 + h], bi = BBi[p * 16 + h];
            const float val = isim ? (lpr * bi + lpi * br) : (lpr * br - lpi * bi); v[j] = n < 128 ? val : 0.f; }
        v4u o; o.x = pk2(v[0], v[1]); o.y = pk2(v[2], v[3]); o.z = pk2(v[4], v[5]); o.w = pk2(v[6], v[7]);
        *(v4u*)(WSb + ((size_t)(g * 256 + n)) * 256 + k0) = o; }
#pragma unroll
    for (int kk = 0; kk < 4; ++kk) { const int ch = tid + 512 * kk, rr = ch >> 6, to = rr >> 1, hol = rr & 1, ho = 2 * q + hol, n = to * 16 + ho, k0 = (ch & 63) * 8;
        float v[8];
#pragma unroll
        for (int j = 0; j < 8; ++j) { const int k = k0 + j; float val;
            if (k < 256) { const int ti = k >> 4, hi = k & 15; val = ti <= to ? KT[((to - ti) * 2 + hol) * 16 + hi] : 0.f; }
            else { const int jj = (k - 256) & 127, p = jj & 63, isim = jj >> 6; const float lpr = LPr[(to + 1) * 64 + p], lpi = LPi[(to + 1) * 64 + p], cr = Cr[ho * 64 + p], ci = Ci[ho * 64 + p];
                val = isim ? -(cr * lpi + ci * lpr) : (cr * lpr - ci * lpi); }
            v[j] = val; }
        v4u o; o.x = pk2(v[0], v[1]); o.y = pk2(v[2], v[3]); o.z = pk2(v[4], v[5]); o.w = pk2(v[6], v[7]);
        *(v4u*)(WYb + ((size_t)(g * 256 + n)) * 512 + k0) = o; }
}

__device__ __forceinline__ void rms_rows2_to_bf16(const float* x0, const float* x1, bf16_t* o0, bf16_t* o1, const float* gain, int lane) {
    const f32x4* xr0 = (const f32x4*)x0 + lane; const f32x4* xr1 = (const f32x4*)x1 + lane;
    f32x4 v[4], w[4]; float s0 = 0.f, s1 = 0.f;
#pragma unroll
    for (int j = 0; j < 4; ++j) { v[j] = xr0[64 * j]; w[j] = xr1[64 * j]; }
#pragma unroll
    for (int j = 0; j < 4; ++j) { s0 += (v[j].x * v[j].x + v[j].y * v[j].y) + (v[j].z * v[j].z + v[j].w * v[j].w); s1 += (w[j].x * w[j].x + w[j].y * w[j].y) + (w[j].z * w[j].z + w[j].w * w[j].w); }
#pragma unroll
    for (int o = 1; o < 64; o <<= 1) { s0 += __shfl_xor(s0, o); s1 += __shfl_xor(s1, o); }
    const float r0 = 1.0f / sqrtf(s0 * (1.0f / DM) + NORM_EPS), r1 = 1.0f / sqrtf(s1 * (1.0f / DM) + NORM_EPS);
    unsigned long long* p0 = (unsigned long long*)o0 + lane; unsigned long long* p1 = (unsigned long long*)o1 + lane;
#pragma unroll
    for (int j = 0; j < 4; ++j) {
        const f32x4 g = gain ? ((const f32x4*)gain)[lane + 64 * j] : (f32x4){1.f, 1.f, 1.f, 1.f};
        p0[64 * j] = (unsigned long long)pk2(v[j].x * r0 * g.x, v[j].y * r0 * g.y) | ((unsigned long long)pk2(v[j].z * r0 * g.z, v[j].w * r0 * g.w) << 32);
        p1[64 * j] = (unsigned long long)pk2(w[j].x * r1 * g.x, w[j].y * r1 * g.y) | ((unsigned long long)pk2(w[j].z * r1 * g.z, w[j].w * r1 * g.w) << 32);
    }
}
__device__ __forceinline__ void transpose_item4(const float* W, int K, int N, bf16_t* WT, const float* ks, LAS float* scr, int item, int lane) {
    const int nblk = N / 32, kb = item / nblk, nb = item % nblk, k0 = 64 * kb, n0 = 32 * nb;
    f32x4 w[8];
#pragma unroll
    for (int i = 0; i < 8; ++i) { const int kk = 8 * i + (lane >> 3); w[i] = *(const f32x4*)(W + (size_t)(k0 + kk) * N + n0 + 4 * (lane & 7)); }
#pragma unroll
    for (int i = 0; i < 8; ++i) { const int kk = 8 * i + (lane >> 3); const float sc = ks ? ks[k0 + kk] : 1.0f; LAS float* d = scr + kk * 33 + 4 * (lane & 7);
        d[0] = w[i].x * sc; d[1] = w[i].y * sc; d[2] = w[i].z * sc; d[3] = w[i].w * sc; }
    LDS_WAIT();
    const int c = lane & 7;
#pragma unroll
    for (int j = 0; j < 4; ++j) { const int n = (lane >> 3) + 8 * j; const LAS float* sp = scr + (8 * c) * 33 + n;
        v4u o; o.x = pk2(sp[0 * 33], sp[1 * 33]); o.y = pk2(sp[2 * 33], sp[3 * 33]); o.z = pk2(sp[4 * 33], sp[5 * 33]); o.w = pk2(sp[6 * 33], sp[7 * 33]);
        *(v4u*)(WT + (size_t)(n0 + n) * K + k0 + 8 * c) = o; }
    LDS_WAIT();
}

__device__ __forceinline__ void phase0(const Args& a, LAS unsigned char* lds) {
    const int tid = otid(), lane = tid & 63, wave = tid >> 6;
    const int gw = blockIdx.x * 8 + wave, NGW = gridDim.x * 8;
    s5_tables(a, lds, tid);
    const float* x = a.in[0]; const float* mem = a.in[1]; const float* norm_g = a.in[2]; const float* w_in = a.in[3];
    const float* w_glu = a.in[12]; const float* mem_norm_g = a.in[16]; const float* w_mem_kv = a.in[17]; const float* w_out = a.in[18];
    bf16_t* XB = (bf16_t*)(a.ws + WS_XB); bf16_t* MEMN = (bf16_t*)(a.ws + WS_MEMN);
    bf16_t* WINT = (bf16_t*)(a.ws + WS_WINT); bf16_t* WKVT = (bf16_t*)(a.ws + WS_WKVT); bf16_t* WOUTT = (bf16_t*)(a.ws + WS_WOUTT); bf16_t* WGLUT = (bf16_t*)(a.ws + WS_WGLUT);
    for (int r2 = gw; r2 < (NTOK + NB * NMEM) / 2; r2 += NGW) { const int r = 2 * r2;
        if (r < NTOK) rms_rows2_to_bf16(x + (size_t)r * DM, x + (size_t)(r + 1) * DM, XB + (size_t)r * DM, XB + (size_t)(r + 1) * DM, nullptr, lane);
        else { const int m = r - NTOK; rms_rows2_to_bf16(mem + (size_t)m * DM, mem + (size_t)(m + 1) * DM, MEMN + (size_t)m * DM, MEMN + (size_t)(m + 1) * DM, mem_norm_g, lane); }
    }
    LAS float* scr = (LAS float*)(lds + wave * 8448);
    constexpr int I_IN = (DM / 64) * (DIN / 32), I_KV = (DM / 64) * (512 / 32), I_OUT = (DM / 64) * (DM / 32), I_GLU = (WSSM / 64) * (WSSM / 32);
    for (int it = gw; it < I_IN + I_KV + I_OUT + I_GLU; it += NGW) {
        int r = it;
        if (r < I_IN) { transpose_item4(w_in, DM, DIN, WINT, norm_g, scr, r, lane); continue; } r -= I_IN;
        if (r < I_KV) { transpose_item4(w_mem_kv, DM, 512, WKVT, nullptr, scr, r, lane); continue; } r -= I_KV;
        if (r < I_OUT) { transpose_item4(w_out, DM, DM, WOUTT, nullptr, scr, r, lane); continue; } r -= I_OUT;
        transpose_item4(w_glu, WSSM, WSSM, WGLUT, nullptr, scr, r, lane);
    }
    const int gt = blockIdx.x * 512 + tid, NT = gridDim.x * 512;
    for (int i = gt; i < 128 * 384 / 2; i += NT) ((unsigned*)(WGLUT + 384 * 384))[i] = 0u;
}

template <class Epi>
__device__ __forceinline__ void gemm_naive(const bf16_t* A, int lda, const bf16_t* Bt, int ldb, int M, int N, int K, LAS unsigned char* lds, int tile0, int ntile_total, const Epi& epi) {
    LAS float* As = (LAS float*)lds;
    LAS float* Bs = As + 32 * 132;
    const int tid = threadIdx.x, ty = tid >> 4, tx = tid & 15;
    const int ntn = N / 64, nt = (M / 128) * ntn;
    (void)ntile_total;
    for (int tile = blockIdx.x - tile0; tile < nt; tile += gridDim.x) {
        if (tile < 0) continue;
        const int tm = tile / ntn, tn = tile % ntn;
        float acc[4][4];
#pragma unroll
        for (int i = 0; i < 4; ++i)
#pragma unroll
            for (int j = 0; j < 4; ++j) acc[i][j] = 0.f;
        for (int k0 = 0; k0 < K; k0 += 32) {
            __syncthreads();
            { const int r = tid >> 2, kc = (tid & 3) * 8; const v4u v = *(const v4u*)(A + (size_t)(tm * 128 + r) * lda + k0 + kc);
              As[(kc + 0) * 132 + r] = bflo(v.x); As[(kc + 1) * 132 + r] = bfhi(v.x); As[(kc + 2) * 132 + r] = bflo(v.y); As[(kc + 3) * 132 + r] = bfhi(v.y);
              As[(kc + 4) * 132 + r] = bflo(v.z); As[(kc + 5) * 132 + r] = bfhi(v.z); As[(kc + 6) * 132 + r] = bflo(v.w); As[(kc + 7) * 132 + r] = bfhi(v.w); }
            if (tid < 256) { const int r = tid >> 2, kc = (tid & 3) * 8; const v4u v = *(const v4u*)(Bt + (size_t)(tn * 64 + r) * ldb + k0 + kc);
              Bs[(kc + 0) * 68 + r] = bflo(v.x); Bs[(kc + 1) * 68 + r] = bfhi(v.x); Bs[(kc + 2) * 68 + r] = bflo(v.y); Bs[(kc + 3) * 68 + r] = bfhi(v.y);
              Bs[(kc + 4) * 68 + r] = bflo(v.z); Bs[(kc + 5) * 68 + r] = bfhi(v.z); Bs[(kc + 6) * 68 + r] = bflo(v.w); Bs[(kc + 7) * 68 + r] = bfhi(v.w); }
            __syncthreads();
#pragma unroll 8
            for (int k = 0; k < 32; ++k) {
                const f32x4 av = *(const LAS f32x4*)(As + k * 132 + ty * 4), bv = *(const LAS f32x4*)(Bs + k * 68 + tx * 4);
#pragma unroll
                for (int i = 0; i < 4; ++i)
#pragma unroll
                    for (int j = 0; j < 4; ++j) acc[i][j] += av[i] * bv[j];
            }
        }
#pragma unroll
        for (int i = 0; i < 4; ++i)
#pragma unroll
            for (int j = 0; j < 4; ++j) epi(tm * 128 + ty * 4 + i, tn * 64 + tx * 4 + j, acc[i][j]);
    }
}

struct EpiStoreBf16 { bf16_t* O; int ldo; __device__ __forceinline__ void operator()(int r, int c, float v) const { O[(size_t)r * ldo + c] = (bf16_t)f2bf(v); } };
struct EpiGlu { const bf16_t* GB; const bf16_t* PROJ; const float* b_glu; bf16_t* YCAT;
    __device__ __forceinline__ void operator()(int r, int c, float v) const {
        const float g = bf2f(GB[(size_t)r * WSSM + c]); const float gate = bf2f(PROJ[(size_t)r * DIN + C_AGATE + c]);
        YCAT[(size_t)r * DM + c] = (bf16_t)f2bf(g * sigmoid_f(v + b_glu[c]) * silu_f(gate)); } };
struct EpiOut { const float* x; float* out; __device__ __forceinline__ void operator()(int r, int c, float v) const { out[(size_t)r * DM + c] = x[(size_t)r * DM + c] + v; } };


namespace pg8 {
typedef short bf16x8 __attribute__((ext_vector_type(8)));
typedef unsigned u32x4 __attribute__((ext_vector_type(4)));
constexpr int BM = 256, BK = 64, HALF = 128, HTB = HALF * BK * 2, STAGE_BYTES = 8 * HTB, NXCD = 8, WGM = 8;
__host__ __device__ __forceinline__ int lds_byte(int r, int c) { const int st = (r >> 4) * 2 + (c >> 5), rr = r & 15, cc = c & 31, ob = rr * 64 + cc * 2; return st * 1024 + (ob ^ (((ob >> 9) & 1) << 5)); }
__host__ __device__ __forceinline__ void stage_rc(int b, int& R, int& C) { const int st = b / 1024, sb = b % 1024, swz = sb ^ (((sb >> 9) & 1) << 5); R = (st >> 1) * 16 + swz / 64; C = (st & 1) * 32 + (swz % 64) / 2; }
__host__ __device__ __forceinline__ int perm32(int rho) { const int n = rho >> 4, i = rho & 15; return 8 * (i >> 2) + 4 * n + (i & 3); }
struct Unit { int pm, pn, z; };
struct Gemm { const bf16_t* A; const bf16_t* Bt; int lda, ldb, K; size_t sAz, sBz; };
struct Order {
    int nM, nN, per, total, G, c;
    __device__ void init(int nM_, int nN_, int nZ_, int G_, int c_) { nM = nM_; nN = nN_; per = nM_ * nN_; total = per * nZ_; G = G_; c = c_; }
    __device__ bool next(int i, Unit& u) const {
        const long L = (long)i * G + c; if (L >= total) return false;
        u.z = (int)(L / per); int wgid = (int)(L % per); const int nwg = per;
        { const int q = nwg / NXCD, r = nwg % NXCD, xcd = wgid % NXCD, off = wgid / NXCD; wgid = (xcd < r ? xcd * (q + 1) : r * (q + 1) + (xcd - r) * q) + off; }
        const int nig = WGM * nN, gid = wgid / nig, fm = gid * WGM, gsz = (nM - fm) < WGM ? (nM - fm) : WGM;
        u.pm = fm + ((wgid % nig) % gsz); u.pn = (wgid % nig) / gsz; return true;
    }
};
typedef __bf16 bf2v_t __attribute__((ext_vector_type(2))); typedef float f2v_t __attribute__((ext_vector_type(2)));
__device__ __forceinline__ unsigned cvt_pk_bf16(float lo, float hi) { const f2v_t v = {lo, hi}; return __builtin_bit_cast(unsigned, __builtin_convertvector(v, bf2v_t)); }

template <class Epi>
__device__ __forceinline__ void gemm_phase(LAS unsigned char* lds, const Gemm g, const Order& S, const Epi& E) {
    int tid = threadIdx.x; asm volatile("" : "+v"(tid));
    const int wid = __builtin_amdgcn_readfirstlane(tid >> 6), lane = tid & 63, wr = wid >> 2, wc = wid & 3, fr = lane & 15, fq = lane >> 4;
    int K = g.K; asm volatile("" : "+s"(K));
    const int nt = K / BK;
    unsigned voffA[2], voffB[2];
#pragma unroll
    for (int i = 0; i < 2; ++i) { int R, C; stage_rc(tid * 16 + i * 8192, R, C); const int Rb = Epi::PERM ? ((R & ~31) + perm32(R & 31)) : R;
        voffA[i] = (unsigned)(R * g.lda + C) * 2u; voffB[i] = (unsigned)(Rb * g.ldb + C) * 2u; }
    const size_t kstep = (size_t)(BK * 2);
    const size_t hstepA = (size_t)HALF * g.lda * 2, hstepB = (size_t)HALF * g.ldb * 2;
    const size_t tstepA = 2 * hstepA, tstepB = 2 * hstepB;
    const unsigned ldsw = (unsigned)wid * 1024u;
    const int aoff = lds_byte(wr * 64 + fr, fq * 8), boff = lds_byte(wc * 32 + fr, fq * 8);
#define PG8_SA(b, h) (((b) * 2 + (h)) * HTB)
#define PG8_SB(b, h) ((4 + (b) * 2 + (h)) * HTB)
#define PG8_STAGE(bufoff, gbase, voff) do { _Pragma("unroll") for (int _i = 0; _i < 2; ++_i) \
        __builtin_amdgcn_global_load_lds((const unsigned*)((const char*)(gbase) + (voff)[_i]), (LAS unsigned*)(lds + (bufoff) + ldsw + _i * 8192), 16, 0, 0); } while (0)
#define PG8_LDA(dst, b, h) do { _Pragma("unroll") for (int m = 0; m < 4; ++m) _Pragma("unroll") for (int k = 0; k < 2; ++k) dst[m][k] = *(const LAS bf16x8*)(lds + PG8_SA(b, h) + aoff + m * 2048 + k * 1024); } while (0)
#define PG8_LDB(dst, b, h) do { _Pragma("unroll") for (int n = 0; n < 2; ++n) _Pragma("unroll") for (int k = 0; k < 2; ++k) dst[n][k] = *(const LAS bf16x8*)(lds + PG8_SB(b, h) + boff + n * 2048 + k * 1024); } while (0)
#define PG8_MMA(ai, bj, At, Bt) do { __builtin_amdgcn_s_setprio(1); _Pragma("unroll") for (int m = 0; m < 4; ++m) _Pragma("unroll") for (int n = 0; n < 2; ++n) _Pragma("unroll") for (int k = 0; k < 2; ++k) \
        acc[ai][bj][m][n] = __builtin_amdgcn_mfma_f32_16x16x32_bf16(Bt[n][k], At[m][k], acc[ai][bj][m][n], 0, 0, 0); __builtin_amdgcn_s_setprio(0); } while (0)
#define PG8_WAIT_V(n) asm volatile("s_waitcnt vmcnt(" #n ")" ::: "memory")
#define PG8_WAIT_L(n) asm volatile("s_waitcnt lgkmcnt(" #n ")" ::: "memory")
#define PG8_BAR __builtin_amdgcn_s_barrier()
#define PG8_SCHED __builtin_amdgcn_sched_barrier(0)
    Unit cur, nxt; int ui = 0;
    if (!S.next(0, cur)) return;
    f32x4 acc[2][2][4][2];
#pragma unroll
    for (int a = 0; a < 2; ++a)
#pragma unroll
        for (int b = 0; b < 2; ++b)
#pragma unroll
            for (int m = 0; m < 4; ++m)
#pragma unroll
                for (int n = 0; n < 2; ++n) acc[a][b][m][n] = (f32x4){0.f, 0.f, 0.f, 0.f};
    bf16x8 At[4][2], B0[2][2], B1[2][2];
    const char* cA = (const char*)(g.A + (size_t)cur.z * g.sAz) + (size_t)cur.pm * tstepA; const char* cB = (const char*)(g.Bt + (size_t)cur.z * g.sBz) + (size_t)cur.pn * tstepB;
    PG8_STAGE(PG8_SB(0, 0), cB, voffB); PG8_STAGE(PG8_SA(0, 0), cA, voffA); PG8_STAGE(PG8_SB(0, 1), cB + hstepB, voffB); PG8_STAGE(PG8_SA(0, 1), cA + hstepA, voffA);
    if (wr == 1) PG8_BAR;
    PG8_WAIT_V(4); PG8_BAR;
    PG8_STAGE(PG8_SB(1, 0), cB + kstep, voffB); PG8_STAGE(PG8_SA(1, 0), cA + kstep, voffA); PG8_STAGE(PG8_SB(1, 1), cB + hstepB + kstep, voffB);
    PG8_WAIT_V(6); PG8_BAR;
    for (;;) {
        const bool has_next = S.next(ui + 1, nxt);
        const char* nA = has_next ? (const char*)(g.A + (size_t)nxt.z * g.sAz) + (size_t)nxt.pm * tstepA : cA; const char* nB = has_next ? (const char*)(g.Bt + (size_t)nxt.z * g.sBz) + (size_t)nxt.pn * tstepB : cB;
        for (int t = 0; t < nt; t += 2) {
            const bool last = (t == nt - 2);
            const char* a1 = cA + (size_t)(t + 1) * kstep;
            const char* a2 = last ? nA : cA + (size_t)(t + 2) * kstep; const char* b2 = last ? nB : cB + (size_t)(t + 2) * kstep;
            const char* a3 = a2 + kstep; const char* b3 = b2 + kstep;
            PG8_LDB(B0, 0, 0); PG8_SCHED; PG8_LDA(At, 0, 0); PG8_STAGE(PG8_SA(1, 1), a1 + hstepA, voffA);
            PG8_WAIT_L(8); PG8_BAR; PG8_WAIT_L(0); PG8_MMA(0, 0, At, B0); PG8_BAR; PG8_SCHED;
            PG8_LDB(B1, 0, 1); PG8_STAGE(PG8_SB(0, 0), b2, voffB);
            PG8_BAR; PG8_WAIT_L(0); PG8_MMA(0, 1, At, B1); PG8_BAR;
            PG8_LDA(At, 0, 1); PG8_STAGE(PG8_SA(0, 0), a2, voffA);
            PG8_BAR; PG8_WAIT_L(0); PG8_MMA(1, 0, At, B0); PG8_BAR; PG8_SCHED;
            PG8_STAGE(PG8_SB(0, 1), b2 + hstepB, voffB);
            PG8_WAIT_V(6); PG8_BAR; PG8_MMA(1, 1, At, B1); PG8_BAR;
            PG8_LDB(B0, 1, 0); PG8_SCHED; PG8_LDA(At, 1, 0); PG8_STAGE(PG8_SA(0, 1), a2 + hstepA, voffA);
            PG8_WAIT_L(8); PG8_BAR; PG8_WAIT_L(0); PG8_MMA(0, 0, At, B0); PG8_BAR; PG8_SCHED;
            PG8_LDB(B1, 1, 1); PG8_STAGE(PG8_SB(1, 0), b3, voffB);
            PG8_BAR; PG8_WAIT_L(0); PG8_MMA(0, 1, At, B1); PG8_BAR;
            PG8_LDA(At, 1, 1); PG8_STAGE(PG8_SA(1, 0), a3, voffA);
            PG8_BAR; PG8_WAIT_L(0); PG8_MMA(1, 0, At, B0); PG8_BAR; PG8_SCHED;
            PG8_STAGE(PG8_SB(1, 1), b3 + hstepB, voffB);
            PG8_WAIT_V(6); PG8_BAR; PG8_MMA(1, 1, At, B1); PG8_BAR;
        }
        if constexpr (!Epi::AFTER_DRAIN) { E(acc, cur, wr, wc, fr, fq); }
        if (!has_next) break;
#pragma unroll
        for (int a = 0; a < 2; ++a)
#pragma unroll
            for (int b = 0; b < 2; ++b)
#pragma unroll
                for (int m = 0; m < 4; ++m)
#pragma unroll
                    for (int n = 0; n < 2; ++n) acc[a][b][m][n] = (f32x4){0.f, 0.f, 0.f, 0.f};
        cur = nxt; cA = nA; cB = nB; ++ui;
    }
    PG8_WAIT_V(0);
    if (wr == 0) PG8_BAR;
    PG8_BAR;
    if constexpr (Epi::AFTER_DRAIN) { E.fused(acc, cur, wr, wc, fr, fq, lds, wid, lane); }
#undef PG8_SA
#undef PG8_SB
#undef PG8_STAGE
#undef PG8_LDA
#undef PG8_LDB
#undef PG8_MMA
#undef PG8_WAIT_V
#undef PG8_WAIT_L
#undef PG8_BAR
#undef PG8_SCHED
}

struct EpiBf16Store {
    static constexpr bool PERM = true, AFTER_DRAIN = false;
    bf16_t* O; int ldc;
    __device__ __forceinline__ void operator()(const f32x4 (&acc)[2][2][4][2], const Unit& u, int wr, int wc, int fr, int fq) const {
        const int row0 = u.pm * BM + wr * 64 + fr, col0 = u.pn * BM + wc * 32 + 8 * fq;
#pragma unroll
        for (int ai = 0; ai < 2; ++ai)
#pragma unroll
            for (int m = 0; m < 4; ++m) { bf16_t* rowp = O + (size_t)(row0 + ai * HALF + m * 16) * ldc + col0;
#pragma unroll
                for (int bj = 0; bj < 2; ++bj) { const f32x4 v0 = acc[ai][bj][m][0], v1 = acc[ai][bj][m][1];
                    u32x4 w; w.x = cvt_pk_bf16(v0[0], v0[1]); w.y = cvt_pk_bf16(v0[2], v0[3]); w.z = cvt_pk_bf16(v1[0], v1[1]); w.w = cvt_pk_bf16(v1[2], v1[3]);
                    *(u32x4*)(rowp + bj * HALF) = w; } }
    }
};

struct EpiProjAY {
    static constexpr bool PERM = true, AFTER_DRAIN = false;
    bf16_t* PROJ; bf16_t* AY;
    __device__ __forceinline__ void operator()(const f32x4 (&acc)[2][2][4][2], const Unit& u, int wr, int wc, int fr, int fq) const {
        const int rowb = u.pm * BM + wr * 64, col0 = u.pn * BM + wc * 32 + 8 * fq;
#pragma unroll
        for (int bj = 0; bj < 2; ++bj) { const int col = col0 + bj * HALF; const bool ay = col < WSSM;
#pragma unroll
            for (int ai = 0; ai < 2; ++ai)
#pragma unroll
                for (int m = 0; m < 4; ++m) { const int rb = rowb + ai * HALF + m * 16;
                    bf16_t* dst = ay ? AY + ((size_t)((col >> 4) * 1024 + (rb >> 4)) * 512 + fr * 16 + (col & 15)) : PROJ + (size_t)(rb + fr) * DIN + col;
                    const f32x4 v0 = acc[ai][bj][m][0], v1 = acc[ai][bj][m][1];
                    u32x4 w; w.x = cvt_pk_bf16(v0[0], v0[1]); w.y = cvt_pk_bf16(v0[2], v0[3]); w.z = cvt_pk_bf16(v1[0], v1[1]); w.w = cvt_pk_bf16(v1[2], v1[3]);
                    *(u32x4*)dst = w; } }
    }
};
struct EpiSend {
    static constexpr bool PERM = false, AFTER_DRAIN = true;
    bf16_t* AY; const float* LAMT; const float* LAM512;
    __device__ __forceinline__ void fused(const f32x4 (&acc)[2][2][4][2], const Unit& u, int wr, int wc, int fr, int fq, LAS unsigned char* lds, int wid, int lane) const {
        LAS float* S = (LAS float*)lds;
        LAS float* E = (LAS float*)(lds + 131072);
#pragma unroll
        for (int ai = 0; ai < 2; ++ai)
#pragma unroll
            for (int m = 0; m < 4; ++m)
#pragma unroll
                for (int n = 0; n < 2; ++n) { const int r = ai * HALF + wr * 64 + m * 16 + fr, c = wc * 32 + n * 16 + 4 * fq; *(LAS f32x4*)(S + r * 128 + c) = acc[ai][0][m][n]; }
        __syncthreads();
        const int g = u.z, b = u.pm, p = lane, seg = wid;
        const float tr = LAMT[(g * NP + p) * 2], ti = LAMT[(g * NP + p) * 2 + 1], hr = LAM512[(g * NP + p) * 2], hi = LAM512[(g * NP + p) * 2 + 1];
        float sr = 0.f, si = 0.f;
        for (int i = 0; i < 32; ++i) { const int row = seg * 32 + i; const float xr = S[row * 128 + p], xi = S[row * 128 + 64 + p];
            const float nr = tr * sr - ti * si + xr, ni = tr * si + ti * sr + xi; sr = nr; si = ni; }
        E[seg * 128 + p] = sr; E[seg * 128 + 64 + p] = si;
        __syncthreads();
        sr = 0.f; si = 0.f;
        for (int s2 = 0; s2 < seg; ++s2) { const float xr = E[s2 * 128 + p], xi = E[s2 * 128 + 64 + p]; const float nr = hr * sr - hi * si + xr, ni = hr * si + hi * sr + xi; sr = nr; si = ni; }
        bf16_t* base = AY + ((size_t)(g * 1024 + b * 256 + seg * 32)) * 512 + 256 + p;
        for (int i = 0; i < 32; ++i) { const int row = seg * 32 + i;
            bf16_t* o = base + (size_t)i * 512;
            o[0] = (bf16_t)f2bf(sr); o[64] = (bf16_t)f2bf(si);
            const float xr = S[row * 128 + p], xi = S[row * 128 + 64 + p];
            const float nr = tr * sr - ti * si + xr, ni = tr * si + ti * sr + xi; sr = nr; si = ni; }
    }
};
struct EpiY {
    static constexpr bool PERM = true, AFTER_DRAIN = false;
    const bf16_t* AY; const float* ssm_d; bf16_t* GB;
    __device__ __forceinline__ void operator()(const f32x4 (&acc)[2][2][4][2], const Unit& u, int wr, int wc, int fr, int fq) const {
        const int g = u.z, b = u.pm;
#pragma unroll
        for (int bj = 0; bj < 2; ++bj) { const int col = bj * HALF + wc * 32 + 8 * fq, t = col >> 4, h0 = col & 15;
            const f32x4 d0 = *(const f32x4*)(ssm_d + g * GH + h0), d1 = *(const f32x4*)(ssm_d + g * GH + h0 + 4);
            u32x4 u8[2][4];
#pragma unroll
            for (int ai = 0; ai < 2; ++ai)
#pragma unroll
                for (int m = 0; m < 4; ++m) { const int crow = ai * HALF + wr * 64 + m * 16 + fr; u8[ai][m] = *(const u32x4*)(AY + ((size_t)(g * 1024 + b * 256 + crow)) * 512 + col); }
#pragma unroll
            for (int ai = 0; ai < 2; ++ai)
#pragma unroll
                for (int m = 0; m < 4; ++m) { const int crow = ai * HALF + wr * 64 + m * 16 + fr;
                    const u32x4 uu = u8[ai][m]; const f32x4 v0 = acc[ai][bj][m][0], v1 = acc[ai][bj][m][1];
                    u32x4 w;
                    w.x = cvt_pk_bf16(gelu_tanh(v0[0] + d0[0] * bflo(uu.x)), gelu_tanh(v0[1] + d0[1] * bfhi(uu.x)));
                    w.y = cvt_pk_bf16(gelu_tanh(v0[2] + d0[2] * bflo(uu.y)), gelu_tanh(v0[3] + d0[3] * bfhi(uu.y)));
                    w.z = cvt_pk_bf16(gelu_tanh(v1[0] + d1[0] * bflo(uu.z)), gelu_tanh(v1[1] + d1[1] * bfhi(uu.z)));
                    w.w = cvt_pk_bf16(gelu_tanh(v1[2] + d1[2] * bflo(uu.w)), gelu_tanh(v1[3] + d1[3] * bfhi(uu.w)));
                    *(u32x4*)(GB + ((size_t)(b * SEQ + crow * 16 + t)) * WSSM + g * GH + h0) = w; }
            asm volatile("" ::: "memory"); }
    }
};
struct EpiGluP {
    static constexpr bool PERM = true, AFTER_DRAIN = false;
    const bf16_t* GB; const bf16_t* PROJ; const float* b_glu; bf16_t* YCAT;
    __device__ __forceinline__ void operator()(const f32x4 (&acc)[2][2][4][2], const Unit& u, int wr, int wc, int fr, int fq) const {
        const int row0 = u.pm * BM + wr * 64 + fr, col0 = u.pn * BM + wc * 32 + 8 * fq;
#pragma unroll
        for (int bj = 0; bj < 2; ++bj) { const int col = col0 + bj * HALF; if (col >= WSSM) continue;
            const f32x4 b0 = *(const f32x4*)(b_glu + col), b1 = *(const f32x4*)(b_glu + col + 4);
#pragma unroll
            for (int ai = 0; ai < 2; ++ai) { if (ai != u.z) continue;
                u32x4 g8[4], a8[4];
#pragma unroll
                for (int m = 0; m < 4; ++m) { const size_t row = (size_t)(row0 + ai * HALF + m * 16); g8[m] = *(const u32x4*)(GB + row * WSSM + col); a8[m] = *(const u32x4*)(PROJ + row * DIN + C_AGATE + col); }
#pragma unroll
                for (int m = 0; m < 4; ++m) { const size_t row = (size_t)(row0 + ai * HALF + m * 16);
                    const f32x4 v0 = acc[ai][bj][m][0] + b0, v1 = acc[ai][bj][m][1] + b1;
                    u32x4 w;
                    w.x = cvt_pk_bf16(bflo(g8[m].x) * sigmoid_f(v0[0]) * silu_f(bflo(a8[m].x)), bfhi(g8[m].x) * sigmoid_f(v0[1]) * silu_f(bfhi(a8[m].x)));
                    w.y = cvt_pk_bf16(bflo(g8[m].y) * sigmoid_f(v0[2]) * silu_f(bflo(a8[m].y)), bfhi(g8[m].y) * sigmoid_f(v0[3]) * silu_f(bfhi(a8[m].y)));
                    w.z = cvt_pk_bf16(bflo(g8[m].z) * sigmoid_f(v1[0]) * silu_f(bflo(a8[m].z)), bfhi(g8[m].z) * sigmoid_f(v1[1]) * silu_f(bfhi(a8[m].z)));
                    w.w = cvt_pk_bf16(bflo(g8[m].w) * sigmoid_f(v1[2]) * silu_f(bflo(a8[m].w)), bfhi(g8[m].w) * sigmoid_f(v1[3]) * silu_f(bfhi(a8[m].w)));
                    *(u32x4*)(YCAT + row * DM + col) = w; }
                asm volatile("" ::: "memory"); } }
    }
};
struct EpiResF32 {
    static constexpr bool PERM = false, AFTER_DRAIN = false;
    const float* x; float* out;
    __device__ __forceinline__ void operator()(const f32x4 (&acc)[2][2][4][2], const Unit& u, int wr, int wc, int fr, int fq) const {
        const int row0 = u.pm * BM + wr * 64 + fr, col0 = u.pn * BM + wc * 32 + 4 * fq;
#pragma unroll
        for (int ai = 0; ai < 2; ++ai)
#pragma unroll
            for (int m = 0; m < 4; ++m) { const size_t off = (size_t)(row0 + ai * HALF + m * 16) * DM + col0;
#pragma unroll
                for (int bj = 0; bj < 2; ++bj)
#pragma unroll
                    for (int n = 0; n < 2; ++n) { const f32x4 xv = *(const f32x4*)(x + off + bj * HALF + n * 16); *(f32x4*)(out + off + bj * HALF + n * 16) = xv + acc[ai][bj][m][n]; }
                asm volatile("" ::: "memory"); }
    }
};

struct EpiOutNorm {
    static constexpr bool PERM = false, AFTER_DRAIN = true;
    const float* x; const float* fg; float* out; float* xch; unsigned* cnt;
    __device__ __forceinline__ void fused(f32x4 (&acc)[2][2][4][2], const Unit& u, int wr, int wc, int fr, int fq, LAS unsigned char* lds, int wid, int lane) const {
        LAS float* P = (LAS float*)lds;
        LAS float* S = (LAS float*)(lds + 8192);
        const int row0 = u.pm * BM + wr * 64 + fr, col0 = u.pn * BM + wc * 32 + 4 * fq;
#pragma unroll
        for (int ai = 0; ai < 2; ++ai) {
            f32x4 xv[4][2][2];
#pragma unroll
            for (int m = 0; m < 4; ++m) { const size_t off = (size_t)(row0 + ai * HALF + m * 16) * DM + col0;
#pragma unroll
                for (int bj = 0; bj < 2; ++bj)
#pragma unroll
                    for (int n = 0; n < 2; ++n) xv[m][bj][n] = *(const f32x4*)(x + off + bj * HALF + n * 16); }
#pragma unroll
            for (int m = 0; m < 4; ++m) { float sq = 0.f;
#pragma unroll
                for (int bj = 0; bj < 2; ++bj)
#pragma unroll
                    for (int n = 0; n < 2; ++n) { const f32x4 hv = acc[ai][bj][m][n] + xv[m][bj][n]; acc[ai][bj][m][n] = hv; sq += (hv[0] * hv[0] + hv[1] * hv[1]) + (hv[2] * hv[2] + hv[3] * hv[3]); }
                sq += __shfl_xor(sq, 16); sq += __shfl_xor(sq, 32);
                if (fq == 0) P[(ai * HALF + wr * 64 + m * 16 + fr) * 4 + wc] = sq; }
            asm volatile("" ::: "memory"); }
        asm volatile("s_waitcnt lgkmcnt(0)" ::: "memory"); __builtin_amdgcn_s_barrier(); asm volatile("" ::: "memory");
        const int row = wid * 32 + (lane & 31);
        if (lane < 32) { const f32x4 pv = *(const LAS f32x4*)(P + row * 4); const float t = (pv[0] + pv[1]) + (pv[2] + pv[3]);
            __hip_atomic_store(xch + ((size_t)(u.pm * BM + row) * 4 + u.pn), t, __ATOMIC_RELAXED, __HIP_MEMORY_SCOPE_AGENT); }
        asm volatile("s_waitcnt vmcnt(0)" ::: "memory");
        if (lane == 0) __hip_atomic_fetch_add(cnt + 64 * u.pm, 1u, __ATOMIC_RELAXED, __HIP_MEMORY_SCOPE_AGENT);
        if (wid == 0) { unsigned sp = 0;
            while ((unsigned)__builtin_amdgcn_readfirstlane(__hip_atomic_load(cnt + 64 * u.pm, __ATOMIC_RELAXED, __HIP_MEMORY_SCOPE_AGENT)) < 32u) { __builtin_amdgcn_s_sleep(2); if (++sp > (1u << 22)) break; }
            __builtin_amdgcn_fence(__ATOMIC_ACQUIRE, "agent"); }
        asm volatile("s_waitcnt vmcnt(0) lgkmcnt(0)" ::: "memory"); __builtin_amdgcn_s_barrier(); asm volatile("" ::: "memory");
        if (lane < 32) { const float* slot = xch + (size_t)(u.pm * BM + row) * 4; float t = 0.f;
#pragma unroll
            for (int q = 0; q < 4; ++q) t += __hip_atomic_load(slot + q, __ATOMIC_RELAXED, __HIP_MEMORY_SCOPE_AGENT);
            S[row] = 1.0f / sqrtf(t * (1.0f / DM) + NORM_EPS); }
        asm volatile("s_waitcnt lgkmcnt(0)" ::: "memory"); __builtin_amdgcn_s_barrier(); asm volatile("" ::: "memory");
        f32x4 gv[2][2];
#pragma unroll
        for (int bj = 0; bj < 2; ++bj)
#pragma unroll
            for (int n = 0; n < 2; ++n) gv[bj][n] = *(const f32x4*)(fg + col0 + bj * HALF + n * 16);
#pragma unroll
        for (int ai = 0; ai < 2; ++ai)
#pragma unroll
            for (int m = 0; m < 4; ++m) { const int r = ai * HALF + wr * 64 + m * 16 + fr; const float rs = S[r]; const size_t off = (size_t)(u.pm * BM + r) * DM + col0;
#pragma unroll
                for (int bj = 0; bj < 2; ++bj)
#pragma unroll
                    for (int n = 0; n < 2; ++n) *(f32x4*)(out + off + bj * HALF + n * 16) = acc[ai][bj][m][n] * rs * gv[bj][n]; }
    }
};
}

__device__ __forceinline__ void s5_naive(const Args& a, int b, int g, int lane) {
    const bf16_t* PROJ = (const bf16_t*)(a.ws + WS_PROJ); bf16_t* GB = (bf16_t*)(a.ws + WS_GB);
    const float* LAMB = (const float*)(a.ws + WS_LAMB); const float* BBAR = (const float*)(a.ws + WS_BBAR);
    const float* c_re = a.in[8]; const float* c_im = a.in[9]; const float* ssm_d = a.in[10];
    const int p = lane, h = lane & 15, pg = lane >> 4;
    const float lr = LAMB[(g * NP + p) * 2], li = LAMB[(g * NP + p) * 2 + 1];
    float bre[16], bim[16], cre[16], cim[16];
#pragma unroll
    for (int j = 0; j < 16; ++j) { bre[j] = BBAR[((g * NP + p) * GH + j) * 2]; bim[j] = BBAR[((g * NP + p) * GH + j) * 2 + 1];
        cre[j] = c_re[(g * GH + h) * NP + pg * 16 + j]; cim[j] = c_im[(g * GH + h) * NP + pg * 16 + j]; }
    const float dd = ssm_d[g * GH + h];
    float sr = 0.f, si = 0.f;
    for (int t = 0; t < SEQ; ++t) {
        const bf16_t* up = PROJ + (size_t)(b * SEQ + t) * DIN + C_AIN + g * GH;
        const v4u u0 = *(const v4u*)up, u1 = *(const v4u*)(up + 8);
        float u[16];
        u[0] = bflo(u0.x); u[1] = bfhi(u0.x); u[2] = bflo(u0.y); u[3] = bfhi(u0.y); u[4] = bflo(u0.z); u[5] = bfhi(u0.z); u[6] = bflo(u0.w); u[7] = bfhi(u0.w);
        u[8] = bflo(u1.x); u[9] = bfhi(u1.x); u[10] = bflo(u1.y); u[11] = bfhi(u1.y); u[12] = bflo(u1.z); u[13] = bfhi(u1.z); u[14] = bflo(u1.w); u[15] = bfhi(u1.w);
        const float uh = bf2f(up[h]);
        float bur = 0.f, bui = 0.f;
#pragma unroll
        for (int j = 0; j < 16; ++j) { bur += bre[j] * u[j]; bui += bim[j] * u[j]; }
        const float nsr = lr * sr - li * si + bur, nsi = lr * si + li * sr + bui;
        sr = nsr; si = nsi;
        float part = 0.f;
#pragma unroll
        for (int j = 0; j < 16; ++j) { const float xr = __shfl(sr, pg * 16 + j), xi = __shfl(si, pg * 16 + j); part += cre[j] * xr - cim[j] * xi; }
        part += __shfl_xor(part, 16); part += __shfl_xor(part, 32);
        const float y = part + dd * uh;
        if (lane < 16) GB[(size_t)(b * SEQ + t) * WSSM + g * GH + h] = (bf16_t)f2bf(gelu_tanh(y));
    }
}

__device__ __forceinline__ void conv_naive(const Args& a, int vb, int nvb) {
    const bf16_t* PROJ = (const bf16_t*)(a.ws + WS_PROJ); bf16_t* YCAT = (bf16_t*)(a.ws + WS_YCAT);
    const float* conv_w = a.in[14]; const float* conv_b = a.in[15];
    const int gt = vb * 512 + otid(), NT = nvb * 512;
    for (int idx = gt; idx < NTOK * WSSM; idx += NT) {
        const int tok = idx / WSSM, c = idx % WSSM, t = tok % SEQ;
        const bf16_t* row = PROJ + (size_t)tok * DIN;
        float acc = conv_b[c];
#pragma unroll
        for (int k = 0; k < 3; ++k) { const int tt = t - 2 + k; if (tt >= 0) { const bf16_t* r2 = PROJ + (size_t)(tok - 2 + k) * DIN; acc += conv_w[k * WSSM + c] * (bf2f(r2[C_CC + c]) * bf2f(r2[C_CIN + c])); } }
        const float y = bf2f(row[C_CB + c]) * acc * silu_f(bf2f(row[C_CGATE + c]));
        YCAT[(size_t)tok * DM + WSSM + c] = (bf16_t)f2bf(y);
    }
}
__device__ __forceinline__ void attn_naive(const Args& a, int vb, int nvb) {
    const bf16_t* PROJ = (const bf16_t*)(a.ws + WS_PROJ); bf16_t* YCAT = (bf16_t*)(a.ws + WS_YCAT); const bf16_t* KV = (const bf16_t*)(a.ws + WS_KV);
    const int gt = vb * 512 + otid(), NT = nvb * 512;
    for (int item = gt; item < NB * 4 * SEQ; item += NT) {
        const int t = item % SEQ, hh = (item / SEQ) % 4, b = item / (4 * SEQ), tok = b * SEQ + t;
        const v4u* qp = (const v4u*)(PROJ + (size_t)tok * DIN + C_Q + hh * 64);
        float q[64], o[64];
#pragma unroll
        for (int i = 0; i < 8; ++i) { const v4u v = qp[i]; q[8 * i] = bflo(v.x); q[8 * i + 1] = bfhi(v.x); q[8 * i + 2] = bflo(v.y); q[8 * i + 3] = bfhi(v.y); q[8 * i + 4] = bflo(v.z); q[8 * i + 5] = bfhi(v.z); q[8 * i + 6] = bflo(v.w); q[8 * i + 7] = bfhi(v.w); }
#pragma unroll
        for (int d = 0; d < 64; ++d) o[d] = 0.f;
        float m = -1e30f, l = 0.f;
        for (int mm = 0; mm < NMEM; ++mm) {
            const v4u* kp = (const v4u*)(KV + (size_t)(b * NMEM + mm) * 512 + hh * 64);
            const v4u* vp = (const v4u*)(KV + (size_t)(b * NMEM + mm) * 512 + 256 + hh * 64);
            float s = 0.f;
#pragma unroll
            for (int i = 0; i < 8; ++i) { const v4u v = kp[i];
                s += q[8 * i] * bflo(v.x) + q[8 * i + 1] * bfhi(v.x) + q[8 * i + 2] * bflo(v.y) + q[8 * i + 3] * bfhi(v.y) + q[8 * i + 4] * bflo(v.z) + q[8 * i + 5] * bfhi(v.z) + q[8 * i + 6] * bflo(v.w) + q[8 * i + 7] * bfhi(v.w); }
            s *= 0.125f;
            const float mn = fmaxf(m, s), sc = __expf(m - mn), pp = __expf(s - mn);
            l = l * sc + pp; m = mn;
#pragma unroll
            for (int i = 0; i < 8; ++i) { const v4u v = vp[i];
                o[8 * i] = o[8 * i] * sc + pp * bflo(v.x); o[8 * i + 1] = o[8 * i + 1] * sc + pp * bfhi(v.x); o[8 * i + 2] = o[8 * i + 2] * sc + pp * bflo(v.y); o[8 * i + 3] = o[8 * i + 3] * sc + pp * bfhi(v.y);
                o[8 * i + 4] = o[8 * i + 4] * sc + pp * bflo(v.z); o[8 * i + 5] = o[8 * i + 5] * sc + pp * bfhi(v.z); o[8 * i + 6] = o[8 * i + 6] * sc + pp * bflo(v.w); o[8 * i + 7] = o[8 * i + 7] * sc + pp * bfhi(v.w); }
        }
        const float inv = 1.0f / l;
        const v4u* gp = (const v4u*)(PROJ + (size_t)tok * DIN + C_QGATE + hh * 64);
        v4u* op = (v4u*)(YCAT + (size_t)tok * DM + 768 + hh * 64);
#pragma unroll
        for (int i = 0; i < 8; ++i) { const v4u gv = gp[i]; v4u w;
            w.x = pk2(o[8 * i] * inv * silu_f(bflo(gv.x)), o[8 * i + 1] * inv * silu_f(bfhi(gv.x)));
            w.y = pk2(o[8 * i + 2] * inv * silu_f(bflo(gv.y)), o[8 * i + 3] * inv * silu_f(bfhi(gv.y)));
            w.z = pk2(o[8 * i + 4] * inv * silu_f(bflo(gv.z)), o[8 * i + 5] * inv * silu_f(bfhi(gv.z)));
            w.w = pk2(o[8 * i + 6] * inv * silu_f(bflo(gv.w)), o[8 * i + 7] * inv * silu_f(bfhi(gv.w)));
            op[i] = w; }
    }
}

typedef short bf16x8_t __attribute__((ext_vector_type(8)));
typedef short s16x4_t __attribute__((ext_vector_type(4)));
typedef float f32x16 __attribute__((ext_vector_type(16)));
typedef __bf16 bf2_t __attribute__((ext_vector_type(2)));
typedef float f2_t __attribute__((ext_vector_type(2)));
typedef unsigned u32x2_t __attribute__((ext_vector_type(2)));
__device__ __forceinline__ unsigned cvt2(float lo, float hi) { const f2_t v = {lo, hi}; return __builtin_bit_cast(unsigned, __builtin_convertvector(v, bf2_t)); }
__device__ __forceinline__ void attn_mfma(const Args& a, LAS unsigned char* lds, int vb, int nvb) {
    const int nj = nvb / 16; if (nj < 1 || vb >= nj * 16) return;
    const int tid = otid(), lane = tid & 63, wave = tid >> 6, r = lane & 31, h = lane >> 5;
    const int bh = vb % 16, j = vb / 16, b = bh >> 2, head = bh & 3;
    const bf16_t* PROJ = (const bf16_t*)(a.ws + WS_PROJ); bf16_t* YCAT = (bf16_t*)(a.ws + WS_YCAT); const bf16_t* KV = (const bf16_t*)(a.ws + WS_KV);
    LAS unsigned char* Kl = lds;
    LAS unsigned char* Vl = lds + 36864;
    for (int c = tid; c < 2048; c += 512) { const int key = c >> 3, dch = c & 7;
        const bf16_t* src = KV + (size_t)(b * NMEM + key) * 512 + head * 64 + dch * 8;
        const v4u kv = *(const v4u*)src, vv = *(const v4u*)(src + 256);
        *(LAS v4u*)(Kl + key * 144 + dch * 16) = kv;
        LAS bf16_t* vd = (LAS bf16_t*)(Vl + (dch * 8) * 520 + key * 2);
        vd[0 * 260] = (bf16_t)(vv.x & 0xffff); vd[1 * 260] = (bf16_t)(vv.x >> 16); vd[2 * 260] = (bf16_t)(vv.y & 0xffff); vd[3 * 260] = (bf16_t)(vv.y >> 16);
        vd[4 * 260] = (bf16_t)(vv.z & 0xffff); vd[5 * 260] = (bf16_t)(vv.z >> 16); vd[6 * 260] = (bf16_t)(vv.w & 0xffff); vd[7 * 260] = (bf16_t)(vv.w >> 16); }
    __syncthreads();
    for (int tile = j * 8 + wave; tile < SEQ / 32; tile += nj * 8) {
        const size_t tok = (size_t)b * SEQ + tile * 32 + r;
        bf16x8_t qf[4];
#pragma unroll
        for (int s4 = 0; s4 < 4; ++s4) qf[s4] = *(const bf16x8_t*)(PROJ + tok * DIN + C_Q + head * 64 + 16 * s4 + 8 * h);
        const float sc = 0.125f * 1.4426950408889634f;
        float mx = -3.0e38f, l = 0.f;
        f32x16 o0, o1;
#pragma unroll
        for (int i = 0; i < 16; ++i) { o0[i] = 0.f; o1[i] = 0.f; }
#pragma unroll 2
        for (int kt = 0; kt < 8; ++kt) {
            f32x16 st;
#pragma unroll
            for (int i = 0; i < 16; ++i) st[i] = 0.f;
#pragma unroll
            for (int s4 = 0; s4 < 4; ++s4) { const bf16x8_t kf = *(const LAS bf16x8_t*)(Kl + (kt * 32 + r) * 144 + (16 * s4 + 8 * h) * 2);
                st = __builtin_amdgcn_mfma_f32_32x32x16_bf16(kf, qf[s4], st, 0, 0, 0); }
            float tm = st[0];
#pragma unroll
            for (int i = 1; i < 16; ++i) tm = fmaxf(tm, st[i]);
            tm = fmaxf(tm, __shfl_xor(tm, 32));
            const float mn = fmaxf(mx, tm), alpha = __builtin_amdgcn_exp2f((mx - mn) * sc), mb = mn * sc;
            mx = mn; l *= alpha;
#pragma unroll
            for (int i = 0; i < 16; ++i) { o0[i] *= alpha; o1[i] *= alpha; }
#pragma unroll
            for (int i = 0; i < 16; ++i) { const float p = __builtin_amdgcn_exp2f(st[i] * sc - mb); st[i] = p; l += p; }
#pragma unroll
            for (int s2 = 0; s2 < 2; ++s2) {
                v4u pw; pw.x = cvt2(st[8 * s2 + 0], st[8 * s2 + 1]); pw.y = cvt2(st[8 * s2 + 2], st[8 * s2 + 3]);
                pw.z = cvt2(st[8 * s2 + 4], st[8 * s2 + 5]); pw.w = cvt2(st[8 * s2 + 6], st[8 * s2 + 7]);
                const bf16x8_t pf = __builtin_bit_cast(bf16x8_t, pw);
                const int koff = (kt * 32 + 16 * s2 + 4 * h) * 2;
                { const s16x4_t lo = *(const LAS s16x4_t*)(Vl + r * 520 + koff), hi = *(const LAS s16x4_t*)(Vl + r * 520 + koff + 16);
                  const bf16x8_t vf = __builtin_shufflevector(lo, hi, 0, 1, 2, 3, 4, 5, 6, 7); o0 = __builtin_amdgcn_mfma_f32_32x32x16_bf16(vf, pf, o0, 0, 0, 0); }
                { const s16x4_t lo = *(const LAS s16x4_t*)(Vl + (32 + r) * 520 + koff), hi = *(const LAS s16x4_t*)(Vl + (32 + r) * 520 + koff + 16);
                  const bf16x8_t vf = __builtin_shufflevector(lo, hi, 0, 1, 2, 3, 4, 5, 6, 7); o1 = __builtin_amdgcn_mfma_f32_32x32x16_bf16(vf, pf, o1, 0, 0, 0); }
            }
        }
        l += __shfl_xor(l, 32);
        const float inv = 1.0f / l;
        const bf16_t* gp = PROJ + tok * DIN + C_QGATE + head * 64; bf16_t* op = YCAT + tok * DM + 768 + head * 64;
#pragma unroll
        for (int q4 = 0; q4 < 4; ++q4) {
            { const int d = 8 * q4 + 4 * h; const u32x2_t gv = *(const u32x2_t*)(gp + d); u32x2_t w;
              w.x = cvt2(o0[4 * q4 + 0] * inv * silu_f(bflo(gv.x)), o0[4 * q4 + 1] * inv * silu_f(bfhi(gv.x))); w.y = cvt2(o0[4 * q4 + 2] * inv * silu_f(bflo(gv.y)), o0[4 * q4 + 3] * inv * silu_f(bfhi(gv.y)));
              *(u32x2_t*)(op + d) = w; }
            { const int d = 32 + 8 * q4 + 4 * h; const u32x2_t gv = *(const u32x2_t*)(gp + d); u32x2_t w;
              w.x = cvt2(o1[4 * q4 + 0] * inv * silu_f(bflo(gv.x)), o1[4 * q4 + 1] * inv * silu_f(bfhi(gv.x))); w.y = cvt2(o1[4 * q4 + 2] * inv * silu_f(bflo(gv.y)), o1[4 * q4 + 3] * inv * silu_f(bfhi(gv.y)));
              *(u32x2_t*)(op + d) = w; }
        }
    }
}
__device__ __forceinline__ void conv_vec(const Args& a, int vb, int nvb) {
    const bf16_t* PROJ = (const bf16_t*)(a.ws + WS_PROJ); bf16_t* YCAT = (bf16_t*)(a.ws + WS_YCAT);
    const float* conv_w = a.in[14]; const float* conv_b = a.in[15];
    const int gt = vb * 512 + otid(), NT = nvb * 512;
    for (int it = gt; it < (NTOK / 4) * 48; it += NT) {
        const int tg = it / 48, c0 = (it % 48) * 8, tok0 = tg * 4, t0 = tok0 % SEQ;
        const bf16_t* row0 = PROJ + (size_t)tok0 * DIN;
        v4u cc[6], ci[6], cb[4], cg[4];
#pragma unroll
        for (int r = 0; r < 6; ++r) { const bool ok = (t0 + r - 2) >= 0; const bf16_t* rp = row0 + (ptrdiff_t)(r - 2) * DIN;
            cc[r] = ok ? *(const v4u*)(rp + C_CC + c0) : (v4u){0u, 0u, 0u, 0u}; ci[r] = ok ? *(const v4u*)(rp + C_CIN + c0) : (v4u){0u, 0u, 0u, 0u}; }
#pragma unroll
        for (int j = 0; j < 4; ++j) { cb[j] = *(const v4u*)(row0 + (size_t)j * DIN + C_CB + c0); cg[j] = *(const v4u*)(row0 + (size_t)j * DIN + C_CGATE + c0); }
        float w[3][8], bb[8];
#pragma unroll
        for (int k = 0; k < 3; ++k) { const f32x4 w0 = *(const f32x4*)(conv_w + k * WSSM + c0), w1 = *(const f32x4*)(conv_w + k * WSSM + c0 + 4);
            w[k][0] = w0.x; w[k][1] = w0.y; w[k][2] = w0.z; w[k][3] = w0.w; w[k][4] = w1.x; w[k][5] = w1.y; w[k][6] = w1.z; w[k][7] = w1.w; }
        { const f32x4 b0 = *(const f32x4*)(conv_b + c0), b1 = *(const f32x4*)(conv_b + c0 + 4); bb[0] = b0.x; bb[1] = b0.y; bb[2] = b0.z; bb[3] = b0.w; bb[4] = b1.x; bb[5] = b1.y; bb[6] = b1.z; bb[7] = b1.w; }
        float u[6][8];
#pragma unroll
        for (int r = 0; r < 6; ++r) { u[r][0] = bflo(cc[r].x) * bflo(ci[r].x); u[r][1] = bfhi(cc[r].x) * bfhi(ci[r].x); u[r][2] = bflo(cc[r].y) * bflo(ci[r].y); u[r][3] = bfhi(cc[r].y) * bfhi(ci[r].y);
            u[r][4] = bflo(cc[r].z) * bflo(ci[r].z); u[r][5] = bfhi(cc[r].z) * bfhi(ci[r].z); u[r][6] = bflo(cc[r].w) * bflo(ci[r].w); u[r][7] = bfhi(cc[r].w) * bfhi(ci[r].w); }
#pragma unroll
        for (int j = 0; j < 4; ++j) { float y[8];
#pragma unroll
            for (int e = 0; e < 8; ++e) y[e] = bb[e] + w[0][e] * u[j][e] + w[1][e] * u[j + 1][e] + w[2][e] * u[j + 2][e];
            v4u o;
            o.x = cvt2(bflo(cb[j].x) * y[0] * silu_f(bflo(cg[j].x)), bfhi(cb[j].x) * y[1] * silu_f(bfhi(cg[j].x)));
            o.y = cvt2(bflo(cb[j].y) * y[2] * silu_f(bflo(cg[j].y)), bfhi(cb[j].y) * y[3] * silu_f(bfhi(cg[j].y)));
            o.z = cvt2(bflo(cb[j].z) * y[4] * silu_f(bflo(cg[j].z)), bfhi(cb[j].z) * y[5] * silu_f(bfhi(cg[j].z)));
            o.w = cvt2(bflo(cb[j].w) * y[6] * silu_f(bflo(cg[j].w)), bfhi(cb[j].w) * y[7] * silu_f(bfhi(cg[j].w)));
            *(v4u*)(YCAT + (size_t)(tok0 + j) * DM + WSSM + c0) = o; }
    }
}
__device__ __forceinline__ void final_norm(const Args& a) {
    const int tid = otid(), lane = tid & 63, gw = blockIdx.x * 8 + (tid >> 6), NGW = gridDim.x * 8;
    const float* fg = a.in[19];
    for (int r = gw; r < NTOK; r += NGW) {
        f32x4* xr = (f32x4*)(a.out + (size_t)r * DM) + lane;
        f32x4 v[4]; float s = 0.f;
#pragma unroll
        for (int j = 0; j < 4; ++j) { v[j] = xr[64 * j]; s += (v[j].x * v[j].x + v[j].y * v[j].y) + (v[j].z * v[j].z + v[j].w * v[j].w); }
        const float rstd = 1.0f / sqrtf(wave_sum(s) * (1.0f / DM) + NORM_EPS);
#pragma unroll
        for (int j = 0; j < 4; ++j) { const f32x4 g = ((const f32x4*)fg)[lane + 64 * j]; xr[64 * j] = v[j] * rstd * g; }
    }
}

__global__ void __launch_bounds__(512, 2) mega(Args a) {
    extern __shared__ __attribute__((aligned(16))) unsigned char smem_raw[];
    LAS unsigned char* lds = (LAS unsigned char*)smem_raw;
    cg::grid_group grid = cg::this_grid();
    volatile LAS unsigned* xst = (volatile LAS unsigned*)(lds + 139264);
    if (threadIdx.x == 0) { xst[0] = 0u; xst[1] = 0u; }
    { unsigned* ctl = (unsigned*)(a.ws + WS_CTL); unsigned* flag = ctl + CTL_FLAG_WORD;
      if (blockIdx.x == 0) { for (int i = threadIdx.x; i < 8192; i += 512) __hip_atomic_store(ctl + i, 0u, __ATOMIC_RELAXED, __HIP_MEMORY_SCOPE_AGENT);
          asm volatile("s_waitcnt vmcnt(0)" ::: "memory"); __syncthreads();
          if (threadIdx.x == 0) { __builtin_amdgcn_fence(__ATOMIC_RELEASE, "agent"); __hip_atomic_store(flag, CTL_TOKEN, __ATOMIC_RELAXED, __HIP_MEMORY_SCOPE_AGENT); } }
      if (threadIdx.x == 0) { unsigned sp = 0; while (__hip_atomic_load(flag, __ATOMIC_RELAXED, __HIP_MEMORY_SCOPE_AGENT) != CTL_TOKEN) { __builtin_amdgcn_s_sleep(1); if (++sp > (1u << 22)) break; }
          __builtin_amdgcn_fence(__ATOMIC_ACQUIRE, "agent"); } }
    __syncthreads();
    const XcdBarrier xbar = xcd_barrier_post((unsigned*)(a.ws + WS_CTL), xst);
    const int bid = blockIdx.x, G = gridDim.x;
    bf16_t* XB = (bf16_t*)(a.ws + WS_XB); bf16_t* MEMN = (bf16_t*)(a.ws + WS_MEMN);
    bf16_t* WINT = (bf16_t*)(a.ws + WS_WINT); bf16_t* WKVT = (bf16_t*)(a.ws + WS_WKVT); bf16_t* WOUTT = (bf16_t*)(a.ws + WS_WOUTT); bf16_t* WGLUT = (bf16_t*)(a.ws + WS_WGLUT);
    bf16_t* PROJ = (bf16_t*)(a.ws + WS_PROJ); bf16_t* KV = (bf16_t*)(a.ws + WS_KV); bf16_t* GB = (bf16_t*)(a.ws + WS_GB); bf16_t* YCAT = (bf16_t*)(a.ws + WS_YCAT);
    bf16_t* AY = (bf16_t*)(a.ws + WS_AY); bf16_t* WSb = (bf16_t*)(a.ws + WS_WS); bf16_t* WYb = (bf16_t*)(a.ws + WS_WY);

#ifndef PROBE_DUP
#define PROBE_DUP -1
#endif
#define REPS(k) for (int rep_ = 0; rep_ < ((PROBE_DUP == (k)) ? 2 : 1); ++rep_)
#ifndef PROBE_SUB
#define PROBE_SUB -1
#endif
    if (a.out == nullptr) grid.sync();
    REPS(0) { phase0(a, lds);
    xcd_barrier(xbar); }
    REPS(1) {
    { pg8::Order S; S.init(NTOK / 256, DIN / 256, 1, G, bid);
      pg8::gemm_phase(lds, pg8::Gemm{XB, WINT, DM, DM, DM, 0, 0}, S, pg8::EpiProjAY{PROJ, AY}); }
    { pg8::Order S; S.init(NB * NMEM / 256, 512 / 256, 1, G, (bid + G - ((NTOK / 256) * (DIN / 256)) % G) % G);
      pg8::gemm_phase(lds, pg8::Gemm{MEMN, WKVT, DM, DM, DM, 0, 0}, S, pg8::EpiBf16Store{KV, 512}); }
    xcd_barrier(xbar); }
    REPS(2) {
    if (bid < NB * NG) { pg8::Order S; S.init(NB, 1, NG, G, bid);
      pg8::gemm_phase(lds, pg8::Gemm{AY, WSb, 512, 256, 256, (size_t)1024 * 512, (size_t)256 * 256}, S, pg8::EpiSend{AY, (const float*)(a.ws + WS_LAMT), (const float*)(a.ws + WS_LAM512)});
      asm volatile("s_waitcnt vmcnt(0)" ::: "memory"); __syncthreads();
      pg8::gemm_phase(lds, pg8::Gemm{AY, WYb, 512, 512, 384, (size_t)1024 * 512, (size_t)256 * 512}, S, pg8::EpiY{AY, a.in[10], GB}); }
    else { attn_mfma(a, lds, bid - NB * NG, G - NB * NG); conv_vec(a, bid - NB * NG, G - NB * NG); }
    xcd_barrier(xbar); }
    REPS(4) {
    { pg8::Order S; S.init(NTOK / 256, 2, 2, G, bid);
      pg8::gemm_phase(lds, pg8::Gemm{GB, WGLUT, WSSM, WSSM, WSSM, 0, 0}, S, pg8::EpiGluP{GB, PROJ, a.in[13], YCAT}); }
    xcd_barrier(xbar); }
    REPS(5) {
    { pg8::Order S; S.init(NTOK / 256, DM / 256, 1, G, bid);
      pg8::gemm_phase(lds, pg8::Gemm{YCAT, WOUTT, DM, DM, DM, 0, 0}, S, pg8::EpiOutNorm{a.in[0], a.in[19], a.out, (float*)(a.ws + WS_XCH), (unsigned*)(a.ws + WS_CTL + CTL_PANEL)}); }
    }
    __syncthreads();
    if (threadIdx.x == 0) { unsigned* ctl = (unsigned*)(a.ws + WS_CTL);
        const unsigned old_ = __hip_atomic_fetch_add(ctl + CTL_EXIT_WORD, 1u, __ATOMIC_RELAXED, __HIP_MEMORY_SCOPE_AGENT);
        if (old_ == (unsigned)G - 1u) __hip_atomic_store(ctl + CTL_FLAG_WORD, CTL_RESET, __ATOMIC_RELAXED, __HIP_MEMORY_SCOPE_AGENT); }
}

extern "C" void kernel_launch(void* const* d_in, const int* in_sizes, int n_in, void* d_out, int out_size, void* d_ws, size_t ws_size, hipStream_t stream) {
    static int grid = 0;
    if (grid == 0) {
        if (n_in != 20 || out_size != NTOK * DM || ws_size < WS_END) { fprintf(stderr, "kernel_launch: unexpected shapes n_in %d out %d ws %zu\n", n_in, out_size, ws_size); grid = -1; return; }
        int dev = 0, cus = 0, per_cu = 0;
        hipGetDevice(&dev);
        hipDeviceGetAttribute(&cus, hipDeviceAttributeMultiprocessorCount, dev);
        if (hipFuncSetAttribute((const void*)mega, hipFuncAttributeMaxDynamicSharedMemorySize, LDS_BYTES) != hipSuccess) { fprintf(stderr, "kernel_launch: hipFuncSetAttribute failed\n"); grid = -1; return; }
        if (hipOccupancyMaxActiveBlocksPerMultiprocessor(&per_cu, (const void*)mega, 512, LDS_BYTES) != hipSuccess || per_cu < 1) { fprintf(stderr, "kernel_launch: occupancy query says %d\n", per_cu); per_cu = 1; }
        (void)hipGetLastError();
        grid = cus;
        if (grid < NB * NG) { fprintf(stderr, "kernel_launch: grid %d too small\n", grid); grid = -1; return; }
    }
    if (grid < 0) return;
    Args a{};
    for (int i = 0; i < 20; ++i) a.in[i] = (const float*)d_in[i];
    a.out = (float*)d_out; a.ws = (unsigned char*)d_ws;
    void* args[] = {&a};
    hipError_t e = hipLaunchCooperativeKernel((const void*)mega, dim3(grid), dim3(512), args, LDS_BYTES, stream);
    if (e != hipSuccess) fprintf(stderr, "cooperative launch failed: %s (grid %d)\n", hipGetErrorString(e), grid);
}
```

```cpp
#include <hip/hip_runtime.h>
#include <hip/hip_cooperative_groups.h>
#include <cstdio>
#include <cstdint>
namespace cg = cooperative_groups;

#define LAS __attribute__((address_space(3)))
typedef unsigned short bf16_t;
typedef unsigned v4u __attribute__((ext_vector_type(4)));
typedef float f32x4 __attribute__((ext_vector_type(4)));

constexpr int NB = 4, SEQ = 4096, DM = 1024, NTOK = NB * SEQ, DIN = 2816, WSSM = 384, NG = 24, GH = 16, NP = 64, NMEM = 256;
constexpr int C_AIN = 0, C_AGATE = 384, C_CIN = 768, C_CB = 1152, C_CC = 1536, C_CGATE = 1920, C_Q = 2304, C_QGATE = 2560;
constexpr float NORM_EPS = 1e-6f;

constexpr size_t MiB = 1u << 20;
constexpr size_t WS_CTL = 0;
constexpr size_t WS_XB = 1 * MiB;
constexpr size_t WS_WINT = 33 * MiB;
constexpr size_t WS_WKVT = 39 * MiB;
constexpr size_t WS_WOUTT = 40 * MiB;
constexpr size_t WS_WGLUT = 42 * MiB;
constexpr size_t WS_MEMN = 43 * MiB;
constexpr size_t WS_KV = 45 * MiB;
constexpr size_t WS_LAMB = 46 * MiB;
constexpr size_t WS_BBAR = 46 * MiB + 65536;
constexpr size_t WS_GB = 47 * MiB;
constexpr size_t WS_PROJ = 59 * MiB;
constexpr size_t WS_YCAT = 147 * MiB;
constexpr size_t WS_AY = 179 * MiB;
constexpr size_t WS_WS = 203 * MiB;
constexpr size_t WS_WY = 206 * MiB;
constexpr size_t WS_LAMT = 212 * MiB;
constexpr size_t WS_LAM512 = 212 * MiB + 65536;
constexpr size_t WS_XCH = 213 * MiB;
constexpr size_t WS_END = 214 * MiB;
constexpr size_t CTL_PANEL = 16384;
constexpr size_t CTL_BYTES = 32768;
constexpr int CTL_EXIT_WORD = 3968, CTL_FLAG_WORD = 8192 + 64;
constexpr unsigned CTL_TOKEN = 0x600DF00Du, CTL_RESET = 0x0BADF00Du;

constexpr int LDS_BYTES = 147456;

struct Args {
    const float* in[20];
    float* out;
    unsigned char* ws;
};

__device__ __forceinline__ unsigned f2bf(float f) { unsigned u = __builtin_bit_cast(unsigned, f); return (u + 0x7fffu + ((u >> 16) & 1u)) >> 16; }
__device__ __forceinline__ unsigned pk2(float lo, float hi) { return f2bf(lo) | (f2bf(hi) << 16); }
__device__ __forceinline__ float bf2f(unsigned short b) { return __builtin_bit_cast(float, ((unsigned)b) << 16); }
__device__ __forceinline__ float bflo(unsigned w) { return __builtin_bit_cast(float, w << 16); }
__device__ __forceinline__ float bfhi(unsigned w) { return __builtin_bit_cast(float, w & 0xffff0000u); }
__device__ __forceinline__ float wave_sum(float v) {
#pragma unroll
    for (int o = 1; o < 64; o <<= 1) v += __shfl_xor(v, o);
    return v;
}
__device__ __forceinline__ float silu_f(float v) { return v * __builtin_amdgcn_rcpf(1.0f + __builtin_amdgcn_exp2f(-1.4426950408889634f * v)); }
__device__ __forceinline__ float sigmoid_f(float v) { return __builtin_amdgcn_rcpf(1.0f + __builtin_amdgcn_exp2f(-1.4426950408889634f * v)); }
__device__ __forceinline__ float gelu_tanh(float v) { const float w = __builtin_fmaf(v * v, -0.10294324f, -2.3022082f); return v * __builtin_amdgcn_rcpf(1.0f + __builtin_amdgcn_exp2f(v * w)); }
#define LDS_WAIT() asm volatile("s_waitcnt lgkmcnt(0)" ::: "memory")
__device__ __forceinline__ int otid() { int t = threadIdx.x; asm volatile("" : "+v"(t)); return t; }

#define XB_TMO      128
#define XB_XCNT(j)  (256  + 64 * (j))
#define XB_XSUB(j)  (1280 + 64 * (j))
#define XB_XGEN(j)  (2304 + 64 * (j))
#define XB_TOP      3328
#define XB_TOPGEN   3392
#define XCD_BAR_WORDS 3456
#define XB_SPIN_CAP (1u << 18)

__device__ __forceinline__ unsigned xb_ld(unsigned* p)              { return __hip_atomic_load(p, __ATOMIC_RELAXED, __HIP_MEMORY_SCOPE_AGENT); }
__device__ __forceinline__ unsigned xb_add(unsigned* p, unsigned v) { return __hip_atomic_fetch_add(p, v, __ATOMIC_RELAXED, __HIP_MEMORY_SCOPE_AGENT); }
__device__ __forceinline__ unsigned xb_xcc_id() { return (unsigned)__builtin_amdgcn_s_getreg((3 << 11) | 20) & 0xFu; }
#define XB_SPIN(cond, bar) do { unsigned _sp = 0; while (cond) { __builtin_amdgcn_s_sleep(1); \
    if ((++_sp & 255u) == 0u) { if (xb_ld(&(bar)[XB_TMO])) break; if (_sp > XB_SPIN_CAP) { atomicAdd(&(bar)[XB_TMO], 1u); break; } } } } while (0)

struct XcdBarrier {
    unsigned* bar; unsigned x;
    volatile LAS unsigned* st;
};

__device__ __forceinline__ XcdBarrier xcd_barrier_post(unsigned* bar, volatile LAS unsigned* st) {
    XcdBarrier b; b.bar = bar; b.x = xb_xcc_id(); b.st = st;
    if (threadIdx.x == 0) (void)xb_add(&bar[XB_XCNT(b.x)], 1u);
    return b;
}
__device__ __forceinline__ void xcd_barrier_complete(unsigned* bar, unsigned x, unsigned& nloc, unsigned& nx) {
    const unsigned G = gridDim.x * gridDim.y * gridDim.z;
    unsigned sum, cnt, mine, sp = 0u;
    for (;;) {
        sum = 0u; cnt = 0u; mine = 0u;
#pragma unroll
        for (unsigned j = 0; j < 16; ++j) { const unsigned c = xb_ld(&bar[XB_XCNT(j)]); sum += c; cnt += (c > 0u) ? 1u : 0u; mine = (j == x) ? c : mine; }
        if (sum == G) break;
        __builtin_amdgcn_s_sleep(1);
        if ((++sp & 255u) == 0u) { if (xb_ld(&bar[XB_TMO])) break; if (sp > XB_SPIN_CAP) { atomicAdd(&bar[XB_TMO], 1u); break; } }
    }
    nloc = mine > 0u ? mine : 1u; nx = cnt > 0u ? cnt : 1u;
}

__device__ __forceinline__ void xcd_barrier(const XcdBarrier& b) {
    asm volatile("s_waitcnt vmcnt(0)" ::: "memory");
    __syncthreads();
    if (threadIdx.x == 0) {
        unsigned* bar = b.bar;
        __builtin_amdgcn_s_waitcnt(0);
        unsigned nloc = b.st[0], nx = b.st[1];
        if (nloc == 0u) { xcd_barrier_complete(bar, b.x, nloc, nx); b.st[0] = nloc; b.st[1] = nx; }
        const unsigned old = xb_add(&bar[XB_XSUB(b.x)], 1u);
        const unsigned gen = old / nloc;
        if (old + 1u == (gen + 1u) * nloc) {
            __builtin_amdgcn_fence(__ATOMIC_RELEASE, "agent");
            asm volatile("s_waitcnt vmcnt(0)" ::: "memory");
            const unsigned og = xb_add(&bar[XB_TOP], 1u);
            const unsigned tg = og / nx;
            if (og + 1u == (tg + 1u) * nx) xb_add(&bar[XB_TOPGEN], 1u);
            else XB_SPIN(xb_ld(&bar[XB_TOPGEN]) == tg, bar);
            __builtin_amdgcn_fence(__ATOMIC_ACQUIRE, "agent");
            xb_add(&bar[XB_XGEN(b.x)], 1u);
            asm volatile("s_waitcnt vmcnt(0)" ::: "memory");
        } else {
            XB_SPIN(xb_ld(&bar[XB_XGEN(b.x)]) == gen, bar);
            __builtin_amdgcn_fence(__ATOMIC_ACQUIRE, "agent");
            asm volatile("s_waitcnt vmcnt(0)" ::: "memory");
        }
    }
    __syncthreads();
}

__device__ __forceinline__ void rms_row_to_bf16(const float* xrow, bf16_t* orow, const float* gain, int lane) {
    const f32x4* xr = (const f32x4*)xrow + lane;
    f32x4 v[4]; float s = 0.f;
#pragma unroll
    for (int j = 0; j < 4; ++j) { v[j] = xr[64 * j]; s += (v[j].x * v[j].x + v[j].y * v[j].y) + (v[j].z * v[j].z + v[j].w * v[j].w); }
    const float rstd = 1.0f / sqrtf(wave_sum(s) * (1.0f / DM) + NORM_EPS);
    unsigned long long* o8 = (unsigned long long*)orow + lane;
#pragma unroll
    for (int j = 0; j < 4; ++j) {
        f32x4 g = gain ? ((const f32x4*)gain)[lane + 64 * j] : (f32x4){1.f, 1.f, 1.f, 1.f};
        o8[64 * j] = (unsigned long long)pk2(v[j].x * rstd * g.x, v[j].y * rstd * g.y) | ((unsigned long long)pk2(v[j].z * rstd * g.z, v[j].w * rstd * g.w) << 32);
    }
}
__device__ __forceinline__ void transpose_item(const float* W, int K, int N, bf16_t* WT, const float* ks, LAS float* scr, int item, int lane) {
    const int nblk = N / 32, kb = item / nblk, nb = item % nblk, k0 = 64 * kb, n0 = 32 * nb;
#pragma unroll 8
    for (int i = 0; i < 32; ++i) { const int kk = 2 * i + (lane >> 5); float w = W[(size_t)(k0 + kk) * N + n0 + (lane & 31)]; if (ks) w *= ks[k0 + kk]; scr[kk * 33 + (lane & 31)] = w; }
    LDS_WAIT();
    const int c = lane & 7;
#pragma unroll
    for (int j = 0; j < 4; ++j) { const int n = (lane >> 3) + 8 * j; const LAS float* s = scr + (8 * c) * 33 + n;
        v4u o; o.x = pk2(s[0 * 33], s[1 * 33]); o.y = pk2(s[2 * 33], s[3 * 33]); o.z = pk2(s[4 * 33], s[5 * 33]); o.w = pk2(s[6 * 33], s[7 * 33]);
        *(v4u*)(WT + (size_t)(n0 + n) * K + k0 + 8 * c) = o; }
    LDS_WAIT();
}


__device__ __forceinline__ void s5_tables(const Args& a, LAS unsigned char* lds, int tid) {
    const int bid = blockIdx.x; if (bid >= 192) return;
    const int g = bid % NG, q = bid / NG;
    const float* lam_re = a.in[4]; const float* lam_im = a.in[5]; const float* b_re = a.in[6]; const float* b_im = a.in[7]; const float* c_re = a.in[8]; const float* c_im = a.in[9]; const float* log_dt = a.in[11];
    LAS float* LPr = (LAS float*)(lds + 69632); LAS float* LPi = LPr + 17 * 64; LAS float* BBr = LPi + 17 * 64; LAS float* BBi = BBr + 1024;
    LAS float* Cr = BBi + 1024; LAS float* Ci = Cr + 1024; LAS float* KT = Ci + 1024;
    if (tid < 64) {
        const int p = tid, i = g * NP + p;
        const double dt = exp((double)log_dt[g]);
        const double lr = lam_re[i], li = lam_im[i];
        const double er = exp(lr * dt), ang = li * dt;
        const double lbr = er * cos(ang), lbi = er * sin(ang);
        const double nr = lbr - 1.0, ni = lbi, den = lr * lr + li * li;
        const double qr = (nr * lr + ni * li) / den, qi = (ni * lr - nr * li) / den;
        for (int h = 0; h < GH; ++h) { const double br = b_re[i * GH + h], bi = b_im[i * GH + h];
            BBr[p * 16 + h] = (float)(qr * br - qi * bi); BBi[p * 16 + h] = (float)(qr * bi + qi * br); }
        double pr = 1.0, pi = 0.0;
        for (int t = 0; t < 16; ++t) { LPr[t * 64 + p] = (float)pr; LPi[t * 64 + p] = (float)pi; const double nr2 = pr * lbr - pi * lbi, ni2 = pr * lbi + pi * lbr; pr = nr2; pi = ni2; }
        LPr[16 * 64 + p] = (float)pr; LPi[16 * 64 + p] = (float)pi;
        double tr = pr, ti = pi;
        if (q == 0) { float* LAMT = (float*)(a.ws + WS_LAMT); LAMT[2 * i] = (float)tr; LAMT[2 * i + 1] = (float)ti; }
        for (int k = 0; k < 5; ++k) { const double nr2 = tr * tr - ti * ti, ni2 = 2.0 * tr * ti; tr = nr2; ti = ni2; }
        if (q == 0) { float* L512 = (float*)(a.ws + WS_LAM512); L512[2 * i] = (float)tr; L512[2 * i + 1] = (float)ti; }
    }
    for (int i = tid; i < 1024; i += 512) { Cr[i] = c_re[g * 1024 + i]; Ci[i] = c_im[g * 1024 + i]; }
    __syncthreads();
    { const int tau = tid >> 5, hol = (tid >> 4) & 1, hi = tid & 15, ho = 2 * q + hol; float sacc = 0.f;
#pragma unroll 4
      for (int p = 0; p < 64; ++p) { const float lpr = LPr[tau * 64 + p], lpi = LPi[tau * 64 + p], br = BBr[p * 16 + hi], bi = BBi[p * 16 + hi];
          const float wr_ = lpr * br - lpi * bi, wi_ = lpr * bi + lpi * br; sacc += Cr[ho * 64 + p] * wr_ - Ci[ho * 64 + p] * wi_; }
      KT[tid] = sacc; }
    __syncthreads();
    bf16_t* WSb = (bf16_t*)(a.ws + WS_WS); bf16_t* WYb = (bf16_t*)(a.ws + WS_WY);
#pragma unroll
    for (int kk = 0; kk < 2; ++kk) { const int ch = tid + 512 * kk, n = 32 * q + (ch >> 5), k0 = (ch & 31) * 8, p = n & 63, isim = (n >> 6) & 1;
        float v[8];
#pragma unroll
        for (int j = 0; j < 8; ++j) { const int k = k0 + j, t = k >> 4, h = k & 15, tau = 15 - t; const float lpr = LPr[tau * 64 + p], lpi = LPi[tau * 64 + p], br = BBr[p * 16 + h], bi = BBi[p * 16 + h];
            const float val = isim ? (lpr * bi + lpi * br) : (lpr * br - lpi * bi); v[j] = n < 128 ? val : 0.f; }
        v4u o; o.x = pk2(v[0], v[1]); o.y = pk2(v[2], v[3]); o.z = pk2(v[4], v[5]); o.w = pk2(v[6], v[7]);
        *(v4u*)(WSb + ((size_t)(g * 256 + n)) * 256 + k0) = o; }
#pragma unroll
    for (int kk = 0; kk < 4; ++kk) { const int ch = tid + 512 * kk, rr = ch >> 6, to = rr >> 1, hol = rr & 1, ho = 2 * q + hol, n = to * 16 + ho, k0 = (ch & 63) * 8;
        float v[8];
#pragma unroll
        for (int j = 0; j < 8; ++j) { const int k = k0 + j; float val;
            if (k < 256) { const int ti = k >> 4, hi = k & 15; val = ti <= to ? KT[((to - ti) * 2 + hol) * 16 + hi] : 0.f; }
            else { const int jj = (k - 256) & 127, p = jj & 63, isim = jj >> 6; const float lpr = LPr[(to + 1) * 64 + p], lpi = LPi[(to + 1) * 64 + p], cr = Cr[ho * 64 + p], ci = Ci[ho * 64 + p];
                val = isim ? -(cr * lpi + ci * lpr) : (cr * lpr - ci * lpi); }
            v[j] = val; }
        v4u o; o.x = pk2(v[0], v[1]); o.y = pk2(v[2], v[3]); o.z = pk2(v[4], v[5]); o.w = pk2(v[6], v[7]);
        *(v4u*)(WYb + ((size_t)(g * 256 + n)) * 512 + k0) = o; }
}

__device__ __forceinline__ void rms_rows2_to_bf16(const float* x0, const float* x1, bf16_t* o0, bf16_t* o1, const float* gain, int lane) {
    const f32x4* xr0 = (const f32x4*)x0 + lane; const f32x4* xr1 = (const f32x4*)x1 + lane;
    f32x4 v[4], w[4]; float s0 = 0.f, s1 = 0.f;
#pragma unroll
    for (int j = 0; j < 4; ++j) { v[j] = xr0[64 * j]; w[j] = xr1[64 * j]; }
#pragma unroll
    for (int j = 0; j < 4; ++j) { s0 += (v[j].x * v[j].x + v[j].y * v[j].y) + (v[j].z * v[j].z + v[j].w * v[j].w); s1 += (w[j].x * w[j].x + w[j].y * w[j].y) + (w[j].z * w[j].z + w[j].w * w[j].w); }
#pragma unroll
    for (int o = 1; o < 64; o <<= 1) { s0 += __shfl_xor(s0, o); s1 += __shfl_xor(s1, o); }
    const float r0 = 1.0f / sqrtf(s0 * (1.0f / DM) + NORM_EPS), r1 = 1.0f / sqrtf(s1 * (1.0f / DM) + NORM_EPS);
    unsigned long long* p0 = (unsigned long long*)o0 + lane; unsigned long long* p1 = (unsigned long long*)o1 + lane;
#pragma unroll
    for (int j = 0; j < 4; ++j) {
        const f32x4 g = gain ? ((const f32x4*)gain)[lane + 64 * j] : (f32x4){1.f, 1.f, 1.f, 1.f};
        p0[64 * j] = (unsigned long long)pk2(v[j].x * r0 * g.x, v[j].y * r0 * g.y) | ((unsigned long long)pk2(v[j].z * r0 * g.z, v[j].w * r0 * g.w) << 32);
        p1[64 * j] = (unsigned long long)pk2(w[j].x * r1 * g.x, w[j].y * r1 * g.y) | ((unsigned long long)pk2(w[j].z * r1 * g.z, w[j].w * r1 * g.w) << 32);
    }
}
__device__ __forceinline__ void transpose_item4(const float* W, int K, int N, bf16_t* WT, const float* ks, LAS float* scr, int item, int lane) {
    const int nblk = N / 32, kb = item / nblk, nb = item % nblk, k0 = 64 * kb, n0 = 32 * nb;
    f32x4 w[8];
#pragma unroll
    for (int i = 0; i < 8; ++i) { const int kk = 8 * i + (lane >> 3); w[i] = *(const f32x4*)(W + (size_t)(k0 + kk) * N + n0 + 4 * (lane & 7)); }
#pragma unroll
    for (int i = 0; i < 8; ++i) { const int kk = 8 * i + (lane >> 3); const float sc = ks ? ks[k0 + kk] : 1.0f; LAS float* d = scr + kk * 33 + 4 * (lane & 7);
        d[0] = w[i].x * sc; d[1] = w[i].y * sc; d[2] = w[i].z * sc; d[3] = w[i].w * sc; }
    LDS_WAIT();
    const int c = lane & 7;
#pragma unroll
    for (int j = 0; j < 4; ++j) { const int n = (lane >> 3) + 8 * j; const LAS float* sp = scr + (8 * c) * 33 + n;
        v4u o; o.x = pk2(sp[0 * 33], sp[1 * 33]); o.y = pk2(sp[2 * 33], sp[3 * 33]); o.z = pk2(sp[4 * 33], sp[5 * 33]); o.w = pk2(sp[6 * 33], sp[7 * 33]);
        *(v4u*)(WT + (size_t)(n0 + n) * K + k0 + 8 * c) = o; }
    LDS_WAIT();
}

__device__ __forceinline__ void phase0(const Args& a, LAS unsigned char* lds) {
    const int tid = otid(), lane = tid & 63, wave = tid >> 6;
    const int gw = blockIdx.x * 8 + wave, NGW = gridDim.x * 8;
    s5_tables(a, lds, tid);
    const float* x = a.in[0]; const float* mem = a.in[1]; const float* norm_g = a.in[2]; const float* w_in = a.in[3];
    const float* w_glu = a.in[12]; const float* mem_norm_g = a.in[16]; const float* w_mem_kv = a.in[17]; const float* w_out = a.in[18];
    bf16_t* XB = (bf16_t*)(a.ws + WS_XB); bf16_t* MEMN = (bf16_t*)(a.ws + WS_MEMN);
    bf16_t* WINT = (bf16_t*)(a.ws + WS_WINT); bf16_t* WKVT = (bf16_t*)(a.ws + WS_WKVT); bf16_t* WOUTT = (bf16_t*)(a.ws + WS_WOUTT); bf16_t* WGLUT = (bf16_t*)(a.ws + WS_WGLUT);
    for (int rnd = 0; rnd < 5; ++rnd) { const int r2 = rnd < 4 ? rnd * NGW + gw : 4 * NGW + (gw - 1536); if (rnd == 4 && (gw < 1536 || r2 >= (NTOK + NB * NMEM) / 2)) break; const int r = 2 * r2;
        if (r < NTOK) rms_rows2_to_bf16(x + (size_t)r * DM, x + (size_t)(r + 1) * DM, XB + (size_t)r * DM, XB + (size_t)(r + 1) * DM, nullptr, lane);
        else { const int m = r - NTOK; rms_rows2_to_bf16(mem + (size_t)m * DM, mem + (size_t)(m + 1) * DM, MEMN + (size_t)m * DM, MEMN + (size_t)(m + 1) * DM, mem_norm_g, lane); }
    }
    LAS float* scr = (LAS float*)(lds + wave * 8448);
    constexpr int I_IN = (DM / 64) * (DIN / 32), I_KV = (DM / 64) * (512 / 32), I_OUT = (DM / 64) * (DM / 32), I_GLU = (WSSM / 64) * (WSSM / 32);
    for (int rnd = 0; rnd < 2; ++rnd) { const int it = rnd == 0 ? gw : NGW + (gw - 1536); if (rnd == 1 && (gw < 1536 || it >= I_IN + I_KV + I_OUT + I_GLU)) break;
        int r = it;
        if (r < I_IN) { transpose_item4(w_in, DM, DIN, WINT, norm_g, scr, r, lane); continue; } r -= I_IN;
        if (r < I_KV) { transpose_item4(w_mem_kv, DM, 512, WKVT, nullptr, scr, r, lane); continue; } r -= I_KV;
        if (r < I_OUT) { transpose_item4(w_out, DM, DM, WOUTT, nullptr, scr, r, lane); continue; } r -= I_OUT;
        transpose_item4(w_glu, WSSM, WSSM, WGLUT, nullptr, scr, r, lane);
    }
    const int gt = blockIdx.x * 512 + tid, NT = gridDim.x * 512;
    for (int i = gt; i < 128 * 384 / 2; i += NT) ((unsigned*)(WGLUT + 384 * 384))[i] = 0u;
}

template <class Epi>
__device__ __forceinline__ void gemm_naive(const bf16_t* A, int lda, const bf16_t* Bt, int ldb, int M, int N, int K, LAS unsigned char* lds, int tile0, int ntile_total, const Epi& epi) {
    LAS float* As = (LAS float*)lds;
    LAS float* Bs = As + 32 * 132;
    const int tid = threadIdx.x, ty = tid >> 4, tx = tid & 15;
    const int ntn = N / 64, nt = (M / 128) * ntn;
    (void)ntile_total;
    for (int tile = blockIdx.x - tile0; tile < nt; tile += gridDim.x) {
        if (tile < 0) continue;
        const int tm = tile / ntn, tn = tile % ntn;
        float acc[4][4];
#pragma unroll
        for (int i = 0; i < 4; ++i)
#pragma unroll
            for (int j = 0; j < 4; ++j) acc[i][j] = 0.f;
        for (int k0 = 0; k0 < K; k0 += 32) {
            __syncthreads();
            { const int r = tid >> 2, kc = (tid & 3) * 8; const v4u v = *(const v4u*)(A + (size_t)(tm * 128 + r) * lda + k0 + kc);
              As[(kc + 0) * 132 + r] = bflo(v.x); As[(kc + 1) * 132 + r] = bfhi(v.x); As[(kc + 2) * 132 + r] = bflo(v.y); As[(kc + 3) * 132 + r] = bfhi(v.y);
              As[(kc + 4) * 132 + r] = bflo(v.z); As[(kc + 5) * 132 + r] = bfhi(v.z); As[(kc + 6) * 132 + r] = bflo(v.w); As[(kc + 7) * 132 + r] = bfhi(v.w); }
            if (tid < 256) { const int r = tid >> 2, kc = (tid & 3) * 8; const v4u v = *(const v4u*)(Bt + (size_t)(tn * 64 + r) * ldb + k0 + kc);
              Bs[(kc + 0) * 68 + r] = bflo(v.x); Bs[(kc + 1) * 68 + r] = bfhi(v.x); Bs[(kc + 2) * 68 + r] = bflo(v.y); Bs[(kc + 3) * 68 + r] = bfhi(v.y);
              Bs[(kc + 4) * 68 + r] = bflo(v.z); Bs[(kc + 5) * 68 + r] = bfhi(v.z); Bs[(kc + 6) * 68 + r] = bflo(v.w); Bs[(kc + 7) * 68 + r] = bfhi(v.w); }
            __syncthreads();
#pragma unroll 8
            for (int k = 0; k < 32; ++k) {
                const f32x4 av = *(const LAS f32x4*)(As + k * 132 + ty * 4), bv = *(const LAS f32x4*)(Bs + k * 68 + tx * 4);
#pragma unroll
                for (int i = 0; i < 4; ++i)
#pragma unroll
                    for (int j = 0; j < 4; ++j) acc[i][j] += av[i] * bv[j];
            }
        }
#pragma unroll
        for (int i = 0; i < 4; ++i)
#pragma unroll
            for (int j = 0; j < 4; ++j) epi(tm * 128 + ty * 4 + i, tn * 64 + tx * 4 + j, acc[i][j]);
    }
}

struct EpiStoreBf16 { bf16_t* O; int ldo; __device__ __forceinline__ void operator()(int r, int c, float v) const { O[(size_t)r * ldo + c] = (bf16_t)f2bf(v); } };
struct EpiGlu { const bf16_t* GB; const bf16_t* PROJ; const float* b_glu; bf16_t* YCAT;
    __device__ __forceinline__ void operator()(int r, int c, float v) const {
        const float g = bf2f(GB[(size_t)r * WSSM + c]); const float gate = bf2f(PROJ[(size_t)r * DIN + C_AGATE + c]);
        YCAT[(size_t)r * DM + c] = (bf16_t)f2bf(g * sigmoid_f(v + b_glu[c]) * silu_f(gate)); } };
struct EpiOut { const float* x; float* out; __device__ __forceinline__ void operator()(int r, int c, float v) const { out[(size_t)r * DM + c] = x[(size_t)r * DM + c] + v; } };


namespace pg8 {
typedef short bf16x8 __attribute__((ext_vector_type(8)));
typedef unsigned u32x4 __attribute__((ext_vector_type(4)));
constexpr int BM = 256, BK = 64, HALF = 128, HTB = HALF * BK * 2, STAGE_BYTES = 8 * HTB, NXCD = 8, WGM = 8;
__host__ __device__ __forceinline__ int lds_byte(int r, int c) { const int st = (r >> 4) * 2 + (c >> 5), rr = r & 15, cc = c & 31, ob = rr * 64 + cc * 2; return st * 1024 + (ob ^ (((ob >> 9) & 1) << 5)); }
__host__ __device__ __forceinline__ void stage_rc(int b, int& R, int& C) { const int st = b / 1024, sb = b % 1024, swz = sb ^ (((sb >> 9) & 1) << 5); R = (st >> 1) * 16 + swz / 64; C = (st & 1) * 32 + (swz % 64) / 2; }
__host__ __device__ __forceinline__ int perm32(int rho) { const int n = rho >> 4, i = rho & 15; return 8 * (i >> 2) + 4 * n + (i & 3); }
struct Unit { int pm, pn, z; };
struct Gemm { const bf16_t* A; const bf16_t* Bt; int lda, ldb, K; size_t sAz, sBz; };
struct Order {
    int nM, nN, per, total, G, c;
    __device__ void init(int nM_, int nN_, int nZ_, int G_, int c_) { nM = nM_; nN = nN_; per = nM_ * nN_; total = per * nZ_; G = G_; c = c_; }
    __device__ bool next(int i, Unit& u) const {
        const long L = (long)i * G + c; if (L >= total) return false;
        u.z = (int)(L / per); int wgid = (int)(L % per); const int nwg = per;
        { const int q = nwg / NXCD, r = nwg % NXCD, xcd = wgid % NXCD, off = wgid / NXCD; wgid = (xcd < r ? xcd * (q + 1) : r * (q + 1) + (xcd - r) * q) + off; }
        const int nig = WGM * nN, gid = wgid / nig, fm = gid * WGM, gsz = (nM - fm) < WGM ? (nM - fm) : WGM;
        u.pm = fm + ((wgid % nig) % gsz); u.pn = (wgid % nig) / gsz; return true;
    }
};
typedef __bf16 bf2v_t __attribute__((ext_vector_type(2))); typedef float f2v_t __attribute__((ext_vector_type(2)));
__device__ __forceinline__ unsigned cvt_pk_bf16(float lo, float hi) { const f2v_t v = {lo, hi}; return __builtin_bit_cast(unsigned, __builtin_convertvector(v, bf2v_t)); }

template <class Epi>
__device__ __forceinline__ void gemm_phase(LAS unsigned char* lds, const Gemm g, const Order& S, const Epi& E) {
    int tid = threadIdx.x; asm volatile("" : "+v"(tid));
    const int wid = __builtin_amdgcn_readfirstlane(tid >> 6), lane = tid & 63, wr = wid >> 2, wc = wid & 3, fr = lane & 15, fq = lane >> 4;
    int K = g.K; asm volatile("" : "+s"(K));
    const int nt = K / BK;
    unsigned voffA[2], voffB[2];
#pragma unroll
    for (int i = 0; i < 2; ++i) { int R, C; stage_rc(tid * 16 + i * 8192, R, C); const int Rb = Epi::PERM ? ((R & ~31) + perm32(R & 31)) : R;
        voffA[i] = (unsigned)(R * g.lda + C) * 2u; voffB[i] = (unsigned)(Rb * g.ldb + C) * 2u; }
    const size_t kstep = (size_t)(BK * 2);
    const size_t hstepA = (size_t)HALF * g.lda * 2, hstepB = (size_t)HALF * g.ldb * 2;
    const size_t tstepA = 2 * hstepA, tstepB = 2 * hstepB;
    const unsigned ldsw = (unsigned)wid * 1024u;
    const int aoff = lds_byte(wr * 64 + fr, fq * 8), boff = lds_byte(wc * 32 + fr, fq * 8);
#define PG8_SA(b, h) (((b) * 2 + (h)) * HTB)
#define PG8_SB(b, h) ((4 + (b) * 2 + (h)) * HTB)
#define PG8_STAGE(bufoff, gbase, voff) do { _Pragma("unroll") for (int _i = 0; _i < 2; ++_i) \
        __builtin_amdgcn_global_load_lds((const unsigned*)((const char*)(gbase) + (voff)[_i]), (LAS unsigned*)(lds + (bufoff) + ldsw + _i * 8192), 16, 0, 0); } while (0)
#define PG8_LDA(dst, b, h) do { _Pragma("unroll") for (int m = 0; m < 4; ++m) _Pragma("unroll") for (int k = 0; k < 2; ++k) dst[m][k] = *(const LAS bf16x8*)(lds + PG8_SA(b, h) + aoff + m * 2048 + k * 1024); } while (0)
#define PG8_LDB(dst, b, h) do { _Pragma("unroll") for (int n = 0; n < 2; ++n) _Pragma("unroll") for (int k = 0; k < 2; ++k) dst[n][k] = *(const LAS bf16x8*)(lds + PG8_SB(b, h) + boff + n * 2048 + k * 1024); } while (0)
#define PG8_MMA(ai, bj, At, Bt) do { __builtin_amdgcn_s_setprio(1); _Pragma("unroll") for (int m = 0; m < 4; ++m) _Pragma("unroll") for (int n = 0; n < 2; ++n) _Pragma("unroll") for (int k = 0; k < 2; ++k) \
        acc[ai][bj][m][n] = __builtin_amdgcn_mfma_f32_16x16x32_bf16(Bt[n][k], At[m][k], acc[ai][bj][m][n], 0, 0, 0); __builtin_amdgcn_s_setprio(0); } while (0)
#define PG8_WAIT_V(n) asm volatile("s_waitcnt vmcnt(" #n ")" ::: "memory")
#define PG8_WAIT_L(n) asm volatile("s_waitcnt lgkmcnt(" #n ")" ::: "memory")
#define PG8_BAR __builtin_amdgcn_s_barrier()
#define PG8_SCHED __builtin_amdgcn_sched_barrier(0)
    Unit cur, nxt; int ui = 0;
    if (!S.next(0, cur)) return;
    f32x4 acc[2][2][4][2];
#pragma unroll
    for (int a = 0; a < 2; ++a)
#pragma unroll
        for (int b = 0; b < 2; ++b)
#pragma unroll
            for (int m = 0; m < 4; ++m)
#pragma unroll
                for (int n = 0; n < 2; ++n) acc[a][b][m][n] = (f32x4){0.f, 0.f, 0.f, 0.f};
    bf16x8 At[4][2], B0[2][2], B1[2][2];
    const char* cA = (const char*)(g.A + (size_t)cur.z * g.sAz) + (size_t)cur.pm * tstepA; const char* cB = (const char*)(g.Bt + (size_t)cur.z * g.sBz) + (size_t)cur.pn * tstepB;
    PG8_STAGE(PG8_SB(0, 0), cB, voffB); PG8_STAGE(PG8_SA(0, 0), cA, voffA); PG8_STAGE(PG8_SB(0, 1), cB + hstepB, voffB); PG8_STAGE(PG8_SA(0, 1), cA + hstepA, voffA);
    if (wr == 1) PG8_BAR;
    PG8_WAIT_V(4); PG8_BAR;
    PG8_STAGE(PG8_SB(1, 0), cB + kstep, voffB); PG8_STAGE(PG8_SA(1, 0), cA + kstep, voffA); PG8_STAGE(PG8_SB(1, 1), cB + hstepB + kstep, voffB);
    PG8_WAIT_V(6); PG8_BAR;
    for (;;) {
        const bool has_next = S.next(ui + 1, nxt);
        const char* nA = has_next ? (const char*)(g.A + (size_t)nxt.z * g.sAz) + (size_t)nxt.pm * tstepA : cA; const char* nB = has_next ? (const char*)(g.Bt + (size_t)nxt.z * g.sBz) + (size_t)nxt.pn * tstepB : cB;
        for (int t = 0; t < nt; t += 2) {
            const bool last = (t == nt - 2);
            const char* a1 = cA + (size_t)(t + 1) * kstep;
            const char* a2 = last ? nA : cA + (size_t)(t + 2) * kstep; const char* b2 = last ? nB : cB + (size_t)(t + 2) * kstep;
            const char* a3 = a2 + kstep; const char* b3 = b2 + kstep;
            PG8_LDB(B0, 0, 0); PG8_SCHED; PG8_LDA(At, 0, 0); PG8_STAGE(PG8_SA(1, 1), a1 + hstepA, voffA);
            PG8_WAIT_L(8); PG8_BAR; PG8_WAIT_L(0); PG8_MMA(0, 0, At, B0); PG8_BAR; PG8_SCHED;
            PG8_LDB(B1, 0, 1); PG8_STAGE(PG8_SB(0, 0), b2, voffB);
            PG8_BAR; PG8_WAIT_L(0); PG8_MMA(0, 1, At, B1); PG8_BAR;
            PG8_LDA(At, 0, 1); PG8_STAGE(PG8_SA(0, 0), a2, voffA);
            PG8_BAR; PG8_WAIT_L(0); PG8_MMA(1, 0, At, B0); PG8_BAR; PG8_SCHED;
            PG8_STAGE(PG8_SB(0, 1), b2 + hstepB, voffB);
            PG8_WAIT_V(6); PG8_BAR; PG8_MMA(1, 1, At, B1); PG8_BAR;
            PG8_LDB(B0, 1, 0); PG8_SCHED; PG8_LDA(At, 1, 0); PG8_STAGE(PG8_SA(0, 1), a2 + hstepA, voffA);
            PG8_WAIT_L(8); PG8_BAR; PG8_WAIT_L(0); PG8_MMA(0, 0, At, B0); PG8_BAR; PG8_SCHED;
            PG8_LDB(B1, 1, 1); PG8_STAGE(PG8_SB(1, 0), b3, voffB);
            PG8_BAR; PG8_WAIT_L(0); PG8_MMA(0, 1, At, B1); PG8_BAR;
            PG8_LDA(At, 1, 1); PG8_STAGE(PG8_SA(1, 0), a3, voffA);
            PG8_BAR; PG8_WAIT_L(0); PG8_MMA(1, 0, At, B0); PG8_BAR; PG8_SCHED;
            PG8_STAGE(PG8_SB(1, 1), b3 + hstepB, voffB);
            PG8_WAIT_V(6); PG8_BAR; PG8_MMA(1, 1, At, B1); PG8_BAR;
        }
        if constexpr (!Epi::AFTER_DRAIN) { E(acc, cur, wr, wc, fr, fq); }
        if (!has_next) break;
#pragma unroll
        for (int a = 0; a < 2; ++a)
#pragma unroll
            for (int b = 0; b < 2; ++b)
#pragma unroll
                for (int m = 0; m < 4; ++m)
#pragma unroll
                    for (int n = 0; n < 2; ++n) acc[a][b][m][n] = (f32x4){0.f, 0.f, 0.f, 0.f};
        cur = nxt; cA = nA; cB = nB; ++ui;
    }
    PG8_WAIT_V(0);
    if (wr == 0) PG8_BAR;
    PG8_BAR;
    if constexpr (Epi::AFTER_DRAIN) { E.fused(acc, cur, wr, wc, fr, fq, lds, wid, lane); }
#undef PG8_SA
#undef PG8_SB
#undef PG8_STAGE
#undef PG8_LDA
#undef PG8_LDB
#undef PG8_MMA
#undef PG8_WAIT_V
#undef PG8_WAIT_L
#undef PG8_BAR
#undef PG8_SCHED
}

struct EpiBf16Store {
    static constexpr bool PERM = true, AFTER_DRAIN = false;
    bf16_t* O; int ldc;
    __device__ __forceinline__ void operator()(const f32x4 (&acc)[2][2][4][2], const Unit& u, int wr, int wc, int fr, int fq) const {
        const int row0 = u.pm * BM + wr * 64 + fr, col0 = u.pn * BM + wc * 32 + 8 * fq;
#pragma unroll
        for (int ai = 0; ai < 2; ++ai)
#pragma unroll
            for (int m = 0; m < 4; ++m) { bf16_t* rowp = O + (size_t)(row0 + ai * HALF + m * 16) * ldc + col0;
#pragma unroll
                for (int bj = 0; bj < 2; ++bj) { const f32x4 v0 = acc[ai][bj][m][0], v1 = acc[ai][bj][m][1];
                    u32x4 w; w.x = cvt_pk_bf16(v0[0], v0[1]); w.y = cvt_pk_bf16(v0[2], v0[3]); w.z = cvt_pk_bf16(v1[0], v1[1]); w.w = cvt_pk_bf16(v1[2], v1[3]);
                    *(u32x4*)(rowp + bj * HALF) = w; } }
    }
};

struct EpiProjAY {
    static constexpr bool PERM = true, AFTER_DRAIN = false;
    bf16_t* PROJ; bf16_t* AY;
    __device__ __forceinline__ void operator()(const f32x4 (&acc)[2][2][4][2], const Unit& u, int wr, int wc, int fr, int fq) const {
        const int rowb = u.pm * BM + wr * 64, col0 = u.pn * BM + wc * 32 + 8 * fq;
#pragma unroll
        for (int bj = 0; bj < 2; ++bj) { const int col = col0 + bj * HALF; const bool ay = col < WSSM;
#pragma unroll
            for (int ai = 0; ai < 2; ++ai)
#pragma unroll
                for (int m = 0; m < 4; ++m) { const int rb = rowb + ai * HALF + m * 16;
                    bf16_t* dst = ay ? AY + ((size_t)((col >> 4) * 1024 + (rb >> 4)) * 512 + fr * 16 + (col & 15)) : PROJ + (size_t)(rb + fr) * DIN + col;
                    const f32x4 v0 = acc[ai][bj][m][0], v1 = acc[ai][bj][m][1];
                    u32x4 w; w.x = cvt_pk_bf16(v0[0], v0[1]); w.y = cvt_pk_bf16(v0[2], v0[3]); w.z = cvt_pk_bf16(v1[0], v1[1]); w.w = cvt_pk_bf16(v1[2], v1[3]);
                    *(u32x4*)dst = w; } }
    }
};
struct EpiSend {
    static constexpr bool PERM = false, AFTER_DRAIN = true;
    bf16_t* AY; const float* LAMT; const float* LAM512;
    __device__ __forceinline__ void fused(const f32x4 (&acc)[2][2][4][2], const Unit& u, int wr, int wc, int fr, int fq, LAS unsigned char* lds, int wid, int lane) const {
        LAS float* S = (LAS float*)lds;
        LAS float* E = (LAS float*)(lds + 131072);
#pragma unroll
        for (int ai = 0; ai < 2; ++ai)
#pragma unroll
            for (int m = 0; m < 4; ++m)
#pragma unroll
                for (int n = 0; n < 2; ++n) { const int r = ai * HALF + wr * 64 + m * 16 + fr, c = wc * 32 + n * 16 + 4 * fq; *(LAS f32x4*)(S + r * 128 + c) = acc[ai][0][m][n]; }
        __syncthreads();
        const int g = u.z, b = u.pm, p = lane, seg = wid;
        const float tr = LAMT[(g * NP + p) * 2], ti = LAMT[(g * NP + p) * 2 + 1], hr = LAM512[(g * NP + p) * 2], hi = LAM512[(g * NP + p) * 2 + 1];
        float sr = 0.f, si = 0.f;
        for (int i = 0; i < 32; ++i) { const int row = seg * 32 + i; const float xr = S[row * 128 + p], xi = S[row * 128 + 64 + p];
            const float nr = tr * sr - ti * si + xr, ni = tr * si + ti * sr + xi; sr = nr; si = ni; }
        E[seg * 128 + p] = sr; E[seg * 128 + 64 + p] = si;
        __syncthreads();
        sr = 0.f; si = 0.f;
        for (int s2 = 0; s2 < seg; ++s2) { const float xr = E[s2 * 128 + p], xi = E[s2 * 128 + 64 + p]; const float nr = hr * sr - hi * si + xr, ni = hr * si + hi * sr + xi; sr = nr; si = ni; }
        bf16_t* base = AY + ((size_t)(g * 1024 + b * 256 + seg * 32)) * 512 + 256 + p;
        for (int i = 0; i < 32; ++i) { const int row = seg * 32 + i;
            bf16_t* o = base + (size_t)i * 512;
            o[0] = (bf16_t)f2bf(sr); o[64] = (bf16_t)f2bf(si);
            const float xr = S[row * 128 + p], xi = S[row * 128 + 64 + p];
            const float nr = tr * sr - ti * si + xr, ni = tr * si + ti * sr + xi; sr = nr; si = ni; }
    }
};
struct EpiY {
    static constexpr bool PERM = true, AFTER_DRAIN = false;
    const bf16_t* AY; const float* ssm_d; bf16_t* GB;
    __device__ __forceinline__ void operator()(const f32x4 (&acc)[2][2][4][2], const Unit& u, int wr, int wc, int fr, int fq) const {
        const int g = u.z, b = u.pm;
#pragma unroll
        for (int bj = 0; bj < 2; ++bj) { const int col = bj * HALF + wc * 32 + 8 * fq, t = col >> 4, h0 = col & 15;
            const f32x4 d0 = *(const f32x4*)(ssm_d + g * GH + h0), d1 = *(const f32x4*)(ssm_d + g * GH + h0 + 4);
            u32x4 u8[2][4];
#pragma unroll
            for (int ai = 0; ai < 2; ++ai)
#pragma unroll
                for (int m = 0; m < 4; ++m) { const int crow = ai * HALF + wr * 64 + m * 16 + fr; u8[ai][m] = *(const u32x4*)(AY + ((size_t)(g * 1024 + b * 256 + crow)) * 512 + col); }
#pragma unroll
            for (int ai = 0; ai < 2; ++ai)
#pragma unroll
                for (int m = 0; m < 4; ++m) { const int crow = ai * HALF + wr * 64 + m * 16 + fr;
                    const u32x4 uu = u8[ai][m]; const f32x4 v0 = acc[ai][bj][m][0], v1 = acc[ai][bj][m][1];
                    u32x4 w;
                    w.x = cvt_pk_bf16(gelu_tanh(v0[0] + d0[0] * bflo(uu.x)), gelu_tanh(v0[1] + d0[1] * bfhi(uu.x)));
                    w.y = cvt_pk_bf16(gelu_tanh(v0[2] + d0[2] * bflo(uu.y)), gelu_tanh(v0[3] + d0[3] * bfhi(uu.y)));
                    w.z = cvt_pk_bf16(gelu_tanh(v1[0] + d1[0] * bflo(uu.z)), gelu_tanh(v1[1] + d1[1] * bfhi(uu.z)));
                    w.w = cvt_pk_bf16(gelu_tanh(v1[2] + d1[2] * bflo(uu.w)), gelu_tanh(v1[3] + d1[3] * bfhi(uu.w)));
                    *(u32x4*)(GB + ((size_t)(b * SEQ + crow * 16 + t)) * WSSM + g * GH + h0) = w; }
            asm volatile("" ::: "memory"); }
    }
};
struct EpiGluP {
    static constexpr bool PERM = true, AFTER_DRAIN = false;
    const bf16_t* GB; const bf16_t* PROJ; const float* b_glu; bf16_t* YCAT;
    __device__ __forceinline__ void operator()(const f32x4 (&acc)[2][2][4][2], const Unit& u, int wr, int wc, int fr, int fq) const {
        const int row0 = u.pm * BM + wr * 64 + fr, col0 = u.pn * BM + wc * 32 + 8 * fq;
#pragma unroll
        for (int bj = 0; bj < 2; ++bj) { const int col = col0 + bj * HALF; if (col >= WSSM) continue;
            const f32x4 b0 = *(const f32x4*)(b_glu + col), b1 = *(const f32x4*)(b_glu + col + 4);
#pragma unroll
            for (int ai = 0; ai < 2; ++ai) { if (ai != u.z) continue;
                u32x4 g8[4], a8[4];
#pragma unroll
                for (int m = 0; m < 4; ++m) { const size_t row = (size_t)(row0 + ai * HALF + m * 16); g8[m] = *(const u32x4*)(GB + row * WSSM + col); a8[m] = *(const u32x4*)(PROJ + row * DIN + C_AGATE + col); }
#pragma unroll
                for (int m = 0; m < 4; ++m) { const size_t row = (size_t)(row0 + ai * HALF + m * 16);
                    const f32x4 v0 = acc[ai][bj][m][0] + b0, v1 = acc[ai][bj][m][1] + b1;
                    u32x4 w;
                    w.x = cvt_pk_bf16(bflo(g8[m].x) * sigmoid_f(v0[0]) * silu_f(bflo(a8[m].x)), bfhi(g8[m].x) * sigmoid_f(v0[1]) * silu_f(bfhi(a8[m].x)));
                    w.y = cvt_pk_bf16(bflo(g8[m].y) * sigmoid_f(v0[2]) * silu_f(bflo(a8[m].y)), bfhi(g8[m].y) * sigmoid_f(v0[3]) * silu_f(bfhi(a8[m].y)));
                    w.z = cvt_pk_bf16(bflo(g8[m].z) * sigmoid_f(v1[0]) * silu_f(bflo(a8[m].z)), bfhi(g8[m].z) * sigmoid_f(v1[1]) * silu_f(bfhi(a8[m].z)));
                    w.w = cvt_pk_bf16(bflo(g8[m].w) * sigmoid_f(v1[2]) * silu_f(bflo(a8[m].w)), bfhi(g8[m].w) * sigmoid_f(v1[3]) * silu_f(bfhi(a8[m].w)));
                    *(u32x4*)(YCAT + row * DM + col) = w; }
                asm volatile("" ::: "memory"); } }
    }
};
struct EpiResF32 {
    static constexpr bool PERM = false, AFTER_DRAIN = false;
    const float* x; float* out;
    __device__ __forceinline__ void operator()(const f32x4 (&acc)[2][2][4][2], const Unit& u, int wr, int wc, int fr, int fq) const {
        const int row0 = u.pm * BM + wr * 64 + fr, col0 = u.pn * BM + wc * 32 + 4 * fq;
#pragma unroll
        for (int ai = 0; ai < 2; ++ai)
#pragma unroll
            for (int m = 0; m < 4; ++m) { const size_t off = (size_t)(row0 + ai * HALF + m * 16) * DM + col0;
#pragma unroll
                for (int bj = 0; bj < 2; ++bj)
#pragma unroll
                    for (int n = 0; n < 2; ++n) { const f32x4 xv = *(const f32x4*)(x + off + bj * HALF + n * 16); *(f32x4*)(out + off + bj * HALF + n * 16) = xv + acc[ai][bj][m][n]; }
                asm volatile("" ::: "memory"); }
    }
};

struct EpiOutNorm {
    static constexpr bool PERM = false, AFTER_DRAIN = true;
    const float* x; const float* fg; float* out; float* xch; unsigned* cnt;
    __device__ __forceinline__ void fused(f32x4 (&acc)[2][2][4][2], const Unit& u, int wr, int wc, int fr, int fq, LAS unsigned char* lds, int wid, int lane) const {
        LAS float* P = (LAS float*)lds;
        LAS float* S = (LAS float*)(lds + 8192);
        const int row0 = u.pm * BM + wr * 64 + fr, col0 = u.pn * BM + wc * 32 + 4 * fq;
#pragma unroll
        for (int ai = 0; ai < 2; ++ai) {
            f32x4 xv[4][2][2];
#pragma unroll
            for (int m = 0; m < 4; ++m) { const size_t off = (size_t)(row0 + ai * HALF + m * 16) * DM + col0;
#pragma unroll
                for (int bj = 0; bj < 2; ++bj)
#pragma unroll
                    for (int n = 0; n < 2; ++n) xv[m][bj][n] = *(const f32x4*)(x + off + bj * HALF + n * 16); }
#pragma unroll
            for (int m = 0; m < 4; ++m) { float sq = 0.f;
#pragma unroll
                for (int bj = 0; bj < 2; ++bj)
#pragma unroll
                    for (int n = 0; n < 2; ++n) { const f32x4 hv = acc[ai][bj][m][n] + xv[m][bj][n]; acc[ai][bj][m][n] = hv; sq += (hv[0] * hv[0] + hv[1] * hv[1]) + (hv[2] * hv[2] + hv[3] * hv[3]); }
                sq += __shfl_xor(sq, 16); sq += __shfl_xor(sq, 32);
                if (fq == 0) P[(ai * HALF + wr * 64 + m * 16 + fr) * 4 + wc] = sq; }
            asm volatile("" ::: "memory"); }
        asm volatile("s_waitcnt lgkmcnt(0)" ::: "memory"); __builtin_amdgcn_s_barrier(); asm volatile("" ::: "memory");
        const int row = wid * 32 + (lane & 31);
        if (lane < 32) { const f32x4 pv = *(const LAS f32x4*)(P + row * 4); const float t = (pv[0] + pv[1]) + (pv[2] + pv[3]);
            __hip_atomic_store(xch + ((size_t)(u.pm * BM + row) * 4 + u.pn), t, __ATOMIC_RELAXED, __HIP_MEMORY_SCOPE_AGENT); }
        asm volatile("s_waitcnt vmcnt(0)" ::: "memory");
        if (lane == 0) __hip_atomic_fetch_add(cnt + 64 * u.pm, 1u, __ATOMIC_RELAXED, __HIP_MEMORY_SCOPE_AGENT);
        if (wid == 0) { unsigned sp = 0;
            while ((unsigned)__builtin_amdgcn_readfirstlane(__hip_atomic_load(cnt + 64 * u.pm, __ATOMIC_RELAXED, __HIP_MEMORY_SCOPE_AGENT)) < 32u) { __builtin_amdgcn_s_sleep(2); if (++sp > (1u << 22)) break; }
            __builtin_amdgcn_fence(__ATOMIC_ACQUIRE, "agent"); }
        asm volatile("s_waitcnt vmcnt(0) lgkmcnt(0)" ::: "memory"); __builtin_amdgcn_s_barrier(); asm volatile("" ::: "memory");
        if (lane < 32) { const float* slot = xch + (size_t)(u.pm * BM + row) * 4; float t = 0.f;
#pragma unroll
            for (int q = 0; q < 4; ++q) t += __hip_atomic_load(slot + q, __ATOMIC_RELAXED, __HIP_MEMORY_SCOPE_AGENT);
            S[row] = 1.0f / sqrtf(t * (1.0f / DM) + NORM_EPS); }
        asm volatile("s_waitcnt lgkmcnt(0)" ::: "memory"); __builtin_amdgcn_s_barrier(); asm volatile("" ::: "memory");
        f32x4 gv[2][2];
#pragma unroll
        for (int bj = 0; bj < 2; ++bj)
#pragma unroll
            for (int n = 0; n < 2; ++n) gv[bj][n] = *(const f32x4*)(fg + col0 + bj * HALF + n * 16);
#pragma unroll
        for (int ai = 0; ai < 2; ++ai)
#pragma unroll
            for (int m = 0; m < 4; ++m) { const int r = ai * HALF + wr * 64 + m * 16 + fr; const float rs = S[r]; const size_t off = (size_t)(u.pm * BM + r) * DM + col0;
#pragma unroll
                for (int bj = 0; bj < 2; ++bj)
#pragma unroll
                    for (int n = 0; n < 2; ++n) *(f32x4*)(out + off + bj * HALF + n * 16) = acc[ai][bj][m][n] * rs * gv[bj][n]; }
    }
};
}

__device__ __forceinline__ void s5_naive(const Args& a, int b, int g, int lane) {
    const bf16_t* PROJ = (const bf16_t*)(a.ws + WS_PROJ); bf16_t* GB = (bf16_t*)(a.ws + WS_GB);
    const float* LAMB = (const float*)(a.ws + WS_LAMB); const float* BBAR = (const float*)(a.ws + WS_BBAR);
    const float* c_re = a.in[8]; const float* c_im = a.in[9]; const float* ssm_d = a.in[10];
    const int p = lane, h = lane & 15, pg = lane >> 4;
    const float lr = LAMB[(g * NP + p) * 2], li = LAMB[(g * NP + p) * 2 + 1];
    float bre[16], bim[16], cre[16], cim[16];
#pragma unroll
    for (int j = 0; j < 16; ++j) { bre[j] = BBAR[((g * NP + p) * GH + j) * 2]; bim[j] = BBAR[((g * NP + p) * GH + j) * 2 + 1];
        cre[j] = c_re[(g * GH + h) * NP + pg * 16 + j]; cim[j] = c_im[(g * GH + h) * NP + pg * 16 + j]; }
    const float dd = ssm_d[g * GH + h];
    float sr = 0.f, si = 0.f;
    for (int t = 0; t < SEQ; ++t) {
        const bf16_t* up = PROJ + (size_t)(b * SEQ + t) * DIN + C_AIN + g * GH;
        const v4u u0 = *(const v4u*)up, u1 = *(const v4u*)(up + 8);
        float u[16];
        u[0] = bflo(u0.x); u[1] = bfhi(u0.x); u[2] = bflo(u0.y); u[3] = bfhi(u0.y); u[4] = bflo(u0.z); u[5] = bfhi(u0.z); u[6] = bflo(u0.w); u[7] = bfhi(u0.w);
        u[8] = bflo(u1.x); u[9] = bfhi(u1.x); u[10] = bflo(u1.y); u[11] = bfhi(u1.y); u[12] = bflo(u1.z); u[13] = bfhi(u1.z); u[14] = bflo(u1.w); u[15] = bfhi(u1.w);
        const float uh = bf2f(up[h]);
        float bur = 0.f, bui = 0.f;
#pragma unroll
        for (int j = 0; j < 16; ++j) { bur += bre[j] * u[j]; bui += bim[j] * u[j]; }
        const float nsr = lr * sr - li * si + bur, nsi = lr * si + li * sr + bui;
        sr = nsr; si = nsi;
        float part = 0.f;
#pragma unroll
        for (int j = 0; j < 16; ++j) { const float xr = __shfl(sr, pg * 16 + j), xi = __shfl(si, pg * 16 + j); part += cre[j] * xr - cim[j] * xi; }
        part += __shfl_xor(part, 16); part += __shfl_xor(part, 32);
        const float y = part + dd * uh;
        if (lane < 16) GB[(size_t)(b * SEQ + t) * WSSM + g * GH + h] = (bf16_t)f2bf(gelu_tanh(y));
    }
}

__device__ __forceinline__ void conv_naive(const Args& a, int vb, int nvb) {
    const bf16_t* PROJ = (const bf16_t*)(a.ws + WS_PROJ); bf16_t* YCAT = (bf16_t*)(a.ws + WS_YCAT);
    const float* conv_w = a.in[14]; const float* conv_b = a.in[15];
    const int gt = vb * 512 + otid(), NT = nvb * 512;
    for (int idx = gt; idx < NTOK * WSSM; idx += NT) {
        const int tok = idx / WSSM, c = idx % WSSM, t = tok % SEQ;
        const bf16_t* row = PROJ + (size_t)tok * DIN;
        float acc = conv_b[c];
#pragma unroll
        for (int k = 0; k < 3; ++k) { const int tt = t - 2 + k; if (tt >= 0) { const bf16_t* r2 = PROJ + (size_t)(tok - 2 + k) * DIN; acc += conv_w[k * WSSM + c] * (bf2f(r2[C_CC + c]) * bf2f(r2[C_CIN + c])); } }
        const float y = bf2f(row[C_CB + c]) * acc * silu_f(bf2f(row[C_CGATE + c]));
        YCAT[(size_t)tok * DM + WSSM + c] = (bf16_t)f2bf(y);
    }
}
__device__ __forceinline__ void attn_naive(const Args& a, int vb, int nvb) {
    const bf16_t* PROJ = (const bf16_t*)(a.ws + WS_PROJ); bf16_t* YCAT = (bf16_t*)(a.ws + WS_YCAT); const bf16_t* KV = (const bf16_t*)(a.ws + WS_KV);
    const int gt = vb * 512 + otid(), NT = nvb * 512;
    for (int item = gt; item < NB * 4 * SEQ; item += NT) {
        const int t = item % SEQ, hh = (item / SEQ) % 4, b = item / (4 * SEQ), tok = b * SEQ + t;
        const v4u* qp = (const v4u*)(PROJ + (size_t)tok * DIN + C_Q + hh * 64);
        float q[64], o[64];
#pragma unroll
        for (int i = 0; i < 8; ++i) { const v4u v = qp[i]; q[8 * i] = bflo(v.x); q[8 * i + 1] = bfhi(v.x); q[8 * i + 2] = bflo(v.y); q[8 * i + 3] = bfhi(v.y); q[8 * i + 4] = bflo(v.z); q[8 * i + 5] = bfhi(v.z); q[8 * i + 6] = bflo(v.w); q[8 * i + 7] = bfhi(v.w); }
#pragma unroll
        for (int d = 0; d < 64; ++d) o[d] = 0.f;
        float m = -1e30f, l = 0.f;
        for (int mm = 0; mm < NMEM; ++mm) {
            const v4u* kp = (const v4u*)(KV + (size_t)(b * NMEM + mm) * 512 + hh * 64);
            const v4u* vp = (const v4u*)(KV + (size_t)(b * NMEM + mm) * 512 + 256 + hh * 64);
            float s = 0.f;
#pragma unroll
            for (int i = 0; i < 8; ++i) { const v4u v = kp[i];
                s += q[8 * i] * bflo(v.x) + q[8 * i + 1] * bfhi(v.x) + q[8 * i + 2] * bflo(v.y) + q[8 * i + 3] * bfhi(v.y) + q[8 * i + 4] * bflo(v.z) + q[8 * i + 5] * bfhi(v.z) + q[8 * i + 6] * bflo(v.w) + q[8 * i + 7] * bfhi(v.w); }
            s *= 0.125f;
            const float mn = fmaxf(m, s), sc = __expf(m - mn), pp = __expf(s - mn);
            l = l * sc + pp; m = mn;
#pragma unroll
            for (int i = 0; i < 8; ++i) { const v4u v = vp[i];
                o[8 * i] = o[8 * i] * sc + pp * bflo(v.x); o[8 * i + 1] = o[8 * i + 1] * sc + pp * bfhi(v.x); o[8 * i + 2] = o[8 * i + 2] * sc + pp * bflo(v.y); o[8 * i + 3] = o[8 * i + 3] * sc + pp * bfhi(v.y);
                o[8 * i + 4] = o[8 * i + 4] * sc + pp * bflo(v.z); o[8 * i + 5] = o[8 * i + 5] * sc + pp * bfhi(v.z); o[8 * i + 6] = o[8 * i + 6] * sc + pp * bflo(v.w); o[8 * i + 7] = o[8 * i + 7] * sc + pp * bfhi(v.w); }
        }
        const float inv = 1.0f / l;
        const v4u* gp = (const v4u*)(PROJ + (size_t)tok * DIN + C_QGATE + hh * 64);
        v4u* op = (v4u*)(YCAT + (size_t)tok * DM + 768 + hh * 64);
#pragma unroll
        for (int i = 0; i < 8; ++i) { const v4u gv = gp[i]; v4u w;
            w.x = pk2(o[8 * i] * inv * silu_f(bflo(gv.x)), o[8 * i + 1] * inv * silu_f(bfhi(gv.x)));
            w.y = pk2(o[8 * i + 2] * inv * silu_f(bflo(gv.y)), o[8 * i + 3] * inv * silu_f(bfhi(gv.y)));
            w.z = pk2(o[8 * i + 4] * inv * silu_f(bflo(gv.z)), o[8 * i + 5] * inv * silu_f(bfhi(gv.z)));
            w.w = pk2(o[8 * i + 6] * inv * silu_f(bflo(gv.w)), o[8 * i + 7] * inv * silu_f(bfhi(gv.w)));
            op[i] = w; }
    }
}

typedef short bf16x8_t __attribute__((ext_vector_type(8)));
typedef short s16x4_t __attribute__((ext_vector_type(4)));
typedef float f32x16 __attribute__((ext_vector_type(16)));
typedef __bf16 bf2_t __attribute__((ext_vector_type(2)));
typedef float f2_t __attribute__((ext_vector_type(2)));
typedef unsigned u32x2_t __attribute__((ext_vector_type(2)));
__device__ __forceinline__ unsigned cvt2(float lo, float hi) { const f2_t v = {lo, hi}; return __builtin_bit_cast(unsigned, __builtin_convertvector(v, bf2_t)); }
__device__ __forceinline__ void attn_mfma(const Args& a, LAS unsigned char* lds, int vb, int nvb) {
    const int nj = nvb / 16; if (nj < 1 || vb >= nj * 16) return;
    const int tid = otid(), lane = tid & 63, wave = tid >> 6, r = lane & 31, h = lane >> 5;
    const int bh = vb % 16, j = vb / 16, b = bh >> 2, head = bh & 3;
    const bf16_t* PROJ = (const bf16_t*)(a.ws + WS_PROJ); bf16_t* YCAT = (bf16_t*)(a.ws + WS_YCAT); const bf16_t* KV = (const bf16_t*)(a.ws + WS_KV);
    LAS unsigned char* Kl = lds;
    LAS unsigned char* Vl = lds + 36864;
    for (int c = tid; c < 2048; c += 512) { const int key = c >> 3, dch = c & 7;
        const bf16_t* src = KV + (size_t)(b * NMEM + key) * 512 + head * 64 + dch * 8;
        const v4u kv = *(const v4u*)src, vv = *(const v4u*)(src + 256);
        *(LAS v4u*)(Kl + key * 144 + dch * 16) = kv;
        LAS bf16_t* vd = (LAS bf16_t*)(Vl + (dch * 8) * 520 + key * 2);
        vd[0 * 260] = (bf16_t)(vv.x & 0xffff); vd[1 * 260] = (bf16_t)(vv.x >> 16); vd[2 * 260] = (bf16_t)(vv.y & 0xffff); vd[3 * 260] = (bf16_t)(vv.y >> 16);
        vd[4 * 260] = (bf16_t)(vv.z & 0xffff); vd[5 * 260] = (bf16_t)(vv.z >> 16); vd[6 * 260] = (bf16_t)(vv.w & 0xffff); vd[7 * 260] = (bf16_t)(vv.w >> 16); }
    __syncthreads();
    for (int tile = j * 8 + wave; tile < SEQ / 32; tile += nj * 8) {
        const size_t tok = (size_t)b * SEQ + tile * 32 + r;
        bf16x8_t qf[4];
#pragma unroll
        for (int s4 = 0; s4 < 4; ++s4) qf[s4] = *(const bf16x8_t*)(PROJ + tok * DIN + C_Q + head * 64 + 16 * s4 + 8 * h);
        const float sc = 0.125f * 1.4426950408889634f;
        float mx = -3.0e38f, l = 0.f;
        f32x16 o0, o1;
#pragma unroll
        for (int i = 0; i < 16; ++i) { o0[i] = 0.f; o1[i] = 0.f; }
#pragma unroll 2
        for (int kt = 0; kt < 8; ++kt) {
            f32x16 st;
#pragma unroll
            for (int i = 0; i < 16; ++i) st[i] = 0.f;
#pragma unroll
            for (int s4 = 0; s4 < 4; ++s4) { const bf16x8_t kf = *(const LAS bf16x8_t*)(Kl + (kt * 32 + r) * 144 + (16 * s4 + 8 * h) * 2);
                st = __builtin_amdgcn_mfma_f32_32x32x16_bf16(kf, qf[s4], st, 0, 0, 0); }
            float tm = st[0];
#pragma unroll
            for (int i = 1; i < 16; ++i) tm = fmaxf(tm, st[i]);
            tm = fmaxf(tm, __shfl_xor(tm, 32));
            const float mn = fmaxf(mx, tm), alpha = __builtin_amdgcn_exp2f((mx - mn) * sc), mb = mn * sc;
            mx = mn; l *= alpha;
#pragma unroll
            for (int i = 0; i < 16; ++i) { o0[i] *= alpha; o1[i] *= alpha; }
#pragma unroll
            for (int i = 0; i < 16; ++i) { const float p = __builtin_amdgcn_exp2f(st[i] * sc - mb); st[i] = p; l += p; }
#pragma unroll
            for (int s2 = 0; s2 < 2; ++s2) {
                v4u pw; pw.x = cvt2(st[8 * s2 + 0], st[8 * s2 + 1]); pw.y = cvt2(st[8 * s2 + 2], st[8 * s2 + 3]);
                pw.z = cvt2(st[8 * s2 + 4], st[8 * s2 + 5]); pw.w = cvt2(st[8 * s2 + 6], st[8 * s2 + 7]);
                const bf16x8_t pf = __builtin_bit_cast(bf16x8_t, pw);
                const int koff = (kt * 32 + 16 * s2 + 4 * h) * 2;
                { const s16x4_t lo = *(const LAS s16x4_t*)(Vl + r * 520 + koff), hi = *(const LAS s16x4_t*)(Vl + r * 520 + koff + 16);
                  const bf16x8_t vf = __builtin_shufflevector(lo, hi, 0, 1, 2, 3, 4, 5, 6, 7); o0 = __builtin_amdgcn_mfma_f32_32x32x16_bf16(vf, pf, o0, 0, 0, 0); }
                { const s16x4_t lo = *(const LAS s16x4_t*)(Vl + (32 + r) * 520 + koff), hi = *(const LAS s16x4_t*)(Vl + (32 + r) * 520 + koff + 16);
                  const bf16x8_t vf = __builtin_shufflevector(lo, hi, 0, 1, 2, 3, 4, 5, 6, 7); o1 = __builtin_amdgcn_mfma_f32_32x32x16_bf16(vf, pf, o1, 0, 0, 0); }
            }
        }
        l += __shfl_xor(l, 32);
        const float inv = 1.0f / l;
        const bf16_t* gp = PROJ + tok * DIN + C_QGATE + head * 64; bf16_t* op = YCAT + tok * DM + 768 + head * 64;
#pragma unroll
        for (int q4 = 0; q4 < 4; ++q4) {
            { const int d = 8 * q4 + 4 * h; const u32x2_t gv = *(const u32x2_t*)(gp + d); u32x2_t w;
              w.x = cvt2(o0[4 * q4 + 0] * inv * silu_f(bflo(gv.x)), o0[4 * q4 + 1] * inv * silu_f(bfhi(gv.x))); w.y = cvt2(o0[4 * q4 + 2] * inv * silu_f(bflo(gv.y)), o0[4 * q4 + 3] * inv * silu_f(bfhi(gv.y)));
              *(u32x2_t*)(op + d) = w; }
            { const int d = 32 + 8 * q4 + 4 * h; const u32x2_t gv = *(const u32x2_t*)(gp + d); u32x2_t w;
              w.x = cvt2(o1[4 * q4 + 0] * inv * silu_f(bflo(gv.x)), o1[4 * q4 + 1] * inv * silu_f(bfhi(gv.x))); w.y = cvt2(o1[4 * q4 + 2] * inv * silu_f(bflo(gv.y)), o1[4 * q4 + 3] * inv * silu_f(bfhi(gv.y)));
              *(u32x2_t*)(op + d) = w; }
        }
    }
}
__device__ __forceinline__ void conv_vec(const Args& a, int vb, int nvb) {
    const bf16_t* PROJ = (const bf16_t*)(a.ws + WS_PROJ); bf16_t* YCAT = (bf16_t*)(a.ws + WS_YCAT);
    const float* conv_w = a.in[14]; const float* conv_b = a.in[15];
    const int gt = vb * 512 + otid(), NT = nvb * 512;
    for (int it = gt; it < (NTOK / 4) * 48; it += NT) {
        const int tg = it / 48, c0 = (it % 48) * 8, tok0 = tg * 4, t0 = tok0 % SEQ;
        const bf16_t* row0 = PROJ + (size_t)tok0 * DIN;
        v4u cc[6], ci[6], cb[4], cg[4];
#pragma unroll
        for (int r = 0; r < 6; ++r) { const bool ok = (t0 + r - 2) >= 0; const bf16_t* rp = row0 + (ptrdiff_t)(r - 2) * DIN;
            cc[r] = ok ? *(const v4u*)(rp + C_CC + c0) : (v4u){0u, 0u, 0u, 0u}; ci[r] = ok ? *(const v4u*)(rp + C_CIN + c0) : (v4u){0u, 0u, 0u, 0u}; }
#pragma unroll
        for (int j = 0; j < 4; ++j) { cb[j] = *(const v4u*)(row0 + (size_t)j * DIN + C_CB + c0); cg[j] = *(const v4u*)(row0 + (size_t)j * DIN + C_CGATE + c0); }
        float w[3][8], bb[8];
#pragma unroll
        for (int k = 0; k < 3; ++k) { const f32x4 w0 = *(const f32x4*)(conv_w + k * WSSM + c0), w1 = *(const f32x4*)(conv_w + k * WSSM + c0 + 4);
            w[k][0] = w0.x; w[k][1] = w0.y; w[k][2] = w0.z; w[k][3] = w0.w; w[k][4] = w1.x; w[k][5] = w1.y; w[k][6] = w1.z; w[k][7] = w1.w; }
        { const f32x4 b0 = *(const f32x4*)(conv_b + c0), b1 = *(const f32x4*)(conv_b + c0 + 4); bb[0] = b0.x; bb[1] = b0.y; bb[2] = b0.z; bb[3] = b0.w; bb[4] = b1.x; bb[5] = b1.y; bb[6] = b1.z; bb[7] = b1.w; }
        float u[6][8];
#pragma unroll
        for (int r = 0; r < 6; ++r) { u[r][0] = bflo(cc[r].x) * bflo(ci[r].x); u[r][1] = bfhi(cc[r].x) * bfhi(ci[r].x); u[r][2] = bflo(cc[r].y) * bflo(ci[r].y); u[r][3] = bfhi(cc[r].y) * bfhi(ci[r].y);
            u[r][4] = bflo(cc[r].z) * bflo(ci[r].z); u[r][5] = bfhi(cc[r].z) * bfhi(ci[r].z); u[r][6] = bflo(cc[r].w) * bflo(ci[r].w); u[r][7] = bfhi(cc[r].w) * bfhi(ci[r].w); }
#pragma unroll
        for (int j = 0; j < 4; ++j) { float y[8];
#pragma unroll
            for (int e = 0; e < 8; ++e) y[e] = bb[e] + w[0][e] * u[j][e] + w[1][e] * u[j + 1][e] + w[2][e] * u[j + 2][e];
            v4u o;
            o.x = cvt2(bflo(cb[j].x) * y[0] * silu_f(bflo(cg[j].x)), bfhi(cb[j].x) * y[1] * silu_f(bfhi(cg[j].x)));
            o.y = cvt2(bflo(cb[j].y) * y[2] * silu_f(bflo(cg[j].y)), bfhi(cb[j].y) * y[3] * silu_f(bfhi(cg[j].y)));
            o.z = cvt2(bflo(cb[j].z) * y[4] * silu_f(bflo(cg[j].z)), bfhi(cb[j].z) * y[5] * silu_f(bfhi(cg[j].z)));
            o.w = cvt2(bflo(cb[j].w) * y[6] * silu_f(bflo(cg[j].w)), bfhi(cb[j].w) * y[7] * silu_f(bfhi(cg[j].w)));
            *(v4u*)(YCAT + (size_t)(tok0 + j) * DM + WSSM + c0) = o; }
    }
}
__device__ __forceinline__ void final_norm(const Args& a) {
    const int tid = otid(), lane = tid & 63, gw = blockIdx.x * 8 + (tid >> 6), NGW = gridDim.x * 8;
    const float* fg = a.in[19];
    for (int r = gw; r < NTOK; r += NGW) {
        f32x4* xr = (f32x4*)(a.out + (size_t)r * DM) + lane;
        f32x4 v[4]; float s = 0.f;
#pragma unroll
        for (int j = 0; j < 4; ++j) { v[j] = xr[64 * j]; s += (v[j].x * v[j].x + v[j].y * v[j].y) + (v[j].z * v[j].z + v[j].w * v[j].w); }
        const float rstd = 1.0f / sqrtf(wave_sum(s) * (1.0f / DM) + NORM_EPS);
#pragma unroll
        for (int j = 0; j < 4; ++j) { const f32x4 g = ((const f32x4*)fg)[lane + 64 * j]; xr[64 * j] = v[j] * rstd * g; }
    }
}

__global__ void __launch_bounds__(512, 2) mega(Args a) {
    extern __shared__ __attribute__((aligned(16))) unsigned char smem_raw[];
    LAS unsigned char* lds = (LAS unsigned char*)smem_raw;
    cg::grid_group grid = cg::this_grid();
    volatile LAS unsigned* xst = (volatile LAS unsigned*)(lds + 139264);
    if (threadIdx.x == 0) { xst[0] = 0u; xst[1] = 0u; }
    { unsigned* ctl = (unsigned*)(a.ws + WS_CTL); unsigned* flag = ctl + CTL_FLAG_WORD;
      if (blockIdx.x == 0) { for (int i = threadIdx.x; i < 8192; i += 512) __hip_atomic_store(ctl + i, 0u, __ATOMIC_RELAXED, __HIP_MEMORY_SCOPE_AGENT);
          asm volatile("s_waitcnt vmcnt(0)" ::: "memory"); __syncthreads();
          if (threadIdx.x == 0) { __builtin_amdgcn_fence(__ATOMIC_RELEASE, "agent"); __hip_atomic_store(flag, CTL_TOKEN, __ATOMIC_RELAXED, __HIP_MEMORY_SCOPE_AGENT); } }
      if (threadIdx.x == 0) { unsigned sp = 0; while (__hip_atomic_load(flag, __ATOMIC_RELAXED, __HIP_MEMORY_SCOPE_AGENT) != CTL_TOKEN) { __builtin_amdgcn_s_sleep(1); if (++sp > (1u << 22)) break; }
          __builtin_amdgcn_fence(__ATOMIC_ACQUIRE, "agent"); } }
    __syncthreads();
    const XcdBarrier xbar = xcd_barrier_post((unsigned*)(a.ws + WS_CTL), xst);
    const int bid = blockIdx.x, G = gridDim.x;
    bf16_t* XB = (bf16_t*)(a.ws + WS_XB); bf16_t* MEMN = (bf16_t*)(a.ws + WS_MEMN);
    bf16_t* WINT = (bf16_t*)(a.ws + WS_WINT); bf16_t* WKVT = (bf16_t*)(a.ws + WS_WKVT); bf16_t* WOUTT = (bf16_t*)(a.ws + WS_WOUTT); bf16_t* WGLUT = (bf16_t*)(a.ws + WS_WGLUT);
    bf16_t* PROJ = (bf16_t*)(a.ws + WS_PROJ); bf16_t* KV = (bf16_t*)(a.ws + WS_KV); bf16_t* GB = (bf16_t*)(a.ws + WS_GB); bf16_t* YCAT = (bf16_t*)(a.ws + WS_YCAT);
    bf16_t* AY = (bf16_t*)(a.ws + WS_AY); bf16_t* WSb = (bf16_t*)(a.ws + WS_WS); bf16_t* WYb = (bf16_t*)(a.ws + WS_WY);

#ifndef PROBE_DUP
#define PROBE_DUP -1
#endif
#define REPS(k) for (int rep_ = 0; rep_ < ((PROBE_DUP == (k)) ? 2 : 1); ++rep_)
#ifndef PROBE_SUB
#define PROBE_SUB -1
#endif
    if (a.out == nullptr) grid.sync();
    REPS(0) { phase0(a, lds);
    xcd_barrier(xbar); }
    REPS(1) {
    { pg8::Order S; S.init(NTOK / 256, DIN / 256, 1, G, bid);
      pg8::gemm_phase(lds, pg8::Gemm{XB, WINT, DM, DM, DM, 0, 0}, S, pg8::EpiProjAY{PROJ, AY}); }
    { pg8::Order S; S.init(NB * NMEM / 256, 512 / 256, 1, G, (bid + G - ((NTOK / 256) * (DIN / 256)) % G) % G);
      pg8::gemm_phase(lds, pg8::Gemm{MEMN, WKVT, DM, DM, DM, 0, 0}, S, pg8::EpiBf16Store{KV, 512}); }
    xcd_barrier(xbar); }
    REPS(2) {
    if (bid < NB * NG) { pg8::Order S; S.init(NB, 1, NG, G, bid);
      pg8::gemm_phase(lds, pg8::Gemm{AY, WSb, 512, 256, 256, (size_t)1024 * 512, (size_t)256 * 256}, S, pg8::EpiSend{AY, (const float*)(a.ws + WS_LAMT), (const float*)(a.ws + WS_LAM512)});
      asm volatile("s_waitcnt vmcnt(0)" ::: "memory"); __syncthreads();
      pg8::gemm_phase(lds, pg8::Gemm{AY, WYb, 512, 512, 384, (size_t)1024 * 512, (size_t)256 * 512}, S, pg8::EpiY{AY, a.in[10], GB}); }
    else { attn_mfma(a, lds, bid - NB * NG, G - NB * NG); conv_vec(a, bid - NB * NG, G - NB * NG); }
    xcd_barrier(xbar); }
    REPS(4) {
    { pg8::Order S; S.init(NTOK / 256, 2, 2, G, bid);
      pg8::gemm_phase(lds, pg8::Gemm{GB, WGLUT, WSSM, WSSM, WSSM, 0, 0}, S, pg8::EpiGluP{GB, PROJ, a.in[13], YCAT}); }
    xcd_barrier(xbar); }
    REPS(5) {
    { pg8::Order S; S.init(NTOK / 256, DM / 256, 1, G, bid);
      pg8::gemm_phase(lds, pg8::Gemm{YCAT, WOUTT, DM, DM, DM, 0, 0}, S, pg8::EpiOutNorm{a.in[0], a.in[19], a.out, (float*)(a.ws + WS_XCH), (unsigned*)(a.ws + WS_CTL + CTL_PANEL)}); }
    }
    __syncthreads();
    if (threadIdx.x == 0) { unsigned* ctl = (unsigned*)(a.ws + WS_CTL);
        const unsigned old_ = __hip_atomic_fetch_add(ctl + CTL_EXIT_WORD, 1u, __ATOMIC_RELAXED, __HIP_MEMORY_SCOPE_AGENT);
        if (old_ == (unsigned)G - 1u) __hip_atomic_store(ctl + CTL_FLAG_WORD, CTL_RESET, __ATOMIC_RELAXED, __HIP_MEMORY_SCOPE_AGENT); }
}

extern "C" void kernel_launch(void* const* d_in, const int* in_sizes, int n_in, void* d_out, int out_size, void* d_ws, size_t ws_size, hipStream_t stream) {
    static int grid = 0;
    if (grid == 0) {
        if (n_in != 20 || out_size != NTOK * DM || ws_size < WS_END) { fprintf(stderr, "kernel_launch: unexpected shapes n_in %d out %d ws %zu\n", n_in, out_size, ws_size); grid = -1; return; }
        int dev = 0, cus = 0, per_cu = 0;
        hipGetDevice(&dev);
        hipDeviceGetAttribute(&cus, hipDeviceAttributeMultiprocessorCount, dev);
        if (hipFuncSetAttribute((const void*)mega, hipFuncAttributeMaxDynamicSharedMemorySize, LDS_BYTES) != hipSuccess) { fprintf(stderr, "kernel_launch: hipFuncSetAttribute failed\n"); grid = -1; return; }
        if (hipOccupancyMaxActiveBlocksPerMultiprocessor(&per_cu, (const void*)mega, 512, LDS_BYTES) != hipSuccess || per_cu < 1) { fprintf(stderr, "kernel_launch: occupancy query says %d\n", per_cu); per_cu = 1; }
        (void)hipGetLastError();
        grid = cus;
        if (grid != 256) { fprintf(stderr, "kernel_launch: built for 256 CUs (one workgroup each), device has %d\n", grid); grid = -1; return; }
        if (grid < NB * NG) { fprintf(stderr, "kernel_launch: grid %d too small\n", grid); grid = -1; return; }
    }
    if (grid < 0) return;
    Args a{};
    for (int i = 0; i < 20; ++i) a.in[i] = (const float*)d_in[i];
    a.out = (float*)d_out; a.ws = (unsigned char*)d_ws;
    void* args[] = {&a};
    hipError_t e = hipLaunchCooperativeKernel((const void*)mega, dim3(grid), dim3(512), args, LDS_BYTES, stream);
    if (e != hipSuccess) fprintf(stderr, "cooperative launch failed: %s (grid %d)\n", hipGetErrorString(e), grid);
}
```

```cpp
#include <hip/hip_runtime.h>
#include <hip/hip_cooperative_groups.h>
#include <cstdio>
#include <cstdint>
namespace cg = cooperative_groups;

#define LAS __attribute__((address_space(3)))
typedef unsigned short bf16_t;
typedef unsigned v4u __attribute__((ext_vector_type(4)));
typedef float f32x4 __attribute__((ext_vector_type(4)));

constexpr int NB = 4, SEQ = 4096, DM = 1024, NTOK = NB * SEQ, DIN = 2816, WSSM = 384, NG = 24, GH = 16, NP = 64, NMEM = 256;
constexpr int C_AIN = 0, C_AGATE = 384, C_CIN = 768, C_CB = 1152, C_CC = 1536, C_CGATE = 1920, C_Q = 2304, C_QGATE = 2560;
constexpr float NORM_EPS = 1e-6f;

constexpr size_t MiB = 1u << 20;
constexpr size_t WS_CTL = 0;
constexpr size_t WS_XB = 1 * MiB;
constexpr size_t WS_WINT = 33 * MiB;
constexpr size_t WS_WKVT = 39 * MiB;
constexpr size_t WS_WOUTT = 40 * MiB;
constexpr size_t WS_WGLUT = 42 * MiB;
constexpr size_t WS_MEMN = 43 * MiB;
constexpr size_t WS_KV = 45 * MiB;
constexpr size_t WS_LAMB = 46 * MiB;
constexpr size_t WS_BBAR = 46 * MiB + 65536;
constexpr size_t WS_GB = 47 * MiB;
constexpr size_t WS_PROJ = 59 * MiB;
constexpr size_t WS_YCAT = 147 * MiB;
constexpr size_t WS_AY = 179 * MiB;
constexpr size_t WS_WS = 203 * MiB;
constexpr size_t WS_WY = 206 * MiB;
constexpr size_t WS_LAMT = 212 * MiB;
constexpr size_t WS_LAM512 = 212 * MiB + 65536;
constexpr size_t WS_XCH = 213 * MiB;
constexpr size_t WS_END = 214 * MiB;
constexpr size_t CTL_PANEL = 16384;
constexpr size_t CTL_BYTES = 32768;
constexpr int CTL_EXIT_WORD = 3968, CTL_FLAG_WORD = 8192 + 64;
constexpr unsigned CTL_TOKEN = 0x600DF00Du, CTL_RESET = 0x0BADF00Du;

constexpr int LDS_BYTES = 147456;

struct Args {
    const float* in[20];
    float* out;
    unsigned char* ws;
};

__device__ __forceinline__ unsigned f2bf(float f) { unsigned u = __builtin_bit_cast(unsigned, f); return (u + 0x7fffu + ((u >> 16) & 1u)) >> 16; }
__device__ __forceinline__ unsigned pk2(float lo, float hi) { return f2bf(lo) | (f2bf(hi) << 16); }
__device__ __forceinline__ float bf2f(unsigned short b) { return __builtin_bit_cast(float, ((unsigned)b) << 16); }
__device__ __forceinline__ float bflo(unsigned w) { return __builtin_bit_cast(float, w << 16); }
__device__ __forceinline__ float bfhi(unsigned w) { return __builtin_bit_cast(float, w & 0xffff0000u); }
__device__ __forceinline__ float wave_sum(float v) {
#pragma unroll
    for (int o = 1; o < 64; o <<= 1) v += __shfl_xor(v, o);
    return v;
}
__device__ __forceinline__ float silu_f(float v) { return v * __builtin_amdgcn_rcpf(1.0f + __builtin_amdgcn_exp2f(-1.4426950408889634f * v)); }
__device__ __forceinline__ float sigmoid_f(float v) { return __builtin_amdgcn_rcpf(1.0f + __builtin_amdgcn_exp2f(-1.4426950408889634f * v)); }
__device__ __forceinline__ float gelu_tanh(float v) { const float w = __builtin_fmaf(v * v, -0.10294324f, -2.3022082f); return v * __builtin_amdgcn_rcpf(1.0f + __builtin_amdgcn_exp2f(v * w)); }
#define LDS_WAIT() asm volatile("s_waitcnt lgkmcnt(0)" ::: "memory")
__device__ __forceinline__ int otid() { int t = threadIdx.x; asm volatile("" : "+v"(t)); return t; }

#define XB_TMO      128
#define XB_XCNT(j)  (256  + 64 * (j))
#define XB_XSUB(j)  (1280 + 64 * (j))
#define XB_XGEN(j)  (2304 + 64 * (j))
#define XB_TOP      3328
#define XB_TOPGEN   3392
#define XCD_BAR_WORDS 3456
#define XB_SPIN_CAP (1u << 18)

__device__ __forceinline__ unsigned xb_ld(unsigned* p)              { return __hip_atomic_load(p, __ATOMIC_RELAXED, __HIP_MEMORY_SCOPE_AGENT); }
__device__ __forceinline__ unsigned xb_add(unsigned* p, unsigned v) { return __hip_atomic_fetch_add(p, v, __ATOMIC_RELAXED, __HIP_MEMORY_SCOPE_AGENT); }
__device__ __forceinline__ unsigned xb_xcc_id() { return (unsigned)__builtin_amdgcn_s_getreg((3 << 11) | 20) & 0xFu; }
#define XB_SPIN(cond, bar) do { unsigned _sp = 0; while (cond) { __builtin_amdgcn_s_sleep(1); \
    if ((++_sp & 255u) == 0u) { if (xb_ld(&(bar)[XB_TMO])) break; if (_sp > XB_SPIN_CAP) { atomicAdd(&(bar)[XB_TMO], 1u); break; } } } } while (0)

struct XcdBarrier {
    unsigned* bar; unsigned x;
    volatile LAS unsigned* st;
};

__device__ __forceinline__ XcdBarrier xcd_barrier_post(unsigned* bar, volatile LAS unsigned* st) {
    XcdBarrier b; b.bar = bar; b.x = xb_xcc_id(); b.st = st;
    if (threadIdx.x == 0) (void)xb_add(&bar[XB_XCNT(b.x)], 1u);
    return b;
}
__device__ __forceinline__ void xcd_barrier_complete(unsigned* bar, unsigned x, unsigned& nloc, unsigned& nx) {
    const unsigned G = gridDim.x * gridDim.y * gridDim.z;
    unsigned sum, cnt, mine, sp = 0u;
    for (;;) {
        sum = 0u; cnt = 0u; mine = 0u;
#pragma unroll
        for (unsigned j = 0; j < 16; ++j) { const unsigned c = xb_ld(&bar[XB_XCNT(j)]); sum += c; cnt += (c > 0u) ? 1u : 0u; mine = (j == x) ? c : mine; }
        if (sum == G) break;
        __builtin_amdgcn_s_sleep(1);
        if ((++sp & 255u) == 0u) { if (xb_ld(&bar[XB_TMO])) break; if (sp > XB_SPIN_CAP) { atomicAdd(&bar[XB_TMO], 1u); break; } }
    }
    nloc = mine > 0u ? mine : 1u; nx = cnt > 0u ? cnt : 1u;
}

__device__ __forceinline__ void xcd_barrier(const XcdBarrier& b) {
    asm volatile("s_waitcnt vmcnt(0)" ::: "memory");
    __syncthreads();
    if (threadIdx.x == 0) {
        unsigned* bar = b.bar;
        __builtin_amdgcn_s_waitcnt(0);
        unsigned nloc = b.st[0], nx = b.st[1];
        if (nloc == 0u) { xcd_barrier_complete(bar, b.x, nloc, nx); b.st[0] = nloc; b.st[1] = nx; }
        const unsigned old = xb_add(&bar[XB_XSUB(b.x)], 1u);
        const unsigned gen = old / nloc;
        if (old + 1u == (gen + 1u) * nloc) {
            __builtin_amdgcn_fence(__ATOMIC_RELEASE, "agent");
            asm volatile("s_waitcnt vmcnt(0)" ::: "memory");
            const unsigned og = xb_add(&bar[XB_TOP], 1u);
            const unsigned tg = og / nx;
            if (og + 1u == (tg + 1u) * nx) xb_add(&bar[XB_TOPGEN], 1u);
            else XB_SPIN(xb_ld(&bar[XB_TOPGEN]) == tg, bar);
            __builtin_amdgcn_fence(__ATOMIC_ACQUIRE, "agent");
            xb_add(&bar[XB_XGEN(b.x)], 1u);
            asm volatile("s_waitcnt vmcnt(0)" ::: "memory");
        } else {
            XB_SPIN(xb_ld(&bar[XB_XGEN(b.x)]) == gen, bar);
            __builtin_amdgcn_fence(__ATOMIC_ACQUIRE, "agent");
            asm volatile("s_waitcnt vmcnt(0)" ::: "memory");
        }
    }
    __syncthreads();
}

__device__ __forceinline__ void rms_row_to_bf16(const float* xrow, bf16_t* orow, const float* gain, int lane) {
    const f32x4* xr = (const f32x4*)xrow + lane;
    f32x4 v[4]; float s = 0.f;
#pragma unroll
    for (int j = 0; j < 4; ++j) { v[j] = xr[64 * j]; s += (v[j].x * v[j].x + v[j].y * v[j].y) + (v[j].z * v[j].z + v[j].w * v[j].w); }
    const float rstd = 1.0f / sqrtf(wave_sum(s) * (1.0f / DM) + NORM_EPS);
    unsigned long long* o8 = (unsigned long long*)orow + lane;
#pragma unroll
    for (int j = 0; j < 4; ++j) {
        f32x4 g = gain ? ((const f32x4*)gain)[lane + 64 * j] : (f32x4){1.f, 1.f, 1.f, 1.f};
        o8[64 * j] = (unsigned long long)pk2(v[j].x * rstd * g.x, v[j].y * rstd * g.y) | ((unsigned long long)pk2(v[j].z * rstd * g.z, v[j].w * rstd * g.w) << 32);
    }
}
__device__ __forceinline__ void transpose_item(const float* W, int K, int N, bf16_t* WT, const float* ks, LAS float* scr, int item, int lane) {
    const int nblk = N / 32, kb = item / nblk, nb = item % nblk, k0 = 64 * kb, n0 = 32 * nb;
#pragma unroll 8
    for (int i = 0; i < 32; ++i) { const int kk = 2 * i + (lane >> 5); float w = W[(size_t)(k0 + kk) * N + n0 + (lane & 31)]; if (ks) w *= ks[k0 + kk]; scr[kk * 33 + (lane & 31)] = w; }
    LDS_WAIT();
    const int c = lane & 7;
#pragma unroll
    for (int j = 0; j < 4; ++j) { const int n = (lane >> 3) + 8 * j; const LAS float* s = scr + (8 * c) * 33 + n;
        v4u o; o.x = pk2(s[0 * 33], s[1 * 33]); o.y = pk2(s[2 * 33], s[3 * 33]); o.z = pk2(s[4 * 33], s[5 * 33]); o.w = pk2(s[6 * 33], s[7 * 33]);
        *(v4u*)(WT + (size_t)(n0 + n) * K + k0 + 8 * c) = o; }
    LDS_WAIT();
}


__device__ __forceinline__ void s5_tables(const Args& a, LAS unsigned char* lds, int tid) {
    const int bid = blockIdx.x; if (bid >= 192) return;
    const int g = bid % NG, q = bid / NG;
    const float* lam_re = a.in[4]; const float* lam_im = a.in[5]; const float* b_re = a.in[6]; const float* b_im = a.in[7]; const float* c_re = a.in[8]; const float* c_im = a.in[9]; const float* log_dt = a.in[11];
    LAS float* LPr = (LAS float*)(lds + 69632); LAS float* LPi = LPr + 17 * 64; LAS float* BBr = LPi + 17 * 64; LAS float* BBi = BBr + 1024;
    LAS float* Cr = BBi + 1024; LAS float* Ci = Cr + 1024; LAS float* KT = Ci + 1024;
    if (tid < 64) {
        const int p = tid, i = g * NP + p;
        const double dt = exp((double)log_dt[g]);
        const double lr = lam_re[i], li = lam_im[i];
        const double er = exp(lr * dt), ang = li * dt;
        const double lbr = er * cos(ang), lbi = er * sin(ang);
        const double nr = lbr - 1.0, ni = lbi, den = lr * lr + li * li;
        const double qr = (nr * lr + ni * li) / den, qi = (ni * lr - nr * li) / den;
        for (int h = 0; h < GH; ++h) { const double br = b_re[i * GH + h], bi = b_im[i * GH + h];
            BBr[p * 16 + h] = (float)(qr * br - qi * bi); BBi[p * 16 + h] = (float)(qr * bi + qi * br); }
        double pr = 1.0, pi = 0.0;
        for (int t = 0; t < 16; ++t) { LPr[t * 64 + p] = (float)pr; LPi[t * 64 + p] = (float)pi; const double nr2 = pr * lbr - pi * lbi, ni2 = pr * lbi + pi * lbr; pr = nr2; pi = ni2; }
        LPr[16 * 64 + p] = (float)pr; LPi[16 * 64 + p] = (float)pi;
        double tr = pr, ti = pi;
        if (q == 0) { float* LAMT = (float*)(a.ws + WS_LAMT); LAMT[2 * i] = (float)tr; LAMT[2 * i + 1] = (float)ti; }
        for (int k = 0; k < 5; ++k) { const double nr2 = tr * tr - ti * ti, ni2 = 2.0 * tr * ti; tr = nr2; ti = ni2; }
        if (q == 0) { float* L512 = (float*)(a.ws + WS_LAM512); L512[2 * i] = (float)tr; L512[2 * i + 1] = (float)ti; }
    }
    for (int i = tid; i < 1024; i += 512) { Cr[i] = c_re[g * 1024 + i]; Ci[i] = c_im[g * 1024 + i]; }
    __syncthreads();
    { const int tau = tid >> 5, hol = (tid >> 4) & 1, hi = tid & 15, ho = 2 * q + hol; float sacc = 0.f;
#pragma unroll 4
      for (int p = 0; p < 64; ++p) { const float lpr = LPr[tau * 64 + p], lpi = LPi[tau * 64 + p], br = BBr[p * 16 + hi], bi = BBi[p * 16 + hi];
          const float wr_ = lpr * br - lpi * bi, wi_ = lpr * bi + lpi * br; sacc += Cr[ho * 64 + p] * wr_ - Ci[ho * 64 + p] * wi_; }
      KT[tid] = sacc; }
    __syncthreads();
    bf16_t* WSb = (bf16_t*)(a.ws + WS_WS); bf16_t* WYb = (bf16_t*)(a.ws + WS_WY);
#pragma unroll
    for (int kk = 0; kk < 2; ++kk) { const int ch = tid + 512 * kk, n = 32 * q + (ch >> 5), k0 = (ch & 31) * 8, p = n & 63, isim = (n >> 6) & 1;
        float v[8];
#pragma unroll
        for (int j = 0; j < 8; ++j) { const int k = k0 + j, t = k >> 4, h = k & 15, tau = 15 - t; const float lpr = LPr[tau * 64 + p], lpi = LPi[tau * 64 + p], br = BBr[p * 16 + h], bi = BBi[p * 16 + h];
            const float val = isim ? (lpr * bi + lpi * br) : (lpr * br - lpi * bi); v[j] = n < 128 ? val : 0.f; }
        v4u o; o.x = pk2(v[0], v[1]); o.y = pk2(v[2], v[3]); o.z = pk2(v[4], v[5]); o.w = pk2(v[6], v[7]);
        *(v4u*)(WSb + ((size_t)(g * 256 + n)) * 256 + k0) = o; }
#pragma unroll
    for (int kk = 0; kk < 4; ++kk) { const int ch = tid + 512 * kk, rr = ch >> 6, to = rr >> 1, hol = rr & 1, ho = 2 * q + hol, n = to * 16 + ho, k0 = (ch & 63) * 8;
        float v[8];
#pragma unroll
        for (int j = 0; j < 8; ++j) { const int k = k0 + j; float val;
            if (k < 256) { const int ti = k >> 4, hi = k & 15; val = ti <= to ? KT[((to - ti) * 2 + hol) * 16 + hi] : 0.f; }
            else { const int jj = (k - 256) & 127, p = jj & 63, isim = jj >> 6; const float lpr = LPr[(to + 1) * 64 + p], lpi = LPi[(to + 1) * 64 + p], cr = Cr[ho * 64 + p], ci = Ci[ho * 64 + p];
                val = isim ? -(cr * lpi + ci * lpr) : (cr * lpr - ci * lpi); }
            v[j] = val; }
        v4u o; o.x = pk2(v[0], v[1]); o.y = pk2(v[2], v[3]); o.z = pk2(v[4], v[5]); o.w = pk2(v[6], v[7]);
        *(v4u*)(WYb + ((size_t)(g * 256 + n)) * 512 + k0) = o; }
}

__device__ __forceinline__ void rms_rows2_to_bf16(const float* x0, const float* x1, bf16_t* o0, bf16_t* o1, const float* gain, int lane) {
    const f32x4* xr0 = (const f32x4*)x0 + lane; const f32x4* xr1 = (const f32x4*)x1 + lane;
    f32x4 v[4], w[4]; float s0 = 0.f, s1 = 0.f;
#pragma unroll
    for (int j = 0; j < 4; ++j) { v[j] = __builtin_nontemporal_load(xr0 + 64 * j); w[j] = __builtin_nontemporal_load(xr1 + 64 * j); }
#pragma unroll
    for (int j = 0; j < 4; ++j) { s0 += (v[j].x * v[j].x + v[j].y * v[j].y) + (v[j].z * v[j].z + v[j].w * v[j].w); s1 += (w[j].x * w[j].x + w[j].y * w[j].y) + (w[j].z * w[j].z + w[j].w * w[j].w); }
#pragma unroll
    for (int o = 1; o < 64; o <<= 1) { s0 += __shfl_xor(s0, o); s1 += __shfl_xor(s1, o); }
    const float r0 = 1.0f / sqrtf(s0 * (1.0f / DM) + NORM_EPS), r1 = 1.0f / sqrtf(s1 * (1.0f / DM) + NORM_EPS);
    unsigned long long* p0 = (unsigned long long*)o0 + lane; unsigned long long* p1 = (unsigned long long*)o1 + lane;
#pragma unroll
    for (int j = 0; j < 4; ++j) {
        const f32x4 g = gain ? ((const f32x4*)gain)[lane + 64 * j] : (f32x4){1.f, 1.f, 1.f, 1.f};
        p0[64 * j] = (unsigned long long)pk2(v[j].x * r0 * g.x, v[j].y * r0 * g.y) | ((unsigned long long)pk2(v[j].z * r0 * g.z, v[j].w * r0 * g.w) << 32);
        p1[64 * j] = (unsigned long long)pk2(w[j].x * r1 * g.x, w[j].y * r1 * g.y) | ((unsigned long long)pk2(w[j].z * r1 * g.z, w[j].w * r1 * g.w) << 32);
    }
}
__device__ __forceinline__ void transpose_item4(const float* W, int K, int N, bf16_t* WT, const float* ks, LAS float* scr, int item, int lane) {
    const int nblk = N / 32, kb = item / nblk, nb = item % nblk, k0 = 64 * kb, n0 = 32 * nb;
    f32x4 w[8];
#pragma unroll
    for (int i = 0; i < 8; ++i) { const int kk = 8 * i + (lane >> 3); w[i] = __builtin_nontemporal_load((const f32x4*)(W + (size_t)(k0 + kk) * N + n0 + 4 * (lane & 7))); }
#pragma unroll
    for (int i = 0; i < 8; ++i) { const int kk = 8 * i + (lane >> 3); const float sc = ks ? ks[k0 + kk] : 1.0f; LAS float* d = scr + kk * 33 + 4 * (lane & 7);
        d[0] = w[i].x * sc; d[1] = w[i].y * sc; d[2] = w[i].z * sc; d[3] = w[i].w * sc; }
    LDS_WAIT();
    const int c = lane & 7;
#pragma unroll
    for (int j = 0; j < 4; ++j) { const int n = (lane >> 3) + 8 * j; const LAS float* sp = scr + (8 * c) * 33 + n;
        v4u o; o.x = pk2(sp[0 * 33], sp[1 * 33]); o.y = pk2(sp[2 * 33], sp[3 * 33]); o.z = pk2(sp[4 * 33], sp[5 * 33]); o.w = pk2(sp[6 * 33], sp[7 * 33]);
        *(v4u*)(WT + (size_t)(n0 + n) * K + k0 + 8 * c) = o; }
    LDS_WAIT();
}

__device__ __forceinline__ void phase0(const Args& a, LAS unsigned char* lds) {
    const int tid = otid(), lane = tid & 63, wave = tid >> 6;
    const int gw = blockIdx.x * 8 + wave, NGW = gridDim.x * 8;
    s5_tables(a, lds, tid);
    const float* x = a.in[0]; const float* mem = a.in[1]; const float* norm_g = a.in[2]; const float* w_in = a.in[3];
    const float* w_glu = a.in[12]; const float* mem_norm_g = a.in[16]; const float* w_mem_kv = a.in[17]; const float* w_out = a.in[18];
    bf16_t* XB = (bf16_t*)(a.ws + WS_XB); bf16_t* MEMN = (bf16_t*)(a.ws + WS_MEMN);
    bf16_t* WINT = (bf16_t*)(a.ws + WS_WINT); bf16_t* WKVT = (bf16_t*)(a.ws + WS_WKVT); bf16_t* WOUTT = (bf16_t*)(a.ws + WS_WOUTT); bf16_t* WGLUT = (bf16_t*)(a.ws + WS_WGLUT);
    for (int rnd = 0; rnd < 5; ++rnd) { const int r2 = rnd < 4 ? rnd * NGW + gw : 4 * NGW + (gw - 1536); if (rnd == 4 && (gw < 1536 || r2 >= (NTOK + NB * NMEM) / 2)) break; const int r = 2 * r2;
        if (r < NTOK) rms_rows2_to_bf16(x + (size_t)r * DM, x + (size_t)(r + 1) * DM, XB + (size_t)r * DM, XB + (size_t)(r + 1) * DM, nullptr, lane);
        else { const int m = r - NTOK; rms_rows2_to_bf16(mem + (size_t)m * DM, mem + (size_t)(m + 1) * DM, MEMN + (size_t)m * DM, MEMN + (size_t)(m + 1) * DM, mem_norm_g, lane); }
    }
    LAS float* scr = (LAS float*)(lds + wave * 8448);
    constexpr int I_IN = (DM / 64) * (DIN / 32), I_KV = (DM / 64) * (512 / 32), I_OUT = (DM / 64) * (DM / 32), I_GLU = (WSSM / 64) * (WSSM / 32);
    for (int rnd = 0; rnd < 2; ++rnd) { const int it = rnd == 0 ? gw : NGW + (gw - 1536); if (rnd == 1 && (gw < 1536 || it >= I_IN + I_KV + I_OUT + I_GLU)) break;
        int r = it;
        if (r < I_IN) { transpose_item4(w_in, DM, DIN, WINT, norm_g, scr, r, lane); continue; } r -= I_IN;
        if (r < I_KV) { transpose_item4(w_mem_kv, DM, 512, WKVT, nullptr, scr, r, lane); continue; } r -= I_KV;
        if (r < I_OUT) { transpose_item4(w_out, DM, DM, WOUTT, nullptr, scr, r, lane); continue; } r -= I_OUT;
        transpose_item4(w_glu, WSSM, WSSM, WGLUT, nullptr, scr, r, lane);
    }
    const int gt = blockIdx.x * 512 + tid, NT = gridDim.x * 512;
    for (int i = gt; i < 128 * 384 / 2; i += NT) ((unsigned*)(WGLUT + 384 * 384))[i] = 0u;
}

template <class Epi>
__device__ __forceinline__ void gemm_naive(const bf16_t* A, int lda, const bf16_t* Bt, int ldb, int M, int N, int K, LAS unsigned char* lds, int tile0, int ntile_total, const Epi& epi) {
    LAS float* As = (LAS float*)lds;
    LAS float* Bs = As + 32 * 132;
    const int tid = threadIdx.x, ty = tid >> 4, tx = tid & 15;
    const int ntn = N / 64, nt = (M / 128) * ntn;
    (void)ntile_total;
    for (int tile = blockIdx.x - tile0; tile < nt; tile += gridDim.x) {
        if (tile < 0) continue;
        const int tm = tile / ntn, tn = tile % ntn;
        float acc[4][4];
#pragma unroll
        for (int i = 0; i < 4; ++i)
#pragma unroll
            for (int j = 0; j < 4; ++j) acc[i][j] = 0.f;
        for (int k0 = 0; k0 < K; k0 += 32) {
            __syncthreads();
            { const int r = tid >> 2, kc = (tid & 3) * 8; const v4u v = *(const v4u*)(A + (size_t)(tm * 128 + r) * lda + k0 + kc);
              As[(kc + 0) * 132 + r] = bflo(v.x); As[(kc + 1) * 132 + r] = bfhi(v.x); As[(kc + 2) * 132 + r] = bflo(v.y); As[(kc + 3) * 132 + r] = bfhi(v.y);
              As[(kc + 4) * 132 + r] = bflo(v.z); As[(kc + 5) * 132 + r] = bfhi(v.z); As[(kc + 6) * 132 + r] = bflo(v.w); As[(kc + 7) * 132 + r] = bfhi(v.w); }
            if (tid < 256) { const int r = tid >> 2, kc = (tid & 3) * 8; const v4u v = *(const v4u*)(Bt + (size_t)(tn * 64 + r) * ldb + k0 + kc);
              Bs[(kc + 0) * 68 + r] = bflo(v.x); Bs[(kc + 1) * 68 + r] = bfhi(v.x); Bs[(kc + 2) * 68 + r] = bflo(v.y); Bs[(kc + 3) * 68 + r] = bfhi(v.y);
              Bs[(kc + 4) * 68 + r] = bflo(v.z); Bs[(kc + 5) * 68 + r] = bfhi(v.z); Bs[(kc + 6) * 68 + r] = bflo(v.w); Bs[(kc + 7) * 68 + r] = bfhi(v.w); }
            __syncthreads();
#pragma unroll 8
            for (int k = 0; k < 32; ++k) {
                const f32x4 av = *(const LAS f32x4*)(As + k * 132 + ty * 4), bv = *(const LAS f32x4*)(Bs + k * 68 + tx * 4);
#pragma unroll
                for (int i = 0; i < 4; ++i)
#pragma unroll
                    for (int j = 0; j < 4; ++j) acc[i][j] += av[i] * bv[j];
            }
        }
#pragma unroll
        for (int i = 0; i < 4; ++i)
#pragma unroll
            for (int j = 0; j < 4; ++j) epi(tm * 128 + ty * 4 + i, tn * 64 + tx * 4 + j, acc[i][j]);
    }
}

struct EpiStoreBf16 { bf16_t* O; int ldo; __device__ __forceinline__ void operator()(int r, int c, float v) const { O[(size_t)r * ldo + c] = (bf16_t)f2bf(v); } };
struct EpiGlu { const bf16_t* GB; const bf16_t* PROJ; const float* b_glu; bf16_t* YCAT;
    __device__ __forceinline__ void operator()(int r, int c, float v) const {
        const float g = bf2f(GB[(size_t)r * WSSM + c]); const float gate = bf2f(PROJ[(size_t)r * DIN + C_AGATE + c]);
        YCAT[(size_t)r * DM + c] = (bf16_t)f2bf(g * sigmoid_f(v + b_glu[c]) * silu_f(gate)); } };
struct EpiOut { const float* x; float* out; __device__ __forceinline__ void operator()(int r, int c, float v) const { out[(size_t)r * DM + c] = x[(size_t)r * DM + c] + v; } };


namespace pg8 {
typedef short bf16x8 __attribute__((ext_vector_type(8)));
typedef unsigned u32x4 __attribute__((ext_vector_type(4)));
constexpr int BM = 256, BK = 64, HALF = 128, HTB = HALF * BK * 2, STAGE_BYTES = 8 * HTB, NXCD = 8, WGM = 8;
__host__ __device__ __forceinline__ int lds_byte(int r, int c) { const int st = (r >> 4) * 2 + (c >> 5), rr = r & 15, cc = c & 31, ob = rr * 64 + cc * 2; return st * 1024 + (ob ^ (((ob >> 9) & 1) << 5)); }
__host__ __device__ __forceinline__ void stage_rc(int b, int& R, int& C) { const int st = b / 1024, sb = b % 1024, swz = sb ^ (((sb >> 9) & 1) << 5); R = (st >> 1) * 16 + swz / 64; C = (st & 1) * 32 + (swz % 64) / 2; }
__host__ __device__ __forceinline__ int perm32(int rho) { const int n = rho >> 4, i = rho & 15; return 8 * (i >> 2) + 4 * n + (i & 3); }
struct Unit { int pm, pn, z; };
struct Gemm { const bf16_t* A; const bf16_t* Bt; int lda, ldb, K; size_t sAz, sBz; };
struct Order {
    int nM, nN, per, total, G, c;
    __device__ void init(int nM_, int nN_, int nZ_, int G_, int c_) { nM = nM_; nN = nN_; per = nM_ * nN_; total = per * nZ_; G = G_; c = c_; }
    __device__ bool next(int i, Unit& u) const {
        const long L = (long)i * G + c; if (L >= total) return false;
        u.z = (int)(L / per); int wgid = (int)(L % per); const int nwg = per;
        { const int q = nwg / NXCD, r = nwg % NXCD, xcd = wgid % NXCD, off = wgid / NXCD; wgid = (xcd < r ? xcd * (q + 1) : r * (q + 1) + (xcd - r) * q) + off; }
        const int nig = WGM * nN, gid = wgid / nig, fm = gid * WGM, gsz = (nM - fm) < WGM ? (nM - fm) : WGM;
        u.pm = fm + ((wgid % nig) % gsz); u.pn = (wgid % nig) / gsz; return true;
    }
};
typedef __bf16 bf2v_t __attribute__((ext_vector_type(2))); typedef float f2v_t __attribute__((ext_vector_type(2)));
__device__ __forceinline__ unsigned cvt_pk_bf16(float lo, float hi) { const f2v_t v = {lo, hi}; return __builtin_bit_cast(unsigned, __builtin_convertvector(v, bf2v_t)); }

template <class Epi>
__device__ __forceinline__ void gemm_phase(LAS unsigned char* lds, const Gemm g, const Order& S, const Epi& E) {
    int tid = threadIdx.x; asm volatile("" : "+v"(tid));
    const int wid = __builtin_amdgcn_readfirstlane(tid >> 6), lane = tid & 63, wr = wid >> 2, wc = wid & 3, fr = lane & 15, fq = lane >> 4;
    int K = g.K; asm volatile("" : "+s"(K));
    const int nt = K / BK;
    unsigned voffA[2], voffB[2];
#pragma unroll
    for (int i = 0; i < 2; ++i) { int R, C; stage_rc(tid * 16 + i * 8192, R, C); const int Rb = Epi::PERM ? ((R & ~31) + perm32(R & 31)) : R;
        voffA[i] = (unsigned)(R * g.lda + C) * 2u; voffB[i] = (unsigned)(Rb * g.ldb + C) * 2u; }
    const size_t kstep = (size_t)(BK * 2);
    const size_t hstepA = (size_t)HALF * g.lda * 2, hstepB = (size_t)HALF * g.ldb * 2;
    const size_t tstepA = 2 * hstepA, tstepB = 2 * hstepB;
    const unsigned ldsw = (unsigned)wid * 1024u;
    const int aoff = lds_byte(wr * 64 + fr, fq * 8), boff = lds_byte(wc * 32 + fr, fq * 8);
#define PG8_SA(b, h) (((b) * 2 + (h)) * HTB)
#define PG8_SB(b, h) ((4 + (b) * 2 + (h)) * HTB)
#define PG8_STAGE(bufoff, gbase, voff) do { _Pragma("unroll") for (int _i = 0; _i < 2; ++_i) \
        __builtin_amdgcn_global_load_lds((const unsigned*)((const char*)(gbase) + (voff)[_i]), (LAS unsigned*)(lds + (bufoff) + ldsw + _i * 8192), 16, 0, 0); } while (0)
#define PG8_LDA(dst, b, h) do { _Pragma("unroll") for (int m = 0; m < 4; ++m) _Pragma("unroll") for (int k = 0; k < 2; ++k) dst[m][k] = *(const LAS bf16x8*)(lds + PG8_SA(b, h) + aoff + m * 2048 + k * 1024); } while (0)
#define PG8_LDB(dst, b, h) do { _Pragma("unroll") for (int n = 0; n < 2; ++n) _Pragma("unroll") for (int k = 0; k < 2; ++k) dst[n][k] = *(const LAS bf16x8*)(lds + PG8_SB(b, h) + boff + n * 2048 + k * 1024); } while (0)
#define PG8_MMA(ai, bj, At, Bt) do { __builtin_amdgcn_s_setprio(1); _Pragma("unroll") for (int m = 0; m < 4; ++m) _Pragma("unroll") for (int n = 0; n < 2; ++n) _Pragma("unroll") for (int k = 0; k < 2; ++k) \
        acc[ai][bj][m][n] = __builtin_amdgcn_mfma_f32_16x16x32_bf16(Bt[n][k], At[m][k], acc[ai][bj][m][n], 0, 0, 0); __builtin_amdgcn_s_setprio(0); } while (0)
#define PG8_WAIT_V(n) asm volatile("s_waitcnt vmcnt(" #n ")" ::: "memory")
#define PG8_WAIT_L(n) asm volatile("s_waitcnt lgkmcnt(" #n ")" ::: "memory")
#define PG8_BAR __builtin_amdgcn_s_barrier()
#define PG8_SCHED __builtin_amdgcn_sched_barrier(0)
    Unit cur, nxt; int ui = 0;
    if (!S.next(0, cur)) return;
    f32x4 acc[2][2][4][2];
#pragma unroll
    for (int a = 0; a < 2; ++a)
#pragma unroll
        for (int b = 0; b < 2; ++b)
#pragma unroll
            for (int m = 0; m < 4; ++m)
#pragma unroll
                for (int n = 0; n < 2; ++n) acc[a][b][m][n] = (f32x4){0.f, 0.f, 0.f, 0.f};
    bf16x8 At[4][2], B0[2][2], B1[2][2];
    const char* cA = (const char*)(g.A + (size_t)cur.z * g.sAz) + (size_t)cur.pm * tstepA; const char* cB = (const char*)(g.Bt + (size_t)cur.z * g.sBz) + (size_t)cur.pn * tstepB;
    PG8_STAGE(PG8_SB(0, 0), cB, voffB); PG8_STAGE(PG8_SA(0, 0), cA, voffA); PG8_STAGE(PG8_SB(0, 1), cB + hstepB, voffB); PG8_STAGE(PG8_SA(0, 1), cA + hstepA, voffA);
    if (wr == 1) PG8_BAR;
    PG8_WAIT_V(4); PG8_BAR;
    PG8_STAGE(PG8_SB(1, 0), cB + kstep, voffB); PG8_STAGE(PG8_SA(1, 0), cA + kstep, voffA); PG8_STAGE(PG8_SB(1, 1), cB + hstepB + kstep, voffB);
    PG8_WAIT_V(6); PG8_BAR;
    for (;;) {
        const bool has_next = S.next(ui + 1, nxt);
        const char* nA = has_next ? (const char*)(g.A + (size_t)nxt.z * g.sAz) + (size_t)nxt.pm * tstepA : cA; const char* nB = has_next ? (const char*)(g.Bt + (size_t)nxt.z * g.sBz) + (size_t)nxt.pn * tstepB : cB;
        for (int t = 0; t < nt; t += 2) {
            const bool last = (t == nt - 2);
            const char* a1 = cA + (size_t)(t + 1) * kstep;
            const char* a2 = last ? nA : cA + (size_t)(t + 2) * kstep; const char* b2 = last ? nB : cB + (size_t)(t + 2) * kstep;
            const char* a3 = a2 + kstep; const char* b3 = b2 + kstep;
            PG8_LDB(B0, 0, 0); PG8_SCHED; PG8_LDA(At, 0, 0); PG8_STAGE(PG8_SA(1, 1), a1 + hstepA, voffA);
            PG8_WAIT_L(8); PG8_BAR; PG8_WAIT_L(0); PG8_MMA(0, 0, At, B0); PG8_BAR; PG8_SCHED;
            PG8_LDB(B1, 0, 1); PG8_STAGE(PG8_SB(0, 0), b2, voffB);
            PG8_BAR; PG8_WAIT_L(0); PG8_MMA(0, 1, At, B1); PG8_BAR;
            PG8_LDA(At, 0, 1); PG8_STAGE(PG8_SA(0, 0), a2, voffA);
            PG8_BAR; PG8_WAIT_L(0); PG8_MMA(1, 0, At, B0); PG8_BAR; PG8_SCHED;
            PG8_STAGE(PG8_SB(0, 1), b2 + hstepB, voffB);
            PG8_WAIT_V(6); PG8_BAR; PG8_MMA(1, 1, At, B1); PG8_BAR;
            PG8_LDB(B0, 1, 0); PG8_SCHED; PG8_LDA(At, 1, 0); PG8_STAGE(PG8_SA(0, 1), a2 + hstepA, voffA);
            PG8_WAIT_L(8); PG8_BAR; PG8_WAIT_L(0); PG8_MMA(0, 0, At, B0); PG8_BAR; PG8_SCHED;
            PG8_LDB(B1, 1, 1); PG8_STAGE(PG8_SB(1, 0), b3, voffB);
            PG8_BAR; PG8_WAIT_L(0); PG8_MMA(0, 1, At, B1); PG8_BAR;
            PG8_LDA(At, 1, 1); PG8_STAGE(PG8_SA(1, 0), a3, voffA);
            PG8_BAR; PG8_WAIT_L(0); PG8_MMA(1, 0, At, B0); PG8_BAR; PG8_SCHED;
            PG8_STAGE(PG8_SB(1, 1), b3 + hstepB, voffB);
            PG8_WAIT_V(6); PG8_BAR; PG8_MMA(1, 1, At, B1); PG8_BAR;
        }
        if constexpr (!Epi::AFTER_DRAIN) { E(acc, cur, wr, wc, fr, fq); }
        if (!has_next) break;
#pragma unroll
        for (int a = 0; a < 2; ++a)
#pragma unroll
            for (int b = 0; b < 2; ++b)
#pragma unroll
                for (int m = 0; m < 4; ++m)
#pragma unroll
                    for (int n = 0; n < 2; ++n) acc[a][b][m][n] = (f32x4){0.f, 0.f, 0.f, 0.f};
        cur = nxt; cA = nA; cB = nB; ++ui;
    }
    PG8_WAIT_V(0);
    if (wr == 0) PG8_BAR;
    PG8_BAR;
    if constexpr (Epi::AFTER_DRAIN) { E.fused(acc, cur, wr, wc, fr, fq, lds, wid, lane); }
#undef PG8_SA
#undef PG8_SB
#undef PG8_STAGE
#undef PG8_LDA
#undef PG8_LDB
#undef PG8_MMA
#undef PG8_WAIT_V
#undef PG8_WAIT_L
#undef PG8_BAR
#undef PG8_SCHED
}

struct EpiBf16Store {
    static constexpr bool PERM = true, AFTER_DRAIN = false;
    bf16_t* O; int ldc;
    __device__ __forceinline__ void operator()(const f32x4 (&acc)[2][2][4][2], const Unit& u, int wr, int wc, int fr, int fq) const {
        const int row0 = u.pm * BM + wr * 64 + fr, col0 = u.pn * BM + wc * 32 + 8 * fq;
#pragma unroll
        for (int ai = 0; ai < 2; ++ai)
#pragma unroll
            for (int m = 0; m < 4; ++m) { bf16_t* rowp = O + (size_t)(row0 + ai * HALF + m * 16) * ldc + col0;
#pragma unroll
                for (int bj = 0; bj < 2; ++bj) { const f32x4 v0 = acc[ai][bj][m][0], v1 = acc[ai][bj][m][1];
                    u32x4 w; w.x = cvt_pk_bf16(v0[0], v0[1]); w.y = cvt_pk_bf16(v0[2], v0[3]); w.z = cvt_pk_bf16(v1[0], v1[1]); w.w = cvt_pk_bf16(v1[2], v1[3]);
                    *(u32x4*)(rowp + bj * HALF) = w; } }
    }
};

struct EpiProjAY {
    static constexpr bool PERM = true, AFTER_DRAIN = false;
    bf16_t* PROJ; bf16_t* AY;
    __device__ __forceinline__ void operator()(const f32x4 (&acc)[2][2][4][2], const Unit& u, int wr, int wc, int fr, int fq) const {
        const int rowb = u.pm * BM + wr * 64, col0 = u.pn * BM + wc * 32 + 8 * fq;
#pragma unroll
        for (int bj = 0; bj < 2; ++bj) { const int col = col0 + bj * HALF; const bool ay = col < WSSM;
#pragma unroll
            for (int ai = 0; ai < 2; ++ai)
#pragma unroll
                for (int m = 0; m < 4; ++m) { const int rb = rowb + ai * HALF + m * 16;
                    bf16_t* dst = ay ? AY + ((size_t)((col >> 4) * 1024 + (rb >> 4)) * 512 + fr * 16 + (col & 15)) : PROJ + (size_t)(rb + fr) * DIN + col;
                    const f32x4 v0 = acc[ai][bj][m][0], v1 = acc[ai][bj][m][1];
                    u32x4 w; w.x = cvt_pk_bf16(v0[0], v0[1]); w.y = cvt_pk_bf16(v0[2], v0[3]); w.z = cvt_pk_bf16(v1[0], v1[1]); w.w = cvt_pk_bf16(v1[2], v1[3]);
                    *(u32x4*)dst = w; } }
    }
};
struct EpiSend {
    static constexpr bool PERM = false, AFTER_DRAIN = true;
    bf16_t* AY; const float* LAMT; const float* LAM512;
    __device__ __forceinline__ void fused(const f32x4 (&acc)[2][2][4][2], const Unit& u, int wr, int wc, int fr, int fq, LAS unsigned char* lds, int wid, int lane) const {
        LAS float* S = (LAS float*)lds;
        LAS float* E = (LAS float*)(lds + 131072);
#pragma unroll
        for (int ai = 0; ai < 2; ++ai)
#pragma unroll
            for (int m = 0; m < 4; ++m)
#pragma unroll
                for (int n = 0; n < 2; ++n) { const int r = ai * HALF + wr * 64 + m * 16 + fr, c = wc * 32 + n * 16 + 4 * fq; *(LAS f32x4*)(S + r * 128 + c) = acc[ai][0][m][n]; }
        __syncthreads();
        const int g = u.z, b = u.pm, p = lane, seg = wid;
        const float tr = LAMT[(g * NP + p) * 2], ti = LAMT[(g * NP + p) * 2 + 1], hr = LAM512[(g * NP + p) * 2], hi = LAM512[(g * NP + p) * 2 + 1];
        float sr = 0.f, si = 0.f;
        for (int i = 0; i < 32; ++i) { const int row = seg * 32 + i; const float xr = S[row * 128 + p], xi = S[row * 128 + 64 + p];
            const float nr = tr * sr - ti * si + xr, ni = tr * si + ti * sr + xi; sr = nr; si = ni; }
        E[seg * 128 + p] = sr; E[seg * 128 + 64 + p] = si;
        __syncthreads();
        sr = 0.f; si = 0.f;
        for (int s2 = 0; s2 < seg; ++s2) { const float xr = E[s2 * 128 + p], xi = E[s2 * 128 + 64 + p]; const float nr = hr * sr - hi * si + xr, ni = hr * si + hi * sr + xi; sr = nr; si = ni; }
        bf16_t* base = AY + ((size_t)(g * 1024 + b * 256 + seg * 32)) * 512 + 256 + p;
        for (int i = 0; i < 32; ++i) { const int row = seg * 32 + i;
            bf16_t* o = base + (size_t)i * 512;
            o[0] = (bf16_t)f2bf(sr); o[64] = (bf16_t)f2bf(si);
            const float xr = S[row * 128 + p], xi = S[row * 128 + 64 + p];
            const float nr = tr * sr - ti * si + xr, ni = tr * si + ti * sr + xi; sr = nr; si = ni; }
    }
};
struct EpiY {
    static constexpr bool PERM = true, AFTER_DRAIN = false;
    const bf16_t* AY; const float* ssm_d; bf16_t* GB;
    __device__ __forceinline__ void operator()(const f32x4 (&acc)[2][2][4][2], const Unit& u, int wr, int wc, int fr, int fq) const {
        const int g = u.z, b = u.pm;
#pragma unroll
        for (int bj = 0; bj < 2; ++bj) { const int col = bj * HALF + wc * 32 + 8 * fq, t = col >> 4, h0 = col & 15;
            const f32x4 d0 = *(const f32x4*)(ssm_d + g * GH + h0), d1 = *(const f32x4*)(ssm_d + g * GH + h0 + 4);
            u32x4 u8[2][4];
#pragma unroll
            for (int ai = 0; ai < 2; ++ai)
#pragma unroll
                for (int m = 0; m < 4; ++m) { const int crow = ai * HALF + wr * 64 + m * 16 + fr; u8[ai][m] = *(const u32x4*)(AY + ((size_t)(g * 1024 + b * 256 + crow)) * 512 + col); }
#pragma unroll
            for (int ai = 0; ai < 2; ++ai)
#pragma unroll
                for (int m = 0; m < 4; ++m) { const int crow = ai * HALF + wr * 64 + m * 16 + fr;
                    const u32x4 uu = u8[ai][m]; const f32x4 v0 = acc[ai][bj][m][0], v1 = acc[ai][bj][m][1];
                    u32x4 w;
                    w.x = cvt_pk_bf16(gelu_tanh(v0[0] + d0[0] * bflo(uu.x)), gelu_tanh(v0[1] + d0[1] * bfhi(uu.x)));
                    w.y = cvt_pk_bf16(gelu_tanh(v0[2] + d0[2] * bflo(uu.y)), gelu_tanh(v0[3] + d0[3] * bfhi(uu.y)));
                    w.z = cvt_pk_bf16(gelu_tanh(v1[0] + d1[0] * bflo(uu.z)), gelu_tanh(v1[1] + d1[1] * bfhi(uu.z)));
                    w.w = cvt_pk_bf16(gelu_tanh(v1[2] + d1[2] * bflo(uu.w)), gelu_tanh(v1[3] + d1[3] * bfhi(uu.w)));
                    *(u32x4*)(GB + ((size_t)(b * SEQ + crow * 16 + t)) * WSSM + g * GH + h0) = w; }
            asm volatile("" ::: "memory"); }
    }
};
struct EpiGluP {
    static constexpr bool PERM = true, AFTER_DRAIN = false;
    const bf16_t* GB; const bf16_t* PROJ; const float* b_glu; bf16_t* YCAT;
    __device__ __forceinline__ void operator()(const f32x4 (&acc)[2][2][4][2], const Unit& u, int wr, int wc, int fr, int fq) const {
        const int row0 = u.pm * BM + wr * 64 + fr, col0 = u.pn * BM + wc * 32 + 8 * fq;
#pragma unroll
        for (int bj = 0; bj < 2; ++bj) { const int col = col0 + bj * HALF; if (col >= WSSM) continue;
            const f32x4 b0 = *(const f32x4*)(b_glu + col), b1 = *(const f32x4*)(b_glu + col + 4);
#pragma unroll
            for (int ai = 0; ai < 2; ++ai) { if (ai != u.z) continue;
                u32x4 g8[4], a8[4];
#pragma unroll
                for (int m = 0; m < 4; ++m) { const size_t row = (size_t)(row0 + ai * HALF + m * 16); g8[m] = *(const u32x4*)(GB + row * WSSM + col); a8[m] = *(const u32x4*)(PROJ + row * DIN + C_AGATE + col); }
#pragma unroll
                for (int m = 0; m < 4; ++m) { const size_t row = (size_t)(row0 + ai * HALF + m * 16);
                    const f32x4 v0 = acc[ai][bj][m][0] + b0, v1 = acc[ai][bj][m][1] + b1;
                    u32x4 w;
                    w.x = cvt_pk_bf16(bflo(g8[m].x) * sigmoid_f(v0[0]) * silu_f(bflo(a8[m].x)), bfhi(g8[m].x) * sigmoid_f(v0[1]) * silu_f(bfhi(a8[m].x)));
                    w.y = cvt_pk_bf16(bflo(g8[m].y) * sigmoid_f(v0[2]) * silu_f(bflo(a8[m].y)), bfhi(g8[m].y) * sigmoid_f(v0[3]) * silu_f(bfhi(a8[m].y)));
                    w.z = cvt_pk_bf16(bflo(g8[m].z) * sigmoid_f(v1[0]) * silu_f(bflo(a8[m].z)), bfhi(g8[m].z) * sigmoid_f(v1[1]) * silu_f(bfhi(a8[m].z)));
                    w.w = cvt_pk_bf16(bflo(g8[m].w) * sigmoid_f(v1[2]) * silu_f(bflo(a8[m].w)), bfhi(g8[m].w) * sigmoid_f(v1[3]) * silu_f(bfhi(a8[m].w)));
                    *(u32x4*)(YCAT + row * DM + col) = w; }
                asm volatile("" ::: "memory"); } }
    }
};
struct EpiResF32 {
    static constexpr bool PERM = false, AFTER_DRAIN = false;
    const float* x; float* out;
    __device__ __forceinline__ void operator()(const f32x4 (&acc)[2][2][4][2], const Unit& u, int wr, int wc, int fr, int fq) const {
        const int row0 = u.pm * BM + wr * 64 + fr, col0 = u.pn * BM + wc * 32 + 4 * fq;
#pragma unroll
        for (int ai = 0; ai < 2; ++ai)
#pragma unroll
            for (int m = 0; m < 4; ++m) { const size_t off = (size_t)(row0 + ai * HALF + m * 16) * DM + col0;
#pragma unroll
                for (int bj = 0; bj < 2; ++bj)
#pragma unroll
                    for (int n = 0; n < 2; ++n) { const f32x4 xv = *(const f32x4*)(x + off + bj * HALF + n * 16); *(f32x4*)(out + off + bj * HALF + n * 16) = xv + acc[ai][bj][m][n]; }
                asm volatile("" ::: "memory"); }
    }
};

struct EpiOutNorm {
    static constexpr bool PERM = false, AFTER_DRAIN = true;
    const float* x; const float* fg; float* out; float* xch; unsigned* cnt;
    __device__ __forceinline__ void fused(f32x4 (&acc)[2][2][4][2], const Unit& u, int wr, int wc, int fr, int fq, LAS unsigned char* lds, int wid, int lane) const {
        LAS float* P = (LAS float*)lds;
        LAS float* S = (LAS float*)(lds + 8192);
        const int row0 = u.pm * BM + wr * 64 + fr, col0 = u.pn * BM + wc * 32 + 4 * fq;
#pragma unroll
        for (int ai = 0; ai < 2; ++ai) {
            f32x4 xv[4][2][2];
#pragma unroll
            for (int m = 0; m < 4; ++m) { const size_t off = (size_t)(row0 + ai * HALF + m * 16) * DM + col0;
#pragma unroll
                for (int bj = 0; bj < 2; ++bj)
#pragma unroll
                    for (int n = 0; n < 2; ++n) xv[m][bj][n] = __builtin_nontemporal_load((const f32x4*)(x + off + bj * HALF + n * 16)); }
#pragma unroll
            for (int m = 0; m < 4; ++m) { float sq = 0.f;
#pragma unroll
                for (int bj = 0; bj < 2; ++bj)
#pragma unroll
                    for (int n = 0; n < 2; ++n) { const f32x4 hv = acc[ai][bj][m][n] + xv[m][bj][n]; acc[ai][bj][m][n] = hv; sq += (hv[0] * hv[0] + hv[1] * hv[1]) + (hv[2] * hv[2] + hv[3] * hv[3]); }
                sq += __shfl_xor(sq, 16); sq += __shfl_xor(sq, 32);
                if (fq == 0) P[(ai * HALF + wr * 64 + m * 16 + fr) * 4 + wc] = sq; }
            asm volatile("" ::: "memory"); }
        asm volatile("s_waitcnt lgkmcnt(0)" ::: "memory"); __builtin_amdgcn_s_barrier(); asm volatile("" ::: "memory");
        const int row = wid * 32 + (lane & 31);
        if (lane < 32) { const f32x4 pv = *(const LAS f32x4*)(P + row * 4); const float t = (pv[0] + pv[1]) + (pv[2] + pv[3]);
            __hip_atomic_store(xch + ((size_t)(u.pm * BM + row) * 4 + u.pn), t, __ATOMIC_RELAXED, __HIP_MEMORY_SCOPE_AGENT); }
        asm volatile("s_waitcnt vmcnt(0)" ::: "memory");
        if (lane == 0) __hip_atomic_fetch_add(cnt + 64 * u.pm, 1u, __ATOMIC_RELAXED, __HIP_MEMORY_SCOPE_AGENT);
        if (wid == 0) { unsigned sp = 0;
            while ((unsigned)__builtin_amdgcn_readfirstlane(__hip_atomic_load(cnt + 64 * u.pm, __ATOMIC_RELAXED, __HIP_MEMORY_SCOPE_AGENT)) < 32u) { __builtin_amdgcn_s_sleep(2); if (++sp > (1u << 22)) break; }
            __builtin_amdgcn_fence(__ATOMIC_ACQUIRE, "agent"); }
        asm volatile("s_waitcnt vmcnt(0) lgkmcnt(0)" ::: "memory"); __builtin_amdgcn_s_barrier(); asm volatile("" ::: "memory");
        if (lane < 32) { const float* slot = xch + (size_t)(u.pm * BM + row) * 4; float t = 0.f;
#pragma unroll
            for (int q = 0; q < 4; ++q) t += __hip_atomic_load(slot + q, __ATOMIC_RELAXED, __HIP_MEMORY_SCOPE_AGENT);
            S[row] = 1.0f / sqrtf(t * (1.0f / DM) + NORM_EPS); }
        asm volatile("s_waitcnt lgkmcnt(0)" ::: "memory"); __builtin_amdgcn_s_barrier(); asm volatile("" ::: "memory");
        f32x4 gv[2][2];
#pragma unroll
        for (int bj = 0; bj < 2; ++bj)
#pragma unroll
            for (int n = 0; n < 2; ++n) gv[bj][n] = *(const f32x4*)(fg + col0 + bj * HALF + n * 16);
#pragma unroll
        for (int ai = 0; ai < 2; ++ai)
#pragma unroll
            for (int m = 0; m < 4; ++m) { const int r = ai * HALF + wr * 64 + m * 16 + fr; const float rs = S[r]; const size_t off = (size_t)(u.pm * BM + r) * DM + col0;
#pragma unroll
                for (int bj = 0; bj < 2; ++bj)
#pragma unroll
                    for (int n = 0; n < 2; ++n) *(f32x4*)(out + off + bj * HALF + n * 16) = acc[ai][bj][m][n] * rs * gv[bj][n]; }
    }
};
}

__device__ __forceinline__ void s5_naive(const Args& a, int b, int g, int lane) {
    const bf16_t* PROJ = (const bf16_t*)(a.ws + WS_PROJ); bf16_t* GB = (bf16_t*)(a.ws + WS_GB);
    const float* LAMB = (const float*)(a.ws + WS_LAMB); const float* BBAR = (const float*)(a.ws + WS_BBAR);
    const float* c_re = a.in[8]; const float* c_im = a.in[9]; const float* ssm_d = a.in[10];
    const int p = lane, h = lane & 15, pg = lane >> 4;
    const float lr = LAMB[(g * NP + p) * 2], li = LAMB[(g * NP + p) * 2 + 1];
    float bre[16], bim[16], cre[16], cim[16];
#pragma unroll
    for (int j = 0; j < 16; ++j) { bre[j] = BBAR[((g * NP + p) * GH + j) * 2]; bim[j] = BBAR[((g * NP + p) * GH + j) * 2 + 1];
        cre[j] = c_re[(g * GH + h) * NP + pg * 16 + j]; cim[j] = c_im[(g * GH + h) * NP + pg * 16 + j]; }
    const float dd = ssm_d[g * GH + h];
    float sr = 0.f, si = 0.f;
    for (int t = 0; t < SEQ; ++t) {
        const bf16_t* up = PROJ + (size_t)(b * SEQ + t) * DIN + C_AIN + g * GH;
        const v4u u0 = *(const v4u*)up, u1 = *(const v4u*)(up + 8);
        float u[16];
        u[0] = bflo(u0.x); u[1] = bfhi(u0.x); u[2] = bflo(u0.y); u[3] = bfhi(u0.y); u[4] = bflo(u0.z); u[5] = bfhi(u0.z); u[6] = bflo(u0.w); u[7] = bfhi(u0.w);
        u[8] = bflo(u1.x); u[9] = bfhi(u1.x); u[10] = bflo(u1.y); u[11] = bfhi(u1.y); u[12] = bflo(u1.z); u[13] = bfhi(u1.z); u[14] = bflo(u1.w); u[15] = bfhi(u1.w);
        const float uh = bf2f(up[h]);
        float bur = 0.f, bui = 0.f;
#pragma unroll
        for (int j = 0; j < 16; ++j) { bur += bre[j] * u[j]; bui += bim[j] * u[j]; }
        const float nsr = lr * sr - li * si + bur, nsi = lr * si + li * sr + bui;
        sr = nsr; si = nsi;
        float part = 0.f;
#pragma unroll
        for (int j = 0; j < 16; ++j) { const float xr = __shfl(sr, pg * 16 + j), xi = __shfl(si, pg * 16 + j); part += cre[j] * xr - cim[j] * xi; }
        part += __shfl_xor(part, 16); part += __shfl_xor(part, 32);
        const float y = part + dd * uh;
        if (lane < 16) GB[(size_t)(b * SEQ + t) * WSSM + g * GH + h] = (bf16_t)f2bf(gelu_tanh(y));
    }
}

__device__ __forceinline__ void conv_naive(const Args& a, int vb, int nvb) {
    const bf16_t* PROJ = (const bf16_t*)(a.ws + WS_PROJ); bf16_t* YCAT = (bf16_t*)(a.ws + WS_YCAT);
    const float* conv_w = a.in[14]; const float* conv_b = a.in[15];
    const int gt = vb * 512 + otid(), NT = nvb * 512;
    for (int idx = gt; idx < NTOK * WSSM; idx += NT) {
        const int tok = idx / WSSM, c = idx % WSSM, t = tok % SEQ;
        const bf16_t* row = PROJ + (size_t)tok * DIN;
        float acc = conv_b[c];
#pragma unroll
        for (int k = 0; k < 3; ++k) { const int tt = t - 2 + k; if (tt >= 0) { const bf16_t* r2 = PROJ + (size_t)(tok - 2 + k) * DIN; acc += conv_w[k * WSSM + c] * (bf2f(r2[C_CC + c]) * bf2f(r2[C_CIN + c])); } }
        const float y = bf2f(row[C_CB + c]) * acc * silu_f(bf2f(row[C_CGATE + c]));
        YCAT[(size_t)tok * DM + WSSM + c] = (bf16_t)f2bf(y);
    }
}
__device__ __forceinline__ void attn_naive(const Args& a, int vb, int nvb) {
    const bf16_t* PROJ = (const bf16_t*)(a.ws + WS_PROJ); bf16_t* YCAT = (bf16_t*)(a.ws + WS_YCAT); const bf16_t* KV = (const bf16_t*)(a.ws + WS_KV);
    const int gt = vb * 512 + otid(), NT = nvb * 512;
    for (int item = gt; item < NB * 4 * SEQ; item += NT) {
        const int t = item % SEQ, hh = (item / SEQ) % 4, b = item / (4 * SEQ), tok = b * SEQ + t;
        const v4u* qp = (const v4u*)(PROJ + (size_t)tok * DIN + C_Q + hh * 64);
        float q[64], o[64];
#pragma unroll
        for (int i = 0; i < 8; ++i) { const v4u v = qp[i]; q[8 * i] = bflo(v.x); q[8 * i + 1] = bfhi(v.x); q[8 * i + 2] = bflo(v.y); q[8 * i + 3] = bfhi(v.y); q[8 * i + 4] = bflo(v.z); q[8 * i + 5] = bfhi(v.z); q[8 * i + 6] = bflo(v.w); q[8 * i + 7] = bfhi(v.w); }
#pragma unroll
        for (int d = 0; d < 64; ++d) o[d] = 0.f;
        float m = -1e30f, l = 0.f;
        for (int mm = 0; mm < NMEM; ++mm) {
            const v4u* kp = (const v4u*)(KV + (size_t)(b * NMEM + mm) * 512 + hh * 64);
            const v4u* vp = (const v4u*)(KV + (size_t)(b * NMEM + mm) * 512 + 256 + hh * 64);
            float s = 0.f;
#pragma unroll
            for (int i = 0; i < 8; ++i) { const v4u v = kp[i];
                s += q[8 * i] * bflo(v.x) + q[8 * i + 1] * bfhi(v.x) + q[8 * i + 2] * bflo(v.y) + q[8 * i + 3] * bfhi(v.y) + q[8 * i + 4] * bflo(v.z) + q[8 * i + 5] * bfhi(v.z) + q[8 * i + 6] * bflo(v.w) + q[8 * i + 7] * bfhi(v.w); }
            s *= 0.125f;
            const float mn = fmaxf(m, s), sc = __expf(m - mn), pp = __expf(s - mn);
            l = l * sc + pp; m = mn;
#pragma unroll
            for (int i = 0; i < 8; ++i) { const v4u v = vp[i];
                o[8 * i] = o[8 * i] * sc + pp * bflo(v.x); o[8 * i + 1] = o[8 * i + 1] * sc + pp * bfhi(v.x); o[8 * i + 2] = o[8 * i + 2] * sc + pp * bflo(v.y); o[8 * i + 3] = o[8 * i + 3] * sc + pp * bfhi(v.y);
                o[8 * i + 4] = o[8 * i + 4] * sc + pp * bflo(v.z); o[8 * i + 5] = o[8 * i + 5] * sc + pp * bfhi(v.z); o[8 * i + 6] = o[8 * i + 6] * sc + pp * bflo(v.w); o[8 * i + 7] = o[8 * i + 7] * sc + pp * bfhi(v.w); }
        }
        const float inv = 1.0f / l;
        const v4u* gp = (const v4u*)(PROJ + (size_t)tok * DIN + C_QGATE + hh * 64);
        v4u* op = (v4u*)(YCAT + (size_t)tok * DM + 768 + hh * 64);
#pragma unroll
        for (int i = 0; i < 8; ++i) { const v4u gv = gp[i]; v4u w;
            w.x = pk2(o[8 * i] * inv * silu_f(bflo(gv.x)), o[8 * i + 1] * inv * silu_f(bfhi(gv.x)));
            w.y = pk2(o[8 * i + 2] * inv * silu_f(bflo(gv.y)), o[8 * i + 3] * inv * silu_f(bfhi(gv.y)));
            w.z = pk2(o[8 * i + 4] * inv * silu_f(bflo(gv.z)), o[8 * i + 5] * inv * silu_f(bfhi(gv.z)));
            w.w = pk2(o[8 * i + 6] * inv * silu_f(bflo(gv.w)), o[8 * i + 7] * inv * silu_f(bfhi(gv.w)));
            op[i] = w; }
    }
}

typedef short bf16x8_t __attribute__((ext_vector_type(8)));
typedef short s16x4_t __attribute__((ext_vector_type(4)));
typedef float f32x16 __attribute__((ext_vector_type(16)));
typedef __bf16 bf2_t __attribute__((ext_vector_type(2)));
typedef float f2_t __attribute__((ext_vector_type(2)));
typedef unsigned u32x2_t __attribute__((ext_vector_type(2)));
__device__ __forceinline__ unsigned cvt2(float lo, float hi) { const f2_t v = {lo, hi}; return __builtin_bit_cast(unsigned, __builtin_convertvector(v, bf2_t)); }
__device__ __forceinline__ void attn_mfma(const Args& a, LAS unsigned char* lds, int vb, int nvb) {
    const int nj = nvb / 16; if (nj < 1 || vb >= nj * 16) return;
    const int tid = otid(), lane = tid & 63, wave = tid >> 6, r = lane & 31, h = lane >> 5;
    const int bh = vb % 16, j = vb / 16, b = bh >> 2, head = bh & 3;
    const bf16_t* PROJ = (const bf16_t*)(a.ws + WS_PROJ); bf16_t* YCAT = (bf16_t*)(a.ws + WS_YCAT); const bf16_t* KV = (const bf16_t*)(a.ws + WS_KV);
    LAS unsigned char* Kl = lds;
    LAS unsigned char* Vl = lds + 36864;
    for (int c = tid; c < 2048; c += 512) { const int key = c >> 3, dch = c & 7;
        const bf16_t* src = KV + (size_t)(b * NMEM + key) * 512 + head * 64 + dch * 8;
        const v4u kv = *(const v4u*)src, vv = *(const v4u*)(src + 256);
        *(LAS v4u*)(Kl + key * 144 + dch * 16) = kv;
        LAS bf16_t* vd = (LAS bf16_t*)(Vl + (dch * 8) * 520 + key * 2);
        vd[0 * 260] = (bf16_t)(vv.x & 0xffff); vd[1 * 260] = (bf16_t)(vv.x >> 16); vd[2 * 260] = (bf16_t)(vv.y & 0xffff); vd[3 * 260] = (bf16_t)(vv.y >> 16);
        vd[4 * 260] = (bf16_t)(vv.z & 0xffff); vd[5 * 260] = (bf16_t)(vv.z >> 16); vd[6 * 260] = (bf16_t)(vv.w & 0xffff); vd[7 * 260] = (bf16_t)(vv.w >> 16); }
    __syncthreads();
    for (int tile = j * 8 + wave; tile < SEQ / 32; tile += nj * 8) {
        const size_t tok = (size_t)b * SEQ + tile * 32 + r;
        bf16x8_t qf[4];
#pragma unroll
        for (int s4 = 0; s4 < 4; ++s4) qf[s4] = *(const bf16x8_t*)(PROJ + tok * DIN + C_Q + head * 64 + 16 * s4 + 8 * h);
        const float sc = 0.125f * 1.4426950408889634f;
        float mx = -3.0e38f, l = 0.f;
        f32x16 o0, o1;
#pragma unroll
        for (int i = 0; i < 16; ++i) { o0[i] = 0.f; o1[i] = 0.f; }
#pragma unroll 2
        for (int kt = 0; kt < 8; ++kt) {
            f32x16 st;
#pragma unroll
            for (int i = 0; i < 16; ++i) st[i] = 0.f;
#pragma unroll
            for (int s4 = 0; s4 < 4; ++s4) { const bf16x8_t kf = *(const LAS bf16x8_t*)(Kl + (kt * 32 + r) * 144 + (16 * s4 + 8 * h) * 2);
                st = __builtin_amdgcn_mfma_f32_32x32x16_bf16(kf, qf[s4], st, 0, 0, 0); }
            float tm = st[0];
#pragma unroll
            for (int i = 1; i < 16; ++i) tm = fmaxf(tm, st[i]);
            tm = fmaxf(tm, __shfl_xor(tm, 32));
            const float mn = fmaxf(mx, tm), alpha = __builtin_amdgcn_exp2f((mx - mn) * sc), mb = mn * sc;
            mx = mn; l *= alpha;
#pragma unroll
            for (int i = 0; i < 16; ++i) { o0[i] *= alpha; o1[i] *= alpha; }
#pragma unroll
            for (int i = 0; i < 16; ++i) { const float p = __builtin_amdgcn_exp2f(st[i] * sc - mb); st[i] = p; l += p; }
#pragma unroll
            for (int s2 = 0; s2 < 2; ++s2) {
                v4u pw; pw.x = cvt2(st[8 * s2 + 0], st[8 * s2 + 1]); pw.y = cvt2(st[8 * s2 + 2], st[8 * s2 + 3]);
                pw.z = cvt2(st[8 * s2 + 4], st[8 * s2 + 5]); pw.w = cvt2(st[8 * s2 + 6], st[8 * s2 + 7]);
                const bf16x8_t pf = __builtin_bit_cast(bf16x8_t, pw);
                const int koff = (kt * 32 + 16 * s2 + 4 * h) * 2;
                { const s16x4_t lo = *(const LAS s16x4_t*)(Vl + r * 520 + koff), hi = *(const LAS s16x4_t*)(Vl + r * 520 + koff + 16);
                  const bf16x8_t vf = __builtin_shufflevector(lo, hi, 0, 1, 2, 3, 4, 5, 6, 7); o0 = __builtin_amdgcn_mfma_f32_32x32x16_bf16(vf, pf, o0, 0, 0, 0); }
                { const s16x4_t lo = *(const LAS s16x4_t*)(Vl + (32 + r) * 520 + koff), hi = *(const LAS s16x4_t*)(Vl + (32 + r) * 520 + koff + 16);
                  const bf16x8_t vf = __builtin_shufflevector(lo, hi, 0, 1, 2, 3, 4, 5, 6, 7); o1 = __builtin_amdgcn_mfma_f32_32x32x16_bf16(vf, pf, o1, 0, 0, 0); }
            }
        }
        l += __shfl_xor(l, 32);
        const float inv = 1.0f / l;
        const bf16_t* gp = PROJ + tok * DIN + C_QGATE + head * 64; bf16_t* op = YCAT + tok * DM + 768 + head * 64;
#pragma unroll
        for (int q4 = 0; q4 < 4; ++q4) {
            { const int d = 8 * q4 + 4 * h; const u32x2_t gv = *(const u32x2_t*)(gp + d); u32x2_t w;
              w.x = cvt2(o0[4 * q4 + 0] * inv * silu_f(bflo(gv.x)), o0[4 * q4 + 1] * inv * silu_f(bfhi(gv.x))); w.y = cvt2(o0[4 * q4 + 2] * inv * silu_f(bflo(gv.y)), o0[4 * q4 + 3] * inv * silu_f(bfhi(gv.y)));
              *(u32x2_t*)(op + d) = w; }
            { const int d = 32 + 8 * q4 + 4 * h; const u32x2_t gv = *(const u32x2_t*)(gp + d); u32x2_t w;
              w.x = cvt2(o1[4 * q4 + 0] * inv * silu_f(bflo(gv.x)), o1[4 * q4 + 1] * inv * silu_f(bfhi(gv.x))); w.y = cvt2(o1[4 * q4 + 2] * inv * silu_f(bflo(gv.y)), o1[4 * q4 + 3] * inv * silu_f(bfhi(gv.y)));
              *(u32x2_t*)(op + d) = w; }
        }
    }
}
__device__ __forceinline__ void conv_vec(const Args& a, int vb, int nvb) {
    const bf16_t* PROJ = (const bf16_t*)(a.ws + WS_PROJ); bf16_t* YCAT = (bf16_t*)(a.ws + WS_YCAT);
    const float* conv_w = a.in[14]; const float* conv_b = a.in[15];
    const int gt = vb * 512 + otid(), NT = nvb * 512;
    for (int it = gt; it < (NTOK / 4) * 48; it += NT) {
        const int tg = it / 48, c0 = (it % 48) * 8, tok0 = tg * 4, t0 = tok0 % SEQ;
        const bf16_t* row0 = PROJ + (size_t)tok0 * DIN;
        v4u cc[6], ci[6], cb[4], cg[4];
#pragma unroll
        for (int r = 0; r < 6; ++r) { const bool ok = (t0 + r - 2) >= 0; const bf16_t* rp = row0 + (ptrdiff_t)(r - 2) * DIN;
            cc[r] = ok ? *(const v4u*)(rp + C_CC + c0) : (v4u){0u, 0u, 0u, 0u}; ci[r] = ok ? *(const v4u*)(rp + C_CIN + c0) : (v4u){0u, 0u, 0u, 0u}; }
#pragma unroll
        for (int j = 0; j < 4; ++j) { cb[j] = *(const v4u*)(row0 + (size_t)j * DIN + C_CB + c0); cg[j] = *(const v4u*)(row0 + (size_t)j * DIN + C_CGATE + c0); }
        float w[3][8], bb[8];
#pragma unroll
        for (int k = 0; k < 3; ++k) { const f32x4 w0 = *(const f32x4*)(conv_w + k * WSSM + c0), w1 = *(const f32x4*)(conv_w + k * WSSM + c0 + 4);
            w[k][0] = w0.x; w[k][1] = w0.y; w[k][2] = w0.z; w[k][3] = w0.w; w[k][4] = w1.x; w[k][5] = w1.y; w[k][6] = w1.z; w[k][7] = w1.w; }
        { const f32x4 b0 = *(const f32x4*)(conv_b + c0), b1 = *(const f32x4*)(conv_b + c0 + 4); bb[0] = b0.x; bb[1] = b0.y; bb[2] = b0.z; bb[3] = b0.w; bb[4] = b1.x; bb[5] = b1.y; bb[6] = b1.z; bb[7] = b1.w; }
        float u[6][8];
#pragma unroll
        for (int r = 0; r < 6; ++r) { u[r][0] = bflo(cc[r].x) * bflo(ci[r].x); u[r][1] = bfhi(cc[r].x) * bfhi(ci[r].x); u[r][2] = bflo(cc[r].y) * bflo(ci[r].y); u[r][3] = bfhi(cc[r].y) * bfhi(ci[r].y);
            u[r][4] = bflo(cc[r].z) * bflo(ci[r].z); u[r][5] = bfhi(cc[r].z) * bfhi(ci[r].z); u[r][6] = bflo(cc[r].w) * bflo(ci[r].w); u[r][7] = bfhi(cc[r].w) * bfhi(ci[r].w); }
#pragma unroll
        for (int j = 0; j < 4; ++j) { float y[8];
#pragma unroll
            for (int e = 0; e < 8; ++e) y[e] = bb[e] + w[0][e] * u[j][e] + w[1][e] * u[j + 1][e] + w[2][e] * u[j + 2][e];
            v4u o;
            o.x = cvt2(bflo(cb[j].x) * y[0] * silu_f(bflo(cg[j].x)), bfhi(cb[j].x) * y[1] * silu_f(bfhi(cg[j].x)));
            o.y = cvt2(bflo(cb[j].y) * y[2] * silu_f(bflo(cg[j].y)), bfhi(cb[j].y) * y[3] * silu_f(bfhi(cg[j].y)));
            o.z = cvt2(bflo(cb[j].z) * y[4] * silu_f(bflo(cg[j].z)), bfhi(cb[j].z) * y[5] * silu_f(bfhi(cg[j].z)));
            o.w = cvt2(bflo(cb[j].w) * y[6] * silu_f(bflo(cg[j].w)), bfhi(cb[j].w) * y[7] * silu_f(bfhi(cg[j].w)));
            *(v4u*)(YCAT + (size_t)(tok0 + j) * DM + WSSM + c0) = o; }
    }
}
__device__ __forceinline__ void final_norm(const Args& a) {
    const int tid = otid(), lane = tid & 63, gw = blockIdx.x * 8 + (tid >> 6), NGW = gridDim.x * 8;
    const float* fg = a.in[19];
    for (int r = gw; r < NTOK; r += NGW) {
        f32x4* xr = (f32x4*)(a.out + (size_t)r * DM) + lane;
        f32x4 v[4]; float s = 0.f;
#pragma unroll
        for (int j = 0; j < 4; ++j) { v[j] = xr[64 * j]; s += (v[j].x * v[j].x + v[j].y * v[j].y) + (v[j].z * v[j].z + v[j].w * v[j].w); }
        const float rstd = 1.0f / sqrtf(wave_sum(s) * (1.0f / DM) + NORM_EPS);
#pragma unroll
        for (int j = 0; j < 4; ++j) { const f32x4 g = ((const f32x4*)fg)[lane + 64 * j]; xr[64 * j] = v[j] * rstd * g; }
    }
}

__global__ void __launch_bounds__(512, 2) mega(Args a) {
    extern __shared__ __attribute__((aligned(16))) unsigned char smem_raw[];
    LAS unsigned char* lds = (LAS unsigned char*)smem_raw;
    cg::grid_group grid = cg::this_grid();
    volatile LAS unsigned* xst = (volatile LAS unsigned*)(lds + 139264);
    if (threadIdx.x == 0) { xst[0] = 0u; xst[1] = 0u; }
    { unsigned* ctl = (unsigned*)(a.ws + WS_CTL); unsigned* flag = ctl + CTL_FLAG_WORD;
      if (blockIdx.x == 0) { for (int i = threadIdx.x; i < 8192; i += 512) __hip_atomic_store(ctl + i, 0u, __ATOMIC_RELAXED, __HIP_MEMORY_SCOPE_AGENT);
          asm volatile("s_waitcnt vmcnt(0)" ::: "memory"); __syncthreads();
          if (threadIdx.x == 0) { __builtin_amdgcn_fence(__ATOMIC_RELEASE, "agent"); __hip_atomic_store(flag, CTL_TOKEN, __ATOMIC_RELAXED, __HIP_MEMORY_SCOPE_AGENT); } }
      if (threadIdx.x == 0) { unsigned sp = 0; while (__hip_atomic_load(flag, __ATOMIC_RELAXED, __HIP_MEMORY_SCOPE_AGENT) != CTL_TOKEN) { __builtin_amdgcn_s_sleep(1); if (++sp > (1u << 22)) break; }
          __builtin_amdgcn_fence(__ATOMIC_ACQUIRE, "agent"); } }
    __syncthreads();
    const XcdBarrier xbar = xcd_barrier_post((unsigned*)(a.ws + WS_CTL), xst);
    const int bid = blockIdx.x, G = gridDim.x;
    bf16_t* XB = (bf16_t*)(a.ws + WS_XB); bf16_t* MEMN = (bf16_t*)(a.ws + WS_MEMN);
    bf16_t* WINT = (bf16_t*)(a.ws + WS_WINT); bf16_t* WKVT = (bf16_t*)(a.ws + WS_WKVT); bf16_t* WOUTT = (bf16_t*)(a.ws + WS_WOUTT); bf16_t* WGLUT = (bf16_t*)(a.ws + WS_WGLUT);
    bf16_t* PROJ = (bf16_t*)(a.ws + WS_PROJ); bf16_t* KV = (bf16_t*)(a.ws + WS_KV); bf16_t* GB = (bf16_t*)(a.ws + WS_GB); bf16_t* YCAT = (bf16_t*)(a.ws + WS_YCAT);
    bf16_t* AY = (bf16_t*)(a.ws + WS_AY); bf16_t* WSb = (bf16_t*)(a.ws + WS_WS); bf16_t* WYb = (bf16_t*)(a.ws + WS_WY);

#ifndef PROBE_DUP
#define PROBE_DUP -1
#endif
#define REPS(k) for (int rep_ = 0; rep_ < ((PROBE_DUP == (k)) ? 2 : 1); ++rep_)
#ifndef PROBE_SUB
#define PROBE_SUB -1
#endif
    if (a.out == nullptr) grid.sync();
    REPS(0) { phase0(a, lds);
    xcd_barrier(xbar); }
    REPS(1) {
    { pg8::Order S; S.init(NTOK / 256, DIN / 256, 1, G, bid);
      pg8::gemm_phase(lds, pg8::Gemm{XB, WINT, DM, DM, DM, 0, 0}, S, pg8::EpiProjAY{PROJ, AY}); }
    { pg8::Order S; S.init(NB * NMEM / 256, 512 / 256, 1, G, (bid + G - ((NTOK / 256) * (DIN / 256)) % G) % G);
      pg8::gemm_phase(lds, pg8::Gemm{MEMN, WKVT, DM, DM, DM, 0, 0}, S, pg8::EpiBf16Store{KV, 512}); }
    xcd_barrier(xbar); }
    REPS(2) {
    if (bid < NB * NG) { pg8::Order S; S.init(NB, 1, NG, G, bid);
      pg8::gemm_phase(lds, pg8::Gemm{AY, WSb, 512, 256, 256, (size_t)1024 * 512, (size_t)256 * 256}, S, pg8::EpiSend{AY, (const float*)(a.ws + WS_LAMT), (const float*)(a.ws + WS_LAM512)});
      asm volatile("s_waitcnt vmcnt(0)" ::: "memory"); __syncthreads();
      pg8::gemm_phase(lds, pg8::Gemm{AY, WYb, 512, 512, 384, (size_t)1024 * 512, (size_t)256 * 512}, S, pg8::EpiY{AY, a.in[10], GB}); }
    else { attn_mfma(a, lds, bid - NB * NG, G - NB * NG); conv_vec(a, bid - NB * NG, G - NB * NG); }
    xcd_barrier(xbar); }
    REPS(4) {
    { pg8::Order S; S.init(NTOK / 256, 2, 2, G, bid);
      pg8::gemm_phase(lds, pg8::Gemm{GB, WGLUT, WSSM, WSSM, WSSM, 0, 0}, S, pg8::EpiGluP{GB, PROJ, a.in[13], YCAT}); }
    xcd_barrier(xbar); }
    REPS(5) {
    { pg8::Order S; S.init(NTOK / 256, DM / 256, 1, G, bid);
      pg8::gemm_phase(lds, pg8::Gemm{YCAT, WOUTT, DM, DM, DM, 0, 0}, S, pg8::EpiOutNorm{a.in[0], a.in[19], a.out, (float*)(a.ws + WS_XCH), (unsigned*)(a.ws + WS_CTL + CTL_PANEL)}); }
    }
    __syncthreads();
    if (threadIdx.x == 0) { unsigned* ctl = (unsigned*)(a.ws + WS_CTL);
        const unsigned old_ = __hip_atomic_fetch_add(ctl + CTL_EXIT_WORD, 1u, __ATOMIC_RELAXED, __HIP_MEMORY_SCOPE_AGENT);
        if (old_ == (unsigned)G - 1u) __hip_atomic_store(ctl + CTL_FLAG_WORD, CTL_RESET, __ATOMIC_RELAXED, __HIP_MEMORY_SCOPE_AGENT); }
}

extern "C" void kernel_launch(void* const* d_in, const int* in_sizes, int n_in, void* d_out, int out_size, void* d_ws, size_t ws_size, hipStream_t stream) {
    static int grid = 0;
    if (grid == 0) {
        if (n_in != 20 || out_size != NTOK * DM || ws_size < WS_END) { fprintf(stderr, "kernel_launch: unexpected shapes n_in %d out %d ws %zu\n", n_in, out_size, ws_size); grid = -1; return; }
        int dev = 0, cus = 0, per_cu = 0;
        hipGetDevice(&dev);
        hipDeviceGetAttribute(&cus, hipDeviceAttributeMultiprocessorCount, dev);
        if (hipFuncSetAttribute((const void*)mega, hipFuncAttributeMaxDynamicSharedMemorySize, LDS_BYTES) != hipSuccess) { fprintf(stderr, "kernel_launch: hipFuncSetAttribute failed\n"); grid = -1; return; }
        if (hipOccupancyMaxActiveBlocksPerMultiprocessor(&per_cu, (const void*)mega, 512, LDS_BYTES) != hipSuccess || per_cu < 1) { fprintf(stderr, "kernel_launch: occupancy query says %d\n", per_cu); per_cu = 1; }
        (void)hipGetLastError();
        grid = cus;
        if (grid != 256) { fprintf(stderr, "kernel_launch: built for 256 CUs (one workgroup each), device has %d\n", grid); grid = -1; return; }
        if (grid < NB * NG) { fprintf(stderr, "kernel_launch: grid %d too small\n", grid); grid = -1; return; }
    }
    if (grid < 0) return;
    Args a{};
    for (int i = 0; i < 20; ++i) a.in[i] = (const float*)d_in[i];
    a.out = (float*)d_out; a.ws = (unsigned char*)d_ws;
    void* args[] = {&a};
    hipError_t e = hipLaunchCooperativeKernel((const void*)mega, dim3(grid), dim3(512), args, LDS_BYTES, stream);
    if (e != hipSuccess) fprintf(stderr, "cooperative launch failed: %s (grid %d)\n", hipGetErrorString(e), grid);
}
```

```cpp
#include <hip/hip_runtime.h>
#include <hip/hip_cooperative_groups.h>
#include <cstdio>
#include <cstdint>
namespace cg = cooperative_groups;

#define LAS __attribute__((address_space(3)))
typedef unsigned short bf16_t;
typedef unsigned v4u __attribute__((ext_vector_type(4)));
typedef float f32x4 __attribute__((ext_vector_type(4)));

constexpr int NB = 4, SEQ = 4096, DM = 1024, NTOK = NB * SEQ, DIN = 2816, WSSM = 384, NG = 24, GH = 16, NP = 64, NMEM = 256;
constexpr int C_AIN = 0, C_AGATE = 384, C_CIN = 768, C_CB = 1152, C_CC = 1536, C_CGATE = 1920, C_Q = 2304, C_QGATE = 2560;
constexpr float NORM_EPS = 1e-6f;

constexpr size_t MiB = 1u << 20;
constexpr size_t WS_CTL = 0;
constexpr size_t WS_XB = 1 * MiB;
constexpr size_t WS_WINT = 33 * MiB;
constexpr size_t WS_WKVT = 39 * MiB;
constexpr size_t WS_WOUTT = 40 * MiB;
constexpr size_t WS_WGLUT = 42 * MiB;
constexpr size_t WS_MEMN = 43 * MiB;
constexpr size_t WS_KV = 45 * MiB;
constexpr size_t WS_LAMB = 46 * MiB;
constexpr size_t WS_BBAR = 46 * MiB + 65536;
constexpr size_t WS_GB = 47 * MiB;
constexpr size_t WS_PROJ = 59 * MiB;
constexpr size_t WS_YCAT = 147 * MiB;
constexpr size_t WS_AY = 179 * MiB;
constexpr size_t WS_WS = 203 * MiB;
constexpr size_t WS_WY = 206 * MiB;
constexpr size_t WS_LAMT = 212 * MiB;
constexpr size_t WS_LAM512 = 212 * MiB + 65536;
constexpr size_t WS_XCH = 213 * MiB;
constexpr size_t WS_END = 214 * MiB;
constexpr size_t CTL_PANEL = 16384;
constexpr size_t CTL_BYTES = 32768;
constexpr int CTL_EXIT_WORD = 3968, CTL_FLAG_WORD = 8192 + 64;
constexpr unsigned CTL_TOKEN = 0x600DF00Du, CTL_RESET = 0x0BADF00Du;

constexpr int LDS_BYTES = 147456;

struct Args {
    const float* in[20];
    float* out;
    unsigned char* ws;
};

__device__ __forceinline__ unsigned f2bf(float f) { unsigned u = __builtin_bit_cast(unsigned, f); return (u + 0x7fffu + ((u >> 16) & 1u)) >> 16; }
__device__ __forceinline__ unsigned pk2(float lo, float hi) { return f2bf(lo) | (f2bf(hi) << 16); }
__device__ __forceinline__ float bf2f(unsigned short b) { return __builtin_bit_cast(float, ((unsigned)b) << 16); }
__device__ __forceinline__ float bflo(unsigned w) { return __builtin_bit_cast(float, w << 16); }
__device__ __forceinline__ float bfhi(unsigned w) { return __builtin_bit_cast(float, w & 0xffff0000u); }
__device__ __forceinline__ float wave_sum(float v) {
#pragma unroll
    for (int o = 1; o < 64; o <<= 1) v += __shfl_xor(v, o);
    return v;
}
__device__ __forceinline__ float silu_f(float v) { return v * __builtin_amdgcn_rcpf(1.0f + __builtin_amdgcn_exp2f(-1.4426950408889634f * v)); }
__device__ __forceinline__ float sigmoid_f(float v) { return __builtin_amdgcn_rcpf(1.0f + __builtin_amdgcn_exp2f(-1.4426950408889634f * v)); }
__device__ __forceinline__ float gelu_tanh(float v) { const float w = __builtin_fmaf(v * v, -0.10294324f, -2.3022082f); return v * __builtin_amdgcn_rcpf(1.0f + __builtin_amdgcn_exp2f(v * w)); }
#define LDS_WAIT() asm volatile("s_waitcnt lgkmcnt(0)" ::: "memory")
__device__ __forceinline__ int otid() { int t = threadIdx.x; asm volatile("" : "+v"(t)); return t; }

#define XB_TMO      128
#define XB_XCNT(j)  (256  + 64 * (j))
#define XB_XSUB(j)  (1280 + 64 * (j))
#define XB_XGEN(j)  (2304 + 64 * (j))
#define XB_TOP      3328
#define XB_TOPGEN   3392
#define XCD_BAR_WORDS 3456
#define XB_SPIN_CAP (1u << 18)

__device__ __forceinline__ unsigned xb_ld(unsigned* p)              { return __hip_atomic_load(p, __ATOMIC_RELAXED, __HIP_MEMORY_SCOPE_AGENT); }
__device__ __forceinline__ unsigned xb_add(unsigned* p, unsigned v) { return __hip_atomic_fetch_add(p, v, __ATOMIC_RELAXED, __HIP_MEMORY_SCOPE_AGENT); }
__device__ __forceinline__ unsigned xb_xcc_id() { return (unsigned)__builtin_amdgcn_s_getreg((3 << 11) | 20) & 0xFu; }
#define XB_SPIN(cond, bar) do { unsigned _sp = 0; while (cond) { __builtin_amdgcn_s_sleep(1); \
    if ((++_sp & 255u) == 0u) { if (xb_ld(&(bar)[XB_TMO])) break; if (_sp > XB_SPIN_CAP) { atomicAdd(&(bar)[XB_TMO], 1u); break; } } } } while (0)

struct XcdBarrier {
    unsigned* bar; unsigned x;
    volatile LAS unsigned* st;
};

__device__ __forceinline__ XcdBarrier xcd_barrier_post(unsigned* bar, volatile LAS unsigned* st) {
    XcdBarrier b; b.bar = bar; b.x = xb_xcc_id(); b.st = st;
    if (threadIdx.x == 0) (void)xb_add(&bar[XB_XCNT(b.x)], 1u);
    return b;
}
__device__ __forceinline__ void xcd_barrier_complete(unsigned* bar, unsigned x, unsigned& nloc, unsigned& nx) {
    const unsigned G = gridDim.x * gridDim.y * gridDim.z;
    unsigned sum, cnt, mine, sp = 0u;
    for (;;) {
        sum = 0u; cnt = 0u; mine = 0u;
#pragma unroll
        for (unsigned j = 0; j < 16; ++j) { const unsigned c = xb_ld(&bar[XB_XCNT(j)]); sum += c; cnt += (c > 0u) ? 1u : 0u; mine = (j == x) ? c : mine; }
        if (sum == G) break;
        __builtin_amdgcn_s_sleep(1);
        if ((++sp & 255u) == 0u) { if (xb_ld(&bar[XB_TMO])) break; if (sp > XB_SPIN_CAP) { atomicAdd(&bar[XB_TMO], 1u); break; } }
    }
    nloc = mine > 0u ? mine : 1u; nx = cnt > 0u ? cnt : 1u;
}

__device__ __forceinline__ void xcd_barrier(const XcdBarrier& b) {
    asm volatile("s_waitcnt vmcnt(0)" ::: "memory");
    __syncthreads();
    if (threadIdx.x == 0) {
        unsigned* bar = b.bar;
        __builtin_amdgcn_s_waitcnt(0);
        unsigned nloc = b.st[0], nx = b.st[1];
        if (nloc == 0u) { xcd_barrier_complete(bar, b.x, nloc, nx); b.st[0] = nloc; b.st[1] = nx; }
        const unsigned old = xb_add(&bar[XB_XSUB(b.x)], 1u);
        const unsigned gen = old / nloc;
        if (old + 1u == (gen + 1u) * nloc) {
            __builtin_amdgcn_fence(__ATOMIC_RELEASE, "agent");
            asm volatile("s_waitcnt vmcnt(0)" ::: "memory");
            const unsigned og = xb_add(&bar[XB_TOP], 1u);
            const unsigned tg = og / nx;
            if (og + 1u == (tg + 1u) * nx) xb_add(&bar[XB_TOPGEN], 1u);
            else XB_SPIN(xb_ld(&bar[XB_TOPGEN]) == tg, bar);
            __builtin_amdgcn_fence(__ATOMIC_ACQUIRE, "agent");
            xb_add(&bar[XB_XGEN(b.x)], 1u);
            asm volatile("s_waitcnt vmcnt(0)" ::: "memory");
        } else {
            XB_SPIN(xb_ld(&bar[XB_XGEN(b.x)]) == gen, bar);
            __builtin_amdgcn_fence(__ATOMIC_ACQUIRE, "agent");
            asm volatile("s_waitcnt vmcnt(0)" ::: "memory");
        }
    }
    __syncthreads();
}

__device__ __forceinline__ void rms_row_to_bf16(const float* xrow, bf16_t* orow, const float* gain, int lane) {
    const f32x4* xr = (const f32x4*)xrow + lane;
    f32x4 v[4]; float s = 0.f;
#pragma unroll
    for (int j = 0; j < 4; ++j) { v[j] = xr[64 * j]; s += (v[j].x * v[j].x + v[j].y * v[j].y) + (v[j].z * v[j].z + v[j].w * v[j].w); }
    const float rstd = 1.0f / sqrtf(wave_sum(s) * (1.0f / DM) + NORM_EPS);
    unsigned long long* o8 = (unsigned long long*)orow + lane;
#pragma unroll
    for (int j = 0; j < 4; ++j) {
        f32x4 g = gain ? ((const f32x4*)gain)[lane + 64 * j] : (f32x4){1.f, 1.f, 1.f, 1.f};
        o8[64 * j] = (unsigned long long)pk2(v[j].x * rstd * g.x, v[j].y * rstd * g.y) | ((unsigned long long)pk2(v[j].z * rstd * g.z, v[j].w * rstd * g.w) << 32);
    }
}
__device__ __forceinline__ void transpose_item(const float* W, int K, int N, bf16_t* WT, const float* ks, LAS float* scr, int item, int lane) {
    const int nblk = N / 32, kb = item / nblk, nb = item % nblk, k0 = 64 * kb, n0 = 32 * nb;
#pragma unroll 8
    for (int i = 0; i < 32; ++i) { const int kk = 2 * i + (lane >> 5); float w = W[(size_t)(k0 + kk) * N + n0 + (lane & 31)]; if (ks) w *= ks[k0 + kk]; scr[kk * 33 + (lane & 31)] = w; }
    LDS_WAIT();
    const int c = lane & 7;
#pragma unroll
    for (int j = 0; j < 4; ++j) { const int n = (lane >> 3) + 8 * j; const LAS float* s = scr + (8 * c) * 33 + n;
        v4u o; o.x = pk2(s[0 * 33], s[1 * 33]); o.y = pk2(s[2 * 33], s[3 * 33]); o.z = pk2(s[4 * 33], s[5 * 33]); o.w = pk2(s[6 * 33], s[7 * 33]);
        *(v4u*)(WT + (size_t)(n0 + n) * K + k0 + 8 * c) = o; }
    LDS_WAIT();
}


__device__ __forceinline__ void s5_tables(const Args& a, LAS unsigned char* lds, int tid) {
    const int bid = blockIdx.x; if (bid >= 192) return;
    const int g = bid % NG, q = bid / NG;
    const float* lam_re = a.in[4]; const float* lam_im = a.in[5]; const float* b_re = a.in[6]; const float* b_im = a.in[7]; const float* c_re = a.in[8]; const float* c_im = a.in[9]; const float* log_dt = a.in[11];
    LAS float* LPr = (LAS float*)(lds + 69632); LAS float* LPi = LPr + 17 * 64; LAS float* BBr = LPi + 17 * 64; LAS float* BBi = BBr + 1024;
    LAS float* Cr = BBi + 1024; LAS float* Ci = Cr + 1024; LAS float* KT = Ci + 1024;
    if (tid < 64) {
        const int p = tid, i = g * NP + p;
        const double dt = exp((double)log_dt[g]);
        const double lr = lam_re[i], li = lam_im[i];
        const double er = exp(lr * dt), ang = li * dt;
        const double lbr = er * cos(ang), lbi = er * sin(ang);
        const double nr = lbr - 1.0, ni = lbi, den = lr * lr + li * li;
        const double qr = (nr * lr + ni * li) / den, qi = (ni * lr - nr * li) / den;
        for (int h = 0; h < GH; ++h) { const double br = b_re[i * GH + h], bi = b_im[i * GH + h];
            BBr[p * 16 + h] = (float)(qr * br - qi * bi); BBi[p * 16 + h] = (float)(qr * bi + qi * br); }
        double pr = 1.0, pi = 0.0;
        for (int t = 0; t < 16; ++t) { LPr[t * 64 + p] = (float)pr; LPi[t * 64 + p] = (float)pi; const double nr2 = pr * lbr - pi * lbi, ni2 = pr * lbi + pi * lbr; pr = nr2; pi = ni2; }
        LPr[16 * 64 + p] = (float)pr; LPi[16 * 64 + p] = (float)pi;
        double tr = pr, ti = pi;
        if (q == 0) { float* LAMT = (float*)(a.ws + WS_LAMT); LAMT[2 * i] = (float)tr; LAMT[2 * i + 1] = (float)ti; }
        for (int k = 0; k < 5; ++k) { const double nr2 = tr * tr - ti * ti, ni2 = 2.0 * tr * ti; tr = nr2; ti = ni2; }
        if (q == 0) { float* L512 = (float*)(a.ws + WS_LAM512); L512[2 * i] = (float)tr; L512[2 * i + 1] = (float)ti; }
    }
    for (int i = tid; i < 1024; i += 512) { Cr[i] = c_re[g * 1024 + i]; Ci[i] = c_im[g * 1024 + i]; }
    __syncthreads();
    { const int tau = tid >> 5, hol = (tid >> 4) & 1, hi = tid & 15, ho = 2 * q + hol; float sacc = 0.f;
#pragma unroll 4
      for (int p = 0; p < 64; ++p) { const float lpr = LPr[tau * 64 + p], lpi = LPi[tau * 64 + p], br = BBr[p * 16 + hi], bi = BBi[p * 16 + hi];
          const float wr_ = lpr * br - lpi * bi, wi_ = lpr * bi + lpi * br; sacc += Cr[ho * 64 + p] * wr_ - Ci[ho * 64 + p] * wi_; }
      KT[tid] = sacc; }
    __syncthreads();
    bf16_t* WSb = (bf16_t*)(a.ws + WS_WS); bf16_t* WYb = (bf16_t*)(a.ws + WS_WY);
#pragma unroll
    for (int kk = 0; kk < 2; ++kk) { const int ch = tid + 512 * kk, n = 32 * q + (ch >> 5), k0 = (ch & 31) * 8, p = n & 63, isim = (n >> 6) & 1;
        float v[8];
#pragma unroll
        for (int j = 0; j < 8; ++j) { const int k = k0 + j, t = k >> 4, h = k & 15, tau = 15 - t; const float lpr = LPr[tau * 64 + p], lpi = LPi[tau * 64 + p], br = BBr[p * 16 + h], bi = BBi[p * 16 + h];
            const float val = isim ? (lpr * bi + lpi * br) : (lpr * br - lpi * bi); v[j] = n < 128 ? val : 0.f; }
        v4u o; o.x = pk2(v[0], v[1]); o.y = pk2(v[2], v[3]); o.z = pk2(v[4], v[5]); o.w = pk2(v[6], v[7]);
        *(v4u*)(WSb + ((size_t)(g * 256 + n)) * 256 + k0) = o; }
#pragma unroll
    for (int kk = 0; kk < 4; ++kk) { const int ch = tid + 512 * kk, rr = ch >> 6, to = rr >> 1, hol = rr & 1, ho = 2 * q + hol, n = to * 16 + ho, k0 = (ch & 63) * 8;
        float v[8];
#pragma unroll
        for (int j = 0; j < 8; ++j) { const int k = k0 + j; float val;
            if (k < 256) { const int ti = k >> 4, hi = k & 15; val = ti <= to ? KT[((to - ti) * 2 + hol) * 16 + hi] : 0.f; }
            else { const int jj = (k - 256) & 127, p = jj & 63, isim = jj >> 6; const float lpr = LPr[(to + 1) * 64 + p], lpi = LPi[(to + 1) * 64 + p], cr = Cr[ho * 64 + p], ci = Ci[ho * 64 + p];
                val = isim ? -(cr * lpi + ci * lpr) : (cr * lpr - ci * lpi); }
            v[j] = val; }
        v4u o; o.x = pk2(v[0], v[1]); o.y = pk2(v[2], v[3]); o.z = pk2(v[4], v[5]); o.w = pk2(v[6], v[7]);
        *(v4u*)(WYb + ((size_t)(g * 256 + n)) * 512 + k0) = o; }
}

__device__ __forceinline__ void rms_rows2_to_bf16(const float* x0, const float* x1, bf16_t* o0, bf16_t* o1, const float* gain, int lane) {
    const f32x4* xr0 = (const f32x4*)x0 + lane; const f32x4* xr1 = (const f32x4*)x1 + lane;
    f32x4 v[4], w[4]; float s0 = 0.f, s1 = 0.f;
#pragma unroll
    for (int j = 0; j < 4; ++j) { v[j] = __builtin_nontemporal_load(xr0 + 64 * j); w[j] = __builtin_nontemporal_load(xr1 + 64 * j); }
#pragma unroll
    for (int j = 0; j < 4; ++j) { s0 += (v[j].x * v[j].x + v[j].y * v[j].y) + (v[j].z * v[j].z + v[j].w * v[j].w); s1 += (w[j].x * w[j].x + w[j].y * w[j].y) + (w[j].z * w[j].z + w[j].w * w[j].w); }
#pragma unroll
    for (int o = 1; o < 64; o <<= 1) { s0 += __shfl_xor(s0, o); s1 += __shfl_xor(s1, o); }
    const float r0 = 1.0f / sqrtf(s0 * (1.0f / DM) + NORM_EPS), r1 = 1.0f / sqrtf(s1 * (1.0f / DM) + NORM_EPS);
    unsigned long long* p0 = (unsigned long long*)o0 + lane; unsigned long long* p1 = (unsigned long long*)o1 + lane;
#pragma unroll
    for (int j = 0; j < 4; ++j) {
        const f32x4 g = gain ? ((const f32x4*)gain)[lane + 64 * j] : (f32x4){1.f, 1.f, 1.f, 1.f};
        p0[64 * j] = (unsigned long long)pk2(v[j].x * r0 * g.x, v[j].y * r0 * g.y) | ((unsigned long long)pk2(v[j].z * r0 * g.z, v[j].w * r0 * g.w) << 32);
        p1[64 * j] = (unsigned long long)pk2(w[j].x * r1 * g.x, w[j].y * r1 * g.y) | ((unsigned long long)pk2(w[j].z * r1 * g.z, w[j].w * r1 * g.w) << 32);
    }
}
__device__ __forceinline__ void transpose_item4(const float* W, int K, int N, bf16_t* WT, const float* ks, LAS float* scr, int item, int lane) {
    const int nblk = N / 32, kb = item / nblk, nb = item % nblk, k0 = 64 * kb, n0 = 32 * nb;
    f32x4 w[8];
#pragma unroll
    for (int i = 0; i < 8; ++i) { const int kk = 8 * i + (lane >> 3); w[i] = __builtin_nontemporal_load((const f32x4*)(W + (size_t)(k0 + kk) * N + n0 + 4 * (lane & 7))); }
#pragma unroll
    for (int i = 0; i < 8; ++i) { const int kk = 8 * i + (lane >> 3); const float sc = ks ? ks[k0 + kk] : 1.0f; LAS float* d = scr + kk * 33 + 4 * (lane & 7);
        d[0] = w[i].x * sc; d[1] = w[i].y * sc; d[2] = w[i].z * sc; d[3] = w[i].w * sc; }
    LDS_WAIT();
    const int c = lane & 7;
#pragma unroll
    for (int j = 0; j < 4; ++j) { const int n = (lane >> 3) + 8 * j; const LAS float* sp = scr + (8 * c) * 33 + n;
        v4u o; o.x = pk2(sp[0 * 33], sp[1 * 33]); o.y = pk2(sp[2 * 33], sp[3 * 33]); o.z = pk2(sp[4 * 33], sp[5 * 33]); o.w = pk2(sp[6 * 33], sp[7 * 33]);
        *(v4u*)(WT + (size_t)(n0 + n) * K + k0 + 8 * c) = o; }
    LDS_WAIT();
}

__device__ __forceinline__ void phase0(const Args& a, LAS unsigned char* lds) {
    const int tid = otid(), lane = tid & 63, wave = tid >> 6;
    const int gw = blockIdx.x * 8 + wave, NGW = gridDim.x * 8;
    s5_tables(a, lds, tid);
    const float* x = a.in[0]; const float* mem = a.in[1]; const float* norm_g = a.in[2]; const float* w_in = a.in[3];
    const float* w_glu = a.in[12]; const float* mem_norm_g = a.in[16]; const float* w_mem_kv = a.in[17]; const float* w_out = a.in[18];
    bf16_t* XB = (bf16_t*)(a.ws + WS_XB); bf16_t* MEMN = (bf16_t*)(a.ws + WS_MEMN);
    bf16_t* WINT = (bf16_t*)(a.ws + WS_WINT); bf16_t* WKVT = (bf16_t*)(a.ws + WS_WKVT); bf16_t* WOUTT = (bf16_t*)(a.ws + WS_WOUTT); bf16_t* WGLUT = (bf16_t*)(a.ws + WS_WGLUT);
    for (int rnd = 0; rnd < 5; ++rnd) { const int r2 = rnd < 4 ? rnd * NGW + gw : 4 * NGW + (gw - 1536); if (rnd == 4 && (gw < 1536 || r2 >= (NTOK + NB * NMEM) / 2)) break; const int r = 2 * r2;
        if (r < NTOK) rms_rows2_to_bf16(x + (size_t)r * DM, x + (size_t)(r + 1) * DM, XB + (size_t)r * DM, XB + (size_t)(r + 1) * DM, nullptr, lane);
        else { const int m = r - NTOK; rms_rows2_to_bf16(mem + (size_t)m * DM, mem + (size_t)(m + 1) * DM, MEMN + (size_t)m * DM, MEMN + (size_t)(m + 1) * DM, mem_norm_g, lane); }
    }
    LAS float* scr = (LAS float*)(lds + wave * 8448);
    constexpr int I_IN = (DM / 64) * (DIN / 32), I_KV = (DM / 64) * (512 / 32), I_OUT = (DM / 64) * (DM / 32), I_GLU = (WSSM / 64) * (WSSM / 32);
    for (int rnd = 0; rnd < 2; ++rnd) { const int it = rnd == 0 ? gw : NGW + (gw - 1536); if (rnd == 1 && (gw < 1536 || it >= I_IN + I_KV + I_OUT + I_GLU)) break;
        int r = it;
        if (r < I_IN) { transpose_item4(w_in, DM, DIN, WINT, norm_g, scr, r, lane); continue; } r -= I_IN;
        if (r < I_KV) { transpose_item4(w_mem_kv, DM, 512, WKVT, nullptr, scr, r, lane); continue; } r -= I_KV;
        if (r < I_OUT) { transpose_item4(w_out, DM, DM, WOUTT, nullptr, scr, r, lane); continue; } r -= I_OUT;
        transpose_item4(w_glu, WSSM, WSSM, WGLUT, nullptr, scr, r, lane);
    }
    const int gt = blockIdx.x * 512 + tid, NT = gridDim.x * 512;
    for (int i = gt; i < 128 * 384 / 2; i += NT) ((unsigned*)(WGLUT + 384 * 384))[i] = 0u;
}

template <class Epi>
__device__ __forceinline__ void gemm_naive(const bf16_t* A, int lda, const bf16_t* Bt, int ldb, int M, int N, int K, LAS unsigned char* lds, int tile0, int ntile_total, const Epi& epi) {
    LAS float* As = (LAS float*)lds;
    LAS float* Bs = As + 32 * 132;
    const int tid = threadIdx.x, ty = tid >> 4, tx = tid & 15;
    const int ntn = N / 64, nt = (M / 128) * ntn;
    (void)ntile_total;
    for (int tile = blockIdx.x - tile0; tile < nt; tile += gridDim.x) {
        if (tile < 0) continue;
        const int tm = tile / ntn, tn = tile % ntn;
        float acc[4][4];
#pragma unroll
        for (int i = 0; i < 4; ++i)
#pragma unroll
            for (int j = 0; j < 4; ++j) acc[i][j] = 0.f;
        for (int k0 = 0; k0 < K; k0 += 32) {
            __syncthreads();
            { const int r = tid >> 2, kc = (tid & 3) * 8; const v4u v = *(const v4u*)(A + (size_t)(tm * 128 + r) * lda + k0 + kc);
              As[(kc + 0) * 132 + r] = bflo(v.x); As[(kc + 1) * 132 + r] = bfhi(v.x); As[(kc + 2) * 132 + r] = bflo(v.y); As[(kc + 3) * 132 + r] = bfhi(v.y);
              As[(kc + 4) * 132 + r] = bflo(v.z); As[(kc + 5) * 132 + r] = bfhi(v.z); As[(kc + 6) * 132 + r] = bflo(v.w); As[(kc + 7) * 132 + r] = bfhi(v.w); }
            if (tid < 256) { const int r = tid >> 2, kc = (tid & 3) * 8; const v4u v = *(const v4u*)(Bt + (size_t)(tn * 64 + r) * ldb + k0 + kc);
              Bs[(kc + 0) * 68 + r] = bflo(v.x); Bs[(kc + 1) * 68 + r] = bfhi(v.x); Bs[(kc + 2) * 68 + r] = bflo(v.y); Bs[(kc + 3) * 68 + r] = bfhi(v.y);
              Bs[(kc + 4) * 68 + r] = bflo(v.z); Bs[(kc + 5) * 68 + r] = bfhi(v.z); Bs[(kc + 6) * 68 + r] = bflo(v.w); Bs[(kc + 7) * 68 + r] = bfhi(v.w); }
            __syncthreads();
#pragma unroll 8
            for (int k = 0; k < 32; ++k) {
                const f32x4 av = *(const LAS f32x4*)(As + k * 132 + ty * 4), bv = *(const LAS f32x4*)(Bs + k * 68 + tx * 4);
#pragma unroll
                for (int i = 0; i < 4; ++i)
#pragma unroll
                    for (int j = 0; j < 4; ++j) acc[i][j] += av[i] * bv[j];
            }
        }
#pragma unroll
        for (int i = 0; i < 4; ++i)
#pragma unroll
            for (int j = 0; j < 4; ++j) epi(tm * 128 + ty * 4 + i, tn * 64 + tx * 4 + j, acc[i][j]);
    }
}

struct EpiStoreBf16 { bf16_t* O; int ldo; __device__ __forceinline__ void operator()(int r, int c, float v) const { O[(size_t)r * ldo + c] = (bf16_t)f2bf(v); } };
struct EpiGlu { const bf16_t* GB; const bf16_t* PROJ; const float* b_glu; bf16_t* YCAT;
    __device__ __forceinline__ void operator()(int r, int c, float v) const {
        const float g = bf2f(GB[(size_t)r * WSSM + c]); const float gate = bf2f(PROJ[(size_t)r * DIN + C_AGATE + c]);
        YCAT[(size_t)r * DM + c] = (bf16_t)f2bf(g * sigmoid_f(v + b_glu[c]) * silu_f(gate)); } };
struct EpiOut { const float* x; float* out; __device__ __forceinline__ void operator()(int r, int c, float v) const { out[(size_t)r * DM + c] = x[(size_t)r * DM + c] + v; } };


namespace pg8 {
typedef short bf16x8 __attribute__((ext_vector_type(8)));
typedef unsigned u32x4 __attribute__((ext_vector_type(4)));
constexpr int BM = 256, BK = 64, HALF = 128, HTB = HALF * BK * 2, STAGE_BYTES = 8 * HTB, NXCD = 8, WGM = 8;
__host__ __device__ __forceinline__ int lds_byte(int r, int c) { const int st = (r >> 4) * 2 + (c >> 5), rr = r & 15, cc = c & 31, ob = rr * 64 + cc * 2; return st * 1024 + (ob ^ (((ob >> 9) & 1) << 5)); }
__host__ __device__ __forceinline__ void stage_rc(int b, int& R, int& C) { const int st = b / 1024, sb = b % 1024, swz = sb ^ (((sb >> 9) & 1) << 5); R = (st >> 1) * 16 + swz / 64; C = (st & 1) * 32 + (swz % 64) / 2; }
__host__ __device__ __forceinline__ int perm32(int rho) { const int n = rho >> 4, i = rho & 15; return 8 * (i >> 2) + 4 * n + (i & 3); }
struct Unit { int pm, pn, z; };
struct Gemm { const bf16_t* A; const bf16_t* Bt; int lda, ldb, K; size_t sAz, sBz; };
struct Order {
    int nM, nN, per, total, G, c;
    __device__ void init(int nM_, int nN_, int nZ_, int G_, int c_) { nM = nM_; nN = nN_; per = nM_ * nN_; total = per * nZ_; G = G_; c = c_; }
    __device__ bool next(int i, Unit& u) const {
        const long L = (long)i * G + c; if (L >= total) return false;
        u.z = (int)(L / per); int wgid = (int)(L % per); const int nwg = per;
        { const int q = nwg / NXCD, r = nwg % NXCD, xcd = wgid % NXCD, off = wgid / NXCD; wgid = (xcd < r ? xcd * (q + 1) : r * (q + 1) + (xcd - r) * q) + off; }
        const int nig = WGM * nN, gid = wgid / nig, fm = gid * WGM, gsz = (nM - fm) < WGM ? (nM - fm) : WGM;
        u.pm = fm + ((wgid % nig) % gsz); u.pn = (wgid % nig) / gsz; return true;
    }
};
typedef __bf16 bf2v_t __attribute__((ext_vector_type(2))); typedef float f2v_t __attribute__((ext_vector_type(2)));
__device__ __forceinline__ unsigned cvt_pk_bf16(float lo, float hi) { const f2v_t v = {lo, hi}; return __builtin_bit_cast(unsigned, __builtin_convertvector(v, bf2v_t)); }

template <bool ALIGN_EPI = false, bool SP2 = false, class Epi>
__device__ __forceinline__ void gemm_phase(LAS unsigned char* lds, const Gemm g, const Order& S, const Epi& E) {
    int tid = threadIdx.x; asm volatile("" : "+v"(tid));
    const int wid = __builtin_amdgcn_readfirstlane(tid >> 6), lane = tid & 63, wr = wid >> 2, wc = wid & 3, fr = lane & 15, fq = lane >> 4;
    int K = g.K; asm volatile("" : "+s"(K));
    const int nt = K / BK;
    unsigned voffA[2], voffB[2];
#pragma unroll
    for (int i = 0; i < 2; ++i) { int R, C; stage_rc(tid * 16 + i * 8192, R, C); const int Rb = Epi::PERM ? ((R & ~31) + perm32(R & 31)) : R;
        voffA[i] = (unsigned)(R * g.lda + C) * 2u; voffB[i] = (unsigned)(Rb * g.ldb + C) * 2u; }
    const size_t kstep = (size_t)(BK * 2);
    const size_t hstepA = (size_t)HALF * g.lda * 2, hstepB = (size_t)HALF * g.ldb * 2;
    const size_t tstepA = 2 * hstepA, tstepB = 2 * hstepB;
    const unsigned ldsw = (unsigned)wid * 1024u;
    const int aoff = lds_byte(wr * 64 + fr, fq * 8), boff = lds_byte(wc * 32 + fr, fq * 8);
#define PG8_SA(b, h) (((b) * 2 + (h)) * HTB)
#define PG8_SB(b, h) ((4 + (b) * 2 + (h)) * HTB)
#define PG8_STAGE(bufoff, gbase, voff) do { _Pragma("unroll") for (int _i = 0; _i < 2; ++_i) \
        __builtin_amdgcn_global_load_lds((const unsigned*)((const char*)(gbase) + (voff)[_i]), (LAS unsigned*)(lds + (bufoff) + ldsw + _i * 8192), 16, 0, 0); } while (0)
#define PG8_LDA(dst, b, h) do { _Pragma("unroll") for (int m = 0; m < 4; ++m) _Pragma("unroll") for (int k = 0; k < 2; ++k) dst[m][k] = *(const LAS bf16x8*)(lds + PG8_SA(b, h) + aoff + m * 2048 + k * 1024); } while (0)
#define PG8_LDB(dst, b, h) do { _Pragma("unroll") for (int n = 0; n < 2; ++n) _Pragma("unroll") for (int k = 0; k < 2; ++k) dst[n][k] = *(const LAS bf16x8*)(lds + PG8_SB(b, h) + boff + n * 2048 + k * 1024); } while (0)
#define PG8_MMA(ai, bj, At, Bt) do { __builtin_amdgcn_s_setprio(1); _Pragma("unroll") for (int m = 0; m < 4; ++m) _Pragma("unroll") for (int n = 0; n < 2; ++n) _Pragma("unroll") for (int k = 0; k < 2; ++k) \
        acc[ai][bj][m][n] = __builtin_amdgcn_mfma_f32_16x16x32_bf16(Bt[n][k], At[m][k], acc[ai][bj][m][n], 0, 0, 0); __builtin_amdgcn_s_setprio(0); } while (0)
#define PG8_WAIT_V(n) asm volatile("s_waitcnt vmcnt(" #n ")" ::: "memory")
#define PG8_WAIT_L(n) asm volatile("s_waitcnt lgkmcnt(" #n ")" ::: "memory")
#define PG8_BAR __builtin_amdgcn_s_barrier()
#define PG8_SCHED __builtin_amdgcn_sched_barrier(0)
    Unit cur, nxt; int ui = 0;
    if (!S.next(0, cur)) return;
    f32x4 acc[2][2][4][2];
#pragma unroll
    for (int a = 0; a < 2; ++a)
#pragma unroll
        for (int b = 0; b < 2; ++b)
#pragma unroll
            for (int m = 0; m < 4; ++m)
#pragma unroll
                for (int n = 0; n < 2; ++n) acc[a][b][m][n] = (f32x4){0.f, 0.f, 0.f, 0.f};
    bf16x8 At[4][2], B0[2][2], B1[2][2];
    const char* cA = (const char*)(g.A + (size_t)cur.z * g.sAz) + (size_t)cur.pm * tstepA; const char* cB = (const char*)(g.Bt + (size_t)cur.z * g.sBz) + (size_t)cur.pn * tstepB;
    if constexpr (SP2) {
        PG8_STAGE(PG8_SB(0, 0), cB, voffB); PG8_STAGE(PG8_SB(0, 1), cB + hstepB, voffB); PG8_STAGE(PG8_SA(0, 0), cA, voffA); PG8_STAGE(PG8_SA(0, 1), cA + hstepA, voffA);
        if (wr == 1) PG8_BAR;
        PG8_WAIT_V(2); PG8_BAR;
        PG8_STAGE(PG8_SB(1, 0), cB + kstep, voffB); PG8_STAGE(PG8_SA(1, 0), cA + kstep, voffA); PG8_STAGE(PG8_SB(1, 1), cB + hstepB + kstep, voffB);
        PG8_WAIT_V(6); PG8_BAR;
    } else {
    PG8_STAGE(PG8_SB(0, 0), cB, voffB); PG8_STAGE(PG8_SA(0, 0), cA, voffA); PG8_STAGE(PG8_SB(0, 1), cB + hstepB, voffB); PG8_STAGE(PG8_SA(0, 1), cA + hstepA, voffA);
    if (wr == 1) PG8_BAR;
    PG8_WAIT_V(4); PG8_BAR;
    PG8_STAGE(PG8_SB(1, 0), cB + kstep, voffB); PG8_STAGE(PG8_SA(1, 0), cA + kstep, voffA); PG8_STAGE(PG8_SB(1, 1), cB + hstepB + kstep, voffB);
    PG8_WAIT_V(6); PG8_BAR;
    }
    for (;;) {
        const bool has_next = S.next(ui + 1, nxt);
        const char* nA = has_next ? (const char*)(g.A + (size_t)nxt.z * g.sAz) + (size_t)nxt.pm * tstepA : cA; const char* nB = has_next ? (const char*)(g.Bt + (size_t)nxt.z * g.sBz) + (size_t)nxt.pn * tstepB : cB;
        for (int t = 0; t < nt; t += 2) {
            const bool last = (t == nt - 2);
            const char* a1 = cA + (size_t)(t + 1) * kstep;
            const char* a2 = last ? nA : cA + (size_t)(t + 2) * kstep; const char* b2 = last ? nB : cB + (size_t)(t + 2) * kstep;
            const char* a3 = a2 + kstep; const char* b3 = b2 + kstep;
            if constexpr (SP2) {
            PG8_LDB(B0, 0, 0); PG8_LDB(B1, 0, 1); PG8_SCHED; PG8_LDA(At, 0, 0); PG8_STAGE(PG8_SA(1, 1), a1 + hstepA, voffA);
            PG8_WAIT_V(8); PG8_WAIT_L(0); PG8_BAR; PG8_MMA(0, 0, At, B0); PG8_MMA(0, 1, At, B1); PG8_BAR; PG8_SCHED;
            PG8_LDA(At, 0, 1); PG8_STAGE(PG8_SB(0, 0), b2, voffB); PG8_STAGE(PG8_SB(0, 1), b2 + hstepB, voffB); PG8_STAGE(PG8_SA(0, 0), a2, voffA);
            PG8_WAIT_V(8); PG8_WAIT_L(0); PG8_BAR; PG8_MMA(1, 0, At, B0); PG8_MMA(1, 1, At, B1); PG8_BAR; PG8_SCHED;
            PG8_LDB(B0, 1, 0); PG8_LDB(B1, 1, 1); PG8_SCHED; PG8_LDA(At, 1, 0); PG8_STAGE(PG8_SA(0, 1), a2 + hstepA, voffA);
            PG8_WAIT_V(8); PG8_WAIT_L(0); PG8_BAR; PG8_MMA(0, 0, At, B0); PG8_MMA(0, 1, At, B1); PG8_BAR; PG8_SCHED;
            PG8_LDA(At, 1, 1); PG8_STAGE(PG8_SB(1, 0), b3, voffB); PG8_STAGE(PG8_SB(1, 1), b3 + hstepB, voffB); PG8_STAGE(PG8_SA(1, 0), a3, voffA);
            PG8_WAIT_V(8); PG8_WAIT_L(0); PG8_BAR; PG8_MMA(1, 0, At, B0); PG8_MMA(1, 1, At, B1); PG8_BAR; PG8_SCHED;
            } else {
            PG8_LDB(B0, 0, 0); PG8_SCHED; PG8_LDA(At, 0, 0); PG8_STAGE(PG8_SA(1, 1), a1 + hstepA, voffA);
            PG8_WAIT_L(8); PG8_BAR; PG8_WAIT_L(0); PG8_MMA(0, 0, At, B0); PG8_BAR; PG8_SCHED;
            PG8_LDB(B1, 0, 1); PG8_STAGE(PG8_SB(0, 0), b2, voffB);
            PG8_BAR; PG8_WAIT_L(0); PG8_MMA(0, 1, At, B1); PG8_BAR;
            PG8_LDA(At, 0, 1); PG8_STAGE(PG8_SA(0, 0), a2, voffA);
            PG8_BAR; PG8_WAIT_L(0); PG8_MMA(1, 0, At, B0); PG8_BAR; PG8_SCHED;
            PG8_STAGE(PG8_SB(0, 1), b2 + hstepB, voffB);
            PG8_WAIT_V(6); PG8_BAR; PG8_MMA(1, 1, At, B1); PG8_BAR;
            PG8_LDB(B0, 1, 0); PG8_SCHED; PG8_LDA(At, 1, 0); PG8_STAGE(PG8_SA(0, 1), a2 + hstepA, voffA);
            PG8_WAIT_L(8); PG8_BAR; PG8_WAIT_L(0); PG8_MMA(0, 0, At, B0); PG8_BAR; PG8_SCHED;
            PG8_LDB(B1, 1, 1); PG8_STAGE(PG8_SB(1, 0), b3, voffB);
            PG8_BAR; PG8_WAIT_L(0); PG8_MMA(0, 1, At, B1); PG8_BAR;
            PG8_LDA(At, 1, 1); PG8_STAGE(PG8_SA(1, 0), a3, voffA);
            PG8_BAR; PG8_WAIT_L(0); PG8_MMA(1, 0, At, B0); PG8_BAR; PG8_SCHED;
            PG8_STAGE(PG8_SB(1, 1), b3 + hstepB, voffB);
            PG8_WAIT_V(6); PG8_BAR; PG8_MMA(1, 1, At, B1); PG8_BAR;
            }
        }
        if constexpr (ALIGN_EPI) { if (wr == 0) PG8_BAR; }
        if constexpr (!Epi::AFTER_DRAIN) { E(acc, cur, wr, wc, fr, fq); }
        if (!has_next) break;
#pragma unroll
        for (int a = 0; a < 2; ++a)
#pragma unroll
            for (int b = 0; b < 2; ++b)
#pragma unroll
                for (int m = 0; m < 4; ++m)
#pragma unroll
                    for (int n = 0; n < 2; ++n) acc[a][b][m][n] = (f32x4){0.f, 0.f, 0.f, 0.f};
        cur = nxt; cA = nA; cB = nB; ++ui;
        if constexpr (ALIGN_EPI) { if (wr == 1) PG8_BAR; }
    }
    PG8_WAIT_V(0);
    if constexpr (!ALIGN_EPI) { if (wr == 0) PG8_BAR; }
    PG8_BAR;
    if constexpr (Epi::AFTER_DRAIN) { E.fused(acc, cur, wr, wc, fr, fq, lds, wid, lane); }
#undef PG8_SA
#undef PG8_SB
#undef PG8_STAGE
#undef PG8_LDA
#undef PG8_LDB
#undef PG8_MMA
#undef PG8_WAIT_V
#undef PG8_WAIT_L
#undef PG8_BAR
#undef PG8_SCHED
}

struct EpiBf16Store {
    static constexpr bool PERM = true, AFTER_DRAIN = false;
    bf16_t* O; int ldc;
    __device__ __forceinline__ void operator()(const f32x4 (&acc)[2][2][4][2], const Unit& u, int wr, int wc, int fr, int fq) const {
        const int row0 = u.pm * BM + wr * 64 + fr, col0 = u.pn * BM + wc * 32 + 8 * fq;
#pragma unroll
        for (int ai = 0; ai < 2; ++ai)
#pragma unroll
            for (int m = 0; m < 4; ++m) { bf16_t* rowp = O + (size_t)(row0 + ai * HALF + m * 16) * ldc + col0;
#pragma unroll
                for (int bj = 0; bj < 2; ++bj) { const f32x4 v0 = acc[ai][bj][m][0], v1 = acc[ai][bj][m][1];
                    u32x4 w; w.x = cvt_pk_bf16(v0[0], v0[1]); w.y = cvt_pk_bf16(v0[2], v0[3]); w.z = cvt_pk_bf16(v1[0], v1[1]); w.w = cvt_pk_bf16(v1[2], v1[3]);
                    *(u32x4*)(rowp + bj * HALF) = w; } }
    }
};

struct EpiProjAY {
    static constexpr bool PERM = true, AFTER_DRAIN = false;
    bf16_t* PROJ; bf16_t* AY;
    __device__ __forceinline__ void operator()(const f32x4 (&acc)[2][2][4][2], const Unit& u, int wr, int wc, int fr, int fq) const {
        const int rowb = u.pm * BM + wr * 64, col0 = u.pn * BM + wc * 32 + 8 * fq;
#pragma unroll
        for (int bj = 0; bj < 2; ++bj) { const int col = col0 + bj * HALF; const bool ay = col < WSSM;
#pragma unroll
            for (int ai = 0; ai < 2; ++ai)
#pragma unroll
                for (int m = 0; m < 4; ++m) { const int rb = rowb + ai * HALF + m * 16;
                    bf16_t* dst = ay ? AY + ((size_t)((col >> 4) * 1024 + (rb >> 4)) * 512 + fr * 16 + (col & 15)) : PROJ + (size_t)(rb + fr) * DIN + col;
                    const f32x4 v0 = acc[ai][bj][m][0], v1 = acc[ai][bj][m][1];
                    u32x4 w; w.x = cvt_pk_bf16(v0[0], v0[1]); w.y = cvt_pk_bf16(v0[2], v0[3]); w.z = cvt_pk_bf16(v1[0], v1[1]); w.w = cvt_pk_bf16(v1[2], v1[3]);
                    *(u32x4*)dst = w; } }
    }
};
struct EpiSend {
    static constexpr bool PERM = false, AFTER_DRAIN = true;
    bf16_t* AY; const float* LAMT; const float* LAM512;
    __device__ __forceinline__ void fused(const f32x4 (&acc)[2][2][4][2], const Unit& u, int wr, int wc, int fr, int fq, LAS unsigned char* lds, int wid, int lane) const {
        LAS float* S = (LAS float*)lds;
        LAS float* E = (LAS float*)(lds + 131072);
#pragma unroll
        for (int ai = 0; ai < 2; ++ai)
#pragma unroll
            for (int m = 0; m < 4; ++m)
#pragma unroll
                for (int n = 0; n < 2; ++n) { const int r = ai * HALF + wr * 64 + m * 16 + fr, c = wc * 32 + n * 16 + 4 * fq; *(LAS f32x4*)(S + r * 128 + c) = acc[ai][0][m][n]; }
        __syncthreads();
        const int g = u.z, b = u.pm, p = lane, seg = wid;
        const float tr = LAMT[(g * NP + p) * 2], ti = LAMT[(g * NP + p) * 2 + 1], hr = LAM512[(g * NP + p) * 2], hi = LAM512[(g * NP + p) * 2 + 1];
        float sr = 0.f, si = 0.f;
        for (int i = 0; i < 32; ++i) { const int row = seg * 32 + i; const float xr = S[row * 128 + p], xi = S[row * 128 + 64 + p];
            const float nr = tr * sr - ti * si + xr, ni = tr * si + ti * sr + xi; sr = nr; si = ni; }
        E[seg * 128 + p] = sr; E[seg * 128 + 64 + p] = si;
        __syncthreads();
        sr = 0.f; si = 0.f;
        for (int s2 = 0; s2 < seg; ++s2) { const float xr = E[s2 * 128 + p], xi = E[s2 * 128 + 64 + p]; const float nr = hr * sr - hi * si + xr, ni = hr * si + hi * sr + xi; sr = nr; si = ni; }
        bf16_t* base = AY + ((size_t)(g * 1024 + b * 256 + seg * 32)) * 512 + 256 + p;
        for (int i = 0; i < 32; ++i) { const int row = seg * 32 + i;
            bf16_t* o = base + (size_t)i * 512;
            o[0] = (bf16_t)f2bf(sr); o[64] = (bf16_t)f2bf(si);
            const float xr = S[row * 128 + p], xi = S[row * 128 + 64 + p];
            const float nr = tr * sr - ti * si + xr, ni = tr * si + ti * sr + xi; sr = nr; si = ni; }
    }
};
struct EpiY {
    static constexpr bool PERM = true, AFTER_DRAIN = false;
    const bf16_t* AY; const float* ssm_d; bf16_t* GB;
    __device__ __forceinline__ void operator()(const f32x4 (&acc)[2][2][4][2], const Unit& u, int wr, int wc, int fr, int fq) const {
        const int g = u.z, b = u.pm;
#pragma unroll
        for (int bj = 0; bj < 2; ++bj) { const int col = bj * HALF + wc * 32 + 8 * fq, t = col >> 4, h0 = col & 15;
            const f32x4 d0 = *(const f32x4*)(ssm_d + g * GH + h0), d1 = *(const f32x4*)(ssm_d + g * GH + h0 + 4);
            u32x4 u8[2][4];
#pragma unroll
            for (int ai = 0; ai < 2; ++ai)
#pragma unroll
                for (int m = 0; m < 4; ++m) { const int crow = ai * HALF + wr * 64 + m * 16 + fr; u8[ai][m] = *(const u32x4*)(AY + ((size_t)(g * 1024 + b * 256 + crow)) * 512 + col); }
#pragma unroll
            for (int ai = 0; ai < 2; ++ai)
#pragma unroll
                for (int m = 0; m < 4; ++m) { const int crow = ai * HALF + wr * 64 + m * 16 + fr;
                    const u32x4 uu = u8[ai][m]; const f32x4 v0 = acc[ai][bj][m][0], v1 = acc[ai][bj][m][1];
                    u32x4 w;
                    w.x = cvt_pk_bf16(gelu_tanh(v0[0] + d0[0] * bflo(uu.x)), gelu_tanh(v0[1] + d0[1] * bfhi(uu.x)));
                    w.y = cvt_pk_bf16(gelu_tanh(v0[2] + d0[2] * bflo(uu.y)), gelu_tanh(v0[3] + d0[3] * bfhi(uu.y)));
                    w.z = cvt_pk_bf16(gelu_tanh(v1[0] + d1[0] * bflo(uu.z)), gelu_tanh(v1[1] + d1[1] * bfhi(uu.z)));
                    w.w = cvt_pk_bf16(gelu_tanh(v1[2] + d1[2] * bflo(uu.w)), gelu_tanh(v1[3] + d1[3] * bfhi(uu.w)));
                    *(u32x4*)(GB + ((size_t)(b * SEQ + crow * 16 + t)) * WSSM + g * GH + h0) = w; }
            asm volatile("" ::: "memory"); }
    }
};
struct EpiGluP {
    static constexpr bool PERM = true, AFTER_DRAIN = false;
    const bf16_t* GB; const bf16_t* PROJ; const float* b_glu; bf16_t* YCAT;
    __device__ __forceinline__ void operator()(const f32x4 (&acc)[2][2][4][2], const Unit& u, int wr, int wc, int fr, int fq) const {
        const int row0 = u.pm * BM + wr * 64 + fr, col0 = u.pn * BM + wc * 32 + 8 * fq;
#pragma unroll
        for (int bj = 0; bj < 2; ++bj) { const int col = col0 + bj * HALF; if (col >= WSSM) continue;
            const f32x4 b0 = *(const f32x4*)(b_glu + col), b1 = *(const f32x4*)(b_glu + col + 4);
#pragma unroll
            for (int ai = 0; ai < 2; ++ai) { if (ai != u.z) continue;
                u32x4 g8[4], a8[4];
#pragma unroll
                for (int m = 0; m < 4; ++m) { const size_t row = (size_t)(row0 + ai * HALF + m * 16); g8[m] = *(const u32x4*)(GB + row * WSSM + col); a8[m] = *(const u32x4*)(PROJ + row * DIN + C_AGATE + col); }
#pragma unroll
                for (int m = 0; m < 4; ++m) { const size_t row = (size_t)(row0 + ai * HALF + m * 16);
                    const f32x4 v0 = acc[ai][bj][m][0] + b0, v1 = acc[ai][bj][m][1] + b1;
                    u32x4 w;
                    w.x = cvt_pk_bf16(bflo(g8[m].x) * sigmoid_f(v0[0]) * silu_f(bflo(a8[m].x)), bfhi(g8[m].x) * sigmoid_f(v0[1]) * silu_f(bfhi(a8[m].x)));
                    w.y = cvt_pk_bf16(bflo(g8[m].y) * sigmoid_f(v0[2]) * silu_f(bflo(a8[m].y)), bfhi(g8[m].y) * sigmoid_f(v0[3]) * silu_f(bfhi(a8[m].y)));
                    w.z = cvt_pk_bf16(bflo(g8[m].z) * sigmoid_f(v1[0]) * silu_f(bflo(a8[m].z)), bfhi(g8[m].z) * sigmoid_f(v1[1]) * silu_f(bfhi(a8[m].z)));
                    w.w = cvt_pk_bf16(bflo(g8[m].w) * sigmoid_f(v1[2]) * silu_f(bflo(a8[m].w)), bfhi(g8[m].w) * sigmoid_f(v1[3]) * silu_f(bfhi(a8[m].w)));
                    *(u32x4*)(YCAT + row * DM + col) = w; }
                asm volatile("" ::: "memory"); } }
    }
};
struct EpiResF32 {
    static constexpr bool PERM = false, AFTER_DRAIN = false;
    const float* x; float* out;
    __device__ __forceinline__ void operator()(const f32x4 (&acc)[2][2][4][2], const Unit& u, int wr, int wc, int fr, int fq) const {
        const int row0 = u.pm * BM + wr * 64 + fr, col0 = u.pn * BM + wc * 32 + 4 * fq;
#pragma unroll
        for (int ai = 0; ai < 2; ++ai)
#pragma unroll
            for (int m = 0; m < 4; ++m) { const size_t off = (size_t)(row0 + ai * HALF + m * 16) * DM + col0;
#pragma unroll
                for (int bj = 0; bj < 2; ++bj)
#pragma unroll
                    for (int n = 0; n < 2; ++n) { const f32x4 xv = *(const f32x4*)(x + off + bj * HALF + n * 16); *(f32x4*)(out + off + bj * HALF + n * 16) = xv + acc[ai][bj][m][n]; }
                asm volatile("" ::: "memory"); }
    }
};

struct EpiOutNorm {
    static constexpr bool PERM = false, AFTER_DRAIN = true;
    const float* x; const float* fg; float* out; float* xch; unsigned* cnt;
    __device__ __forceinline__ void fused(f32x4 (&acc)[2][2][4][2], const Unit& u, int wr, int wc, int fr, int fq, LAS unsigned char* lds, int wid, int lane) const {
        LAS float* P = (LAS float*)lds;
        LAS float* S = (LAS float*)(lds + 8192);
        const int row0 = u.pm * BM + wr * 64 + fr, col0 = u.pn * BM + wc * 32 + 4 * fq;
#pragma unroll
        for (int ai = 0; ai < 2; ++ai) {
            f32x4 xv[4][2][2];
#pragma unroll
            for (int m = 0; m < 4; ++m) { const size_t off = (size_t)(row0 + ai * HALF + m * 16) * DM + col0;
#pragma unroll
                for (int bj = 0; bj < 2; ++bj)
#pragma unroll
                    for (int n = 0; n < 2; ++n) xv[m][bj][n] = __builtin_nontemporal_load((const f32x4*)(x + off + bj * HALF + n * 16)); }
#pragma unroll
            for (int m = 0; m < 4; ++m) { float sq = 0.f;
#pragma unroll
                for (int bj = 0; bj < 2; ++bj)
#pragma unroll
                    for (int n = 0; n < 2; ++n) { const f32x4 hv = acc[ai][bj][m][n] + xv[m][bj][n]; acc[ai][bj][m][n] = hv; sq += (hv[0] * hv[0] + hv[1] * hv[1]) + (hv[2] * hv[2] + hv[3] * hv[3]); }
                sq += __shfl_xor(sq, 16); sq += __shfl_xor(sq, 32);
                if (fq == 0) P[(ai * HALF + wr * 64 + m * 16 + fr) * 4 + wc] = sq; }
            asm volatile("" ::: "memory"); }
        asm volatile("s_waitcnt lgkmcnt(0)" ::: "memory"); __builtin_amdgcn_s_barrier(); asm volatile("" ::: "memory");
        const int row = wid * 32 + (lane & 31);
        if (lane < 32) { const f32x4 pv = *(const LAS f32x4*)(P + row * 4); const float t = (pv[0] + pv[1]) + (pv[2] + pv[3]);
            __hip_atomic_store(xch + ((size_t)(u.pm * BM + row) * 4 + u.pn), t, __ATOMIC_RELAXED, __HIP_MEMORY_SCOPE_AGENT); }
        asm volatile("s_waitcnt vmcnt(0)" ::: "memory");
        if (lane == 0) __hip_atomic_fetch_add(cnt + 64 * u.pm, 1u, __ATOMIC_RELAXED, __HIP_MEMORY_SCOPE_AGENT);
        if (wid == 0) { unsigned sp = 0;
            while ((unsigned)__builtin_amdgcn_readfirstlane(__hip_atomic_load(cnt + 64 * u.pm, __ATOMIC_RELAXED, __HIP_MEMORY_SCOPE_AGENT)) < 32u) { __builtin_amdgcn_s_sleep(2); if (++sp > (1u << 22)) break; }
            __builtin_amdgcn_fence(__ATOMIC_ACQUIRE, "agent"); }
        asm volatile("s_waitcnt vmcnt(0) lgkmcnt(0)" ::: "memory"); __builtin_amdgcn_s_barrier(); asm volatile("" ::: "memory");
        if (lane < 32) { const float* slot = xch + (size_t)(u.pm * BM + row) * 4; float t = 0.f;
#pragma unroll
            for (int q = 0; q < 4; ++q) t += __hip_atomic_load(slot + q, __ATOMIC_RELAXED, __HIP_MEMORY_SCOPE_AGENT);
            S[row] = 1.0f / sqrtf(t * (1.0f / DM) + NORM_EPS); }
        asm volatile("s_waitcnt lgkmcnt(0)" ::: "memory"); __builtin_amdgcn_s_barrier(); asm volatile("" ::: "memory");
        f32x4 gv[2][2];
#pragma unroll
        for (int bj = 0; bj < 2; ++bj)
#pragma unroll
            for (int n = 0; n < 2; ++n) gv[bj][n] = *(const f32x4*)(fg + col0 + bj * HALF + n * 16);
#pragma unroll
        for (int ai = 0; ai < 2; ++ai)
#pragma unroll
            for (int m = 0; m < 4; ++m) { const int r = ai * HALF + wr * 64 + m * 16 + fr; const float rs = S[r]; const size_t off = (size_t)(u.pm * BM + r) * DM + col0;
#pragma unroll
                for (int bj = 0; bj < 2; ++bj)
#pragma unroll
                    for (int n = 0; n < 2; ++n) *(f32x4*)(out + off + bj * HALF + n * 16) = acc[ai][bj][m][n] * rs * gv[bj][n]; }
    }
};
}

__device__ __forceinline__ void s5_naive(const Args& a, int b, int g, int lane) {
    const bf16_t* PROJ = (const bf16_t*)(a.ws + WS_PROJ); bf16_t* GB = (bf16_t*)(a.ws + WS_GB);
    const float* LAMB = (const float*)(a.ws + WS_LAMB); const float* BBAR = (const float*)(a.ws + WS_BBAR);
    const float* c_re = a.in[8]; const float* c_im = a.in[9]; const float* ssm_d = a.in[10];
    const int p = lane, h = lane & 15, pg = lane >> 4;
    const float lr = LAMB[(g * NP + p) * 2], li = LAMB[(g * NP + p) * 2 + 1];
    float bre[16], bim[16], cre[16], cim[16];
#pragma unroll
    for (int j = 0; j < 16; ++j) { bre[j] = BBAR[((g * NP + p) * GH + j) * 2]; bim[j] = BBAR[((g * NP + p) * GH + j) * 2 + 1];
        cre[j] = c_re[(g * GH + h) * NP + pg * 16 + j]; cim[j] = c_im[(g * GH + h) * NP + pg * 16 + j]; }
    const float dd = ssm_d[g * GH + h];
    float sr = 0.f, si = 0.f;
    for (int t = 0; t < SEQ; ++t) {
        const bf16_t* up = PROJ + (size_t)(b * SEQ + t) * DIN + C_AIN + g * GH;
        const v4u u0 = *(const v4u*)up, u1 = *(const v4u*)(up + 8);
        float u[16];
        u[0] = bflo(u0.x); u[1] = bfhi(u0.x); u[2] = bflo(u0.y); u[3] = bfhi(u0.y); u[4] = bflo(u0.z); u[5] = bfhi(u0.z); u[6] = bflo(u0.w); u[7] = bfhi(u0.w);
        u[8] = bflo(u1.x); u[9] = bfhi(u1.x); u[10] = bflo(u1.y); u[11] = bfhi(u1.y); u[12] = bflo(u1.z); u[13] = bfhi(u1.z); u[14] = bflo(u1.w); u[15] = bfhi(u1.w);
        const float uh = bf2f(up[h]);
        float bur = 0.f, bui = 0.f;
#pragma unroll
        for (int j = 0; j < 16; ++j) { bur += bre[j] * u[j]; bui += bim[j] * u[j]; }
        const float nsr = lr * sr - li * si + bur, nsi = lr * si + li * sr + bui;
        sr = nsr; si = nsi;
        float part = 0.f;
#pragma unroll
        for (int j = 0; j < 16; ++j) { const float xr = __shfl(sr, pg * 16 + j), xi = __shfl(si, pg * 16 + j); part += cre[j] * xr - cim[j] * xi; }
        part += __shfl_xor(part, 16); part += __shfl_xor(part, 32);
        const float y = part + dd * uh;
        if (lane < 16) GB[(size_t)(b * SEQ + t) * WSSM + g * GH + h] = (bf16_t)f2bf(gelu_tanh(y));
    }
}

__device__ __forceinline__ void conv_naive(const Args& a, int vb, int nvb) {
    const bf16_t* PROJ = (const bf16_t*)(a.ws + WS_PROJ); bf16_t* YCAT = (bf16_t*)(a.ws + WS_YCAT);
    const float* conv_w = a.in[14]; const float* conv_b = a.in[15];
    const int gt = vb * 512 + otid(), NT = nvb * 512;
    for (int idx = gt; idx < NTOK * WSSM; idx += NT) {
        const int tok = idx / WSSM, c = idx % WSSM, t = tok % SEQ;
        const bf16_t* row = PROJ + (size_t)tok * DIN;
        float acc = conv_b[c];
#pragma unroll
        for (int k = 0; k < 3; ++k) { const int tt = t - 2 + k; if (tt >= 0) { const bf16_t* r2 = PROJ + (size_t)(tok - 2 + k) * DIN; acc += conv_w[k * WSSM + c] * (bf2f(r2[C_CC + c]) * bf2f(r2[C_CIN + c])); } }
        const float y = bf2f(row[C_CB + c]) * acc * silu_f(bf2f(row[C_CGATE + c]));
        YCAT[(size_t)tok * DM + WSSM + c] = (bf16_t)f2bf(y);
    }
}
__device__ __forceinline__ void attn_naive(const Args& a, int vb, int nvb) {
    const bf16_t* PROJ = (const bf16_t*)(a.ws + WS_PROJ); bf16_t* YCAT = (bf16_t*)(a.ws + WS_YCAT); const bf16_t* KV = (const bf16_t*)(a.ws + WS_KV);
    const int gt = vb * 512 + otid(), NT = nvb * 512;
    for (int item = gt; item < NB * 4 * SEQ; item += NT) {
        const int t = item % SEQ, hh = (item / SEQ) % 4, b = item / (4 * SEQ), tok = b * SEQ + t;
        const v4u* qp = (const v4u*)(PROJ + (size_t)tok * DIN + C_Q + hh * 64);
        float q[64], o[64];
#pragma unroll
        for (int i = 0; i < 8; ++i) { const v4u v = qp[i]; q[8 * i] = bflo(v.x); q[8 * i + 1] = bfhi(v.x); q[8 * i + 2] = bflo(v.y); q[8 * i + 3] = bfhi(v.y); q[8 * i + 4] = bflo(v.z); q[8 * i + 5] = bfhi(v.z); q[8 * i + 6] = bflo(v.w); q[8 * i + 7] = bfhi(v.w); }
#pragma unroll
        for (int d = 0; d < 64; ++d) o[d] = 0.f;
        float m = -1e30f, l = 0.f;
        for (int mm = 0; mm < NMEM; ++mm) {
            const v4u* kp = (const v4u*)(KV + (size_t)(b * NMEM + mm) * 512 + hh * 64);
            const v4u* vp = (const v4u*)(KV + (size_t)(b * NMEM + mm) * 512 + 256 + hh * 64);
            float s = 0.f;
#pragma unroll
            for (int i = 0; i < 8; ++i) { const v4u v = kp[i];
                s += q[8 * i] * bflo(v.x) + q[8 * i + 1] * bfhi(v.x) + q[8 * i + 2] * bflo(v.y) + q[8 * i + 3] * bfhi(v.y) + q[8 * i + 4] * bflo(v.z) + q[8 * i + 5] * bfhi(v.z) + q[8 * i + 6] * bflo(v.w) + q[8 * i + 7] * bfhi(v.w); }
            s *= 0.125f;
            const float mn = fmaxf(m, s), sc = __expf(m - mn), pp = __expf(s - mn);
            l = l * sc + pp; m = mn;
#pragma unroll
            for (int i = 0; i < 8; ++i) { const v4u v = vp[i];
                o[8 * i] = o[8 * i] * sc + pp * bflo(v.x); o[8 * i + 1] = o[8 * i + 1] * sc + pp * bfhi(v.x); o[8 * i + 2] = o[8 * i + 2] * sc + pp * bflo(v.y); o[8 * i + 3] = o[8 * i + 3] * sc + pp * bfhi(v.y);
                o[8 * i + 4] = o[8 * i + 4] * sc + pp * bflo(v.z); o[8 * i + 5] = o[8 * i + 5] * sc + pp * bfhi(v.z); o[8 * i + 6] = o[8 * i + 6] * sc + pp * bflo(v.w); o[8 * i + 7] = o[8 * i + 7] * sc + pp * bfhi(v.w); }
        }
        const float inv = 1.0f / l;
        const v4u* gp = (const v4u*)(PROJ + (size_t)tok * DIN + C_QGATE + hh * 64);
        v4u* op = (v4u*)(YCAT + (size_t)tok * DM + 768 + hh * 64);
#pragma unroll
        for (int i = 0; i < 8; ++i) { const v4u gv = gp[i]; v4u w;
            w.x = pk2(o[8 * i] * inv * silu_f(bflo(gv.x)), o[8 * i + 1] * inv * silu_f(bfhi(gv.x)));
            w.y = pk2(o[8 * i + 2] * inv * silu_f(bflo(gv.y)), o[8 * i + 3] * inv * silu_f(bfhi(gv.y)));
            w.z = pk2(o[8 * i + 4] * inv * silu_f(bflo(gv.z)), o[8 * i + 5] * inv * silu_f(bfhi(gv.z)));
            w.w = pk2(o[8 * i + 6] * inv * silu_f(bflo(gv.w)), o[8 * i + 7] * inv * silu_f(bfhi(gv.w)));
            op[i] = w; }
    }
}

typedef short bf16x8_t __attribute__((ext_vector_type(8)));
typedef short s16x4_t __attribute__((ext_vector_type(4)));
typedef float f32x16 __attribute__((ext_vector_type(16)));
typedef __bf16 bf2_t __attribute__((ext_vector_type(2)));
typedef float f2_t __attribute__((ext_vector_type(2)));
typedef unsigned u32x2_t __attribute__((ext_vector_type(2)));
__device__ __forceinline__ unsigned cvt2(float lo, float hi) { const f2_t v = {lo, hi}; return __builtin_bit_cast(unsigned, __builtin_convertvector(v, bf2_t)); }
__device__ __forceinline__ void attn_mfma(const Args& a, LAS unsigned char* lds, int vb, int nvb) {
    const int nj = nvb / 16; if (nj < 1 || vb >= nj * 16) return;
    const int tid = otid(), lane = tid & 63, wave = tid >> 6, r = lane & 31, h = lane >> 5;
    const int bh = vb % 16, j = vb / 16, b = bh >> 2, head = bh & 3;
    const bf16_t* PROJ = (const bf16_t*)(a.ws + WS_PROJ); bf16_t* YCAT = (bf16_t*)(a.ws + WS_YCAT); const bf16_t* KV = (const bf16_t*)(a.ws + WS_KV);
    LAS unsigned char* Kl = lds;
    LAS unsigned char* Vl = lds + 36864;
    for (int c = tid; c < 2048; c += 512) { const int key = c >> 3, dch = c & 7;
        const bf16_t* src = KV + (size_t)(b * NMEM + key) * 512 + head * 64 + dch * 8;
        const v4u kv = *(const v4u*)src, vv = *(const v4u*)(src + 256);
        *(LAS v4u*)(Kl + key * 144 + dch * 16) = kv;
        LAS bf16_t* vd = (LAS bf16_t*)(Vl + (dch * 8) * 520 + key * 2);
        vd[0 * 260] = (bf16_t)(vv.x & 0xffff); vd[1 * 260] = (bf16_t)(vv.x >> 16); vd[2 * 260] = (bf16_t)(vv.y & 0xffff); vd[3 * 260] = (bf16_t)(vv.y >> 16);
        vd[4 * 260] = (bf16_t)(vv.z & 0xffff); vd[5 * 260] = (bf16_t)(vv.z >> 16); vd[6 * 260] = (bf16_t)(vv.w & 0xffff); vd[7 * 260] = (bf16_t)(vv.w >> 16); }
    __syncthreads();
    for (int tile = j * 8 + wave; tile < SEQ / 32; tile += nj * 8) {
        const size_t tok = (size_t)b * SEQ + tile * 32 + r;
        bf16x8_t qf[4];
#pragma unroll
        for (int s4 = 0; s4 < 4; ++s4) qf[s4] = *(const bf16x8_t*)(PROJ + tok * DIN + C_Q + head * 64 + 16 * s4 + 8 * h);
        const float sc = 0.125f * 1.4426950408889634f;
        float mx = -3.0e38f, l = 0.f;
        f32x16 o0, o1;
#pragma unroll
        for (int i = 0; i < 16; ++i) { o0[i] = 0.f; o1[i] = 0.f; }
#pragma unroll 2
        for (int kt = 0; kt < 8; ++kt) {
            f32x16 st;
#pragma unroll
            for (int i = 0; i < 16; ++i) st[i] = 0.f;
#pragma unroll
            for (int s4 = 0; s4 < 4; ++s4) { const bf16x8_t kf = *(const LAS bf16x8_t*)(Kl + (kt * 32 + r) * 144 + (16 * s4 + 8 * h) * 2);
                st = __builtin_amdgcn_mfma_f32_32x32x16_bf16(kf, qf[s4], st, 0, 0, 0); }
            float tm = st[0];
#pragma unroll
            for (int i = 1; i < 16; ++i) tm = fmaxf(tm, st[i]);
            tm = fmaxf(tm, __shfl_xor(tm, 32));
            const float mn = fmaxf(mx, tm), alpha = __builtin_amdgcn_exp2f((mx - mn) * sc), mb = mn * sc;
            mx = mn; l *= alpha;
#pragma unroll
            for (int i = 0; i < 16; ++i) { o0[i] *= alpha; o1[i] *= alpha; }
#pragma unroll
            for (int i = 0; i < 16; ++i) { const float p = __builtin_amdgcn_exp2f(st[i] * sc - mb); st[i] = p; l += p; }
#pragma unroll
            for (int s2 = 0; s2 < 2; ++s2) {
                v4u pw; pw.x = cvt2(st[8 * s2 + 0], st[8 * s2 + 1]); pw.y = cvt2(st[8 * s2 + 2], st[8 * s2 + 3]);
                pw.z = cvt2(st[8 * s2 + 4], st[8 * s2 + 5]); pw.w = cvt2(st[8 * s2 + 6], st[8 * s2 + 7]);
                const bf16x8_t pf = __builtin_bit_cast(bf16x8_t, pw);
                const int koff = (kt * 32 + 16 * s2 + 4 * h) * 2;
                { const s16x4_t lo = *(const LAS s16x4_t*)(Vl + r * 520 + koff), hi = *(const LAS s16x4_t*)(Vl + r * 520 + koff + 16);
                  const bf16x8_t vf = __builtin_shufflevector(lo, hi, 0, 1, 2, 3, 4, 5, 6, 7); o0 = __builtin_amdgcn_mfma_f32_32x32x16_bf16(vf, pf, o0, 0, 0, 0); }
                { const s16x4_t lo = *(const LAS s16x4_t*)(Vl + (32 + r) * 520 + koff), hi = *(const LAS s16x4_t*)(Vl + (32 + r) * 520 + koff + 16);
                  const bf16x8_t vf = __builtin_shufflevector(lo, hi, 0, 1, 2, 3, 4, 5, 6, 7); o1 = __builtin_amdgcn_mfma_f32_32x32x16_bf16(vf, pf, o1, 0, 0, 0); }
            }
        }
        l += __shfl_xor(l, 32);
        const float inv = 1.0f / l;
        const bf16_t* gp = PROJ + tok * DIN + C_QGATE + head * 64; bf16_t* op = YCAT + tok * DM + 768 + head * 64;
#pragma unroll
        for (int q4 = 0; q4 < 4; ++q4) {
            { const int d = 8 * q4 + 4 * h; const u32x2_t gv = *(const u32x2_t*)(gp + d); u32x2_t w;
              w.x = cvt2(o0[4 * q4 + 0] * inv * silu_f(bflo(gv.x)), o0[4 * q4 + 1] * inv * silu_f(bfhi(gv.x))); w.y = cvt2(o0[4 * q4 + 2] * inv * silu_f(bflo(gv.y)), o0[4 * q4 + 3] * inv * silu_f(bfhi(gv.y)));
              *(u32x2_t*)(op + d) = w; }
            { const int d = 32 + 8 * q4 + 4 * h; const u32x2_t gv = *(const u32x2_t*)(gp + d); u32x2_t w;
              w.x = cvt2(o1[4 * q4 + 0] * inv * silu_f(bflo(gv.x)), o1[4 * q4 + 1] * inv * silu_f(bfhi(gv.x))); w.y = cvt2(o1[4 * q4 + 2] * inv * silu_f(bflo(gv.y)), o1[4 * q4 + 3] * inv * silu_f(bfhi(gv.y)));
              *(u32x2_t*)(op + d) = w; }
        }
    }
}
__device__ __forceinline__ void conv_vec(const Args& a, int vb, int nvb) {
    const bf16_t* PROJ = (const bf16_t*)(a.ws + WS_PROJ); bf16_t* YCAT = (bf16_t*)(a.ws + WS_YCAT);
    const float* conv_w = a.in[14]; const float* conv_b = a.in[15];
    const int gt = vb * 512 + otid(), NT = nvb * 512;
    for (int it = gt; it < (NTOK / 4) * 48; it += NT) {
        const int tg = it / 48, c0 = (it % 48) * 8, tok0 = tg * 4, t0 = tok0 % SEQ;
        const bf16_t* row0 = PROJ + (size_t)tok0 * DIN;
        v4u cc[6], ci[6], cb[4], cg[4];
#pragma unroll
        for (int r = 0; r < 6; ++r) { const bool ok = (t0 + r - 2) >= 0; const bf16_t* rp = row0 + (ptrdiff_t)(r - 2) * DIN;
            cc[r] = ok ? *(const v4u*)(rp + C_CC + c0) : (v4u){0u, 0u, 0u, 0u}; ci[r] = ok ? *(const v4u*)(rp + C_CIN + c0) : (v4u){0u, 0u, 0u, 0u}; }
#pragma unroll
        for (int j = 0; j < 4; ++j) { cb[j] = *(const v4u*)(row0 + (size_t)j * DIN + C_CB + c0); cg[j] = *(const v4u*)(row0 + (size_t)j * DIN + C_CGATE + c0); }
        float w[3][8], bb[8];
#pragma unroll
        for (int k = 0; k < 3; ++k) { const f32x4 w0 = *(const f32x4*)(conv_w + k * WSSM + c0), w1 = *(const f32x4*)(conv_w + k * WSSM + c0 + 4);
            w[k][0] = w0.x; w[k][1] = w0.y; w[k][2] = w0.z; w[k][3] = w0.w; w[k][4] = w1.x; w[k][5] = w1.y; w[k][6] = w1.z; w[k][7] = w1.w; }
        { const f32x4 b0 = *(const f32x4*)(conv_b + c0), b1 = *(const f32x4*)(conv_b + c0 + 4); bb[0] = b0.x; bb[1] = b0.y; bb[2] = b0.z; bb[3] = b0.w; bb[4] = b1.x; bb[5] = b1.y; bb[6] = b1.z; bb[7] = b1.w; }
        float u[6][8];
#pragma unroll
        for (int r = 0; r < 6; ++r) { u[r][0] = bflo(cc[r].x) * bflo(ci[r].x); u[r][1] = bfhi(cc[r].x) * bfhi(ci[r].x); u[r][2] = bflo(cc[r].y) * bflo(ci[r].y); u[r][3] = bfhi(cc[r].y) * bfhi(ci[r].y);
            u[r][4] = bflo(cc[r].z) * bflo(ci[r].z); u[r][5] = bfhi(cc[r].z) * bfhi(ci[r].z); u[r][6] = bflo(cc[r].w) * bflo(ci[r].w); u[r][7] = bfhi(cc[r].w) * bfhi(ci[r].w); }
#pragma unroll
        for (int j = 0; j < 4; ++j) { float y[8];
#pragma unroll
            for (int e = 0; e < 8; ++e) y[e] = bb[e] + w[0][e] * u[j][e] + w[1][e] * u[j + 1][e] + w[2][e] * u[j + 2][e];
            v4u o;
            o.x = cvt2(bflo(cb[j].x) * y[0] * silu_f(bflo(cg[j].x)), bfhi(cb[j].x) * y[1] * silu_f(bfhi(cg[j].x)));
            o.y = cvt2(bflo(cb[j].y) * y[2] * silu_f(bflo(cg[j].y)), bfhi(cb[j].y) * y[3] * silu_f(bfhi(cg[j].y)));
            o.z = cvt2(bflo(cb[j].z) * y[4] * silu_f(bflo(cg[j].z)), bfhi(cb[j].z) * y[5] * silu_f(bfhi(cg[j].z)));
            o.w = cvt2(bflo(cb[j].w) * y[6] * silu_f(bflo(cg[j].w)), bfhi(cb[j].w) * y[7] * silu_f(bfhi(cg[j].w)));
            *(v4u*)(YCAT + (size_t)(tok0 + j) * DM + WSSM + c0) = o; }
    }
}
__device__ __forceinline__ void final_norm(const Args& a) {
    const int tid = otid(), lane = tid & 63, gw = blockIdx.x * 8 + (tid >> 6), NGW = gridDim.x * 8;
    const float* fg = a.in[19];
    for (int r = gw; r < NTOK; r += NGW) {
        f32x4* xr = (f32x4*)(a.out + (size_t)r * DM) + lane;
        f32x4 v[4]; float s = 0.f;
#pragma unroll
        for (int j = 0; j < 4; ++j) { v[j] = xr[64 * j]; s += (v[j].x * v[j].x + v[j].y * v[j].y) + (v[j].z * v[j].z + v[j].w * v[j].w); }
        const float rstd = 1.0f / sqrtf(wave_sum(s) * (1.0f / DM) + NORM_EPS);
#pragma unroll
        for (int j = 0; j < 4; ++j) { const f32x4 g = ((const f32x4*)fg)[lane + 64 * j]; xr[64 * j] = v[j] * rstd * g; }
    }
}

__global__ void __launch_bounds__(512, 2) mega(Args a) {
    extern __shared__ __attribute__((aligned(16))) unsigned char smem_raw[];
    LAS unsigned char* lds = (LAS unsigned char*)smem_raw;
    cg::grid_group grid = cg::this_grid();
    volatile LAS unsigned* xst = (volatile LAS unsigned*)(lds + 139264);
    if (threadIdx.x == 0) { xst[0] = 0u; xst[1] = 0u; }
    { unsigned* ctl = (unsigned*)(a.ws + WS_CTL); unsigned* flag = ctl + CTL_FLAG_WORD;
      if (blockIdx.x == 0) { for (int i = threadIdx.x; i < 8192; i += 512) __hip_atomic_store(ctl + i, 0u, __ATOMIC_RELAXED, __HIP_MEMORY_SCOPE_AGENT);
          asm volatile("s_waitcnt vmcnt(0)" ::: "memory"); __syncthreads();
          if (threadIdx.x == 0) { __builtin_amdgcn_fence(__ATOMIC_RELEASE, "agent"); __hip_atomic_store(flag, CTL_TOKEN, __ATOMIC_RELAXED, __HIP_MEMORY_SCOPE_AGENT); } }
      if (threadIdx.x == 0) { unsigned sp = 0; while (__hip_atomic_load(flag, __ATOMIC_RELAXED, __HIP_MEMORY_SCOPE_AGENT) != CTL_TOKEN) { __builtin_amdgcn_s_sleep(1); if (++sp > (1u << 22)) break; }
          __builtin_amdgcn_fence(__ATOMIC_ACQUIRE, "agent"); } }
    __syncthreads();
    const XcdBarrier xbar = xcd_barrier_post((unsigned*)(a.ws + WS_CTL), xst);
    const int bid = blockIdx.x, G = gridDim.x;
    bf16_t* XB = (bf16_t*)(a.ws + WS_XB); bf16_t* MEMN = (bf16_t*)(a.ws + WS_MEMN);
    bf16_t* WINT = (bf16_t*)(a.ws + WS_WINT); bf16_t* WKVT = (bf16_t*)(a.ws + WS_WKVT); bf16_t* WOUTT = (bf16_t*)(a.ws + WS_WOUTT); bf16_t* WGLUT = (bf16_t*)(a.ws + WS_WGLUT);
    bf16_t* PROJ = (bf16_t*)(a.ws + WS_PROJ); bf16_t* KV = (bf16_t*)(a.ws + WS_KV); bf16_t* GB = (bf16_t*)(a.ws + WS_GB); bf16_t* YCAT = (bf16_t*)(a.ws + WS_YCAT);
    bf16_t* AY = (bf16_t*)(a.ws + WS_AY); bf16_t* WSb = (bf16_t*)(a.ws + WS_WS); bf16_t* WYb = (bf16_t*)(a.ws + WS_WY);

#ifndef PROBE_DUP
#define PROBE_DUP -1
#endif
#define REPS(k) for (int rep_ = 0; rep_ < ((PROBE_DUP == (k)) ? 2 : 1); ++rep_)
#ifndef PROBE_SUB
#define PROBE_SUB -1
#endif
    if (a.out == nullptr) grid.sync();
    REPS(0) { phase0(a, lds);
    xcd_barrier(xbar); }
    REPS(1) {
    { pg8::Order S; S.init(NTOK / 256, DIN / 256, 1, G, bid);
      pg8::gemm_phase<true, true>(lds, pg8::Gemm{XB, WINT, DM, DM, DM, 0, 0}, S, pg8::EpiProjAY{PROJ, AY}); }
    { pg8::Order S; S.init(NB * NMEM / 256, 512 / 256, 1, G, (bid + G - ((NTOK / 256) * (DIN / 256)) % G) % G);
      pg8::gemm_phase<false, true>(lds, pg8::Gemm{MEMN, WKVT, DM, DM, DM, 0, 0}, S, pg8::EpiBf16Store{KV, 512}); }
    xcd_barrier(xbar); }
    REPS(2) {
    if (bid < NB * NG) { pg8::Order S; S.init(NB, 1, NG, G, bid);
      pg8::gemm_phase<false, true>(lds, pg8::Gemm{AY, WSb, 512, 256, 256, (size_t)1024 * 512, (size_t)256 * 256}, S, pg8::EpiSend{AY, (const float*)(a.ws + WS_LAMT), (const float*)(a.ws + WS_LAM512)});
      asm volatile("s_waitcnt vmcnt(0)" ::: "memory"); __syncthreads();
      pg8::gemm_phase<false, true>(lds, pg8::Gemm{AY, WYb, 512, 512, 384, (size_t)1024 * 512, (size_t)256 * 512}, S, pg8::EpiY{AY, a.in[10], GB}); }
    else { attn_mfma(a, lds, bid - NB * NG, G - NB * NG); conv_vec(a, bid - NB * NG, G - NB * NG); }
    xcd_barrier(xbar); }
    REPS(4) {
    { pg8::Order S; S.init(NTOK / 256, 2, 2, G, bid);
      pg8::gemm_phase<false, true>(lds, pg8::Gemm{GB, WGLUT, WSSM, WSSM, WSSM, 0, 0}, S, pg8::EpiGluP{GB, PROJ, a.in[13], YCAT}); }
    xcd_barrier(xbar); }
    REPS(5) {
    { pg8::Order S; S.init(NTOK / 256, DM / 256, 1, G, bid);
      pg8::gemm_phase<false, true>(lds, pg8::Gemm{YCAT, WOUTT, DM, DM, DM, 0, 0}, S, pg8::EpiOutNorm{a.in[0], a.in[19], a.out, (float*)(a.ws + WS_XCH), (unsigned*)(a.ws + WS_CTL + CTL_PANEL)}); }
    }
    __syncthreads();
    if (threadIdx.x == 0) { unsigned* ctl = (unsigned*)(a.ws + WS_CTL);
        const unsigned old_ = __hip_atomic_fetch_add(ctl + CTL_EXIT_WORD, 1u, __ATOMIC_RELAXED, __HIP_MEMORY_SCOPE_AGENT);
        if (old_ == (unsigned)G - 1u) __hip_atomic_store(ctl + CTL_FLAG_WORD, CTL_RESET, __ATOMIC_RELAXED, __HIP_MEMORY_SCOPE_AGENT); }
}

extern "C" void kernel_launch(void* const* d_in, const int* in_sizes, int n_in, void* d_out, int out_size, void* d_ws, size_t ws_size, hipStream_t stream) {
    static int grid = 0;
    if (grid == 0) {
        if (n_in != 20 || out_size != NTOK * DM || ws_size < WS_END) { fprintf(stderr, "kernel_launch: unexpected shapes n_in %d out %d ws %zu\n", n_in, out_size, ws_size); grid = -1; return; }
        int dev = 0, cus = 0, per_cu = 0;
        hipGetDevice(&dev);
        hipDeviceGetAttribute(&cus, hipDeviceAttributeMultiprocessorCount, dev);
        if (hipFuncSetAttribute((const void*)mega, hipFuncAttributeMaxDynamicSharedMemorySize, LDS_BYTES) != hipSuccess) { fprintf(stderr, "kernel_launch: hipFuncSetAttribute failed\n"); grid = -1; return; }
        if (hipOccupancyMaxActiveBlocksPerMultiprocessor(&per_cu, (const void*)mega, 512, LDS_BYTES) != hipSuccess || per_cu < 1) { fprintf(stderr, "kernel_launch: occupancy query says %d\n", per_cu); per_cu = 1; }
        (void)hipGetLastError();
        grid = cus;
        if (grid != 256) { fprintf(stderr, "kernel_launch: built for 256 CUs (one workgroup each), device has %d\n", grid); grid = -1; return; }
        if (grid < NB * NG) { fprintf(stderr, "kernel_launch: grid %d too small\n", grid); grid = -1; return; }
    }
    if (grid < 0) return;
    Args a{};
    for (int i = 0; i < 20; ++i) a.in[i] = (const float*)d_in[i];
    a.out = (float*)d_out; a.ws = (unsigned char*)d_ws;
    void* args[] = {&a};
    hipError_t e = hipLaunchCooperativeKernel((const void*)mega, dim3(grid), dim3(512), args, LDS_BYTES, stream);
    if (e != hipSuccess) fprintf(stderr, "cooperative launch failed: %s (grid %d)\n", hipGetErrorString(e), grid);
}
```

```cpp
#include <hip/hip_runtime.h>
#include <hip/hip_cooperative_groups.h>
#include <cstdio>
#include <cstdint>
namespace cg = cooperative_groups;

#define LAS __attribute__((address_space(3)))
typedef unsigned short bf16_t;
typedef unsigned v4u __attribute__((ext_vector_type(4)));
typedef float f32x4 __attribute__((ext_vector_type(4)));

constexpr int NB = 4, SEQ = 4096, DM = 1024, NTOK = NB * SEQ, DIN = 2816, WSSM = 384, NG = 24, GH = 16, NP = 64, NMEM = 256;
constexpr int C_AIN = 0, C_AGATE = 384, C_CIN = 768, C_CB = 1152, C_CC = 1536, C_CGATE = 1920, C_Q = 2304, C_QGATE = 2560;
constexpr float NORM_EPS = 1e-6f;

constexpr size_t MiB = 1u << 20;
constexpr size_t WS_CTL = 0;
constexpr size_t WS_XB = 1 * MiB;
constexpr size_t WS_WINT = 33 * MiB;
constexpr size_t WS_WKVT = 39 * MiB;
constexpr size_t WS_WOUTT = 40 * MiB;
constexpr size_t WS_WGLUT = 42 * MiB;
constexpr size_t WS_MEMN = 43 * MiB;
constexpr size_t WS_KV = 45 * MiB;
constexpr size_t WS_LAMB = 46 * MiB;
constexpr size_t WS_BBAR = 46 * MiB + 65536;
constexpr size_t WS_GB = 47 * MiB;
constexpr size_t WS_PROJ = 59 * MiB;
constexpr size_t WS_YCAT = 147 * MiB;
constexpr size_t WS_AY = 179 * MiB;
constexpr size_t WS_WS = 203 * MiB;
constexpr size_t WS_WY = 206 * MiB;
constexpr size_t WS_LAMT = 212 * MiB;
constexpr size_t WS_LAM512 = 212 * MiB + 65536;
constexpr size_t WS_XCH = 213 * MiB;
constexpr size_t WS_RINV = 214 * MiB;
constexpr size_t WS_END = 215 * MiB;
constexpr size_t CTL_PANEL = 16384;
constexpr size_t CTL_BYTES = 32768;
constexpr int CTL_EXIT_WORD = 3968, CTL_FLAG_WORD = 8192 + 64;
constexpr unsigned CTL_TOKEN = 0x600DF00Du, CTL_RESET = 0x0BADF00Du;

constexpr int LDS_BYTES = 147456;

struct Args {
    const float* in[20];
    float* out;
    unsigned char* ws;
};

__device__ __forceinline__ unsigned f2bf(float f) { unsigned u = __builtin_bit_cast(unsigned, f); return (u + 0x7fffu + ((u >> 16) & 1u)) >> 16; }
__device__ __forceinline__ unsigned pk2(float lo, float hi) { return f2bf(lo) | (f2bf(hi) << 16); }
__device__ __forceinline__ float bf2f(unsigned short b) { return __builtin_bit_cast(float, ((unsigned)b) << 16); }
__device__ __forceinline__ float bflo(unsigned w) { return __builtin_bit_cast(float, w << 16); }
__device__ __forceinline__ float bfhi(unsigned w) { return __builtin_bit_cast(float, w & 0xffff0000u); }
__device__ __forceinline__ float wave_sum(float v) {
#pragma unroll
    for (int o = 1; o < 64; o <<= 1) v += __shfl_xor(v, o);
    return v;
}
__device__ __forceinline__ float silu_f(float v) { return v * __builtin_amdgcn_rcpf(1.0f + __builtin_amdgcn_exp2f(-1.4426950408889634f * v)); }
__device__ __forceinline__ float sigmoid_f(float v) { return __builtin_amdgcn_rcpf(1.0f + __builtin_amdgcn_exp2f(-1.4426950408889634f * v)); }
__device__ __forceinline__ float gelu_tanh(float v) { const float w = __builtin_fmaf(v * v, -0.10294324f, -2.3022082f); return v * __builtin_amdgcn_rcpf(1.0f + __builtin_amdgcn_exp2f(v * w)); }
#define LDS_WAIT() asm volatile("s_waitcnt lgkmcnt(0)" ::: "memory")
__device__ __forceinline__ int otid() { int t = threadIdx.x; asm volatile("" : "+v"(t)); return t; }

#define XB_TMO      128
#define XB_XCNT(j)  (256  + 64 * (j))
#define XB_XSUB(j)  (1280 + 64 * (j))
#define XB_XGEN(j)  (2304 + 64 * (j))
#define XB_TOP      3328
#define XB_TOPGEN   3392
#define XCD_BAR_WORDS 3456
#define XB_SPIN_CAP (1u << 18)

__device__ __forceinline__ unsigned xb_ld(unsigned* p)              { return __hip_atomic_load(p, __ATOMIC_RELAXED, __HIP_MEMORY_SCOPE_AGENT); }
__device__ __forceinline__ unsigned xb_add(unsigned* p, unsigned v) { return __hip_atomic_fetch_add(p, v, __ATOMIC_RELAXED, __HIP_MEMORY_SCOPE_AGENT); }
__device__ __forceinline__ unsigned xb_xcc_id() { return (unsigned)__builtin_amdgcn_s_getreg((3 << 11) | 20) & 0xFu; }
#define XB_SPIN(cond, bar) do { unsigned _sp = 0; while (cond) { __builtin_amdgcn_s_sleep(1); \
    if ((++_sp & 255u) == 0u) { if (xb_ld(&(bar)[XB_TMO])) break; if (_sp > XB_SPIN_CAP) { atomicAdd(&(bar)[XB_TMO], 1u); break; } } } } while (0)

struct XcdBarrier {
    unsigned* bar; unsigned x;
    volatile LAS unsigned* st;
};

__device__ __forceinline__ XcdBarrier xcd_barrier_post(unsigned* bar, volatile LAS unsigned* st) {
    XcdBarrier b; b.bar = bar; b.x = xb_xcc_id(); b.st = st;
    if (threadIdx.x == 0) (void)xb_add(&bar[XB_XCNT(b.x)], 1u);
    return b;
}
__device__ __forceinline__ void xcd_barrier_complete(unsigned* bar, unsigned x, unsigned& nloc, unsigned& nx) {
    const unsigned G = gridDim.x * gridDim.y * gridDim.z;
    unsigned sum, cnt, mine, sp = 0u;
    for (;;) {
        sum = 0u; cnt = 0u; mine = 0u;
#pragma unroll
        for (unsigned j = 0; j < 16; ++j) { const unsigned c = xb_ld(&bar[XB_XCNT(j)]); sum += c; cnt += (c > 0u) ? 1u : 0u; mine = (j == x) ? c : mine; }
        if (sum == G) break;
        __builtin_amdgcn_s_sleep(1);
        if ((++sp & 255u) == 0u) { if (xb_ld(&bar[XB_TMO])) break; if (sp > XB_SPIN_CAP) { atomicAdd(&bar[XB_TMO], 1u); break; } }
    }
    nloc = mine > 0u ? mine : 1u; nx = cnt > 0u ? cnt : 1u;
}

__device__ __forceinline__ void xcd_barrier(const XcdBarrier& b) {
    asm volatile("s_waitcnt vmcnt(0)" ::: "memory");
    __syncthreads();
    if (threadIdx.x == 0) {
        unsigned* bar = b.bar;
        __builtin_amdgcn_s_waitcnt(0);
        unsigned nloc = b.st[0], nx = b.st[1];
        if (nloc == 0u) { xcd_barrier_complete(bar, b.x, nloc, nx); b.st[0] = nloc; b.st[1] = nx; }
        const unsigned old = xb_add(&bar[XB_XSUB(b.x)], 1u);
        const unsigned gen = old / nloc;
        if (old + 1u == (gen + 1u) * nloc) {
            __builtin_amdgcn_fence(__ATOMIC_RELEASE, "agent");
            asm volatile("s_waitcnt vmcnt(0)" ::: "memory");
            const unsigned og = xb_add(&bar[XB_TOP], 1u);
            const unsigned tg = og / nx;
            if (og + 1u == (tg + 1u) * nx) xb_add(&bar[XB_TOPGEN], 1u);
            else XB_SPIN(xb_ld(&bar[XB_TOPGEN]) == tg, bar);
            __builtin_amdgcn_fence(__ATOMIC_ACQUIRE, "agent");
            xb_add(&bar[XB_XGEN(b.x)], 1u);
            asm volatile("s_waitcnt vmcnt(0)" ::: "memory");
        } else {
            XB_SPIN(xb_ld(&bar[XB_XGEN(b.x)]) == gen, bar);
            __builtin_amdgcn_fence(__ATOMIC_ACQUIRE, "agent");
            asm volatile("s_waitcnt vmcnt(0)" ::: "memory");
        }
    }
    __syncthreads();
}

__device__ __forceinline__ void rms_row_to_bf16(const float* xrow, bf16_t* orow, const float* gain, int lane) {
    const f32x4* xr = (const f32x4*)xrow + lane;
    f32x4 v[4]; float s = 0.f;
#pragma unroll
    for (int j = 0; j < 4; ++j) { v[j] = xr[64 * j]; s += (v[j].x * v[j].x + v[j].y * v[j].y) + (v[j].z * v[j].z + v[j].w * v[j].w); }
    const float rstd = 1.0f / sqrtf(wave_sum(s) * (1.0f / DM) + NORM_EPS);
    unsigned long long* o8 = (unsigned long long*)orow + lane;
#pragma unroll
    for (int j = 0; j < 4; ++j) {
        f32x4 g = gain ? ((const f32x4*)gain)[lane + 64 * j] : (f32x4){1.f, 1.f, 1.f, 1.f};
        o8[64 * j] = (unsigned long long)pk2(v[j].x * rstd * g.x, v[j].y * rstd * g.y) | ((unsigned long long)pk2(v[j].z * rstd * g.z, v[j].w * rstd * g.w) << 32);
    }
}
__device__ __forceinline__ void transpose_item(const float* W, int K, int N, bf16_t* WT, const float* ks, LAS float* scr, int item, int lane) {
    const int nblk = N / 32, kb = item / nblk, nb = item % nblk, k0 = 64 * kb, n0 = 32 * nb;
#pragma unroll 8
    for (int i = 0; i < 32; ++i) { const int kk = 2 * i + (lane >> 5); float w = W[(size_t)(k0 + kk) * N + n0 + (lane & 31)]; if (ks) w *= ks[k0 + kk]; scr[kk * 33 + (lane & 31)] = w; }
    LDS_WAIT();
    const int c = lane & 7;
#pragma unroll
    for (int j = 0; j < 4; ++j) { const int n = (lane >> 3) + 8 * j; const LAS float* s = scr + (8 * c) * 33 + n;
        v4u o; o.x = pk2(s[0 * 33], s[1 * 33]); o.y = pk2(s[2 * 33], s[3 * 33]); o.z = pk2(s[4 * 33], s[5 * 33]); o.w = pk2(s[6 * 33], s[7 * 33]);
        *(v4u*)(WT + (size_t)(n0 + n) * K + k0 + 8 * c) = o; }
    LDS_WAIT();
}


__device__ __forceinline__ void s5_tables(const Args& a, LAS unsigned char* lds, int tid) {
    const int bid = blockIdx.x; if (bid >= 192) return;
    const int g = bid % NG, q = bid / NG;
    const float* lam_re = a.in[4]; const float* lam_im = a.in[5]; const float* b_re = a.in[6]; const float* b_im = a.in[7]; const float* c_re = a.in[8]; const float* c_im = a.in[9]; const float* log_dt = a.in[11];
    LAS float* LPr = (LAS float*)(lds + 69632); LAS float* LPi = LPr + 17 * 64; LAS float* BBr = LPi + 17 * 64; LAS float* BBi = BBr + 1024;
    LAS float* Cr = BBi + 1024; LAS float* Ci = Cr + 1024; LAS float* KT = Ci + 1024;
    if (tid < 64) {
        const int p = tid, i = g * NP + p;
        const double dt = exp((double)log_dt[g]);
        const double lr = lam_re[i], li = lam_im[i];
        const double er = exp(lr * dt), ang = li * dt;
        const double lbr = er * cos(ang), lbi = er * sin(ang);
        const double nr = lbr - 1.0, ni = lbi, den = lr * lr + li * li;
        const double qr = (nr * lr + ni * li) / den, qi = (ni * lr - nr * li) / den;
        for (int h = 0; h < GH; ++h) { const double br = b_re[i * GH + h], bi = b_im[i * GH + h];
            BBr[p * 16 + h] = (float)(qr * br - qi * bi); BBi[p * 16 + h] = (float)(qr * bi + qi * br); }
        double pr = 1.0, pi = 0.0;
        for (int t = 0; t < 16; ++t) { LPr[t * 64 + p] = (float)pr; LPi[t * 64 + p] = (float)pi; const double nr2 = pr * lbr - pi * lbi, ni2 = pr * lbi + pi * lbr; pr = nr2; pi = ni2; }
        LPr[16 * 64 + p] = (float)pr; LPi[16 * 64 + p] = (float)pi;
        double tr = pr, ti = pi;
        if (q == 0) { float* LAMT = (float*)(a.ws + WS_LAMT); LAMT[2 * i] = (float)tr; LAMT[2 * i + 1] = (float)ti; }
        for (int k = 0; k < 5; ++k) { const double nr2 = tr * tr - ti * ti, ni2 = 2.0 * tr * ti; tr = nr2; ti = ni2; }
        if (q == 0) { float* L512 = (float*)(a.ws + WS_LAM512); L512[2 * i] = (float)tr; L512[2 * i + 1] = (float)ti; }
    }
    for (int i = tid; i < 1024; i += 512) { Cr[i] = c_re[g * 1024 + i]; Ci[i] = c_im[g * 1024 + i]; }
    __syncthreads();
    { const int tau = tid >> 5, hol = (tid >> 4) & 1, hi = tid & 15, ho = 2 * q + hol; float sacc = 0.f;
#pragma unroll 4
      for (int p = 0; p < 64; ++p) { const float lpr = LPr[tau * 64 + p], lpi = LPi[tau * 64 + p], br = BBr[p * 16 + hi], bi = BBi[p * 16 + hi];
          const float wr_ = lpr * br - lpi * bi, wi_ = lpr * bi + lpi * br; sacc += Cr[ho * 64 + p] * wr_ - Ci[ho * 64 + p] * wi_; }
      KT[tid] = sacc; }
    __syncthreads();
    bf16_t* WSb = (bf16_t*)(a.ws + WS_WS); bf16_t* WYb = (bf16_t*)(a.ws + WS_WY);
#pragma unroll
    for (int kk = 0; kk < 2; ++kk) { const int ch = tid + 512 * kk, n = 32 * q + (ch >> 5), k0 = (ch & 31) * 8, p = n & 63, isim = (n >> 6) & 1;
        float v[8];
#pragma unroll
        for (int j = 0; j < 8; ++j) { const int k = k0 + j, t = k >> 4, h = k & 15, tau = 15 - t; const float lpr = LPr[tau * 64 + p], lpi = LPi[tau * 64 + p], br = BBr[p * 16 + h], bi = BBi[p * 16 + h];
            const float val = isim ? (lpr * bi + lpi * br) : (lpr * br - lpi * bi); v[j] = n < 128 ? val : 0.f; }
        v4u o; o.x = pk2(v[0], v[1]); o.y = pk2(v[2], v[3]); o.z = pk2(v[4], v[5]); o.w = pk2(v[6], v[7]);
        *(v4u*)(WSb + ((size_t)(g * 256 + n)) * 256 + k0) = o; }
#pragma unroll
    for (int kk = 0; kk < 4; ++kk) { const int ch = tid + 512 * kk, rr = ch >> 6, to = rr >> 1, hol = rr & 1, ho = 2 * q + hol, n = to * 16 + ho, k0 = (ch & 63) * 8;
        float v[8];
#pragma unroll
        for (int j = 0; j < 8; ++j) { const int k = k0 + j; float val;
            if (k < 256) { const int ti = k >> 4, hi = k & 15; val = ti <= to ? KT[((to - ti) * 2 + hol) * 16 + hi] : 0.f; }
            else { const int jj = (k - 256) & 127, p = jj & 63, isim = jj >> 6; const float lpr = LPr[(to + 1) * 64 + p], lpi = LPi[(to + 1) * 64 + p], cr = Cr[ho * 64 + p], ci = Ci[ho * 64 + p];
                val = isim ? -(cr * lpi + ci * lpr) : (cr * lpr - ci * lpi); }
            v[j] = val; }
        v4u o; o.x = pk2(v[0], v[1]); o.y = pk2(v[2], v[3]); o.z = pk2(v[4], v[5]); o.w = pk2(v[6], v[7]);
        *(v4u*)(WYb + ((size_t)(g * 256 + n)) * 512 + k0) = o; }
}

__device__ __forceinline__ void rms_rows2_to_bf16(const float* x0, const float* x1, bf16_t* o0, bf16_t* o1, const float* gain, int lane, float* rinv = nullptr) {
    const f32x4* xr0 = (const f32x4*)x0 + lane; const f32x4* xr1 = (const f32x4*)x1 + lane;
    f32x4 v[4], w[4]; float s0 = 0.f, s1 = 0.f;
#pragma unroll
    for (int j = 0; j < 4; ++j) { v[j] = __builtin_nontemporal_load(xr0 + 64 * j); w[j] = __builtin_nontemporal_load(xr1 + 64 * j); }
#pragma unroll
    for (int j = 0; j < 4; ++j) { s0 += (v[j].x * v[j].x + v[j].y * v[j].y) + (v[j].z * v[j].z + v[j].w * v[j].w); s1 += (w[j].x * w[j].x + w[j].y * w[j].y) + (w[j].z * w[j].z + w[j].w * w[j].w); }
#pragma unroll
    for (int o = 1; o < 64; o <<= 1) { s0 += __shfl_xor(s0, o); s1 += __shfl_xor(s1, o); }
    const float q0 = sqrtf(s0 * (1.0f / DM) + NORM_EPS), q1 = sqrtf(s1 * (1.0f / DM) + NORM_EPS);
    const float r0 = 1.0f / q0, r1 = 1.0f / q1;
    if (rinv && lane == 0) { rinv[0] = q0; rinv[1] = q1; }
    unsigned long long* p0 = (unsigned long long*)o0 + lane; unsigned long long* p1 = (unsigned long long*)o1 + lane;
#pragma unroll
    for (int j = 0; j < 4; ++j) {
        const f32x4 g = gain ? ((const f32x4*)gain)[lane + 64 * j] : (f32x4){1.f, 1.f, 1.f, 1.f};
        p0[64 * j] = (unsigned long long)pk2(v[j].x * r0 * g.x, v[j].y * r0 * g.y) | ((unsigned long long)pk2(v[j].z * r0 * g.z, v[j].w * r0 * g.w) << 32);
        p1[64 * j] = (unsigned long long)pk2(w[j].x * r1 * g.x, w[j].y * r1 * g.y) | ((unsigned long long)pk2(w[j].z * r1 * g.z, w[j].w * r1 * g.w) << 32);
    }
}
__device__ __forceinline__ void transpose_item4(const float* W, int K, int N, bf16_t* WT, const float* ks, LAS float* scr, int item, int lane) {
    const int nblk = N / 32, kb = item / nblk, nb = item % nblk, k0 = 64 * kb, n0 = 32 * nb;
    f32x4 w[8];
#pragma unroll
    for (int i = 0; i < 8; ++i) { const int kk = 8 * i + (lane >> 3); w[i] = __builtin_nontemporal_load((const f32x4*)(W + (size_t)(k0 + kk) * N + n0 + 4 * (lane & 7))); }
#pragma unroll
    for (int i = 0; i < 8; ++i) { const int kk = 8 * i + (lane >> 3); const float sc = ks ? ks[k0 + kk] : 1.0f; LAS float* d = scr + kk * 33 + 4 * (lane & 7);
        d[0] = w[i].x * sc; d[1] = w[i].y * sc; d[2] = w[i].z * sc; d[3] = w[i].w * sc; }
    LDS_WAIT();
    const int c = lane & 7;
#pragma unroll
    for (int j = 0; j < 4; ++j) { const int n = (lane >> 3) + 8 * j; const LAS float* sp = scr + (8 * c) * 33 + n;
        v4u o; o.x = pk2(sp[0 * 33], sp[1 * 33]); o.y = pk2(sp[2 * 33], sp[3 * 33]); o.z = pk2(sp[4 * 33], sp[5 * 33]); o.w = pk2(sp[6 * 33], sp[7 * 33]);
        *(v4u*)(WT + (size_t)(n0 + n) * K + k0 + 8 * c) = o; }
    LDS_WAIT();
}

__device__ __forceinline__ void phase0(const Args& a, LAS unsigned char* lds) {
    const int tid = otid(), lane = tid & 63, wave = tid >> 6;
    const int gw = blockIdx.x * 8 + wave, NGW = gridDim.x * 8;
    s5_tables(a, lds, tid);
    const float* x = a.in[0]; const float* mem = a.in[1]; const float* norm_g = a.in[2]; const float* w_in = a.in[3];
    const float* w_glu = a.in[12]; const float* mem_norm_g = a.in[16]; const float* w_mem_kv = a.in[17]; const float* w_out = a.in[18];
    bf16_t* XB = (bf16_t*)(a.ws + WS_XB); bf16_t* MEMN = (bf16_t*)(a.ws + WS_MEMN);
    bf16_t* WINT = (bf16_t*)(a.ws + WS_WINT); bf16_t* WKVT = (bf16_t*)(a.ws + WS_WKVT); bf16_t* WOUTT = (bf16_t*)(a.ws + WS_WOUTT); bf16_t* WGLUT = (bf16_t*)(a.ws + WS_WGLUT);
    for (int rnd = 0; rnd < 5; ++rnd) { const int r2 = rnd < 4 ? rnd * NGW + gw : 4 * NGW + (gw - 1536); if (rnd == 4 && (gw < 1536 || r2 >= (NTOK + NB * NMEM) / 2)) break; const int r = 2 * r2;
        if (r < NTOK) rms_rows2_to_bf16(x + (size_t)r * DM, x + (size_t)(r + 1) * DM, XB + (size_t)r * DM, XB + (size_t)(r + 1) * DM, nullptr, lane, (float*)(a.ws + WS_RINV) + r);
        else { const int m = r - NTOK; rms_rows2_to_bf16(mem + (size_t)m * DM, mem + (size_t)(m + 1) * DM, MEMN + (size_t)m * DM, MEMN + (size_t)(m + 1) * DM, mem_norm_g, lane); }
    }
    LAS float* scr = (LAS float*)(lds + wave * 8448);
    constexpr int I_IN = (DM / 64) * (DIN / 32), I_KV = (DM / 64) * (512 / 32), I_OUT = (DM / 64) * (DM / 32), I_GLU = (WSSM / 64) * (WSSM / 32);
    for (int rnd = 0; rnd < 2; ++rnd) { const int it = rnd == 0 ? gw : NGW + (gw - 1536); if (rnd == 1 && (gw < 1536 || it >= I_IN + I_KV + I_OUT + I_GLU)) break;
        int r = it;
        if (r < I_IN) { transpose_item4(w_in, DM, DIN, WINT, norm_g, scr, r, lane); continue; } r -= I_IN;
        if (r < I_KV) { transpose_item4(w_mem_kv, DM, 512, WKVT, nullptr, scr, r, lane); continue; } r -= I_KV;
        if (r < I_OUT) { transpose_item4(w_out, DM, DM, WOUTT, nullptr, scr, r, lane); continue; } r -= I_OUT;
        transpose_item4(w_glu, WSSM, WSSM, WGLUT, nullptr, scr, r, lane);
    }
    const int gt = blockIdx.x * 512 + tid, NT = gridDim.x * 512;
    for (int i = gt; i < 128 * 384 / 2; i += NT) ((unsigned*)(WGLUT + 384 * 384))[i] = 0u;
}

template <class Epi>
__device__ __forceinline__ void gemm_naive(const bf16_t* A, int lda, const bf16_t* Bt, int ldb, int M, int N, int K, LAS unsigned char* lds, int tile0, int ntile_total, const Epi& epi) {
    LAS float* As = (LAS float*)lds;
    LAS float* Bs = As + 32 * 132;
    const int tid = threadIdx.x, ty = tid >> 4, tx = tid & 15;
    const int ntn = N / 64, nt = (M / 128) * ntn;
    (void)ntile_total;
    for (int tile = blockIdx.x - tile0; tile < nt; tile += gridDim.x) {
        if (tile < 0) continue;
        const int tm = tile / ntn, tn = tile % ntn;
        float acc[4][4];
#pragma unroll
        for (int i = 0; i < 4; ++i)
#pragma unroll
            for (int j = 0; j < 4; ++j) acc[i][j] = 0.f;
        for (int k0 = 0; k0 < K; k0 += 32) {
            __syncthreads();
            { const int r = tid >> 2, kc = (tid & 3) * 8; const v4u v = *(const v4u*)(A + (size_t)(tm * 128 + r) * lda + k0 + kc);
              As[(kc + 0) * 132 + r] = bflo(v.x); As[(kc + 1) * 132 + r] = bfhi(v.x); As[(kc + 2) * 132 + r] = bflo(v.y); As[(kc + 3) * 132 + r] = bfhi(v.y);
              As[(kc + 4) * 132 + r] = bflo(v.z); As[(kc + 5) * 132 + r] = bfhi(v.z); As[(kc + 6) * 132 + r] = bflo(v.w); As[(kc + 7) * 132 + r] = bfhi(v.w); }
            if (tid < 256) { const int r = tid >> 2, kc = (tid & 3) * 8; const v4u v = *(const v4u*)(Bt + (size_t)(tn * 64 + r) * ldb + k0 + kc);
              Bs[(kc + 0) * 68 + r] = bflo(v.x); Bs[(kc + 1) * 68 + r] = bfhi(v.x); Bs[(kc + 2) * 68 + r] = bflo(v.y); Bs[(kc + 3) * 68 + r] = bfhi(v.y);
              Bs[(kc + 4) * 68 + r] = bflo(v.z); Bs[(kc + 5) * 68 + r] = bfhi(v.z); Bs[(kc + 6) * 68 + r] = bflo(v.w); Bs[(kc + 7) * 68 + r] = bfhi(v.w); }
            __syncthreads();
#pragma unroll 8
            for (int k = 0; k < 32; ++k) {
                const f32x4 av = *(const LAS f32x4*)(As + k * 132 + ty * 4), bv = *(const LAS f32x4*)(Bs + k * 68 + tx * 4);
#pragma unroll
                for (int i = 0; i < 4; ++i)
#pragma unroll
                    for (int j = 0; j < 4; ++j) acc[i][j] += av[i] * bv[j];
            }
        }
#pragma unroll
        for (int i = 0; i < 4; ++i)
#pragma unroll
            for (int j = 0; j < 4; ++j) epi(tm * 128 + ty * 4 + i, tn * 64 + tx * 4 + j, acc[i][j]);
    }
}

struct EpiStoreBf16 { bf16_t* O; int ldo; __device__ __forceinline__ void operator()(int r, int c, float v) const { O[(size_t)r * ldo + c] = (bf16_t)f2bf(v); } };
struct EpiGlu { const bf16_t* GB; const bf16_t* PROJ; const float* b_glu; bf16_t* YCAT;
    __device__ __forceinline__ void operator()(int r, int c, float v) const {
        const float g = bf2f(GB[(size_t)r * WSSM + c]); const float gate = bf2f(PROJ[(size_t)r * DIN + C_AGATE + c]);
        YCAT[(size_t)r * DM + c] = (bf16_t)f2bf(g * sigmoid_f(v + b_glu[c]) * silu_f(gate)); } };
struct EpiOut { const float* x; float* out; __device__ __forceinline__ void operator()(int r, int c, float v) const { out[(size_t)r * DM + c] = x[(size_t)r * DM + c] + v; } };


namespace pg8 {
typedef short bf16x8 __attribute__((ext_vector_type(8)));
typedef unsigned u32x4 __attribute__((ext_vector_type(4)));
constexpr int BM = 256, BK = 64, HALF = 128, HTB = HALF * BK * 2, STAGE_BYTES = 8 * HTB, NXCD = 8, WGM = 8;
__host__ __device__ __forceinline__ int lds_byte(int r, int c) { const int st = (r >> 4) * 2 + (c >> 5), rr = r & 15, cc = c & 31, ob = rr * 64 + cc * 2; return st * 1024 + (ob ^ (((ob >> 9) & 1) << 5)); }
__host__ __device__ __forceinline__ void stage_rc(int b, int& R, int& C) { const int st = b / 1024, sb = b % 1024, swz = sb ^ (((sb >> 9) & 1) << 5); R = (st >> 1) * 16 + swz / 64; C = (st & 1) * 32 + (swz % 64) / 2; }
__host__ __device__ __forceinline__ int perm32(int rho) { const int n = rho >> 4, i = rho & 15; return 8 * (i >> 2) + 4 * n + (i & 3); }
struct Unit { int pm, pn, z; };
struct Gemm { const bf16_t* A; const bf16_t* Bt; int lda, ldb, K; size_t sAz, sBz; };
struct Order {
    int nM, nN, per, total, G, c;
    __device__ void init(int nM_, int nN_, int nZ_, int G_, int c_) { nM = nM_; nN = nN_; per = nM_ * nN_; total = per * nZ_; G = G_; c = c_; }
    __device__ bool next(int i, Unit& u) const {
        const long L = (long)i * G + c; if (L >= total) return false;
        u.z = (int)(L / per); int wgid = (int)(L % per); const int nwg = per;
        { const int q = nwg / NXCD, r = nwg % NXCD, xcd = wgid % NXCD, off = wgid / NXCD; wgid = (xcd < r ? xcd * (q + 1) : r * (q + 1) + (xcd - r) * q) + off; }
        const int nig = WGM * nN, gid = wgid / nig, fm = gid * WGM, gsz = (nM - fm) < WGM ? (nM - fm) : WGM;
        u.pm = fm + ((wgid % nig) % gsz); u.pn = (wgid % nig) / gsz; return true;
    }
};
typedef __bf16 bf2v_t __attribute__((ext_vector_type(2))); typedef float f2v_t __attribute__((ext_vector_type(2)));
__device__ __forceinline__ unsigned cvt_pk_bf16(float lo, float hi) { const f2v_t v = {lo, hi}; return __builtin_bit_cast(unsigned, __builtin_convertvector(v, bf2v_t)); }

template <bool ALIGN_EPI = false, bool SP2 = false, class Epi>
__device__ __forceinline__ void gemm_phase(LAS unsigned char* lds, const Gemm g, const Order& S, const Epi& E) {
    int tid = threadIdx.x; asm volatile("" : "+v"(tid));
    const int wid = __builtin_amdgcn_readfirstlane(tid >> 6), lane = tid & 63, wr = wid >> 2, wc = wid & 3, fr = lane & 15, fq = lane >> 4;
    int K = g.K; asm volatile("" : "+s"(K));
    const int nt = K / BK;
    unsigned voffA[2], voffB[2];
#pragma unroll
    for (int i = 0; i < 2; ++i) { int R, C; stage_rc(tid * 16 + i * 8192, R, C); const int Rb = Epi::PERM ? ((R & ~31) + perm32(R & 31)) : R;
        voffA[i] = (unsigned)(R * g.lda + C) * 2u; voffB[i] = (unsigned)(Rb * g.ldb + C) * 2u; }
    const size_t kstep = (size_t)(BK * 2);
    const size_t hstepA = (size_t)HALF * g.lda * 2, hstepB = (size_t)HALF * g.ldb * 2;
    const size_t tstepA = 2 * hstepA, tstepB = 2 * hstepB;
    const unsigned ldsw = (unsigned)wid * 1024u;
    const int aoff = lds_byte(wr * 64 + fr, fq * 8), boff = lds_byte(wc * 32 + fr, fq * 8);
#define PG8_SA(b, h) (((b) * 2 + (h)) * HTB)
#define PG8_SB(b, h) ((4 + (b) * 2 + (h)) * HTB)
#define PG8_STAGE(bufoff, gbase, voff) do { _Pragma("unroll") for (int _i = 0; _i < 2; ++_i) \
        __builtin_amdgcn_global_load_lds((const unsigned*)((const char*)(gbase) + (voff)[_i]), (LAS unsigned*)(lds + (bufoff) + ldsw + _i * 8192), 16, 0, 0); } while (0)
#define PG8_LDA(dst, b, h) do { _Pragma("unroll") for (int m = 0; m < 4; ++m) _Pragma("unroll") for (int k = 0; k < 2; ++k) dst[m][k] = *(const LAS bf16x8*)(lds + PG8_SA(b, h) + aoff + m * 2048 + k * 1024); } while (0)
#define PG8_LDB(dst, b, h) do { _Pragma("unroll") for (int n = 0; n < 2; ++n) _Pragma("unroll") for (int k = 0; k < 2; ++k) dst[n][k] = *(const LAS bf16x8*)(lds + PG8_SB(b, h) + boff + n * 2048 + k * 1024); } while (0)
#define PG8_MMA(ai, bj, At, Bt) do { __builtin_amdgcn_s_setprio(1); _Pragma("unroll") for (int m = 0; m < 4; ++m) _Pragma("unroll") for (int n = 0; n < 2; ++n) _Pragma("unroll") for (int k = 0; k < 2; ++k) \
        acc[ai][bj][m][n] = __builtin_amdgcn_mfma_f32_16x16x32_bf16(Bt[n][k], At[m][k], acc[ai][bj][m][n], 0, 0, 0); __builtin_amdgcn_s_setprio(0); } while (0)
#define PG8_WAIT_V(n) asm volatile("s_waitcnt vmcnt(" #n ")" ::: "memory")
#define PG8_WAIT_L(n) asm volatile("s_waitcnt lgkmcnt(" #n ")" ::: "memory")
#define PG8_BAR __builtin_amdgcn_s_barrier()
#define PG8_SCHED __builtin_amdgcn_sched_barrier(0)
    Unit cur, nxt; int ui = 0;
    if (!S.next(0, cur)) return;
    f32x4 acc[2][2][4][2];
#pragma unroll
    for (int a = 0; a < 2; ++a)
#pragma unroll
        for (int b = 0; b < 2; ++b)
#pragma unroll
            for (int m = 0; m < 4; ++m)
#pragma unroll
                for (int n = 0; n < 2; ++n) acc[a][b][m][n] = (f32x4){0.f, 0.f, 0.f, 0.f};
    bf16x8 At[4][2], B0[2][2], B1[2][2];
    const char* cA = (const char*)(g.A + (size_t)cur.z * g.sAz) + (size_t)cur.pm * tstepA; const char* cB = (const char*)(g.Bt + (size_t)cur.z * g.sBz) + (size_t)cur.pn * tstepB;
    if constexpr (SP2) {
        PG8_STAGE(PG8_SB(0, 0), cB, voffB); PG8_STAGE(PG8_SB(0, 1), cB + hstepB, voffB); PG8_STAGE(PG8_SA(0, 0), cA, voffA); PG8_STAGE(PG8_SA(0, 1), cA + hstepA, voffA);
        if (wr == 1) PG8_BAR;
        PG8_WAIT_V(2); PG8_BAR;
        PG8_STAGE(PG8_SB(1, 0), cB + kstep, voffB); PG8_STAGE(PG8_SA(1, 0), cA + kstep, voffA); PG8_STAGE(PG8_SB(1, 1), cB + hstepB + kstep, voffB);
        PG8_WAIT_V(6); PG8_BAR;
    } else {
    PG8_STAGE(PG8_SB(0, 0), cB, voffB); PG8_STAGE(PG8_SA(0, 0), cA, voffA); PG8_STAGE(PG8_SB(0, 1), cB + hstepB, voffB); PG8_STAGE(PG8_SA(0, 1), cA + hstepA, voffA);
    if (wr == 1) PG8_BAR;
    PG8_WAIT_V(4); PG8_BAR;
    PG8_STAGE(PG8_SB(1, 0), cB + kstep, voffB); PG8_STAGE(PG8_SA(1, 0), cA + kstep, voffA); PG8_STAGE(PG8_SB(1, 1), cB + hstepB + kstep, voffB);
    PG8_WAIT_V(6); PG8_BAR;
    }
    for (;;) {
        const bool has_next = S.next(ui + 1, nxt);
        const char* nA = has_next ? (const char*)(g.A + (size_t)nxt.z * g.sAz) + (size_t)nxt.pm * tstepA : cA; const char* nB = has_next ? (const char*)(g.Bt + (size_t)nxt.z * g.sBz) + (size_t)nxt.pn * tstepB : cB;
        for (int t = 0; t < nt; t += 2) {
            const bool last = (t == nt - 2);
            const char* a1 = cA + (size_t)(t + 1) * kstep;
            const char* a2 = last ? nA : cA + (size_t)(t + 2) * kstep; const char* b2 = last ? nB : cB + (size_t)(t + 2) * kstep;
            const char* a3 = a2 + kstep; const char* b3 = b2 + kstep;
            if constexpr (SP2) {
            PG8_LDB(B0, 0, 0); PG8_LDB(B1, 0, 1); PG8_SCHED; PG8_LDA(At, 0, 0); PG8_STAGE(PG8_SA(1, 1), a1 + hstepA, voffA);
            PG8_WAIT_V(8); PG8_WAIT_L(0); PG8_BAR; PG8_MMA(0, 0, At, B0); PG8_MMA(0, 1, At, B1); PG8_BAR; PG8_SCHED;
            PG8_LDA(At, 0, 1); PG8_STAGE(PG8_SB(0, 0), b2, voffB); PG8_STAGE(PG8_SB(0, 1), b2 + hstepB, voffB); PG8_STAGE(PG8_SA(0, 0), a2, voffA);
            PG8_WAIT_V(8); PG8_WAIT_L(0); PG8_BAR; PG8_MMA(1, 0, At, B0); PG8_MMA(1, 1, At, B1); PG8_BAR; PG8_SCHED;
            PG8_LDB(B0, 1, 0); PG8_LDB(B1, 1, 1); PG8_SCHED; PG8_LDA(At, 1, 0); PG8_STAGE(PG8_SA(0, 1), a2 + hstepA, voffA);
            PG8_WAIT_V(8); PG8_WAIT_L(0); PG8_BAR; PG8_MMA(0, 0, At, B0); PG8_MMA(0, 1, At, B1); PG8_BAR; PG8_SCHED;
            PG8_LDA(At, 1, 1); PG8_STAGE(PG8_SB(1, 0), b3, voffB); PG8_STAGE(PG8_SB(1, 1), b3 + hstepB, voffB); PG8_STAGE(PG8_SA(1, 0), a3, voffA);
            PG8_WAIT_V(8); PG8_WAIT_L(0); PG8_BAR; PG8_MMA(1, 0, At, B0); PG8_MMA(1, 1, At, B1); PG8_BAR; PG8_SCHED;
            } else {
            PG8_LDB(B0, 0, 0); PG8_SCHED; PG8_LDA(At, 0, 0); PG8_STAGE(PG8_SA(1, 1), a1 + hstepA, voffA);
            PG8_WAIT_L(8); PG8_BAR; PG8_WAIT_L(0); PG8_MMA(0, 0, At, B0); PG8_BAR; PG8_SCHED;
            PG8_LDB(B1, 0, 1); PG8_STAGE(PG8_SB(0, 0), b2, voffB);
            PG8_BAR; PG8_WAIT_L(0); PG8_MMA(0, 1, At, B1); PG8_BAR;
            PG8_LDA(At, 0, 1); PG8_STAGE(PG8_SA(0, 0), a2, voffA);
            PG8_BAR; PG8_WAIT_L(0); PG8_MMA(1, 0, At, B0); PG8_BAR; PG8_SCHED;
            PG8_STAGE(PG8_SB(0, 1), b2 + hstepB, voffB);
            PG8_WAIT_V(6); PG8_BAR; PG8_MMA(1, 1, At, B1); PG8_BAR;
            PG8_LDB(B0, 1, 0); PG8_SCHED; PG8_LDA(At, 1, 0); PG8_STAGE(PG8_SA(0, 1), a2 + hstepA, voffA);
            PG8_WAIT_L(8); PG8_BAR; PG8_WAIT_L(0); PG8_MMA(0, 0, At, B0); PG8_BAR; PG8_SCHED;
            PG8_LDB(B1, 1, 1); PG8_STAGE(PG8_SB(1, 0), b3, voffB);
            PG8_BAR; PG8_WAIT_L(0); PG8_MMA(0, 1, At, B1); PG8_BAR;
            PG8_LDA(At, 1, 1); PG8_STAGE(PG8_SA(1, 0), a3, voffA);
            PG8_BAR; PG8_WAIT_L(0); PG8_MMA(1, 0, At, B0); PG8_BAR; PG8_SCHED;
            PG8_STAGE(PG8_SB(1, 1), b3 + hstepB, voffB);
            PG8_WAIT_V(6); PG8_BAR; PG8_MMA(1, 1, At, B1); PG8_BAR;
            }
        }
        if constexpr (ALIGN_EPI) { if (wr == 0) PG8_BAR; }
        if constexpr (!Epi::AFTER_DRAIN) { E(acc, cur, wr, wc, fr, fq); }
        if (!has_next) break;
#pragma unroll
        for (int a = 0; a < 2; ++a)
#pragma unroll
            for (int b = 0; b < 2; ++b)
#pragma unroll
                for (int m = 0; m < 4; ++m)
#pragma unroll
                    for (int n = 0; n < 2; ++n) acc[a][b][m][n] = (f32x4){0.f, 0.f, 0.f, 0.f};
        cur = nxt; cA = nA; cB = nB; ++ui;
        if constexpr (ALIGN_EPI) { if (wr == 1) PG8_BAR; }
    }
    PG8_WAIT_V(0);
    if constexpr (!ALIGN_EPI) { if (wr == 0) PG8_BAR; }
    PG8_BAR;
    if constexpr (Epi::AFTER_DRAIN) { E.fused(acc, cur, wr, wc, fr, fq, lds, wid, lane); }
#undef PG8_SA
#undef PG8_SB
#undef PG8_STAGE
#undef PG8_LDA
#undef PG8_LDB
#undef PG8_MMA
#undef PG8_WAIT_V
#undef PG8_WAIT_L
#undef PG8_BAR
#undef PG8_SCHED
}

struct EpiBf16Store {
    static constexpr bool PERM = true, AFTER_DRAIN = false;
    bf16_t* O; int ldc;
    __device__ __forceinline__ void operator()(const f32x4 (&acc)[2][2][4][2], const Unit& u, int wr, int wc, int fr, int fq) const {
        const int row0 = u.pm * BM + wr * 64 + fr, col0 = u.pn * BM + wc * 32 + 8 * fq;
#pragma unroll
        for (int ai = 0; ai < 2; ++ai)
#pragma unroll
            for (int m = 0; m < 4; ++m) { bf16_t* rowp = O + (size_t)(row0 + ai * HALF + m * 16) * ldc + col0;
#pragma unroll
                for (int bj = 0; bj < 2; ++bj) { const f32x4 v0 = acc[ai][bj][m][0], v1 = acc[ai][bj][m][1];
                    u32x4 w; w.x = cvt_pk_bf16(v0[0], v0[1]); w.y = cvt_pk_bf16(v0[2], v0[3]); w.z = cvt_pk_bf16(v1[0], v1[1]); w.w = cvt_pk_bf16(v1[2], v1[3]);
                    *(u32x4*)(rowp + bj * HALF) = w; } }
    }
};

struct EpiProjAY {
    static constexpr bool PERM = true, AFTER_DRAIN = false;
    bf16_t* PROJ; bf16_t* AY;
    __device__ __forceinline__ void operator()(const f32x4 (&acc)[2][2][4][2], const Unit& u, int wr, int wc, int fr, int fq) const {
        const int rowb = u.pm * BM + wr * 64, col0 = u.pn * BM + wc * 32 + 8 * fq;
#pragma unroll
        for (int bj = 0; bj < 2; ++bj) { const int col = col0 + bj * HALF; const bool ay = col < WSSM;
#pragma unroll
            for (int ai = 0; ai < 2; ++ai)
#pragma unroll
                for (int m = 0; m < 4; ++m) { const int rb = rowb + ai * HALF + m * 16;
                    bf16_t* dst = ay ? AY + ((size_t)((col >> 4) * 1024 + (rb >> 4)) * 512 + fr * 16 + (col & 15)) : PROJ + (size_t)(rb + fr) * DIN + col;
                    const f32x4 v0 = acc[ai][bj][m][0], v1 = acc[ai][bj][m][1];
                    u32x4 w; w.x = cvt_pk_bf16(v0[0], v0[1]); w.y = cvt_pk_bf16(v0[2], v0[3]); w.z = cvt_pk_bf16(v1[0], v1[1]); w.w = cvt_pk_bf16(v1[2], v1[3]);
                    *(u32x4*)dst = w; } }
    }
};
struct EpiSend {
    static constexpr bool PERM = false, AFTER_DRAIN = true;
    bf16_t* AY; const float* LAMT; const float* LAM512;
    __device__ __forceinline__ void fused(const f32x4 (&acc)[2][2][4][2], const Unit& u, int wr, int wc, int fr, int fq, LAS unsigned char* lds, int wid, int lane) const {
        LAS float* S = (LAS float*)lds;
        LAS float* E = (LAS float*)(lds + 131072);
#pragma unroll
        for (int ai = 0; ai < 2; ++ai)
#pragma unroll
            for (int m = 0; m < 4; ++m)
#pragma unroll
                for (int n = 0; n < 2; ++n) { const int r = ai * HALF + wr * 64 + m * 16 + fr, c = wc * 32 + n * 16 + 4 * fq; *(LAS f32x4*)(S + r * 128 + c) = acc[ai][0][m][n]; }
        __syncthreads();
        const int g = u.z, b = u.pm, p = lane, seg = wid;
        const float tr = LAMT[(g * NP + p) * 2], ti = LAMT[(g * NP + p) * 2 + 1], hr = LAM512[(g * NP + p) * 2], hi = LAM512[(g * NP + p) * 2 + 1];
        float sr = 0.f, si = 0.f;
        for (int i = 0; i < 32; ++i) { const int row = seg * 32 + i; const float xr = S[row * 128 + p], xi = S[row * 128 + 64 + p];
            const float nr = tr * sr - ti * si + xr, ni = tr * si + ti * sr + xi; sr = nr; si = ni; }
        E[seg * 128 + p] = sr; E[seg * 128 + 64 + p] = si;
        __syncthreads();
        sr = 0.f; si = 0.f;
        for (int s2 = 0; s2 < seg; ++s2) { const float xr = E[s2 * 128 + p], xi = E[s2 * 128 + 64 + p]; const float nr = hr * sr - hi * si + xr, ni = hr * si + hi * sr + xi; sr = nr; si = ni; }
        bf16_t* base = AY + ((size_t)(g * 1024 + b * 256 + seg * 32)) * 512 + 256 + p;
        for (int i = 0; i < 32; ++i) { const int row = seg * 32 + i;
            bf16_t* o = base + (size_t)i * 512;
            o[0] = (bf16_t)f2bf(sr); o[64] = (bf16_t)f2bf(si);
            const float xr = S[row * 128 + p], xi = S[row * 128 + 64 + p];
            const float nr = tr * sr - ti * si + xr, ni = tr * si + ti * sr + xi; sr = nr; si = ni; }
    }
};
struct EpiY {
    static constexpr bool PERM = true, AFTER_DRAIN = false;
    const bf16_t* AY; const float* ssm_d; bf16_t* GB;
    __device__ __forceinline__ void operator()(const f32x4 (&acc)[2][2][4][2], const Unit& u, int wr, int wc, int fr, int fq) const {
        const int g = u.z, b = u.pm;
#pragma unroll
        for (int bj = 0; bj < 2; ++bj) { const int col = bj * HALF + wc * 32 + 8 * fq, t = col >> 4, h0 = col & 15;
            const f32x4 d0 = *(const f32x4*)(ssm_d + g * GH + h0), d1 = *(const f32x4*)(ssm_d + g * GH + h0 + 4);
            u32x4 u8[2][4];
#pragma unroll
            for (int ai = 0; ai < 2; ++ai)
#pragma unroll
                for (int m = 0; m < 4; ++m) { const int crow = ai * HALF + wr * 64 + m * 16 + fr; u8[ai][m] = *(const u32x4*)(AY + ((size_t)(g * 1024 + b * 256 + crow)) * 512 + col); }
#pragma unroll
            for (int ai = 0; ai < 2; ++ai)
#pragma unroll
                for (int m = 0; m < 4; ++m) { const int crow = ai * HALF + wr * 64 + m * 16 + fr;
                    const u32x4 uu = u8[ai][m]; const f32x4 v0 = acc[ai][bj][m][0], v1 = acc[ai][bj][m][1];
                    u32x4 w;
                    w.x = cvt_pk_bf16(gelu_tanh(v0[0] + d0[0] * bflo(uu.x)), gelu_tanh(v0[1] + d0[1] * bfhi(uu.x)));
                    w.y = cvt_pk_bf16(gelu_tanh(v0[2] + d0[2] * bflo(uu.y)), gelu_tanh(v0[3] + d0[3] * bfhi(uu.y)));
                    w.z = cvt_pk_bf16(gelu_tanh(v1[0] + d1[0] * bflo(uu.z)), gelu_tanh(v1[1] + d1[1] * bfhi(uu.z)));
                    w.w = cvt_pk_bf16(gelu_tanh(v1[2] + d1[2] * bflo(uu.w)), gelu_tanh(v1[3] + d1[3] * bfhi(uu.w)));
                    *(u32x4*)(GB + ((size_t)(b * SEQ + crow * 16 + t)) * WSSM + g * GH + h0) = w; }
            asm volatile("" ::: "memory"); }
    }
};
struct EpiGluP {
    static constexpr bool PERM = true, AFTER_DRAIN = false;
    const bf16_t* GB; const bf16_t* PROJ; const float* b_glu; bf16_t* YCAT;
    __device__ __forceinline__ void operator()(const f32x4 (&acc)[2][2][4][2], const Unit& u, int wr, int wc, int fr, int fq) const {
        const int row0 = u.pm * BM + wr * 64 + fr, col0 = u.pn * BM + wc * 32 + 8 * fq;
#pragma unroll
        for (int bj = 0; bj < 2; ++bj) { const int col = col0 + bj * HALF; if (col >= WSSM) continue;
            const f32x4 b0 = *(const f32x4*)(b_glu + col), b1 = *(const f32x4*)(b_glu + col + 4);
#pragma unroll
            for (int ai = 0; ai < 2; ++ai) { if (ai != u.z) continue;
                u32x4 g8[4], a8[4];
#pragma unroll
                for (int m = 0; m < 4; ++m) { const size_t row = (size_t)(row0 + ai * HALF + m * 16); g8[m] = *(const u32x4*)(GB + row * WSSM + col); a8[m] = *(const u32x4*)(PROJ + row * DIN + C_AGATE + col); }
#pragma unroll
                for (int m = 0; m < 4; ++m) { const size_t row = (size_t)(row0 + ai * HALF + m * 16);
                    const f32x4 v0 = acc[ai][bj][m][0] + b0, v1 = acc[ai][bj][m][1] + b1;
                    u32x4 w;
                    w.x = cvt_pk_bf16(bflo(g8[m].x) * sigmoid_f(v0[0]) * silu_f(bflo(a8[m].x)), bfhi(g8[m].x) * sigmoid_f(v0[1]) * silu_f(bfhi(a8[m].x)));
                    w.y = cvt_pk_bf16(bflo(g8[m].y) * sigmoid_f(v0[2]) * silu_f(bflo(a8[m].y)), bfhi(g8[m].y) * sigmoid_f(v0[3]) * silu_f(bfhi(a8[m].y)));
                    w.z = cvt_pk_bf16(bflo(g8[m].z) * sigmoid_f(v1[0]) * silu_f(bflo(a8[m].z)), bfhi(g8[m].z) * sigmoid_f(v1[1]) * silu_f(bfhi(a8[m].z)));
                    w.w = cvt_pk_bf16(bflo(g8[m].w) * sigmoid_f(v1[2]) * silu_f(bflo(a8[m].w)), bfhi(g8[m].w) * sigmoid_f(v1[3]) * silu_f(bfhi(a8[m].w)));
                    *(u32x4*)(YCAT + row * DM + col) = w; }
                asm volatile("" ::: "memory"); } }
    }
};
struct EpiResF32 {
    static constexpr bool PERM = false, AFTER_DRAIN = false;
    const float* x; float* out;
    __device__ __forceinline__ void operator()(const f32x4 (&acc)[2][2][4][2], const Unit& u, int wr, int wc, int fr, int fq) const {
        const int row0 = u.pm * BM + wr * 64 + fr, col0 = u.pn * BM + wc * 32 + 4 * fq;
#pragma unroll
        for (int ai = 0; ai < 2; ++ai)
#pragma unroll
            for (int m = 0; m < 4; ++m) { const size_t off = (size_t)(row0 + ai * HALF + m * 16) * DM + col0;
#pragma unroll
                for (int bj = 0; bj < 2; ++bj)
#pragma unroll
                    for (int n = 0; n < 2; ++n) { const f32x4 xv = *(const f32x4*)(x + off + bj * HALF + n * 16); *(f32x4*)(out + off + bj * HALF + n * 16) = xv + acc[ai][bj][m][n]; }
                asm volatile("" ::: "memory"); }
    }
};

struct EpiOutNorm {
    static constexpr bool PERM = false, AFTER_DRAIN = true;
    const bf16_t* xb; const float* rinv; const float* fg; float* out; float* xch; unsigned* cnt;
    __device__ __forceinline__ void fused(f32x4 (&acc)[2][2][4][2], const Unit& u, int wr, int wc, int fr, int fq, LAS unsigned char* lds, int wid, int lane) const {
        LAS float* P = (LAS float*)lds;
        LAS float* S = (LAS float*)(lds + 8192);
        const int row0 = u.pm * BM + wr * 64 + fr, col0 = u.pn * BM + wc * 32 + 4 * fq;
        typedef unsigned u32x2v __attribute__((ext_vector_type(2)));
        u32x2v xv[2][4][2][2]; float ri[2][4];
#pragma unroll
        for (int ai = 0; ai < 2; ++ai)
#pragma unroll
            for (int m = 0; m < 4; ++m) { const size_t off = (size_t)(row0 + ai * HALF + m * 16) * DM + col0; ri[ai][m] = rinv[row0 + ai * HALF + m * 16];
#pragma unroll
                for (int bj = 0; bj < 2; ++bj)
#pragma unroll
                    for (int n = 0; n < 2; ++n) xv[ai][m][bj][n] = *(const u32x2v*)(xb + off + bj * HALF + n * 16); }
#pragma unroll
        for (int ai = 0; ai < 2; ++ai)
#pragma unroll
            for (int m = 0; m < 4; ++m) { float sq = 0.f; const float rv = ri[ai][m];
#pragma unroll
                for (int bj = 0; bj < 2; ++bj)
#pragma unroll
                    for (int n = 0; n < 2; ++n) { const u32x2v w = xv[ai][m][bj][n]; const f32x4 xf = {bflo(w.x) * rv, bfhi(w.x) * rv, bflo(w.y) * rv, bfhi(w.y) * rv};
                        const f32x4 hv = acc[ai][bj][m][n] + xf; acc[ai][bj][m][n] = hv; sq += (hv[0] * hv[0] + hv[1] * hv[1]) + (hv[2] * hv[2] + hv[3] * hv[3]); }
                sq += __shfl_xor(sq, 16); sq += __shfl_xor(sq, 32);
                if (fq == 0) P[(ai * HALF + wr * 64 + m * 16 + fr) * 4 + wc] = sq; }
        asm volatile("s_waitcnt lgkmcnt(0)" ::: "memory"); __builtin_amdgcn_s_barrier(); asm volatile("" ::: "memory");
        const int row = wid * 32 + (lane & 31);
        if (lane < 32) { const f32x4 pv = *(const LAS f32x4*)(P + row * 4); const float t = (pv[0] + pv[1]) + (pv[2] + pv[3]);
            __hip_atomic_store(xch + ((size_t)(u.pm * BM + row) * 4 + u.pn), t, __ATOMIC_RELAXED, __HIP_MEMORY_SCOPE_AGENT); }
        asm volatile("s_waitcnt vmcnt(0)" ::: "memory");
        if (lane == 0) __hip_atomic_fetch_add(cnt + 64 * u.pm, 1u, __ATOMIC_RELAXED, __HIP_MEMORY_SCOPE_AGENT);
        if (wid == 0) { unsigned sp = 0;
            while ((unsigned)__builtin_amdgcn_readfirstlane(__hip_atomic_load(cnt + 64 * u.pm, __ATOMIC_RELAXED, __HIP_MEMORY_SCOPE_AGENT)) < 32u) { __builtin_amdgcn_s_sleep(2); if (++sp > (1u << 22)) break; }
            __builtin_amdgcn_fence(__ATOMIC_ACQUIRE, "agent"); }
        asm volatile("s_waitcnt vmcnt(0) lgkmcnt(0)" ::: "memory"); __builtin_amdgcn_s_barrier(); asm volatile("" ::: "memory");
        if (lane < 32) { const float* slot = xch + (size_t)(u.pm * BM + row) * 4; float t = 0.f;
#pragma unroll
            for (int q = 0; q < 4; ++q) t += __hip_atomic_load(slot + q, __ATOMIC_RELAXED, __HIP_MEMORY_SCOPE_AGENT);
            S[row] = 1.0f / sqrtf(t * (1.0f / DM) + NORM_EPS); }
        asm volatile("s_waitcnt lgkmcnt(0)" ::: "memory"); __builtin_amdgcn_s_barrier(); asm volatile("" ::: "memory");
        f32x4 gv[2][2];
#pragma unroll
        for (int bj = 0; bj < 2; ++bj)
#pragma unroll
            for (int n = 0; n < 2; ++n) gv[bj][n] = *(const f32x4*)(fg + col0 + bj * HALF + n * 16);
#pragma unroll
        for (int ai = 0; ai < 2; ++ai)
#pragma unroll
            for (int m = 0; m < 4; ++m) { const int r = ai * HALF + wr * 64 + m * 16 + fr; const float rs = S[r]; const size_t off = (size_t)(u.pm * BM + r) * DM + col0;
#pragma unroll
                for (int bj = 0; bj < 2; ++bj)
#pragma unroll
                    for (int n = 0; n < 2; ++n) *(f32x4*)(out + off + bj * HALF + n * 16) = acc[ai][bj][m][n] * rs * gv[bj][n]; }
    }
};
}

__device__ __forceinline__ void s5_naive(const Args& a, int b, int g, int lane) {
    const bf16_t* PROJ = (const bf16_t*)(a.ws + WS_PROJ); bf16_t* GB = (bf16_t*)(a.ws + WS_GB);
    const float* LAMB = (const float*)(a.ws + WS_LAMB); const float* BBAR = (const float*)(a.ws + WS_BBAR);
    const float* c_re = a.in[8]; const float* c_im = a.in[9]; const float* ssm_d = a.in[10];
    const int p = lane, h = lane & 15, pg = lane >> 4;
    const float lr = LAMB[(g * NP + p) * 2], li = LAMB[(g * NP + p) * 2 + 1];
    float bre[16], bim[16], cre[16], cim[16];
#pragma unroll
    for (int j = 0; j < 16; ++j) { bre[j] = BBAR[((g * NP + p) * GH + j) * 2]; bim[j] = BBAR[((g * NP + p) * GH + j) * 2 + 1];
        cre[j] = c_re[(g * GH + h) * NP + pg * 16 + j]; cim[j] = c_im[(g * GH + h) * NP + pg * 16 + j]; }
    const float dd = ssm_d[g * GH + h];
    float sr = 0.f, si = 0.f;
    for (int t = 0; t < SEQ; ++t) {
        const bf16_t* up = PROJ + (size_t)(b * SEQ + t) * DIN + C_AIN + g * GH;
        const v4u u0 = *(const v4u*)up, u1 = *(const v4u*)(up + 8);
        float u[16];
        u[0] = bflo(u0.x); u[1] = bfhi(u0.x); u[2] = bflo(u0.y); u[3] = bfhi(u0.y); u[4] = bflo(u0.z); u[5] = bfhi(u0.z); u[6] = bflo(u0.w); u[7] = bfhi(u0.w);
        u[8] = bflo(u1.x); u[9] = bfhi(u1.x); u[10] = bflo(u1.y); u[11] = bfhi(u1.y); u[12] = bflo(u1.z); u[13] = bfhi(u1.z); u[14] = bflo(u1.w); u[15] = bfhi(u1.w);
        const float uh = bf2f(up[h]);
        float bur = 0.f, bui = 0.f;
#pragma unroll
        for (int j = 0; j < 16; ++j) { bur += bre[j] * u[j]; bui += bim[j] * u[j]; }
        const float nsr = lr * sr - li * si + bur, nsi = lr * si + li * sr + bui;
        sr = nsr; si = nsi;
        float part = 0.f;
#pragma unroll
        for (int j = 0; j < 16; ++j) { const float xr = __shfl(sr, pg * 16 + j), xi = __shfl(si, pg * 16 + j); part += cre[j] * xr - cim[j] * xi; }
        part += __shfl_xor(part, 16); part += __shfl_xor(part, 32);
        const float y = part + dd * uh;
        if (lane < 16) GB[(size_t)(b * SEQ + t) * WSSM + g * GH + h] = (bf16_t)f2bf(gelu_tanh(y));
    }
}

__device__ __forceinline__ void conv_naive(const Args& a, int vb, int nvb) {
    const bf16_t* PROJ = (const bf16_t*)(a.ws + WS_PROJ); bf16_t* YCAT = (bf16_t*)(a.ws + WS_YCAT);
    const float* conv_w = a.in[14]; const float* conv_b = a.in[15];
    const int gt = vb * 512 + otid(), NT = nvb * 512;
    for (int idx = gt; idx < NTOK * WSSM; idx += NT) {
        const int tok = idx / WSSM, c = idx % WSSM, t = tok % SEQ;
        const bf16_t* row = PROJ + (size_t)tok * DIN;
        float acc = conv_b[c];
#pragma unroll
        for (int k = 0; k < 3; ++k) { const int tt = t - 2 + k; if (tt >= 0) { const bf16_t* r2 = PROJ + (size_t)(tok - 2 + k) * DIN; acc += conv_w[k * WSSM + c] * (bf2f(r2[C_CC + c]) * bf2f(r2[C_CIN + c])); } }
        const float y = bf2f(row[C_CB + c]) * acc * silu_f(bf2f(row[C_CGATE + c]));
        YCAT[(size_t)tok * DM + WSSM + c] = (bf16_t)f2bf(y);
    }
}
__device__ __forceinline__ void attn_naive(const Args& a, int vb, int nvb) {
    const bf16_t* PROJ = (const bf16_t*)(a.ws + WS_PROJ); bf16_t* YCAT = (bf16_t*)(a.ws + WS_YCAT); const bf16_t* KV = (const bf16_t*)(a.ws + WS_KV);
    const int gt = vb * 512 + otid(), NT = nvb * 512;
    for (int item = gt; item < NB * 4 * SEQ; item += NT) {
        const int t = item % SEQ, hh = (item / SEQ) % 4, b = item / (4 * SEQ), tok = b * SEQ + t;
        const v4u* qp = (const v4u*)(PROJ + (size_t)tok * DIN + C_Q + hh * 64);
        float q[64], o[64];
#pragma unroll
        for (int i = 0; i < 8; ++i) { const v4u v = qp[i]; q[8 * i] = bflo(v.x); q[8 * i + 1] = bfhi(v.x); q[8 * i + 2] = bflo(v.y); q[8 * i + 3] = bfhi(v.y); q[8 * i + 4] = bflo(v.z); q[8 * i + 5] = bfhi(v.z); q[8 * i + 6] = bflo(v.w); q[8 * i + 7] = bfhi(v.w); }
#pragma unroll
        for (int d = 0; d < 64; ++d) o[d] = 0.f;
        float m = -1e30f, l = 0.f;
        for (int mm = 0; mm < NMEM; ++mm) {
            const v4u* kp = (const v4u*)(KV + (size_t)(b * NMEM + mm) * 512 + hh * 64);
            const v4u* vp = (const v4u*)(KV + (size_t)(b * NMEM + mm) * 512 + 256 + hh * 64);
            float s = 0.f;
#pragma unroll
            for (int i = 0; i < 8; ++i) { const v4u v = kp[i];
                s += q[8 * i] * bflo(v.x) + q[8 * i + 1] * bfhi(v.x) + q[8 * i + 2] * bflo(v.y) + q[8 * i + 3] * bfhi(v.y) + q[8 * i + 4] * bflo(v.z) + q[8 * i + 5] * bfhi(v.z) + q[8 * i + 6] * bflo(v.w) + q[8 * i + 7] * bfhi(v.w); }
            s *= 0.125f;
            const float mn = fmaxf(m, s), sc = __expf(m - mn), pp = __expf(s - mn);
            l = l * sc + pp; m = mn;
#pragma unroll
            for (int i = 0; i < 8; ++i) { const v4u v = vp[i];
                o[8 * i] = o[8 * i] * sc + pp * bflo(v.x); o[8 * i + 1] = o[8 * i + 1] * sc + pp * bfhi(v.x); o[8 * i + 2] = o[8 * i + 2] * sc + pp * bflo(v.y); o[8 * i + 3] = o[8 * i + 3] * sc + pp * bfhi(v.y);
                o[8 * i + 4] = o[8 * i + 4] * sc + pp * bflo(v.z); o[8 * i + 5] = o[8 * i + 5] * sc + pp * bfhi(v.z); o[8 * i + 6] = o[8 * i + 6] * sc + pp * bflo(v.w); o[8 * i + 7] = o[8 * i + 7] * sc + pp * bfhi(v.w); }
        }
        const float inv = 1.0f / l;
        const v4u* gp = (const v4u*)(PROJ + (size_t)tok * DIN + C_QGATE + hh * 64);
        v4u* op = (v4u*)(YCAT + (size_t)tok * DM + 768 + hh * 64);
#pragma unroll
        for (int i = 0; i < 8; ++i) { const v4u gv = gp[i]; v4u w;
            w.x = pk2(o[8 * i] * inv * silu_f(bflo(gv.x)), o[8 * i + 1] * inv * silu_f(bfhi(gv.x)));
            w.y = pk2(o[8 * i + 2] * inv * silu_f(bflo(gv.y)), o[8 * i + 3] * inv * silu_f(bfhi(gv.y)));
            w.z = pk2(o[8 * i + 4] * inv * silu_f(bflo(gv.z)), o[8 * i + 5] * inv * silu_f(bfhi(gv.z)));
            w.w = pk2(o[8 * i + 6] * inv * silu_f(bflo(gv.w)), o[8 * i + 7] * inv * silu_f(bfhi(gv.w)));
            op[i] = w; }
    }
}

typedef short bf16x8_t __attribute__((ext_vector_type(8)));
typedef short s16x4_t __attribute__((ext_vector_type(4)));
typedef float f32x16 __attribute__((ext_vector_type(16)));
typedef __bf16 bf2_t __attribute__((ext_vector_type(2)));
typedef float f2_t __attribute__((ext_vector_type(2)));
typedef unsigned u32x2_t __attribute__((ext_vector_type(2)));
__device__ __forceinline__ unsigned cvt2(float lo, float hi) { const f2_t v = {lo, hi}; return __builtin_bit_cast(unsigned, __builtin_convertvector(v, bf2_t)); }
__device__ __forceinline__ void attn_mfma(const Args& a, LAS unsigned char* lds, int vb, int nvb) {
    const int nj = nvb / 16; if (nj < 1 || vb >= nj * 16) return;
    const int tid = otid(), lane = tid & 63, wave = tid >> 6, r = lane & 31, h = lane >> 5;
    const int bh = vb % 16, j = vb / 16, b = bh >> 2, head = bh & 3;
    const bf16_t* PROJ = (const bf16_t*)(a.ws + WS_PROJ); bf16_t* YCAT = (bf16_t*)(a.ws + WS_YCAT); const bf16_t* KV = (const bf16_t*)(a.ws + WS_KV);
    LAS unsigned char* Kl = lds;
    LAS unsigned char* Vl = lds + 36864;
    for (int c = tid; c < 2048; c += 512) { const int key = c >> 3, dch = c & 7;
        const bf16_t* src = KV + (size_t)(b * NMEM + key) * 512 + head * 64 + dch * 8;
        const v4u kv = *(const v4u*)src, vv = *(const v4u*)(src + 256);
        *(LAS v4u*)(Kl + key * 144 + dch * 16) = kv;
        LAS bf16_t* vd = (LAS bf16_t*)(Vl + (dch * 8) * 520 + key * 2);
        vd[0 * 260] = (bf16_t)(vv.x & 0xffff); vd[1 * 260] = (bf16_t)(vv.x >> 16); vd[2 * 260] = (bf16_t)(vv.y & 0xffff); vd[3 * 260] = (bf16_t)(vv.y >> 16);
        vd[4 * 260] = (bf16_t)(vv.z & 0xffff); vd[5 * 260] = (bf16_t)(vv.z >> 16); vd[6 * 260] = (bf16_t)(vv.w & 0xffff); vd[7 * 260] = (bf16_t)(vv.w >> 16); }
    __syncthreads();
    for (int tile = j * 8 + wave; tile < SEQ / 32; tile += nj * 8) {
        const size_t tok = (size_t)b * SEQ + tile * 32 + r;
        bf16x8_t qf[4];
#pragma unroll
        for (int s4 = 0; s4 < 4; ++s4) qf[s4] = *(const bf16x8_t*)(PROJ + tok * DIN + C_Q + head * 64 + 16 * s4 + 8 * h);
        const float sc = 0.125f * 1.4426950408889634f;
        float mx = -3.0e38f, l = 0.f;
        f32x16 o0, o1;
#pragma unroll
        for (int i = 0; i < 16; ++i) { o0[i] = 0.f; o1[i] = 0.f; }
#pragma unroll 2
        for (int kt = 0; kt < 8; ++kt) {
            f32x16 st;
#pragma unroll
            for (int i = 0; i < 16; ++i) st[i] = 0.f;
#pragma unroll
            for (int s4 = 0; s4 < 4; ++s4) { const bf16x8_t kf = *(const LAS bf16x8_t*)(Kl + (kt * 32 + r) * 144 + (16 * s4 + 8 * h) * 2);
                st = __builtin_amdgcn_mfma_f32_32x32x16_bf16(kf, qf[s4], st, 0, 0, 0); }
            float tm = st[0];
#pragma unroll
            for (int i = 1; i < 16; ++i) tm = fmaxf(tm, st[i]);
            tm = fmaxf(tm, __shfl_xor(tm, 32));
            const float mn = fmaxf(mx, tm), alpha = __builtin_amdgcn_exp2f((mx - mn) * sc), mb = mn * sc;
            mx = mn; l *= alpha;
#pragma unroll
            for (int i = 0; i < 16; ++i) { o0[i] *= alpha; o1[i] *= alpha; }
#pragma unroll
            for (int i = 0; i < 16; ++i) { const float p = __builtin_amdgcn_exp2f(st[i] * sc - mb); st[i] = p; l += p; }
#pragma unroll
            for (int s2 = 0; s2 < 2; ++s2) {
                v4u pw; pw.x = cvt2(st[8 * s2 + 0], st[8 * s2 + 1]); pw.y = cvt2(st[8 * s2 + 2], st[8 * s2 + 3]);
                pw.z = cvt2(st[8 * s2 + 4], st[8 * s2 + 5]); pw.w = cvt2(st[8 * s2 + 6], st[8 * s2 + 7]);
                const bf16x8_t pf = __builtin_bit_cast(bf16x8_t, pw);
                const int koff = (kt * 32 + 16 * s2 + 4 * h) * 2;
                { const s16x4_t lo = *(const LAS s16x4_t*)(Vl + r * 520 + koff), hi = *(const LAS s16x4_t*)(Vl + r * 520 + koff + 16);
                  const bf16x8_t vf = __builtin_shufflevector(lo, hi, 0, 1, 2, 3, 4, 5, 6, 7); o0 = __builtin_amdgcn_mfma_f32_32x32x16_bf16(vf, pf, o0, 0, 0, 0); }
                { const s16x4_t lo = *(const LAS s16x4_t*)(Vl + (32 + r) * 520 + koff), hi = *(const LAS s16x4_t*)(Vl + (32 + r) * 520 + koff + 16);
                  const bf16x8_t vf = __builtin_shufflevector(lo, hi, 0, 1, 2, 3, 4, 5, 6, 7); o1 = __builtin_amdgcn_mfma_f32_32x32x16_bf16(vf, pf, o1, 0, 0, 0); }
            }
        }
        l += __shfl_xor(l, 32);
        const float inv = 1.0f / l;
        const bf16_t* gp = PROJ + tok * DIN + C_QGATE + head * 64; bf16_t* op = YCAT + tok * DM + 768 + head * 64;
#pragma unroll
        for (int q4 = 0; q4 < 4; ++q4) {
            { const int d = 8 * q4 + 4 * h; const u32x2_t gv = *(const u32x2_t*)(gp + d); u32x2_t w;
              w.x = cvt2(o0[4 * q4 + 0] * inv * silu_f(bflo(gv.x)), o0[4 * q4 + 1] * inv * silu_f(bfhi(gv.x))); w.y = cvt2(o0[4 * q4 + 2] * inv * silu_f(bflo(gv.y)), o0[4 * q4 + 3] * inv * silu_f(bfhi(gv.y)));
              *(u32x2_t*)(op + d) = w; }
            { const int d = 32 + 8 * q4 + 4 * h; const u32x2_t gv = *(const u32x2_t*)(gp + d); u32x2_t w;
              w.x = cvt2(o1[4 * q4 + 0] * inv * silu_f(bflo(gv.x)), o1[4 * q4 + 1] * inv * silu_f(bfhi(gv.x))); w.y = cvt2(o1[4 * q4 + 2] * inv * silu_f(bflo(gv.y)), o1[4 * q4 + 3] * inv * silu_f(bfhi(gv.y)));
              *(u32x2_t*)(op + d) = w; }
        }
    }
}
__device__ __forceinline__ void conv_vec(const Args& a, int vb, int nvb) {
    const bf16_t* PROJ = (const bf16_t*)(a.ws + WS_PROJ); bf16_t* YCAT = (bf16_t*)(a.ws + WS_YCAT);
    const float* conv_w = a.in[14]; const float* conv_b = a.in[15];
    const int gt = vb * 512 + otid(), NT = nvb * 512;
    for (int it = gt; it < (NTOK / 4) * 48; it += NT) {
        const int tg = it / 48, c0 = (it % 48) * 8, tok0 = tg * 4, t0 = tok0 % SEQ;
        const bf16_t* row0 = PROJ + (size_t)tok0 * DIN;
        v4u cc[6], ci[6], cb[4], cg[4];
#pragma unroll
        for (int r = 0; r < 6; ++r) { const bool ok = (t0 + r - 2) >= 0; const bf16_t* rp = row0 + (ptrdiff_t)(r - 2) * DIN;
            cc[r] = ok ? *(const v4u*)(rp + C_CC + c0) : (v4u){0u, 0u, 0u, 0u}; ci[r] = ok ? *(const v4u*)(rp + C_CIN + c0) : (v4u){0u, 0u, 0u, 0u}; }
#pragma unroll
        for (int j = 0; j < 4; ++j) { cb[j] = *(const v4u*)(row0 + (size_t)j * DIN + C_CB + c0); cg[j] = *(const v4u*)(row0 + (size_t)j * DIN + C_CGATE + c0); }
        float w[3][8], bb[8];
#pragma unroll
        for (int k = 0; k < 3; ++k) { const f32x4 w0 = *(const f32x4*)(conv_w + k * WSSM + c0), w1 = *(const f32x4*)(conv_w + k * WSSM + c0 + 4);
            w[k][0] = w0.x; w[k][1] = w0.y; w[k][2] = w0.z; w[k][3] = w0.w; w[k][4] = w1.x; w[k][5] = w1.y; w[k][6] = w1.z; w[k][7] = w1.w; }
        { const f32x4 b0 = *(const f32x4*)(conv_b + c0), b1 = *(const f32x4*)(conv_b + c0 + 4); bb[0] = b0.x; bb[1] = b0.y; bb[2] = b0.z; bb[3] = b0.w; bb[4] = b1.x; bb[5] = b1.y; bb[6] = b1.z; bb[7] = b1.w; }
        float u[6][8];
#pragma unroll
        for (int r = 0; r < 6; ++r) { u[r][0] = bflo(cc[r].x) * bflo(ci[r].x); u[r][1] = bfhi(cc[r].x) * bfhi(ci[r].x); u[r][2] = bflo(cc[r].y) * bflo(ci[r].y); u[r][3] = bfhi(cc[r].y) * bfhi(ci[r].y);
            u[r][4] = bflo(cc[r].z) * bflo(ci[r].z); u[r][5] = bfhi(cc[r].z) * bfhi(ci[r].z); u[r][6] = bflo(cc[r].w) * bflo(ci[r].w); u[r][7] = bfhi(cc[r].w) * bfhi(ci[r].w); }
#pragma unroll
        for (int j = 0; j < 4; ++j) { float y[8];
#pragma unroll
            for (int e = 0; e < 8; ++e) y[e] = bb[e] + w[0][e] * u[j][e] + w[1][e] * u[j + 1][e] + w[2][e] * u[j + 2][e];
            v4u o;
            o.x = cvt2(bflo(cb[j].x) * y[0] * silu_f(bflo(cg[j].x)), bfhi(cb[j].x) * y[1] * silu_f(bfhi(cg[j].x)));
            o.y = cvt2(bflo(cb[j].y) * y[2] * silu_f(bflo(cg[j].y)), bfhi(cb[j].y) * y[3] * silu_f(bfhi(cg[j].y)));
            o.z = cvt2(bflo(cb[j].z) * y[4] * silu_f(bflo(cg[j].z)), bfhi(cb[j].z) * y[5] * silu_f(bfhi(cg[j].z)));
            o.w = cvt2(bflo(cb[j].w) * y[6] * silu_f(bflo(cg[j].w)), bfhi(cb[j].w) * y[7] * silu_f(bfhi(cg[j].w)));
            *(v4u*)(YCAT + (size_t)(tok0 + j) * DM + WSSM + c0) = o; }
    }
}
__device__ __forceinline__ void final_norm(const Args& a) {
    const int tid = otid(), lane = tid & 63, gw = blockIdx.x * 8 + (tid >> 6), NGW = gridDim.x * 8;
    const float* fg = a.in[19];
    for (int r = gw; r < NTOK; r += NGW) {
        f32x4* xr = (f32x4*)(a.out + (size_t)r * DM) + lane;
        f32x4 v[4]; float s = 0.f;
#pragma unroll
        for (int j = 0; j < 4; ++j) { v[j] = xr[64 * j]; s += (v[j].x * v[j].x + v[j].y * v[j].y) + (v[j].z * v[j].z + v[j].w * v[j].w); }
        const float rstd = 1.0f / sqrtf(wave_sum(s) * (1.0f / DM) + NORM_EPS);
#pragma unroll
        for (int j = 0; j < 4; ++j) { const f32x4 g = ((const f32x4*)fg)[lane + 64 * j]; xr[64 * j] = v[j] * rstd * g; }
    }
}

__global__ void __launch_bounds__(512, 2) mega(Args a) {
    extern __shared__ __attribute__((aligned(16))) unsigned char smem_raw[];
    LAS unsigned char* lds = (LAS unsigned char*)smem_raw;
    cg::grid_group grid = cg::this_grid();
    volatile LAS unsigned* xst = (volatile LAS unsigned*)(lds + 139264);
    if (threadIdx.x == 0) { xst[0] = 0u; xst[1] = 0u; }
    { unsigned* ctl = (unsigned*)(a.ws + WS_CTL); unsigned* flag = ctl + CTL_FLAG_WORD;
      if (blockIdx.x == 0) { for (int i = threadIdx.x; i < 8192; i += 512) __hip_atomic_store(ctl + i, 0u, __ATOMIC_RELAXED, __HIP_MEMORY_SCOPE_AGENT);
          asm volatile("s_waitcnt vmcnt(0)" ::: "memory"); __syncthreads();
          if (threadIdx.x == 0) { __builtin_amdgcn_fence(__ATOMIC_RELEASE, "agent"); __hip_atomic_store(flag, CTL_TOKEN, __ATOMIC_RELAXED, __HIP_MEMORY_SCOPE_AGENT); } }
      if (threadIdx.x == 0) { unsigned sp = 0; while (__hip_atomic_load(flag, __ATOMIC_RELAXED, __HIP_MEMORY_SCOPE_AGENT) != CTL_TOKEN) { __builtin_amdgcn_s_sleep(1); if (++sp > (1u << 22)) break; }
          __builtin_amdgcn_fence(__ATOMIC_ACQUIRE, "agent"); } }
    __syncthreads();
    const XcdBarrier xbar = xcd_barrier_post((unsigned*)(a.ws + WS_CTL), xst);
    const int bid = blockIdx.x, G = gridDim.x;
    bf16_t* XB = (bf16_t*)(a.ws + WS_XB); bf16_t* MEMN = (bf16_t*)(a.ws + WS_MEMN);
    bf16_t* WINT = (bf16_t*)(a.ws + WS_WINT); bf16_t* WKVT = (bf16_t*)(a.ws + WS_WKVT); bf16_t* WOUTT = (bf16_t*)(a.ws + WS_WOUTT); bf16_t* WGLUT = (bf16_t*)(a.ws + WS_WGLUT);
    bf16_t* PROJ = (bf16_t*)(a.ws + WS_PROJ); bf16_t* KV = (bf16_t*)(a.ws + WS_KV); bf16_t* GB = (bf16_t*)(a.ws + WS_GB); bf16_t* YCAT = (bf16_t*)(a.ws + WS_YCAT);
    bf16_t* AY = (bf16_t*)(a.ws + WS_AY); bf16_t* WSb = (bf16_t*)(a.ws + WS_WS); bf16_t* WYb = (bf16_t*)(a.ws + WS_WY);

#ifndef PROBE_DUP
#define PROBE_DUP -1
#endif
#define REPS(k) for (int rep_ = 0; rep_ < ((PROBE_DUP == (k)) ? 2 : 1); ++rep_)
#ifndef PROBE_SUB
#define PROBE_SUB -1
#endif
    if (a.out == nullptr) grid.sync();
    REPS(0) { phase0(a, lds);
    xcd_barrier(xbar); }
    REPS(1) {
    { pg8::Order S; S.init(NTOK / 256, DIN / 256, 1, G, bid);
      pg8::gemm_phase<true, true>(lds, pg8::Gemm{XB, WINT, DM, DM, DM, 0, 0}, S, pg8::EpiProjAY{PROJ, AY}); }
    { pg8::Order S; S.init(NB * NMEM / 256, 512 / 256, 1, G, (bid + G - ((NTOK / 256) * (DIN / 256)) % G) % G);
      pg8::gemm_phase<false, true>(lds, pg8::Gemm{MEMN, WKVT, DM, DM, DM, 0, 0}, S, pg8::EpiBf16Store{KV, 512}); }
    xcd_barrier(xbar); }
    REPS(2) {
    if (bid < NB * NG) { pg8::Order S; S.init(NB, 1, NG, G, bid);
      pg8::gemm_phase<false, true>(lds, pg8::Gemm{AY, WSb, 512, 256, 256, (size_t)1024 * 512, (size_t)256 * 256}, S, pg8::EpiSend{AY, (const float*)(a.ws + WS_LAMT), (const float*)(a.ws + WS_LAM512)});
      asm volatile("s_waitcnt vmcnt(0)" ::: "memory"); __syncthreads();
      pg8::gemm_phase<false, true>(lds, pg8::Gemm{AY, WYb, 512, 512, 384, (size_t)1024 * 512, (size_t)256 * 512}, S, pg8::EpiY{AY, a.in[10], GB}); }
    else { attn_mfma(a, lds, bid - NB * NG, G - NB * NG); conv_vec(a, bid - NB * NG, G - NB * NG); }
    xcd_barrier(xbar); }
    REPS(4) {
    { pg8::Order S; S.init(NTOK / 256, 2, 2, G, bid);
      pg8::gemm_phase<false, true>(lds, pg8::Gemm{GB, WGLUT, WSSM, WSSM, WSSM, 0, 0}, S, pg8::EpiGluP{GB, PROJ, a.in[13], YCAT}); }
    xcd_barrier(xbar); }
    REPS(5) {
    { pg8::Order S; S.init(NTOK / 256, DM / 256, 1, G, bid);
      pg8::gemm_phase<false, true>(lds, pg8::Gemm{YCAT, WOUTT, DM, DM, DM, 0, 0}, S, pg8::EpiOutNorm{XB, (const float*)(a.ws + WS_RINV), a.in[19], a.out, (float*)(a.ws + WS_XCH), (unsigned*)(a.ws + WS_CTL + CTL_PANEL)}); }
    }
    __syncthreads();
    if (threadIdx.x == 0) { unsigned* ctl = (unsigned*)(a.ws + WS_CTL);
        const unsigned old_ = __hip_atomic_fetch_add(ctl + CTL_EXIT_WORD, 1u, __ATOMIC_RELAXED, __HIP_MEMORY_SCOPE_AGENT);
        if (old_ == (unsigned)G - 1u) __hip_atomic_store(ctl + CTL_FLAG_WORD, CTL_RESET, __ATOMIC_RELAXED, __HIP_MEMORY_SCOPE_AGENT); }
}

extern "C" void kernel_launch(void* const* d_in, const int* in_sizes, int n_in, void* d_out, int out_size, void* d_ws, size_t ws_size, hipStream_t stream) {
    static int grid = 0;
    if (grid == 0) {
        if (n_in != 20 || out_size != NTOK * DM || ws_size < WS_END) { fprintf(stderr, "kernel_launch: unexpected shapes n_in %d out %d ws %zu\n", n_in, out_size, ws_size); grid = -1; return; }
        int dev = 0, cus = 0, per_cu = 0;
        hipGetDevice(&dev);
        hipDeviceGetAttribute(&cus, hipDeviceAttributeMultiprocessorCount, dev);
        if (hipFuncSetAttribute((const void*)mega, hipFuncAttributeMaxDynamicSharedMemorySize, LDS_BYTES) != hipSuccess) { fprintf(stderr, "kernel_launch: hipFuncSetAttribute failed\n"); grid = -1; return; }
        if (hipOccupancyMaxActiveBlocksPerMultiprocessor(&per_cu, (const void*)mega, 512, LDS_BYTES) != hipSuccess || per_cu < 1) { fprintf(stderr, "kernel_launch: occupancy query says %d\n", per_cu); per_cu = 1; }
        (void)hipGetLastError();
        grid = cus;
        if (grid != 256) { fprintf(stderr, "kernel_launch: built for 256 CUs (one workgroup each), device has %d\n", grid); grid = -1; return; }
        if (grid < NB * NG) { fprintf(stderr, "kernel_launch: grid %d too small\n", grid); grid = -1; return; }
    }
    if (grid < 0) return;
    Args a{};
    for (int i = 0; i < 20; ++i) a.in[i] = (const float*)d_in[i];
    a.out = (float*)d_out; a.ws = (unsigned char*)d_ws;
    void* args[] = {&a};
    hipError_t e = hipLaunchCooperativeKernel((const void*)mega, dim3(grid), dim3(512), args, LDS_BYTES, stream);
    if (e != hipSuccess) fprintf(stderr, "cooperative launch failed: %s (grid %d)\n", hipGetErrorString(e), grid);
}
```

```cpp
#include <hip/hip_runtime.h>
#include <hip/hip_cooperative_groups.h>
#include <cstdio>
#include <cstdint>
namespace cg = cooperative_groups;

#define LAS __attribute__((address_space(3)))
typedef unsigned short bf16_t;
typedef unsigned v4u __attribute__((ext_vector_type(4)));
typedef float f32x4 __attribute__((ext_vector_type(4)));

constexpr int NB = 4, SEQ = 4096, DM = 1024, NTOK = NB * SEQ, DIN = 2816, WSSM = 384, NG = 24, GH = 16, NP = 64, NMEM = 256;
constexpr int C_AIN = 0, C_AGATE = 384, C_CIN = 768, C_CB = 1152, C_CC = 1536, C_CGATE = 1920, C_Q = 2304, C_QGATE = 2560;
constexpr int C_U = 768, C_W = 1152;
constexpr float NORM_EPS = 1e-6f;

constexpr size_t MiB = 1u << 20;
constexpr size_t WS_CTL = 0;
constexpr size_t WS_XB = 1 * MiB;
constexpr size_t WS_WINT = 33 * MiB;
constexpr size_t WS_WKVT = 39 * MiB;
constexpr size_t WS_WOUTT = 40 * MiB;
constexpr size_t WS_WGLUT = 42 * MiB;
constexpr size_t WS_MEMN = 43 * MiB;
constexpr size_t WS_KV = 45 * MiB;
constexpr size_t WS_LAMB = 46 * MiB;
constexpr size_t WS_BBAR = 46 * MiB + 65536;
constexpr size_t WS_GB = 47 * MiB;
constexpr size_t WS_PROJ = 59 * MiB;
constexpr size_t WS_YCAT = 147 * MiB;
constexpr size_t WS_AY = 179 * MiB;
constexpr size_t WS_WS = 203 * MiB;
constexpr size_t WS_WY = 206 * MiB;
constexpr size_t WS_LAMT = 212 * MiB;
constexpr size_t WS_LAM512 = 212 * MiB + 65536;
constexpr size_t WS_XCH = 213 * MiB;
constexpr size_t WS_RINV = 214 * MiB;
constexpr size_t WS_END = 215 * MiB;
constexpr size_t CTL_PANEL = 16384;
constexpr size_t CTL_BYTES = 32768;
constexpr int CTL_EXIT_WORD = 3968, CTL_FLAG_WORD = 8192 + 64;
constexpr unsigned CTL_TOKEN = 0x600DF00Du, CTL_RESET = 0x0BADF00Du;

constexpr int LDS_BYTES = 147456;

struct Args {
    const float* in[20];
    float* out;
    unsigned char* ws;
};

__device__ __forceinline__ unsigned f2bf(float f) { unsigned u = __builtin_bit_cast(unsigned, f); return (u + 0x7fffu + ((u >> 16) & 1u)) >> 16; }
__device__ __forceinline__ unsigned pk2(float lo, float hi) { return f2bf(lo) | (f2bf(hi) << 16); }
__device__ __forceinline__ float bf2f(unsigned short b) { return __builtin_bit_cast(float, ((unsigned)b) << 16); }
__device__ __forceinline__ float bflo(unsigned w) { return __builtin_bit_cast(float, w << 16); }
__device__ __forceinline__ float bfhi(unsigned w) { return __builtin_bit_cast(float, w & 0xffff0000u); }
__device__ __forceinline__ float wave_sum(float v) {
#pragma unroll
    for (int o = 1; o < 64; o <<= 1) v += __shfl_xor(v, o);
    return v;
}
__device__ __forceinline__ float silu_f(float v) { return v * __builtin_amdgcn_rcpf(1.0f + __builtin_amdgcn_exp2f(-1.4426950408889634f * v)); }
__device__ __forceinline__ float sigmoid_f(float v) { return __builtin_amdgcn_rcpf(1.0f + __builtin_amdgcn_exp2f(-1.4426950408889634f * v)); }
__device__ __forceinline__ float gelu_tanh(float v) { const float w = __builtin_fmaf(v * v, -0.10294324f, -2.3022082f); return v * __builtin_amdgcn_rcpf(1.0f + __builtin_amdgcn_exp2f(v * w)); }
#define LDS_WAIT() asm volatile("s_waitcnt lgkmcnt(0)" ::: "memory")
__device__ __forceinline__ int otid() { int t = threadIdx.x; asm volatile("" : "+v"(t)); return t; }

#define XB_TMO      128
#define XB_XCNT(j)  (256  + 64 * (j))
#define XB_XSUB(j)  (1280 + 64 * (j))
#define XB_XGEN(j)  (2304 + 64 * (j))
#define XB_TOP      3328
#define XB_TOPGEN   3392
#define XCD_BAR_WORDS 3456
#define XB_SPIN_CAP (1u << 18)

__device__ __forceinline__ unsigned xb_ld(unsigned* p)              { return __hip_atomic_load(p, __ATOMIC_RELAXED, __HIP_MEMORY_SCOPE_AGENT); }
__device__ __forceinline__ unsigned xb_add(unsigned* p, unsigned v) { return __hip_atomic_fetch_add(p, v, __ATOMIC_RELAXED, __HIP_MEMORY_SCOPE_AGENT); }
__device__ __forceinline__ unsigned xb_xcc_id() { return (unsigned)__builtin_amdgcn_s_getreg((3 << 11) | 20) & 0xFu; }
#define XB_SPIN(cond, bar) do { unsigned _sp = 0; while (cond) { __builtin_amdgcn_s_sleep(1); \
    if ((++_sp & 255u) == 0u) { if (xb_ld(&(bar)[XB_TMO])) break; if (_sp > XB_SPIN_CAP) { atomicAdd(&(bar)[XB_TMO], 1u); break; } } } } while (0)

struct XcdBarrier {
    unsigned* bar; unsigned x;
    volatile LAS unsigned* st;
};

__device__ __forceinline__ XcdBarrier xcd_barrier_post(unsigned* bar, volatile LAS unsigned* st) {
    XcdBarrier b; b.bar = bar; b.x = xb_xcc_id(); b.st = st;
    if (threadIdx.x == 0) (void)xb_add(&bar[XB_XCNT(b.x)], 1u);
    return b;
}
__device__ __forceinline__ void xcd_barrier_complete(unsigned* bar, unsigned x, unsigned& nloc, unsigned& nx) {
    const unsigned G = gridDim.x * gridDim.y * gridDim.z;
    unsigned sum, cnt, mine, sp = 0u;
    for (;;) {
        sum = 0u; cnt = 0u; mine = 0u;
#pragma unroll
        for (unsigned j = 0; j < 16; ++j) { const unsigned c = xb_ld(&bar[XB_XCNT(j)]); sum += c; cnt += (c > 0u) ? 1u : 0u; mine = (j == x) ? c : mine; }
        if (sum == G) break;
        __builtin_amdgcn_s_sleep(1);
        if ((++sp & 255u) == 0u) { if (xb_ld(&bar[XB_TMO])) break; if (sp > XB_SPIN_CAP) { atomicAdd(&bar[XB_TMO], 1u); break; } }
    }
    nloc = mine > 0u ? mine : 1u; nx = cnt > 0u ? cnt : 1u;
}

__device__ __forceinline__ void xcd_barrier(const XcdBarrier& b) {
    asm volatile("s_waitcnt vmcnt(0)" ::: "memory");
    __syncthreads();
    if (threadIdx.x == 0) {
        unsigned* bar = b.bar;
        __builtin_amdgcn_s_waitcnt(0);
        unsigned nloc = b.st[0], nx = b.st[1];
        if (nloc == 0u) { xcd_barrier_complete(bar, b.x, nloc, nx); b.st[0] = nloc; b.st[1] = nx; }
        const unsigned old = xb_add(&bar[XB_XSUB(b.x)], 1u);
        const unsigned gen = old / nloc;
        if (old + 1u == (gen + 1u) * nloc) {
            __builtin_amdgcn_fence(__ATOMIC_RELEASE, "agent");
            asm volatile("s_waitcnt vmcnt(0)" ::: "memory");
            const unsigned og = xb_add(&bar[XB_TOP], 1u);
            const unsigned tg = og / nx;
            if (og + 1u == (tg + 1u) * nx) xb_add(&bar[XB_TOPGEN], 1u);
            else XB_SPIN(xb_ld(&bar[XB_TOPGEN]) == tg, bar);
            __builtin_amdgcn_fence(__ATOMIC_ACQUIRE, "agent");
            xb_add(&bar[XB_XGEN(b.x)], 1u);
            asm volatile("s_waitcnt vmcnt(0)" ::: "memory");
        } else {
            XB_SPIN(xb_ld(&bar[XB_XGEN(b.x)]) == gen, bar);
            __builtin_amdgcn_fence(__ATOMIC_ACQUIRE, "agent");
            asm volatile("s_waitcnt vmcnt(0)" ::: "memory");
        }
    }
    __syncthreads();
}

__device__ __forceinline__ void rms_row_to_bf16(const float* xrow, bf16_t* orow, const float* gain, int lane) {
    const f32x4* xr = (const f32x4*)xrow + lane;
    f32x4 v[4]; float s = 0.f;
#pragma unroll
    for (int j = 0; j < 4; ++j) { v[j] = xr[64 * j]; s += (v[j].x * v[j].x + v[j].y * v[j].y) + (v[j].z * v[j].z + v[j].w * v[j].w); }
    const float rstd = 1.0f / sqrtf(wave_sum(s) * (1.0f / DM) + NORM_EPS);
    unsigned long long* o8 = (unsigned long long*)orow + lane;
#pragma unroll
    for (int j = 0; j < 4; ++j) {
        f32x4 g = gain ? ((const f32x4*)gain)[lane + 64 * j] : (f32x4){1.f, 1.f, 1.f, 1.f};
        o8[64 * j] = (unsigned long long)pk2(v[j].x * rstd * g.x, v[j].y * rstd * g.y) | ((unsigned long long)pk2(v[j].z * rstd * g.z, v[j].w * rstd * g.w) << 32);
    }
}
__device__ __forceinline__ void transpose_item(const float* W, int K, int N, bf16_t* WT, const float* ks, LAS float* scr, int item, int lane) {
    const int nblk = N / 32, kb = item / nblk, nb = item % nblk, k0 = 64 * kb, n0 = 32 * nb;
#pragma unroll 8
    for (int i = 0; i < 32; ++i) { const int kk = 2 * i + (lane >> 5); float w = W[(size_t)(k0 + kk) * N + n0 + (lane & 31)]; if (ks) w *= ks[k0 + kk]; scr[kk * 33 + (lane & 31)] = w; }
    LDS_WAIT();
    const int c = lane & 7;
#pragma unroll
    for (int j = 0; j < 4; ++j) { const int n = (lane >> 3) + 8 * j; const LAS float* s = scr + (8 * c) * 33 + n;
        v4u o; o.x = pk2(s[0 * 33], s[1 * 33]); o.y = pk2(s[2 * 33], s[3 * 33]); o.z = pk2(s[4 * 33], s[5 * 33]); o.w = pk2(s[6 * 33], s[7 * 33]);
        *(v4u*)(WT + (size_t)(n0 + n) * K + k0 + 8 * c) = o; }
    LDS_WAIT();
}


__device__ __forceinline__ void s5_tables(const Args& a, LAS unsigned char* lds, int tid) {
    const int bid = blockIdx.x; if (bid >= 192) return;
    const int g = bid % NG, q = bid / NG;
    const float* lam_re = a.in[4]; const float* lam_im = a.in[5]; const float* b_re = a.in[6]; const float* b_im = a.in[7]; const float* c_re = a.in[8]; const float* c_im = a.in[9]; const float* log_dt = a.in[11];
    LAS float* LPr = (LAS float*)(lds + 69632); LAS float* LPi = LPr + 17 * 64; LAS float* BBr = LPi + 17 * 64; LAS float* BBi = BBr + 1024;
    LAS float* Cr = BBi + 1024; LAS float* Ci = Cr + 1024; LAS float* KT = Ci + 1024;
    if (tid < 64) {
        const int p = tid, i = g * NP + p;
        const double dt = exp((double)log_dt[g]);
        const double lr = lam_re[i], li = lam_im[i];
        const double er = exp(lr * dt), ang = li * dt;
        const double lbr = er * cos(ang), lbi = er * sin(ang);
        const double nr = lbr - 1.0, ni = lbi, den = lr * lr + li * li;
        const double qr = (nr * lr + ni * li) / den, qi = (ni * lr - nr * li) / den;
        for (int h = 0; h < GH; ++h) { const double br = b_re[i * GH + h], bi = b_im[i * GH + h];
            BBr[p * 16 + h] = (float)(qr * br - qi * bi); BBi[p * 16 + h] = (float)(qr * bi + qi * br); }
        double pr = 1.0, pi = 0.0;
        for (int t = 0; t < 16; ++t) { LPr[t * 64 + p] = (float)pr; LPi[t * 64 + p] = (float)pi; const double nr2 = pr * lbr - pi * lbi, ni2 = pr * lbi + pi * lbr; pr = nr2; pi = ni2; }
        LPr[16 * 64 + p] = (float)pr; LPi[16 * 64 + p] = (float)pi;
        double tr = pr, ti = pi;
        if (q == 0) { float* LAMT = (float*)(a.ws + WS_LAMT); LAMT[2 * i] = (float)tr; LAMT[2 * i + 1] = (float)ti; }
        for (int k = 0; k < 5; ++k) { const double nr2 = tr * tr - ti * ti, ni2 = 2.0 * tr * ti; tr = nr2; ti = ni2; }
        if (q == 0) { float* L512 = (float*)(a.ws + WS_LAM512); L512[2 * i] = (float)tr; L512[2 * i + 1] = (float)ti; }
    }
    for (int i = tid; i < 1024; i += 512) { Cr[i] = c_re[g * 1024 + i]; Ci[i] = c_im[g * 1024 + i]; }
    __syncthreads();
    { const int tau = tid >> 5, hol = (tid >> 4) & 1, hi = tid & 15, ho = 2 * q + hol; float sacc = 0.f;
#pragma unroll 4
      for (int p = 0; p < 64; ++p) { const float lpr = LPr[tau * 64 + p], lpi = LPi[tau * 64 + p], br = BBr[p * 16 + hi], bi = BBi[p * 16 + hi];
          const float wr_ = lpr * br - lpi * bi, wi_ = lpr * bi + lpi * br; sacc += Cr[ho * 64 + p] * wr_ - Ci[ho * 64 + p] * wi_; }
      KT[tid] = sacc; }
    __syncthreads();
    bf16_t* WSb = (bf16_t*)(a.ws + WS_WS); bf16_t* WYb = (bf16_t*)(a.ws + WS_WY);
#pragma unroll
    for (int kk = 0; kk < 2; ++kk) { const int ch = tid + 512 * kk, n = 32 * q + (ch >> 5), k0 = (ch & 31) * 8, p = n & 63, isim = (n >> 6) & 1;
        float v[8];
#pragma unroll
        for (int j = 0; j < 8; ++j) { const int k = k0 + j, t = k >> 4, h = k & 15, tau = 15 - t; const float lpr = LPr[tau * 64 + p], lpi = LPi[tau * 64 + p], br = BBr[p * 16 + h], bi = BBi[p * 16 + h];
            const float val = isim ? (lpr * bi + lpi * br) : (lpr * br - lpi * bi); v[j] = n < 128 ? val : 0.f; }
        v4u o; o.x = pk2(v[0], v[1]); o.y = pk2(v[2], v[3]); o.z = pk2(v[4], v[5]); o.w = pk2(v[6], v[7]);
        *(v4u*)(WSb + ((size_t)(g * 256 + n)) * 256 + k0) = o; }
#pragma unroll
    for (int kk = 0; kk < 4; ++kk) { const int ch = tid + 512 * kk, rr = ch >> 6, to = rr >> 1, hol = rr & 1, ho = 2 * q + hol, n = to * 16 + ho, k0 = (ch & 63) * 8;
        float v[8];
#pragma unroll
        for (int j = 0; j < 8; ++j) { const int k = k0 + j; float val;
            if (k < 256) { const int ti = k >> 4, hi = k & 15; val = ti <= to ? KT[((to - ti) * 2 + hol) * 16 + hi] : 0.f; }
            else { const int jj = (k - 256) & 127, p = jj & 63, isim = jj >> 6; const float lpr = LPr[(to + 1) * 64 + p], lpi = LPi[(to + 1) * 64 + p], cr = Cr[ho * 64 + p], ci = Ci[ho * 64 + p];
                val = isim ? -(cr * lpi + ci * lpr) : (cr * lpr - ci * lpi); }
            v[j] = val; }
        v4u o; o.x = pk2(v[0], v[1]); o.y = pk2(v[2], v[3]); o.z = pk2(v[4], v[5]); o.w = pk2(v[6], v[7]);
        *(v4u*)(WYb + ((size_t)(g * 256 + n)) * 512 + k0) = o; }
}

__device__ __forceinline__ void rms_rows2_to_bf16(const float* x0, const float* x1, bf16_t* o0, bf16_t* o1, const float* gain, int lane, float* rinv = nullptr) {
    const f32x4* xr0 = (const f32x4*)x0 + lane; const f32x4* xr1 = (const f32x4*)x1 + lane;
    f32x4 v[4], w[4]; float s0 = 0.f, s1 = 0.f;
#pragma unroll
    for (int j = 0; j < 4; ++j) { v[j] = __builtin_nontemporal_load(xr0 + 64 * j); w[j] = __builtin_nontemporal_load(xr1 + 64 * j); }
#pragma unroll
    for (int j = 0; j < 4; ++j) { s0 += (v[j].x * v[j].x + v[j].y * v[j].y) + (v[j].z * v[j].z + v[j].w * v[j].w); s1 += (w[j].x * w[j].x + w[j].y * w[j].y) + (w[j].z * w[j].z + w[j].w * w[j].w); }
#pragma unroll
    for (int o = 1; o < 64; o <<= 1) { s0 += __shfl_xor(s0, o); s1 += __shfl_xor(s1, o); }
    const float q0 = sqrtf(s0 * (1.0f / DM) + NORM_EPS), q1 = sqrtf(s1 * (1.0f / DM) + NORM_EPS);
    const float r0 = 1.0f / q0, r1 = 1.0f / q1;
    if (rinv && lane == 0) { rinv[0] = q0; rinv[1] = q1; }
    unsigned long long* p0 = (unsigned long long*)o0 + lane; unsigned long long* p1 = (unsigned long long*)o1 + lane;
#pragma unroll
    for (int j = 0; j < 4; ++j) {
        const f32x4 g = gain ? ((const f32x4*)gain)[lane + 64 * j] : (f32x4){1.f, 1.f, 1.f, 1.f};
        p0[64 * j] = (unsigned long long)pk2(v[j].x * r0 * g.x, v[j].y * r0 * g.y) | ((unsigned long long)pk2(v[j].z * r0 * g.z, v[j].w * r0 * g.w) << 32);
        p1[64 * j] = (unsigned long long)pk2(w[j].x * r1 * g.x, w[j].y * r1 * g.y) | ((unsigned long long)pk2(w[j].z * r1 * g.z, w[j].w * r1 * g.w) << 32);
    }
}
__device__ __forceinline__ int win_dest_col(int n) {
    if (n < 768 || n >= 2304) return n;
    const int q = (n - 768) / 384, ch = (n - 768) % 384, base = (q == 0 || q == 2) ? 768 : 1536, half = (q >= 2) ? 128 : 0;
    return base + 256 * (ch >> 7) + half + (ch & 127);
}
__device__ __forceinline__ void transpose_item4(const float* W, int K, int N, bf16_t* WT, const float* ks, LAS float* scr, int item, int lane, bool winmap = false) {
    const int nblk = N / 32, kb = item / nblk, nb = item % nblk, k0 = 64 * kb, n0 = 32 * nb, d0 = winmap ? win_dest_col(n0) : n0;
    f32x4 w[8];
#pragma unroll
    for (int i = 0; i < 8; ++i) { const int kk = 8 * i + (lane >> 3); w[i] = __builtin_nontemporal_load((const f32x4*)(W + (size_t)(k0 + kk) * N + n0 + 4 * (lane & 7))); }
#pragma unroll
    for (int i = 0; i < 8; ++i) { const int kk = 8 * i + (lane >> 3); const float sc = ks ? ks[k0 + kk] : 1.0f; LAS float* d = scr + kk * 33 + 4 * (lane & 7);
        d[0] = w[i].x * sc; d[1] = w[i].y * sc; d[2] = w[i].z * sc; d[3] = w[i].w * sc; }
    LDS_WAIT();
    const int c = lane & 7;
#pragma unroll
    for (int j = 0; j < 4; ++j) { const int n = (lane >> 3) + 8 * j; const LAS float* sp = scr + (8 * c) * 33 + n;
        v4u o; o.x = pk2(sp[0 * 33], sp[1 * 33]); o.y = pk2(sp[2 * 33], sp[3 * 33]); o.z = pk2(sp[4 * 33], sp[5 * 33]); o.w = pk2(sp[6 * 33], sp[7 * 33]);
        *(v4u*)(WT + (size_t)(d0 + n) * K + k0 + 8 * c) = o; }
    LDS_WAIT();
}

__device__ __forceinline__ void phase0(const Args& a, LAS unsigned char* lds) {
    const int tid = otid(), lane = tid & 63, wave = tid >> 6;
    const int gw = blockIdx.x * 8 + wave, NGW = gridDim.x * 8;
    s5_tables(a, lds, tid);
    const float* x = a.in[0]; const float* mem = a.in[1]; const float* norm_g = a.in[2]; const float* w_in = a.in[3];
    const float* w_glu = a.in[12]; const float* mem_norm_g = a.in[16]; const float* w_mem_kv = a.in[17]; const float* w_out = a.in[18];
    bf16_t* XB = (bf16_t*)(a.ws + WS_XB); bf16_t* MEMN = (bf16_t*)(a.ws + WS_MEMN);
    bf16_t* WINT = (bf16_t*)(a.ws + WS_WINT); bf16_t* WKVT = (bf16_t*)(a.ws + WS_WKVT); bf16_t* WOUTT = (bf16_t*)(a.ws + WS_WOUTT); bf16_t* WGLUT = (bf16_t*)(a.ws + WS_WGLUT);
    for (int rnd = 0; rnd < 5; ++rnd) { const int r2 = rnd < 4 ? rnd * NGW + gw : 4 * NGW + (gw - 1536); if (rnd == 4 && (gw < 1536 || r2 >= (NTOK + NB * NMEM) / 2)) break; const int r = 2 * r2;
        if (r < NTOK) rms_rows2_to_bf16(x + (size_t)r * DM, x + (size_t)(r + 1) * DM, XB + (size_t)r * DM, XB + (size_t)(r + 1) * DM, nullptr, lane, (float*)(a.ws + WS_RINV) + r);
        else { const int m = r - NTOK; rms_rows2_to_bf16(mem + (size_t)m * DM, mem + (size_t)(m + 1) * DM, MEMN + (size_t)m * DM, MEMN + (size_t)(m + 1) * DM, mem_norm_g, lane); }
    }
    LAS float* scr = (LAS float*)(lds + wave * 8448);
    constexpr int I_IN = (DM / 64) * (DIN / 32), I_KV = (DM / 64) * (512 / 32), I_OUT = (DM / 64) * (DM / 32), I_GLU = (WSSM / 64) * (WSSM / 32);
    for (int rnd = 0; rnd < 2; ++rnd) { const int it = rnd == 0 ? gw : NGW + (gw - 1536); if (rnd == 1 && (gw < 1536 || it >= I_IN + I_KV + I_OUT + I_GLU)) break;
        int r = it;
        if (r < I_IN) { transpose_item4(w_in, DM, DIN, WINT, norm_g, scr, r, lane, true); continue; } r -= I_IN;
        if (r < I_KV) { transpose_item4(w_mem_kv, DM, 512, WKVT, nullptr, scr, r, lane); continue; } r -= I_KV;
        if (r < I_OUT) { transpose_item4(w_out, DM, DM, WOUTT, nullptr, scr, r, lane); continue; } r -= I_OUT;
        transpose_item4(w_glu, WSSM, WSSM, WGLUT, nullptr, scr, r, lane);
    }
    const int gt = blockIdx.x * 512 + tid, NT = gridDim.x * 512;
    for (int i = gt; i < 128 * 384 / 2; i += NT) ((unsigned*)(WGLUT + 384 * 384))[i] = 0u;
}

template <class Epi>
__device__ __forceinline__ void gemm_naive(const bf16_t* A, int lda, const bf16_t* Bt, int ldb, int M, int N, int K, LAS unsigned char* lds, int tile0, int ntile_total, const Epi& epi) {
    LAS float* As = (LAS float*)lds;
    LAS float* Bs = As + 32 * 132;
    const int tid = threadIdx.x, ty = tid >> 4, tx = tid & 15;
    const int ntn = N / 64, nt = (M / 128) * ntn;
    (void)ntile_total;
    for (int tile = blockIdx.x - tile0; tile < nt; tile += gridDim.x) {
        if (tile < 0) continue;
        const int tm = tile / ntn, tn = tile % ntn;
        float acc[4][4];
#pragma unroll
        for (int i = 0; i < 4; ++i)
#pragma unroll
            for (int j = 0; j < 4; ++j) acc[i][j] = 0.f;
        for (int k0 = 0; k0 < K; k0 += 32) {
            __syncthreads();
            { const int r = tid >> 2, kc = (tid & 3) * 8; const v4u v = *(const v4u*)(A + (size_t)(tm * 128 + r) * lda + k0 + kc);
              As[(kc + 0) * 132 + r] = bflo(v.x); As[(kc + 1) * 132 + r] = bfhi(v.x); As[(kc + 2) * 132 + r] = bflo(v.y); As[(kc + 3) * 132 + r] = bfhi(v.y);
              As[(kc + 4) * 132 + r] = bflo(v.z); As[(kc + 5) * 132 + r] = bfhi(v.z); As[(kc + 6) * 132 + r] = bflo(v.w); As[(kc + 7) * 132 + r] = bfhi(v.w); }
            if (tid < 256) { const int r = tid >> 2, kc = (tid & 3) * 8; const v4u v = *(const v4u*)(Bt + (size_t)(tn * 64 + r) * ldb + k0 + kc);
              Bs[(kc + 0) * 68 + r] = bflo(v.x); Bs[(kc + 1) * 68 + r] = bfhi(v.x); Bs[(kc + 2) * 68 + r] = bflo(v.y); Bs[(kc + 3) * 68 + r] = bfhi(v.y);
              Bs[(kc + 4) * 68 + r] = bflo(v.z); Bs[(kc + 5) * 68 + r] = bfhi(v.z); Bs[(kc + 6) * 68 + r] = bflo(v.w); Bs[(kc + 7) * 68 + r] = bfhi(v.w); }
            __syncthreads();
#pragma unroll 8
            for (int k = 0; k < 32; ++k) {
                const f32x4 av = *(const LAS f32x4*)(As + k * 132 + ty * 4), bv = *(const LAS f32x4*)(Bs + k * 68 + tx * 4);
#pragma unroll
                for (int i = 0; i < 4; ++i)
#pragma unroll
                    for (int j = 0; j < 4; ++j) acc[i][j] += av[i] * bv[j];
            }
        }
#pragma unroll
        for (int i = 0; i < 4; ++i)
#pragma unroll
            for (int j = 0; j < 4; ++j) epi(tm * 128 + ty * 4 + i, tn * 64 + tx * 4 + j, acc[i][j]);
    }
}

struct EpiStoreBf16 { bf16_t* O; int ldo; __device__ __forceinline__ void operator()(int r, int c, float v) const { O[(size_t)r * ldo + c] = (bf16_t)f2bf(v); } };
struct EpiGlu { const bf16_t* GB; const bf16_t* PROJ; const float* b_glu; bf16_t* YCAT;
    __device__ __forceinline__ void operator()(int r, int c, float v) const {
        const float g = bf2f(GB[(size_t)r * WSSM + c]); const float gate = bf2f(PROJ[(size_t)r * DIN + C_AGATE + c]);
        YCAT[(size_t)r * DM + c] = (bf16_t)f2bf(g * sigmoid_f(v + b_glu[c]) * silu_f(gate)); } };
struct EpiOut { const float* x; float* out; __device__ __forceinline__ void operator()(int r, int c, float v) const { out[(size_t)r * DM + c] = x[(size_t)r * DM + c] + v; } };


namespace pg8 {
typedef short bf16x8 __attribute__((ext_vector_type(8)));
typedef unsigned u32x4 __attribute__((ext_vector_type(4)));
constexpr int BM = 256, BK = 64, HALF = 128, HTB = HALF * BK * 2, STAGE_BYTES = 8 * HTB, NXCD = 8, WGM = 8;
__host__ __device__ __forceinline__ int lds_byte(int r, int c) { const int st = (r >> 4) * 2 + (c >> 5), rr = r & 15, cc = c & 31, ob = rr * 64 + cc * 2; return st * 1024 + (ob ^ (((ob >> 9) & 1) << 5)); }
__host__ __device__ __forceinline__ void stage_rc(int b, int& R, int& C) { const int st = b / 1024, sb = b % 1024, swz = sb ^ (((sb >> 9) & 1) << 5); R = (st >> 1) * 16 + swz / 64; C = (st & 1) * 32 + (swz % 64) / 2; }
__host__ __device__ __forceinline__ int perm32(int rho) { const int n = rho >> 4, i = rho & 15; return 8 * (i >> 2) + 4 * n + (i & 3); }
struct Unit { int pm, pn, z; };
struct Gemm { const bf16_t* A; const bf16_t* Bt; int lda, ldb, K; size_t sAz, sBz; };
struct Order {
    int nM, nN, per, total, G, c;
    __device__ void init(int nM_, int nN_, int nZ_, int G_, int c_) { nM = nM_; nN = nN_; per = nM_ * nN_; total = per * nZ_; G = G_; c = c_; }
    __device__ bool next(int i, Unit& u) const {
        const long L = (long)i * G + c; if (L >= total) return false;
        u.z = (int)(L / per); int wgid = (int)(L % per); const int nwg = per;
        { const int q = nwg / NXCD, r = nwg % NXCD, xcd = wgid % NXCD, off = wgid / NXCD; wgid = (xcd < r ? xcd * (q + 1) : r * (q + 1) + (xcd - r) * q) + off; }
        const int nig = WGM * nN, gid = wgid / nig, fm = gid * WGM, gsz = (nM - fm) < WGM ? (nM - fm) : WGM;
        u.pm = fm + ((wgid % nig) % gsz); u.pn = (wgid % nig) / gsz; return true;
    }
};
typedef __bf16 bf2v_t __attribute__((ext_vector_type(2))); typedef float f2v_t __attribute__((ext_vector_type(2)));
__device__ __forceinline__ unsigned cvt_pk_bf16(float lo, float hi) { const f2v_t v = {lo, hi}; return __builtin_bit_cast(unsigned, __builtin_convertvector(v, bf2v_t)); }

template <bool ALIGN_EPI = false, bool SP2 = false, class Epi>
__device__ __forceinline__ void gemm_phase(LAS unsigned char* lds, const Gemm g, const Order& S, const Epi& E) {
    int tid = threadIdx.x; asm volatile("" : "+v"(tid));
    const int wid = __builtin_amdgcn_readfirstlane(tid >> 6), lane = tid & 63, wr = wid >> 2, wc = wid & 3, fr = lane & 15, fq = lane >> 4;
    int K = g.K; asm volatile("" : "+s"(K));
    const int nt = K / BK;
    unsigned voffA[2], voffB[2];
#pragma unroll
    for (int i = 0; i < 2; ++i) { int R, C; stage_rc(tid * 16 + i * 8192, R, C); const int Rb = Epi::PERM ? ((R & ~31) + perm32(R & 31)) : R;
        voffA[i] = (unsigned)(R * g.lda + C) * 2u; voffB[i] = (unsigned)(Rb * g.ldb + C) * 2u; }
    const size_t kstep = (size_t)(BK * 2);
    const size_t hstepA = (size_t)HALF * g.lda * 2, hstepB = (size_t)HALF * g.ldb * 2;
    const size_t tstepA = 2 * hstepA, tstepB = 2 * hstepB;
    const unsigned ldsw = (unsigned)wid * 1024u;
    const int aoff = lds_byte(wr * 64 + fr, fq * 8), boff = lds_byte(wc * 32 + fr, fq * 8);
#define PG8_SA(b, h) (((b) * 2 + (h)) * HTB)
#define PG8_SB(b, h) ((4 + (b) * 2 + (h)) * HTB)
#define PG8_STAGE(bufoff, gbase, voff) do { _Pragma("unroll") for (int _i = 0; _i < 2; ++_i) \
        __builtin_amdgcn_global_load_lds((const unsigned*)((const char*)(gbase) + (voff)[_i]), (LAS unsigned*)(lds + (bufoff) + ldsw + _i * 8192), 16, 0, 0); } while (0)
#define PG8_LDA(dst, b, h) do { _Pragma("unroll") for (int m = 0; m < 4; ++m) _Pragma("unroll") for (int k = 0; k < 2; ++k) dst[m][k] = *(const LAS bf16x8*)(lds + PG8_SA(b, h) + aoff + m * 2048 + k * 1024); } while (0)
#define PG8_LDB(dst, b, h) do { _Pragma("unroll") for (int n = 0; n < 2; ++n) _Pragma("unroll") for (int k = 0; k < 2; ++k) dst[n][k] = *(const LAS bf16x8*)(lds + PG8_SB(b, h) + boff + n * 2048 + k * 1024); } while (0)
#define PG8_MMA(ai, bj, At, Bt) do { __builtin_amdgcn_s_setprio(1); _Pragma("unroll") for (int m = 0; m < 4; ++m) _Pragma("unroll") for (int n = 0; n < 2; ++n) _Pragma("unroll") for (int k = 0; k < 2; ++k) \
        acc[ai][bj][m][n] = __builtin_amdgcn_mfma_f32_16x16x32_bf16(Bt[n][k], At[m][k], acc[ai][bj][m][n], 0, 0, 0); __builtin_amdgcn_s_setprio(0); } while (0)
#define PG8_WAIT_V(n) asm volatile("s_waitcnt vmcnt(" #n ")" ::: "memory")
#define PG8_WAIT_L(n) asm volatile("s_waitcnt lgkmcnt(" #n ")" ::: "memory")
#define PG8_BAR __builtin_amdgcn_s_barrier()
#define PG8_SCHED __builtin_amdgcn_sched_barrier(0)
    Unit cur, nxt; int ui = 0;
    if (!S.next(0, cur)) return;
    f32x4 acc[2][2][4][2];
#pragma unroll
    for (int a = 0; a < 2; ++a)
#pragma unroll
        for (int b = 0; b < 2; ++b)
#pragma unroll
            for (int m = 0; m < 4; ++m)
#pragma unroll
                for (int n = 0; n < 2; ++n) acc[a][b][m][n] = (f32x4){0.f, 0.f, 0.f, 0.f};
    bf16x8 At[4][2], B0[2][2], B1[2][2];
    const char* cA = (const char*)(g.A + (size_t)cur.z * g.sAz) + (size_t)cur.pm * tstepA; const char* cB = (const char*)(g.Bt + (size_t)cur.z * g.sBz) + (size_t)cur.pn * tstepB;
    if constexpr (SP2) {
        PG8_STAGE(PG8_SB(0, 0), cB, voffB); PG8_STAGE(PG8_SB(0, 1), cB + hstepB, voffB); PG8_STAGE(PG8_SA(0, 0), cA, voffA); PG8_STAGE(PG8_SA(0, 1), cA + hstepA, voffA);
        if (wr == 1) PG8_BAR;
        PG8_WAIT_V(2); PG8_BAR;
        PG8_STAGE(PG8_SB(1, 0), cB + kstep, voffB); PG8_STAGE(PG8_SA(1, 0), cA + kstep, voffA); PG8_STAGE(PG8_SB(1, 1), cB + hstepB + kstep, voffB);
        PG8_WAIT_V(6); PG8_BAR;
    } else {
    PG8_STAGE(PG8_SB(0, 0), cB, voffB); PG8_STAGE(PG8_SA(0, 0), cA, voffA); PG8_STAGE(PG8_SB(0, 1), cB + hstepB, voffB); PG8_STAGE(PG8_SA(0, 1), cA + hstepA, voffA);
    if (wr == 1) PG8_BAR;
    PG8_WAIT_V(4); PG8_BAR;
    PG8_STAGE(PG8_SB(1, 0), cB + kstep, voffB); PG8_STAGE(PG8_SA(1, 0), cA + kstep, voffA); PG8_STAGE(PG8_SB(1, 1), cB + hstepB + kstep, voffB);
    PG8_WAIT_V(6); PG8_BAR;
    }
    for (;;) {
        const bool has_next = S.next(ui + 1, nxt);
        const char* nA = has_next ? (const char*)(g.A + (size_t)nxt.z * g.sAz) + (size_t)nxt.pm * tstepA : cA; const char* nB = has_next ? (const char*)(g.Bt + (size_t)nxt.z * g.sBz) + (size_t)nxt.pn * tstepB : cB;
        for (int t = 0; t < nt; t += 2) {
            const bool last = (t == nt - 2);
            const char* a1 = cA + (size_t)(t + 1) * kstep;
            const char* a2 = last ? nA : cA + (size_t)(t + 2) * kstep; const char* b2 = last ? nB : cB + (size_t)(t + 2) * kstep;
            const char* a3 = a2 + kstep; const char* b3 = b2 + kstep;
            if constexpr (SP2) {
            PG8_LDB(B0, 0, 0); PG8_LDB(B1, 0, 1); PG8_SCHED; PG8_LDA(At, 0, 0); PG8_STAGE(PG8_SA(1, 1), a1 + hstepA, voffA);
            PG8_WAIT_V(8); PG8_WAIT_L(0); PG8_BAR; PG8_MMA(0, 0, At, B0); PG8_MMA(0, 1, At, B1); PG8_BAR; PG8_SCHED;
            PG8_LDA(At, 0, 1); PG8_STAGE(PG8_SB(0, 0), b2, voffB); PG8_STAGE(PG8_SB(0, 1), b2 + hstepB, voffB); PG8_STAGE(PG8_SA(0, 0), a2, voffA);
            PG8_WAIT_V(8); PG8_WAIT_L(0); PG8_BAR; PG8_MMA(1, 0, At, B0); PG8_MMA(1, 1, At, B1); PG8_BAR; PG8_SCHED;
            PG8_LDB(B0, 1, 0); PG8_LDB(B1, 1, 1); PG8_SCHED; PG8_LDA(At, 1, 0); PG8_STAGE(PG8_SA(0, 1), a2 + hstepA, voffA);
            PG8_WAIT_V(8); PG8_WAIT_L(0); PG8_BAR; PG8_MMA(0, 0, At, B0); PG8_MMA(0, 1, At, B1); PG8_BAR; PG8_SCHED;
            PG8_LDA(At, 1, 1); PG8_STAGE(PG8_SB(1, 0), b3, voffB); PG8_STAGE(PG8_SB(1, 1), b3 + hstepB, voffB); PG8_STAGE(PG8_SA(1, 0), a3, voffA);
            PG8_WAIT_V(8); PG8_WAIT_L(0); PG8_BAR; PG8_MMA(1, 0, At, B0); PG8_MMA(1, 1, At, B1); PG8_BAR; PG8_SCHED;
            } else {
            PG8_LDB(B0, 0, 0); PG8_SCHED; PG8_LDA(At, 0, 0); PG8_STAGE(PG8_SA(1, 1), a1 + hstepA, voffA);
            PG8_WAIT_L(8); PG8_BAR; PG8_WAIT_L(0); PG8_MMA(0, 0, At, B0); PG8_BAR; PG8_SCHED;
            PG8_LDB(B1, 0, 1); PG8_STAGE(PG8_SB(0, 0), b2, voffB);
            PG8_BAR; PG8_WAIT_L(0); PG8_MMA(0, 1, At, B1); PG8_BAR;
            PG8_LDA(At, 0, 1); PG8_STAGE(PG8_SA(0, 0), a2, voffA);
            PG8_BAR; PG8_WAIT_L(0); PG8_MMA(1, 0, At, B0); PG8_BAR; PG8_SCHED;
            PG8_STAGE(PG8_SB(0, 1), b2 + hstepB, voffB);
            PG8_WAIT_V(6); PG8_BAR; PG8_MMA(1, 1, At, B1); PG8_BAR;
            PG8_LDB(B0, 1, 0); PG8_SCHED; PG8_LDA(At, 1, 0); PG8_STAGE(PG8_SA(0, 1), a2 + hstepA, voffA);
            PG8_WAIT_L(8); PG8_BAR; PG8_WAIT_L(0); PG8_MMA(0, 0, At, B0); PG8_BAR; PG8_SCHED;
            PG8_LDB(B1, 1, 1); PG8_STAGE(PG8_SB(1, 0), b3, voffB);
            PG8_BAR; PG8_WAIT_L(0); PG8_MMA(0, 1, At, B1); PG8_BAR;
            PG8_LDA(At, 1, 1); PG8_STAGE(PG8_SA(1, 0), a3, voffA);
            PG8_BAR; PG8_WAIT_L(0); PG8_MMA(1, 0, At, B0); PG8_BAR; PG8_SCHED;
            PG8_STAGE(PG8_SB(1, 1), b3 + hstepB, voffB);
            PG8_WAIT_V(6); PG8_BAR; PG8_MMA(1, 1, At, B1); PG8_BAR;
            }
        }
        if constexpr (ALIGN_EPI) { if (wr == 0) PG8_BAR; }
        if constexpr (!Epi::AFTER_DRAIN) { E(acc, cur, wr, wc, fr, fq); }
        if (!has_next) break;
#pragma unroll
        for (int a = 0; a < 2; ++a)
#pragma unroll
            for (int b = 0; b < 2; ++b)
#pragma unroll
                for (int m = 0; m < 4; ++m)
#pragma unroll
                    for (int n = 0; n < 2; ++n) acc[a][b][m][n] = (f32x4){0.f, 0.f, 0.f, 0.f};
        cur = nxt; cA = nA; cB = nB; ++ui;
        if constexpr (ALIGN_EPI) { if (wr == 1) PG8_BAR; }
    }
    PG8_WAIT_V(0);
    if constexpr (!ALIGN_EPI) { if (wr == 0) PG8_BAR; }
    PG8_BAR;
    if constexpr (Epi::AFTER_DRAIN) { E.fused(acc, cur, wr, wc, fr, fq, lds, wid, lane); }
#undef PG8_SA
#undef PG8_SB
#undef PG8_STAGE
#undef PG8_LDA
#undef PG8_LDB
#undef PG8_MMA
#undef PG8_WAIT_V
#undef PG8_WAIT_L
#undef PG8_BAR
#undef PG8_SCHED
}

struct EpiBf16Store {
    static constexpr bool PERM = true, AFTER_DRAIN = false;
    bf16_t* O; int ldc;
    __device__ __forceinline__ void operator()(const f32x4 (&acc)[2][2][4][2], const Unit& u, int wr, int wc, int fr, int fq) const {
        const int row0 = u.pm * BM + wr * 64 + fr, col0 = u.pn * BM + wc * 32 + 8 * fq;
#pragma unroll
        for (int ai = 0; ai < 2; ++ai)
#pragma unroll
            for (int m = 0; m < 4; ++m) { bf16_t* rowp = O + (size_t)(row0 + ai * HALF + m * 16) * ldc + col0;
#pragma unroll
                for (int bj = 0; bj < 2; ++bj) { const f32x4 v0 = acc[ai][bj][m][0], v1 = acc[ai][bj][m][1];
                    u32x4 w; w.x = cvt_pk_bf16(v0[0], v0[1]); w.y = cvt_pk_bf16(v0[2], v0[3]); w.z = cvt_pk_bf16(v1[0], v1[1]); w.w = cvt_pk_bf16(v1[2], v1[3]);
                    *(u32x4*)(rowp + bj * HALF) = w; } }
    }
};

struct EpiProjAY {
    static constexpr bool PERM = true, AFTER_DRAIN = false;
    bf16_t* PROJ; bf16_t* AY;
    __device__ __forceinline__ void operator()(const f32x4 (&acc)[2][2][4][2], const Unit& u, int wr, int wc, int fr, int fq) const {
        const int rowb = u.pm * BM + wr * 64, col0 = u.pn * BM + wc * 32 + 8 * fq;
        if (u.pn >= 3 && u.pn <= 8) {
            const bool gate = u.pn >= 6; const int colo = (gate ? C_W + (u.pn - 6) * HALF : C_U + (u.pn - 3) * HALF) + wc * 32 + 8 * fq;
#pragma unroll
            for (int ai = 0; ai < 2; ++ai)
#pragma unroll
                for (int m = 0; m < 4; ++m) { const int rb = rowb + ai * HALF + m * 16;
                    const f32x4 a0 = acc[ai][0][m][0], a1 = acc[ai][0][m][1], b0 = acc[ai][1][m][0], b1 = acc[ai][1][m][1];
                    f32x4 p0, p1;
                    if (gate) { p0 = (f32x4){a0[0] * silu_f(b0[0]), a0[1] * silu_f(b0[1]), a0[2] * silu_f(b0[2]), a0[3] * silu_f(b0[3])}; p1 = (f32x4){a1[0] * silu_f(b1[0]), a1[1] * silu_f(b1[1]), a1[2] * silu_f(b1[2]), a1[3] * silu_f(b1[3])}; }
                    else { p0 = a0 * b0; p1 = a1 * b1; }
                    u32x4 w; w.x = cvt_pk_bf16(p0[0], p0[1]); w.y = cvt_pk_bf16(p0[2], p0[3]); w.z = cvt_pk_bf16(p1[0], p1[1]); w.w = cvt_pk_bf16(p1[2], p1[3]);
                    *(u32x4*)(PROJ + (size_t)(rb + fr) * DIN + colo) = w; }
            return; }
#pragma unroll
        for (int bj = 0; bj < 2; ++bj) { const int col = col0 + bj * HALF; const bool ay = col < WSSM;
#pragma unroll
            for (int ai = 0; ai < 2; ++ai)
#pragma unroll
                for (int m = 0; m < 4; ++m) { const int rb = rowb + ai * HALF + m * 16;
                    bf16_t* dst = ay ? AY + ((size_t)((col >> 4) * 1024 + (rb >> 4)) * 512 + fr * 16 + (col & 15)) : PROJ + (size_t)(rb + fr) * DIN + col;
                    const f32x4 v0 = acc[ai][bj][m][0], v1 = acc[ai][bj][m][1];
                    u32x4 w; w.x = cvt_pk_bf16(v0[0], v0[1]); w.y = cvt_pk_bf16(v0[2], v0[3]); w.z = cvt_pk_bf16(v1[0], v1[1]); w.w = cvt_pk_bf16(v1[2], v1[3]);
                    *(u32x4*)dst = w; } }
    }
};
struct EpiSend {
    static constexpr bool PERM = false, AFTER_DRAIN = true;
    bf16_t* AY; const float* LAMT; const float* LAM512;
    __device__ __forceinline__ void fused(const f32x4 (&acc)[2][2][4][2], const Unit& u, int wr, int wc, int fr, int fq, LAS unsigned char* lds, int wid, int lane) const {
        LAS float* S = (LAS float*)lds;
        LAS float* E = (LAS float*)(lds + 131072);
#pragma unroll
        for (int ai = 0; ai < 2; ++ai)
#pragma unroll
            for (int m = 0; m < 4; ++m)
#pragma unroll
                for (int n = 0; n < 2; ++n) { const int r = ai * HALF + wr * 64 + m * 16 + fr, c = wc * 32 + n * 16 + 4 * fq; *(LAS f32x4*)(S + r * 128 + c) = acc[ai][0][m][n]; }
        __syncthreads();
        const int g = u.z, b = u.pm, p = lane, seg = wid;
        const float tr = LAMT[(g * NP + p) * 2], ti = LAMT[(g * NP + p) * 2 + 1], hr = LAM512[(g * NP + p) * 2], hi = LAM512[(g * NP + p) * 2 + 1];
        float sr = 0.f, si = 0.f;
        for (int i = 0; i < 32; ++i) { const int row = seg * 32 + i; const float xr = S[row * 128 + p], xi = S[row * 128 + 64 + p];
            const float nr = tr * sr - ti * si + xr, ni = tr * si + ti * sr + xi; sr = nr; si = ni; }
        E[seg * 128 + p] = sr; E[seg * 128 + 64 + p] = si;
        __syncthreads();
        sr = 0.f; si = 0.f;
        for (int s2 = 0; s2 < seg; ++s2) { const float xr = E[s2 * 128 + p], xi = E[s2 * 128 + 64 + p]; const float nr = hr * sr - hi * si + xr, ni = hr * si + hi * sr + xi; sr = nr; si = ni; }
        bf16_t* base = AY + ((size_t)(g * 1024 + b * 256 + seg * 32)) * 512 + 256 + p;
        for (int i = 0; i < 32; ++i) { const int row = seg * 32 + i;
            bf16_t* o = base + (size_t)i * 512;
            o[0] = (bf16_t)f2bf(sr); o[64] = (bf16_t)f2bf(si);
            const float xr = S[row * 128 + p], xi = S[row * 128 + 64 + p];
            const float nr = tr * sr - ti * si + xr, ni = tr * si + ti * sr + xi; sr = nr; si = ni; }
    }
};
struct EpiY {
    static constexpr bool PERM = true, AFTER_DRAIN = false;
    const bf16_t* AY; const float* ssm_d; bf16_t* GB;
    __device__ __forceinline__ void operator()(const f32x4 (&acc)[2][2][4][2], const Unit& u, int wr, int wc, int fr, int fq) const {
        const int g = u.z, b = u.pm;
#pragma unroll
        for (int bj = 0; bj < 2; ++bj) { const int col = bj * HALF + wc * 32 + 8 * fq, t = col >> 4, h0 = col & 15;
            const f32x4 d0 = *(const f32x4*)(ssm_d + g * GH + h0), d1 = *(const f32x4*)(ssm_d + g * GH + h0 + 4);
            u32x4 u8[2][4];
#pragma unroll
            for (int ai = 0; ai < 2; ++ai)
#pragma unroll
                for (int m = 0; m < 4; ++m) { const int crow = ai * HALF + wr * 64 + m * 16 + fr; u8[ai][m] = *(const u32x4*)(AY + ((size_t)(g * 1024 + b * 256 + crow)) * 512 + col); }
#pragma unroll
            for (int ai = 0; ai < 2; ++ai)
#pragma unroll
                for (int m = 0; m < 4; ++m) { const int crow = ai * HALF + wr * 64 + m * 16 + fr;
                    const u32x4 uu = u8[ai][m]; const f32x4 v0 = acc[ai][bj][m][0], v1 = acc[ai][bj][m][1];
                    u32x4 w;
                    w.x = cvt_pk_bf16(gelu_tanh(v0[0] + d0[0] * bflo(uu.x)), gelu_tanh(v0[1] + d0[1] * bfhi(uu.x)));
                    w.y = cvt_pk_bf16(gelu_tanh(v0[2] + d0[2] * bflo(uu.y)), gelu_tanh(v0[3] + d0[3] * bfhi(uu.y)));
                    w.z = cvt_pk_bf16(gelu_tanh(v1[0] + d1[0] * bflo(uu.z)), gelu_tanh(v1[1] + d1[1] * bfhi(uu.z)));
                    w.w = cvt_pk_bf16(gelu_tanh(v1[2] + d1[2] * bflo(uu.w)), gelu_tanh(v1[3] + d1[3] * bfhi(uu.w)));
                    *(u32x4*)(GB + ((size_t)(b * SEQ + crow * 16 + t)) * WSSM + g * GH + h0) = w; }
            asm volatile("" ::: "memory"); }
    }
};
struct EpiGluP {
    static constexpr bool PERM = true, AFTER_DRAIN = false;
    const bf16_t* GB; const bf16_t* PROJ; const float* b_glu; bf16_t* YCAT;
    __device__ __forceinline__ void operator()(const f32x4 (&acc)[2][2][4][2], const Unit& u, int wr, int wc, int fr, int fq) const {
        const int row0 = u.pm * BM + wr * 64 + fr, col0 = u.pn * BM + wc * 32 + 8 * fq;
#pragma unroll
        for (int bj = 0; bj < 2; ++bj) { const int col = col0 + bj * HALF; if (col >= WSSM) continue;
            const f32x4 b0 = *(const f32x4*)(b_glu + col), b1 = *(const f32x4*)(b_glu + col + 4);
#pragma unroll
            for (int ai = 0; ai < 2; ++ai) { if (ai != u.z) continue;
                u32x4 g8[4], a8[4];
#pragma unroll
                for (int m = 0; m < 4; ++m) { const size_t row = (size_t)(row0 + ai * HALF + m * 16); g8[m] = *(const u32x4*)(GB + row * WSSM + col); a8[m] = *(const u32x4*)(PROJ + row * DIN + C_AGATE + col); }
#pragma unroll
                for (int m = 0; m < 4; ++m) { const size_t row = (size_t)(row0 + ai * HALF + m * 16);
                    const f32x4 v0 = acc[ai][bj][m][0] + b0, v1 = acc[ai][bj][m][1] + b1;
                    u32x4 w;
                    w.x = cvt_pk_bf16(bflo(g8[m].x) * sigmoid_f(v0[0]) * silu_f(bflo(a8[m].x)), bfhi(g8[m].x) * sigmoid_f(v0[1]) * silu_f(bfhi(a8[m].x)));
                    w.y = cvt_pk_bf16(bflo(g8[m].y) * sigmoid_f(v0[2]) * silu_f(bflo(a8[m].y)), bfhi(g8[m].y) * sigmoid_f(v0[3]) * silu_f(bfhi(a8[m].y)));
                    w.z = cvt_pk_bf16(bflo(g8[m].z) * sigmoid_f(v1[0]) * silu_f(bflo(a8[m].z)), bfhi(g8[m].z) * sigmoid_f(v1[1]) * silu_f(bfhi(a8[m].z)));
                    w.w = cvt_pk_bf16(bflo(g8[m].w) * sigmoid_f(v1[2]) * silu_f(bflo(a8[m].w)), bfhi(g8[m].w) * sigmoid_f(v1[3]) * silu_f(bfhi(a8[m].w)));
                    *(u32x4*)(YCAT + row * DM + col) = w; }
                asm volatile("" ::: "memory"); } }
    }
};
struct EpiResF32 {
    static constexpr bool PERM = false, AFTER_DRAIN = false;
    const float* x; float* out;
    __device__ __forceinline__ void operator()(const f32x4 (&acc)[2][2][4][2], const Unit& u, int wr, int wc, int fr, int fq) const {
        const int row0 = u.pm * BM + wr * 64 + fr, col0 = u.pn * BM + wc * 32 + 4 * fq;
#pragma unroll
        for (int ai = 0; ai < 2; ++ai)
#pragma unroll
            for (int m = 0; m < 4; ++m) { const size_t off = (size_t)(row0 + ai * HALF + m * 16) * DM + col0;
#pragma unroll
                for (int bj = 0; bj < 2; ++bj)
#pragma unroll
                    for (int n = 0; n < 2; ++n) { const f32x4 xv = *(const f32x4*)(x + off + bj * HALF + n * 16); *(f32x4*)(out + off + bj * HALF + n * 16) = xv + acc[ai][bj][m][n]; }
                asm volatile("" ::: "memory"); }
    }
};

struct EpiOutNorm {
    static constexpr bool PERM = false, AFTER_DRAIN = true;
    const bf16_t* xb; const float* rinv; const float* fg; float* out; float* xch; unsigned* cnt;
    __device__ __forceinline__ void fused(f32x4 (&acc)[2][2][4][2], const Unit& u, int wr, int wc, int fr, int fq, LAS unsigned char* lds, int wid, int lane) const {
        LAS float* P = (LAS float*)lds;
        LAS float* S = (LAS float*)(lds + 8192);
        const int row0 = u.pm * BM + wr * 64 + fr, col0 = u.pn * BM + wc * 32 + 4 * fq;
        typedef unsigned u32x2v __attribute__((ext_vector_type(2)));
        u32x2v xv[2][4][2][2]; float ri[2][4];
#pragma unroll
        for (int ai = 0; ai < 2; ++ai)
#pragma unroll
            for (int m = 0; m < 4; ++m) { const size_t off = (size_t)(row0 + ai * HALF + m * 16) * DM + col0; ri[ai][m] = rinv[row0 + ai * HALF + m * 16];
#pragma unroll
                for (int bj = 0; bj < 2; ++bj)
#pragma unroll
                    for (int n = 0; n < 2; ++n) xv[ai][m][bj][n] = *(const u32x2v*)(xb + off + bj * HALF + n * 16); }
#pragma unroll
        for (int ai = 0; ai < 2; ++ai)
#pragma unroll
            for (int m = 0; m < 4; ++m) { float sq = 0.f; const float rv = ri[ai][m];
#pragma unroll
                for (int bj = 0; bj < 2; ++bj)
#pragma unroll
                    for (int n = 0; n < 2; ++n) { const u32x2v w = xv[ai][m][bj][n]; const f32x4 xf = {bflo(w.x) * rv, bfhi(w.x) * rv, bflo(w.y) * rv, bfhi(w.y) * rv};
                        const f32x4 hv = acc[ai][bj][m][n] + xf; acc[ai][bj][m][n] = hv; sq += (hv[0] * hv[0] + hv[1] * hv[1]) + (hv[2] * hv[2] + hv[3] * hv[3]); }
                sq += __shfl_xor(sq, 16); sq += __shfl_xor(sq, 32);
                if (fq == 0) P[(ai * HALF + wr * 64 + m * 16 + fr) * 4 + wc] = sq; }
        asm volatile("s_waitcnt lgkmcnt(0)" ::: "memory"); __builtin_amdgcn_s_barrier(); asm volatile("" ::: "memory");
        const int row = wid * 32 + (lane & 31);
        if (lane < 32) { const f32x4 pv = *(const LAS f32x4*)(P + row * 4); const float t = (pv[0] + pv[1]) + (pv[2] + pv[3]);
            __hip_atomic_store(xch + ((size_t)(u.pm * BM + row) * 4 + u.pn), t, __ATOMIC_RELAXED, __HIP_MEMORY_SCOPE_AGENT); }
        asm volatile("s_waitcnt vmcnt(0)" ::: "memory");
        if (lane == 0) __hip_atomic_fetch_add(cnt + 64 * u.pm, 1u, __ATOMIC_RELAXED, __HIP_MEMORY_SCOPE_AGENT);
        if (wid == 0) { unsigned sp = 0;
            while ((unsigned)__builtin_amdgcn_readfirstlane(__hip_atomic_load(cnt + 64 * u.pm, __ATOMIC_RELAXED, __HIP_MEMORY_SCOPE_AGENT)) < 32u) { __builtin_amdgcn_s_sleep(2); if (++sp > (1u << 22)) break; }
            __builtin_amdgcn_fence(__ATOMIC_ACQUIRE, "agent"); }
        asm volatile("s_waitcnt vmcnt(0) lgkmcnt(0)" ::: "memory"); __builtin_amdgcn_s_barrier(); asm volatile("" ::: "memory");
        if (lane < 32) { const float* slot = xch + (size_t)(u.pm * BM + row) * 4; float t = 0.f;
#pragma unroll
            for (int q = 0; q < 4; ++q) t += __hip_atomic_load(slot + q, __ATOMIC_RELAXED, __HIP_MEMORY_SCOPE_AGENT);
            S[row] = 1.0f / sqrtf(t * (1.0f / DM) + NORM_EPS); }
        asm volatile("s_waitcnt lgkmcnt(0)" ::: "memory"); __builtin_amdgcn_s_barrier(); asm volatile("" ::: "memory");
        f32x4 gv[2][2];
#pragma unroll
        for (int bj = 0; bj < 2; ++bj)
#pragma unroll
            for (int n = 0; n < 2; ++n) gv[bj][n] = *(const f32x4*)(fg + col0 + bj * HALF + n * 16);
#pragma unroll
        for (int ai = 0; ai < 2; ++ai)
#pragma unroll
            for (int m = 0; m < 4; ++m) { const int r = ai * HALF + wr * 64 + m * 16 + fr; const float rs = S[r]; const size_t off = (size_t)(u.pm * BM + r) * DM + col0;
#pragma unroll
                for (int bj = 0; bj < 2; ++bj)
#pragma unroll
                    for (int n = 0; n < 2; ++n) *(f32x4*)(out + off + bj * HALF + n * 16) = acc[ai][bj][m][n] * rs * gv[bj][n]; }
    }
};
}

__device__ __forceinline__ void s5_naive(const Args& a, int b, int g, int lane) {
    const bf16_t* PROJ = (const bf16_t*)(a.ws + WS_PROJ); bf16_t* GB = (bf16_t*)(a.ws + WS_GB);
    const float* LAMB = (const float*)(a.ws + WS_LAMB); const float* BBAR = (const float*)(a.ws + WS_BBAR);
    const float* c_re = a.in[8]; const float* c_im = a.in[9]; const float* ssm_d = a.in[10];
    const int p = lane, h = lane & 15, pg = lane >> 4;
    const float lr = LAMB[(g * NP + p) * 2], li = LAMB[(g * NP + p) * 2 + 1];
    float bre[16], bim[16], cre[16], cim[16];
#pragma unroll
    for (int j = 0; j < 16; ++j) { bre[j] = BBAR[((g * NP + p) * GH + j) * 2]; bim[j] = BBAR[((g * NP + p) * GH + j) * 2 + 1];
        cre[j] = c_re[(g * GH + h) * NP + pg * 16 + j]; cim[j] = c_im[(g * GH + h) * NP + pg * 16 + j]; }
    const float dd = ssm_d[g * GH + h];
    float sr = 0.f, si = 0.f;
    for (int t = 0; t < SEQ; ++t) {
        const bf16_t* up = PROJ + (size_t)(b * SEQ + t) * DIN + C_AIN + g * GH;
        const v4u u0 = *(const v4u*)up, u1 = *(const v4u*)(up + 8);
        float u[16];
        u[0] = bflo(u0.x); u[1] = bfhi(u0.x); u[2] = bflo(u0.y); u[3] = bfhi(u0.y); u[4] = bflo(u0.z); u[5] = bfhi(u0.z); u[6] = bflo(u0.w); u[7] = bfhi(u0.w);
        u[8] = bflo(u1.x); u[9] = bfhi(u1.x); u[10] = bflo(u1.y); u[11] = bfhi(u1.y); u[12] = bflo(u1.z); u[13] = bfhi(u1.z); u[14] = bflo(u1.w); u[15] = bfhi(u1.w);
        const float uh = bf2f(up[h]);
        float bur = 0.f, bui = 0.f;
#pragma unroll
        for (int j = 0; j < 16; ++j) { bur += bre[j] * u[j]; bui += bim[j] * u[j]; }
        const float nsr = lr * sr - li * si + bur, nsi = lr * si + li * sr + bui;
        sr = nsr; si = nsi;
        float part = 0.f;
#pragma unroll
        for (int j = 0; j < 16; ++j) { const float xr = __shfl(sr, pg * 16 + j), xi = __shfl(si, pg * 16 + j); part += cre[j] * xr - cim[j] * xi; }
        part += __shfl_xor(part, 16); part += __shfl_xor(part, 32);
        const float y = part + dd * uh;
        if (lane < 16) GB[(size_t)(b * SEQ + t) * WSSM + g * GH + h] = (bf16_t)f2bf(gelu_tanh(y));
    }
}

__device__ __forceinline__ void conv_naive(const Args& a, int vb, int nvb) {
    const bf16_t* PROJ = (const bf16_t*)(a.ws + WS_PROJ); bf16_t* YCAT = (bf16_t*)(a.ws + WS_YCAT);
    const float* conv_w = a.in[14]; const float* conv_b = a.in[15];
    const int gt = vb * 512 + otid(), NT = nvb * 512;
    for (int idx = gt; idx < NTOK * WSSM; idx += NT) {
        const int tok = idx / WSSM, c = idx % WSSM, t = tok % SEQ;
        const bf16_t* row = PROJ + (size_t)tok * DIN;
        float acc = conv_b[c];
#pragma unroll
        for (int k = 0; k < 3; ++k) { const int tt = t - 2 + k; if (tt >= 0) { const bf16_t* r2 = PROJ + (size_t)(tok - 2 + k) * DIN; acc += conv_w[k * WSSM + c] * (bf2f(r2[C_CC + c]) * bf2f(r2[C_CIN + c])); } }
        const float y = bf2f(row[C_CB + c]) * acc * silu_f(bf2f(row[C_CGATE + c]));
        YCAT[(size_t)tok * DM + WSSM + c] = (bf16_t)f2bf(y);
    }
}
__device__ __forceinline__ void attn_naive(const Args& a, int vb, int nvb) {
    const bf16_t* PROJ = (const bf16_t*)(a.ws + WS_PROJ); bf16_t* YCAT = (bf16_t*)(a.ws + WS_YCAT); const bf16_t* KV = (const bf16_t*)(a.ws + WS_KV);
    const int gt = vb * 512 + otid(), NT = nvb * 512;
    for (int item = gt; item < NB * 4 * SEQ; item += NT) {
        const int t = item % SEQ, hh = (item / SEQ) % 4, b = item / (4 * SEQ), tok = b * SEQ + t;
        const v4u* qp = (const v4u*)(PROJ + (size_t)tok * DIN + C_Q + hh * 64);
        float q[64], o[64];
#pragma unroll
        for (int i = 0; i < 8; ++i) { const v4u v = qp[i]; q[8 * i] = bflo(v.x); q[8 * i + 1] = bfhi(v.x); q[8 * i + 2] = bflo(v.y); q[8 * i + 3] = bfhi(v.y); q[8 * i + 4] = bflo(v.z); q[8 * i + 5] = bfhi(v.z); q[8 * i + 6] = bflo(v.w); q[8 * i + 7] = bfhi(v.w); }
#pragma unroll
        for (int d = 0; d < 64; ++d) o[d] = 0.f;
        float m = -1e30f, l = 0.f;
        for (int mm = 0; mm < NMEM; ++mm) {
            const v4u* kp = (const v4u*)(KV + (size_t)(b * NMEM + mm) * 512 + hh * 64);
            const v4u* vp = (const v4u*)(KV + (size_t)(b * NMEM + mm) * 512 + 256 + hh * 64);
            float s = 0.f;
#pragma unroll
            for (int i = 0; i < 8; ++i) { const v4u v = kp[i];
                s += q[8 * i] * bflo(v.x) + q[8 * i + 1] * bfhi(v.x) + q[8 * i + 2] * bflo(v.y) + q[8 * i + 3] * bfhi(v.y) + q[8 * i + 4] * bflo(v.z) + q[8 * i + 5] * bfhi(v.z) + q[8 * i + 6] * bflo(v.w) + q[8 * i + 7] * bfhi(v.w); }
            s *= 0.125f;
            const float mn = fmaxf(m, s), sc = __expf(m - mn), pp = __expf(s - mn);
            l = l * sc + pp; m = mn;
#pragma unroll
            for (int i = 0; i < 8; ++i) { const v4u v = vp[i];
                o[8 * i] = o[8 * i] * sc + pp * bflo(v.x); o[8 * i + 1] = o[8 * i + 1] * sc + pp * bfhi(v.x); o[8 * i + 2] = o[8 * i + 2] * sc + pp * bflo(v.y); o[8 * i + 3] = o[8 * i + 3] * sc + pp * bfhi(v.y);
                o[8 * i + 4] = o[8 * i + 4] * sc + pp * bflo(v.z); o[8 * i + 5] = o[8 * i + 5] * sc + pp * bfhi(v.z); o[8 * i + 6] = o[8 * i + 6] * sc + pp * bflo(v.w); o[8 * i + 7] = o[8 * i + 7] * sc + pp * bfhi(v.w); }
        }
        const float inv = 1.0f / l;
        const v4u* gp = (const v4u*)(PROJ + (size_t)tok * DIN + C_QGATE + hh * 64);
        v4u* op = (v4u*)(YCAT + (size_t)tok * DM + 768 + hh * 64);
#pragma unroll
        for (int i = 0; i < 8; ++i) { const v4u gv = gp[i]; v4u w;
            w.x = pk2(o[8 * i] * inv * silu_f(bflo(gv.x)), o[8 * i + 1] * inv * silu_f(bfhi(gv.x)));
            w.y = pk2(o[8 * i + 2] * inv * silu_f(bflo(gv.y)), o[8 * i + 3] * inv * silu_f(bfhi(gv.y)));
            w.z = pk2(o[8 * i + 4] * inv * silu_f(bflo(gv.z)), o[8 * i + 5] * inv * silu_f(bfhi(gv.z)));
            w.w = pk2(o[8 * i + 6] * inv * silu_f(bflo(gv.w)), o[8 * i + 7] * inv * silu_f(bfhi(gv.w)));
            op[i] = w; }
    }
}

typedef short bf16x8_t __attribute__((ext_vector_type(8)));
typedef short s16x4_t __attribute__((ext_vector_type(4)));
typedef float f32x16 __attribute__((ext_vector_type(16)));
typedef __bf16 bf2_t __attribute__((ext_vector_type(2)));
typedef float f2_t __attribute__((ext_vector_type(2)));
typedef unsigned u32x2_t __attribute__((ext_vector_type(2)));
__device__ __forceinline__ unsigned cvt2(float lo, float hi) { const f2_t v = {lo, hi}; return __builtin_bit_cast(unsigned, __builtin_convertvector(v, bf2_t)); }
__device__ __forceinline__ void attn_mfma(const Args& a, LAS unsigned char* lds, int vb, int nvb) {
    const int nj = nvb / 16; if (nj < 1 || vb >= nj * 16) return;
    const int tid = otid(), lane = tid & 63, wave = tid >> 6, r = lane & 31, h = lane >> 5;
    const int bh = vb % 16, j = vb / 16, b = bh >> 2, head = bh & 3;
    const bf16_t* PROJ = (const bf16_t*)(a.ws + WS_PROJ); bf16_t* YCAT = (bf16_t*)(a.ws + WS_YCAT); const bf16_t* KV = (const bf16_t*)(a.ws + WS_KV);
    LAS unsigned char* Kl = lds;
    LAS unsigned char* Vl = lds + 36864;
    for (int c = tid; c < 2048; c += 512) { const int key = c >> 3, dch = c & 7;
        const bf16_t* src = KV + (size_t)(b * NMEM + key) * 512 + head * 64 + dch * 8;
        const v4u kv = *(const v4u*)src, vv = *(const v4u*)(src + 256);
        *(LAS v4u*)(Kl + key * 144 + dch * 16) = kv;
        LAS bf16_t* vd = (LAS bf16_t*)(Vl + (dch * 8) * 520 + key * 2);
        vd[0 * 260] = (bf16_t)(vv.x & 0xffff); vd[1 * 260] = (bf16_t)(vv.x >> 16); vd[2 * 260] = (bf16_t)(vv.y & 0xffff); vd[3 * 260] = (bf16_t)(vv.y >> 16);
        vd[4 * 260] = (bf16_t)(vv.z & 0xffff); vd[5 * 260] = (bf16_t)(vv.z >> 16); vd[6 * 260] = (bf16_t)(vv.w & 0xffff); vd[7 * 260] = (bf16_t)(vv.w >> 16); }
    __syncthreads();
    for (int tile = j * 8 + wave; tile < SEQ / 32; tile += nj * 8) {
        const size_t tok = (size_t)b * SEQ + tile * 32 + r;
        bf16x8_t qf[4];
#pragma unroll
        for (int s4 = 0; s4 < 4; ++s4) qf[s4] = *(const bf16x8_t*)(PROJ + tok * DIN + C_Q + head * 64 + 16 * s4 + 8 * h);
        const float sc = 0.125f * 1.4426950408889634f;
        float mx = -3.0e38f, l = 0.f;
        f32x16 o0, o1;
#pragma unroll
        for (int i = 0; i < 16; ++i) { o0[i] = 0.f; o1[i] = 0.f; }
#pragma unroll 2
        for (int kt = 0; kt < 8; ++kt) {
            f32x16 st;
#pragma unroll
            for (int i = 0; i < 16; ++i) st[i] = 0.f;
#pragma unroll
            for (int s4 = 0; s4 < 4; ++s4) { const bf16x8_t kf = *(const LAS bf16x8_t*)(Kl + (kt * 32 + r) * 144 + (16 * s4 + 8 * h) * 2);
                st = __builtin_amdgcn_mfma_f32_32x32x16_bf16(kf, qf[s4], st, 0, 0, 0); }
            float tm = st[0];
#pragma unroll
            for (int i = 1; i < 16; ++i) tm = fmaxf(tm, st[i]);
            tm = fmaxf(tm, __shfl_xor(tm, 32));
            const float mn = fmaxf(mx, tm), alpha = __builtin_amdgcn_exp2f((mx - mn) * sc), mb = mn * sc;
            mx = mn; l *= alpha;
#pragma unroll
            for (int i = 0; i < 16; ++i) { o0[i] *= alpha; o1[i] *= alpha; }
#pragma unroll
            for (int i = 0; i < 16; ++i) { const float p = __builtin_amdgcn_exp2f(st[i] * sc - mb); st[i] = p; l += p; }
#pragma unroll
            for (int s2 = 0; s2 < 2; ++s2) {
                v4u pw; pw.x = cvt2(st[8 * s2 + 0], st[8 * s2 + 1]); pw.y = cvt2(st[8 * s2 + 2], st[8 * s2 + 3]);
                pw.z = cvt2(st[8 * s2 + 4], st[8 * s2 + 5]); pw.w = cvt2(st[8 * s2 + 6], st[8 * s2 + 7]);
                const bf16x8_t pf = __builtin_bit_cast(bf16x8_t, pw);
                const int koff = (kt * 32 + 16 * s2 + 4 * h) * 2;
                { const s16x4_t lo = *(const LAS s16x4_t*)(Vl + r * 520 + koff), hi = *(const LAS s16x4_t*)(Vl + r * 520 + koff + 16);
                  const bf16x8_t vf = __builtin_shufflevector(lo, hi, 0, 1, 2, 3, 4, 5, 6, 7); o0 = __builtin_amdgcn_mfma_f32_32x32x16_bf16(vf, pf, o0, 0, 0, 0); }
                { const s16x4_t lo = *(const LAS s16x4_t*)(Vl + (32 + r) * 520 + koff), hi = *(const LAS s16x4_t*)(Vl + (32 + r) * 520 + koff + 16);
                  const bf16x8_t vf = __builtin_shufflevector(lo, hi, 0, 1, 2, 3, 4, 5, 6, 7); o1 = __builtin_amdgcn_mfma_f32_32x32x16_bf16(vf, pf, o1, 0, 0, 0); }
            }
        }
        l += __shfl_xor(l, 32);
        const float inv = 1.0f / l;
        const bf16_t* gp = PROJ + tok * DIN + C_QGATE + head * 64; bf16_t* op = YCAT + tok * DM + 768 + head * 64;
#pragma unroll
        for (int q4 = 0; q4 < 4; ++q4) {
            { const int d = 8 * q4 + 4 * h; const u32x2_t gv = *(const u32x2_t*)(gp + d); u32x2_t w;
              w.x = cvt2(o0[4 * q4 + 0] * inv * silu_f(bflo(gv.x)), o0[4 * q4 + 1] * inv * silu_f(bfhi(gv.x))); w.y = cvt2(o0[4 * q4 + 2] * inv * silu_f(bflo(gv.y)), o0[4 * q4 + 3] * inv * silu_f(bfhi(gv.y)));
              *(u32x2_t*)(op + d) = w; }
            { const int d = 32 + 8 * q4 + 4 * h; const u32x2_t gv = *(const u32x2_t*)(gp + d); u32x2_t w;
              w.x = cvt2(o1[4 * q4 + 0] * inv * silu_f(bflo(gv.x)), o1[4 * q4 + 1] * inv * silu_f(bfhi(gv.x))); w.y = cvt2(o1[4 * q4 + 2] * inv * silu_f(bflo(gv.y)), o1[4 * q4 + 3] * inv * silu_f(bfhi(gv.y)));
              *(u32x2_t*)(op + d) = w; }
        }
    }
}
__device__ __forceinline__ void conv_vec(const Args& a, int vb, int nvb) {
    const bf16_t* PROJ = (const bf16_t*)(a.ws + WS_PROJ); bf16_t* YCAT = (bf16_t*)(a.ws + WS_YCAT);
    const float* conv_w = a.in[14]; const float* conv_b = a.in[15];
    const int gt = vb * 512 + otid(), NT = nvb * 512;
    for (int it = gt; it < (NTOK / 4) * 48; it += NT) {
        const int tg = it / 48, c0 = (it % 48) * 8, tok0 = tg * 4, t0 = tok0 % SEQ;
        const bf16_t* row0 = PROJ + (size_t)tok0 * DIN;
        v4u uu[6], ww[4];
#pragma unroll
        for (int r = 0; r < 6; ++r) { const bool ok = (t0 + r - 2) >= 0; const bf16_t* rp = row0 + (ptrdiff_t)(r - 2) * DIN; uu[r] = ok ? *(const v4u*)(rp + C_U + c0) : (v4u){0u, 0u, 0u, 0u}; }
#pragma unroll
        for (int j = 0; j < 4; ++j) ww[j] = *(const v4u*)(row0 + (size_t)j * DIN + C_W + c0);
        float w[3][8], bb[8];
#pragma unroll
        for (int k = 0; k < 3; ++k) { const f32x4 w0 = *(const f32x4*)(conv_w + k * WSSM + c0), w1 = *(const f32x4*)(conv_w + k * WSSM + c0 + 4);
            w[k][0] = w0.x; w[k][1] = w0.y; w[k][2] = w0.z; w[k][3] = w0.w; w[k][4] = w1.x; w[k][5] = w1.y; w[k][6] = w1.z; w[k][7] = w1.w; }
        { const f32x4 b0 = *(const f32x4*)(conv_b + c0), b1 = *(const f32x4*)(conv_b + c0 + 4); bb[0] = b0.x; bb[1] = b0.y; bb[2] = b0.z; bb[3] = b0.w; bb[4] = b1.x; bb[5] = b1.y; bb[6] = b1.z; bb[7] = b1.w; }
        float u[6][8];
#pragma unroll
        for (int r = 0; r < 6; ++r) { u[r][0] = bflo(uu[r].x); u[r][1] = bfhi(uu[r].x); u[r][2] = bflo(uu[r].y); u[r][3] = bfhi(uu[r].y); u[r][4] = bflo(uu[r].z); u[r][5] = bfhi(uu[r].z); u[r][6] = bflo(uu[r].w); u[r][7] = bfhi(uu[r].w); }
#pragma unroll
        for (int j = 0; j < 4; ++j) { float y[8];
#pragma unroll
            for (int e = 0; e < 8; ++e) y[e] = bb[e] + w[0][e] * u[j][e] + w[1][e] * u[j + 1][e] + w[2][e] * u[j + 2][e];
            v4u o;
            o.x = cvt2(bflo(ww[j].x) * y[0], bfhi(ww[j].x) * y[1]); o.y = cvt2(bflo(ww[j].y) * y[2], bfhi(ww[j].y) * y[3]);
            o.z = cvt2(bflo(ww[j].z) * y[4], bfhi(ww[j].z) * y[5]); o.w = cvt2(bflo(ww[j].w) * y[6], bfhi(ww[j].w) * y[7]);
            *(v4u*)(YCAT + (size_t)(tok0 + j) * DM + WSSM + c0) = o; }
    }
}
__device__ __forceinline__ void final_norm(const Args& a) {
    const int tid = otid(), lane = tid & 63, gw = blockIdx.x * 8 + (tid >> 6), NGW = gridDim.x * 8;
    const float* fg = a.in[19];
    for (int r = gw; r < NTOK; r += NGW) {
        f32x4* xr = (f32x4*)(a.out + (size_t)r * DM) + lane;
        f32x4 v[4]; float s = 0.f;
#pragma unroll
        for (int j = 0; j < 4; ++j) { v[j] = xr[64 * j]; s += (v[j].x * v[j].x + v[j].y * v[j].y) + (v[j].z * v[j].z + v[j].w * v[j].w); }
        const float rstd = 1.0f / sqrtf(wave_sum(s) * (1.0f / DM) + NORM_EPS);
#pragma unroll
        for (int j = 0; j < 4; ++j) { const f32x4 g = ((const f32x4*)fg)[lane + 64 * j]; xr[64 * j] = v[j] * rstd * g; }
    }
}

__global__ void __launch_bounds__(512, 2) mega(Args a) {
    extern __shared__ __attribute__((aligned(16))) unsigned char smem_raw[];
    LAS unsigned char* lds = (LAS unsigned char*)smem_raw;
    cg::grid_group grid = cg::this_grid();
    volatile LAS unsigned* xst = (volatile LAS unsigned*)(lds + 139264);
    if (threadIdx.x == 0) { xst[0] = 0u; xst[1] = 0u; }
    { unsigned* ctl = (unsigned*)(a.ws + WS_CTL); unsigned* flag = ctl + CTL_FLAG_WORD;
      if (blockIdx.x == 0) { for (int i = threadIdx.x; i < 8192; i += 512) __hip_atomic_store(ctl + i, 0u, __ATOMIC_RELAXED, __HIP_MEMORY_SCOPE_AGENT);
          asm volatile("s_waitcnt vmcnt(0)" ::: "memory"); __syncthreads();
          if (threadIdx.x == 0) { __builtin_amdgcn_fence(__ATOMIC_RELEASE, "agent"); __hip_atomic_store(flag, CTL_TOKEN, __ATOMIC_RELAXED, __HIP_MEMORY_SCOPE_AGENT); } }
      if (threadIdx.x == 0) { unsigned sp = 0; while (__hip_atomic_load(flag, __ATOMIC_RELAXED, __HIP_MEMORY_SCOPE_AGENT) != CTL_TOKEN) { __builtin_amdgcn_s_sleep(1); if (++sp > (1u << 22)) break; }
          __builtin_amdgcn_fence(__ATOMIC_ACQUIRE, "agent"); } }
    __syncthreads();
    const XcdBarrier xbar = xcd_barrier_post((unsigned*)(a.ws + WS_CTL), xst);
    const int bid = blockIdx.x, G = gridDim.x;
    bf16_t* XB = (bf16_t*)(a.ws + WS_XB); bf16_t* MEMN = (bf16_t*)(a.ws + WS_MEMN);
    bf16_t* WINT = (bf16_t*)(a.ws + WS_WINT); bf16_t* WKVT = (bf16_t*)(a.ws + WS_WKVT); bf16_t* WOUTT = (bf16_t*)(a.ws + WS_WOUTT); bf16_t* WGLUT = (bf16_t*)(a.ws + WS_WGLUT);
    bf16_t* PROJ = (bf16_t*)(a.ws + WS_PROJ); bf16_t* KV = (bf16_t*)(a.ws + WS_KV); bf16_t* GB = (bf16_t*)(a.ws + WS_GB); bf16_t* YCAT = (bf16_t*)(a.ws + WS_YCAT);
    bf16_t* AY = (bf16_t*)(a.ws + WS_AY); bf16_t* WSb = (bf16_t*)(a.ws + WS_WS); bf16_t* WYb = (bf16_t*)(a.ws + WS_WY);

#ifndef PROBE_DUP
#define PROBE_DUP -1
#endif
#define REPS(k) for (int rep_ = 0; rep_ < ((PROBE_DUP == (k)) ? 2 : 1); ++rep_)
#ifndef PROBE_SUB
#define PROBE_SUB -1
#endif
    if (a.out == nullptr) grid.sync();
    REPS(0) { phase0(a, lds);
    xcd_barrier(xbar); }
    REPS(1) {
    { pg8::Order S; S.init(NTOK / 256, DIN / 256, 1, G, bid);
      pg8::gemm_phase<true, true>(lds, pg8::Gemm{XB, WINT, DM, DM, DM, 0, 0}, S, pg8::EpiProjAY{PROJ, AY}); }
    { pg8::Order S; S.init(NB * NMEM / 256, 512 / 256, 1, G, (bid + G - ((NTOK / 256) * (DIN / 256)) % G) % G);
      pg8::gemm_phase<false, true>(lds, pg8::Gemm{MEMN, WKVT, DM, DM, DM, 0, 0}, S, pg8::EpiBf16Store{KV, 512}); }
    xcd_barrier(xbar); }
    REPS(2) {
    if (bid < NB * NG) { pg8::Order S; S.init(NB, 1, NG, G, bid);
      pg8::gemm_phase<false, true>(lds, pg8::Gemm{AY, WSb, 512, 256, 256, (size_t)1024 * 512, (size_t)256 * 256}, S, pg8::EpiSend{AY, (const float*)(a.ws + WS_LAMT), (const float*)(a.ws + WS_LAM512)});
      asm volatile("s_waitcnt vmcnt(0)" ::: "memory"); __syncthreads();
      pg8::gemm_phase<false, true>(lds, pg8::Gemm{AY, WYb, 512, 512, 384, (size_t)1024 * 512, (size_t)256 * 512}, S, pg8::EpiY{AY, a.in[10], GB}); }
    else { attn_mfma(a, lds, bid - NB * NG, G - NB * NG); conv_vec(a, bid - NB * NG, G - NB * NG); }
    xcd_barrier(xbar); }
    REPS(4) {
    { pg8::Order S; S.init(NTOK / 256, 2, 2, G, bid);
      pg8::gemm_phase<false, true>(lds, pg8::Gemm{GB, WGLUT, WSSM, WSSM, WSSM, 0, 0}, S, pg8::EpiGluP{GB, PROJ, a.in[13], YCAT}); }
    xcd_barrier(xbar); }
    REPS(5) {
    { pg8::Order S; S.init(NTOK / 256, DM / 256, 1, G, bid);
      pg8::gemm_phase<false, true>(lds, pg8::Gemm{YCAT, WOUTT, DM, DM, DM, 0, 0}, S, pg8::EpiOutNorm{XB, (const float*)(a.ws + WS_RINV), a.in[19], a.out, (float*)(a.ws + WS_XCH), (unsigned*)(a.ws + WS_CTL + CTL_PANEL)}); }
    }
    __syncthreads();
    if (threadIdx.x == 0) { unsigned* ctl = (unsigned*)(a.ws + WS_CTL);
        const unsigned old_ = __hip_atomic_fetch_add(ctl + CTL_EXIT_WORD, 1u, __ATOMIC_RELAXED, __HIP_MEMORY_SCOPE_AGENT);
        if (old_ == (unsigned)G - 1u) __hip_atomic_store(ctl + CTL_FLAG_WORD, CTL_RESET, __ATOMIC_RELAXED, __HIP_MEMORY_SCOPE_AGENT); }
}

extern "C" void kernel_launch(void* const* d_in, const int* in_sizes, int n_in, void* d_out, int out_size, void* d_ws, size_t ws_size, hipStream_t stream) {
    static int grid = 0;
    if (grid == 0) {
        if (n_in != 20 || out_size != NTOK * DM || ws_size < WS_END) { fprintf(stderr, "kernel_launch: unexpected shapes n_in %d out %d ws %zu\n", n_in, out_size, ws_size); grid = -1; return; }
        int dev = 0, cus = 0, per_cu = 0;
        hipGetDevice(&dev);
        hipDeviceGetAttribute(&cus, hipDeviceAttributeMultiprocessorCount, dev);
        if (hipFuncSetAttribute((const void*)mega, hipFuncAttributeMaxDynamicSharedMemorySize, LDS_BYTES) != hipSuccess) { fprintf(stderr, "kernel_launch: hipFuncSetAttribute failed\n"); grid = -1; return; }
        if (hipOccupancyMaxActiveBlocksPerMultiprocessor(&per_cu, (const void*)mega, 512, LDS_BYTES) != hipSuccess || per_cu < 1) { fprintf(stderr, "kernel_launch: occupancy query says %d\n", per_cu); per_cu = 1; }
        (void)hipGetLastError();
        grid = cus;
        if (grid != 256) { fprintf(stderr, "kernel_launch: built for 256 CUs (one workgroup each), device has %d\n", grid); grid = -1; return; }
        if (grid < NB * NG) { fprintf(stderr, "kernel_launch: grid %d too small\n", grid); grid = -1; return; }
    }
    if (grid < 0) return;
    Args a{};
    for (int i = 0; i < 20; ++i) a.in[i] = (const float*)d_in[i];
    a.out = (float*)d_out; a.ws = (unsigned char*)d_ws;
    void* args[] = {&a};
    hipError_t e = hipLaunchCooperativeKernel((const void*)mega, dim3(grid), dim3(512), args, LDS_BYTES, stream);
    if (e != hipSuccess) fprintf(stderr, "cooperative launch failed: %s (grid %d)\n", hipGetErrorString(e), grid);
}
```

```cpp
#include <hip/hip_runtime.h>
#include <hip/hip_cooperative_groups.h>
#include <cstdio>
#include <cstdint>
namespace cg = cooperative_groups;

#define LAS __attribute__((address_space(3)))
typedef unsigned short bf16_t;
typedef unsigned v4u __attribute__((ext_vector_type(4)));
typedef float f32x4 __attribute__((ext_vector_type(4)));

constexpr int NB = 4, SEQ = 4096, DM = 1024, NTOK = NB * SEQ, DIN = 2816, WSSM = 384, NG = 24, GH = 16, NP = 64, NMEM = 256;
constexpr int C_AIN = 0, C_AGATE = 384, C_CIN = 768, C_CB = 1152, C_CC = 1536, C_CGATE = 1920, C_Q = 2304, C_QGATE = 2560;
constexpr int C_U = 768, C_W = 1152;
constexpr float NORM_EPS = 1e-6f;

constexpr size_t MiB = 1u << 20;
constexpr size_t WS_CTL = 0;
constexpr size_t WS_XB = 1 * MiB;
constexpr size_t WS_WINT = 33 * MiB;
constexpr size_t WS_WKVT = 39 * MiB;
constexpr size_t WS_WOUTT = 40 * MiB;
constexpr size_t WS_WGLUT = 42 * MiB;
constexpr size_t WS_MEMN = 43 * MiB;
constexpr size_t WS_KV = 45 * MiB;
constexpr size_t WS_LAMB = 46 * MiB;
constexpr size_t WS_BBAR = 46 * MiB + 65536;
constexpr size_t WS_GB = 47 * MiB;
constexpr size_t WS_PROJ = 59 * MiB;
constexpr size_t WS_YCAT = 147 * MiB;
constexpr size_t WS_AY = 179 * MiB;
constexpr size_t WS_WS = 203 * MiB;
constexpr size_t WS_WY = 206 * MiB;
constexpr size_t WS_LAMT = 212 * MiB;
constexpr size_t WS_LAM512 = 212 * MiB + 65536;
constexpr size_t WS_XCH = 213 * MiB;
constexpr size_t WS_RINV = 214 * MiB;
constexpr size_t WS_END = 215 * MiB;
constexpr size_t CTL_PANEL = 16384;
constexpr size_t CTL_BYTES = 32768;
constexpr int CTL_EXIT_WORD = 3968, CTL_FLAG_WORD = 8192 + 64;
constexpr unsigned CTL_TOKEN = 0x600DF00Du, CTL_RESET = 0x0BADF00Du;

constexpr int LDS_BYTES = 147456;

struct Args {
    const float* in[20];
    float* out;
    unsigned char* ws;
};

__device__ __forceinline__ unsigned f2bf(float f) { unsigned u = __builtin_bit_cast(unsigned, f); return (u + 0x7fffu + ((u >> 16) & 1u)) >> 16; }
__device__ __forceinline__ unsigned pk2(float lo, float hi) { return f2bf(lo) | (f2bf(hi) << 16); }
__device__ __forceinline__ float bf2f(unsigned short b) { return __builtin_bit_cast(float, ((unsigned)b) << 16); }
__device__ __forceinline__ float bflo(unsigned w) { return __builtin_bit_cast(float, w << 16); }
__device__ __forceinline__ float bfhi(unsigned w) { return __builtin_bit_cast(float, w & 0xffff0000u); }
__device__ __forceinline__ float wave_sum(float v) {
#pragma unroll
    for (int o = 1; o < 64; o <<= 1) v += __shfl_xor(v, o);
    return v;
}
__device__ __forceinline__ float silu_f(float v) { return v * __builtin_amdgcn_rcpf(1.0f + __builtin_amdgcn_exp2f(-1.4426950408889634f * v)); }
__device__ __forceinline__ float sigmoid_f(float v) { return __builtin_amdgcn_rcpf(1.0f + __builtin_amdgcn_exp2f(-1.4426950408889634f * v)); }
__device__ __forceinline__ float gelu_tanh(float v) { const float w = __builtin_fmaf(v * v, -0.10294324f, -2.3022082f); return v * __builtin_amdgcn_rcpf(1.0f + __builtin_amdgcn_exp2f(v * w)); }
#define LDS_WAIT() asm volatile("s_waitcnt lgkmcnt(0)" ::: "memory")
__device__ __forceinline__ int otid() { int t = threadIdx.x; asm volatile("" : "+v"(t)); return t; }

#define XB_TMO      128
#define XB_XCNT(j)  (256  + 64 * (j))
#define XB_XSUB(j)  (1280 + 64 * (j))
#define XB_XGEN(j)  (2304 + 64 * (j))
#define XB_TOP      3328
#define XB_TOPGEN   3392
#define XCD_BAR_WORDS 3456
#define XB_SPIN_CAP (1u << 18)

__device__ __forceinline__ unsigned xb_ld(unsigned* p)              { return __hip_atomic_load(p, __ATOMIC_RELAXED, __HIP_MEMORY_SCOPE_AGENT); }
__device__ __forceinline__ unsigned xb_add(unsigned* p, unsigned v) { return __hip_atomic_fetch_add(p, v, __ATOMIC_RELAXED, __HIP_MEMORY_SCOPE_AGENT); }
__device__ __forceinline__ unsigned xb_xcc_id() { return (unsigned)__builtin_amdgcn_s_getreg((3 << 11) | 20) & 0xFu; }
#define XB_SPIN(cond, bar) do { unsigned _sp = 0; while (cond) { __builtin_amdgcn_s_sleep(1); \
    if ((++_sp & 255u) == 0u) { if (xb_ld(&(bar)[XB_TMO])) break; if (_sp > XB_SPIN_CAP) { atomicAdd(&(bar)[XB_TMO], 1u); break; } } } } while (0)

struct XcdBarrier {
    unsigned* bar; unsigned x;
    volatile LAS unsigned* st;
};

__device__ __forceinline__ XcdBarrier xcd_barrier_post(unsigned* bar, volatile LAS unsigned* st) {
    XcdBarrier b; b.bar = bar; b.x = xb_xcc_id(); b.st = st;
    if (threadIdx.x == 0) (void)xb_add(&bar[XB_XCNT(b.x)], 1u);
    return b;
}
__device__ __forceinline__ void xcd_barrier_complete(unsigned* bar, unsigned x, unsigned& nloc, unsigned& nx) {
    const unsigned G = gridDim.x * gridDim.y * gridDim.z;
    unsigned sum, cnt, mine, sp = 0u;
    for (;;) {
        sum = 0u; cnt = 0u; mine = 0u;
#pragma unroll
        for (unsigned j = 0; j < 16; ++j) { const unsigned c = xb_ld(&bar[XB_XCNT(j)]); sum += c; cnt += (c > 0u) ? 1u : 0u; mine = (j == x) ? c : mine; }
        if (sum == G) break;
        __builtin_amdgcn_s_sleep(1);
        if ((++sp & 255u) == 0u) { if (xb_ld(&bar[XB_TMO])) break; if (sp > XB_SPIN_CAP) { atomicAdd(&bar[XB_TMO], 1u); break; } }
    }
    nloc = mine > 0u ? mine : 1u; nx = cnt > 0u ? cnt : 1u;
}

__device__ __forceinline__ void xcd_barrier(const XcdBarrier& b) {
    asm volatile("s_waitcnt vmcnt(0)" ::: "memory");
    __syncthreads();
    if (threadIdx.x == 0) {
        unsigned* bar = b.bar;
        __builtin_amdgcn_s_waitcnt(0);
        unsigned nloc = b.st[0], nx = b.st[1];
        if (nloc == 0u) { xcd_barrier_complete(bar, b.x, nloc, nx); b.st[0] = nloc; b.st[1] = nx; }
        const unsigned old = xb_add(&bar[XB_XSUB(b.x)], 1u);
        const unsigned gen = old / nloc;
        if (old + 1u == (gen + 1u) * nloc) {
            __builtin_amdgcn_fence(__ATOMIC_RELEASE, "agent");
            asm volatile("s_waitcnt vmcnt(0)" ::: "memory");
            const unsigned og = xb_add(&bar[XB_TOP], 1u);
            const unsigned tg = og / nx;
            if (og + 1u == (tg + 1u) * nx) xb_add(&bar[XB_TOPGEN], 1u);
            else XB_SPIN(xb_ld(&bar[XB_TOPGEN]) == tg, bar);
            __builtin_amdgcn_fence(__ATOMIC_ACQUIRE, "agent");
            xb_add(&bar[XB_XGEN(b.x)], 1u);
            asm volatile("s_waitcnt vmcnt(0)" ::: "memory");
        } else {
            XB_SPIN(xb_ld(&bar[XB_XGEN(b.x)]) == gen, bar);
            __builtin_amdgcn_fence(__ATOMIC_ACQUIRE, "agent");
            asm volatile("s_waitcnt vmcnt(0)" ::: "memory");
        }
    }
    __syncthreads();
}

__device__ __forceinline__ void rms_row_to_bf16(const float* xrow, bf16_t* orow, const float* gain, int lane) {
    const f32x4* xr = (const f32x4*)xrow + lane;
    f32x4 v[4]; float s = 0.f;
#pragma unroll
    for (int j = 0; j < 4; ++j) { v[j] = xr[64 * j]; s += (v[j].x * v[j].x + v[j].y * v[j].y) + (v[j].z * v[j].z + v[j].w * v[j].w); }
    const float rstd = 1.0f / sqrtf(wave_sum(s) * (1.0f / DM) + NORM_EPS);
    unsigned long long* o8 = (unsigned long long*)orow + lane;
#pragma unroll
    for (int j = 0; j < 4; ++j) {
        f32x4 g = gain ? ((const f32x4*)gain)[lane + 64 * j] : (f32x4){1.f, 1.f, 1.f, 1.f};
        o8[64 * j] = (unsigned long long)pk2(v[j].x * rstd * g.x, v[j].y * rstd * g.y) | ((unsigned long long)pk2(v[j].z * rstd * g.z, v[j].w * rstd * g.w) << 32);
    }
}
__device__ __forceinline__ void transpose_item(const float* W, int K, int N, bf16_t* WT, const float* ks, LAS float* scr, int item, int lane) {
    const int nblk = N / 32, kb = item / nblk, nb = item % nblk, k0 = 64 * kb, n0 = 32 * nb;
#pragma unroll 8
    for (int i = 0; i < 32; ++i) { const int kk = 2 * i + (lane >> 5); float w = W[(size_t)(k0 + kk) * N + n0 + (lane & 31)]; if (ks) w *= ks[k0 + kk]; scr[kk * 33 + (lane & 31)] = w; }
    LDS_WAIT();
    const int c = lane & 7;
#pragma unroll
    for (int j = 0; j < 4; ++j) { const int n = (lane >> 3) + 8 * j; const LAS float* s = scr + (8 * c) * 33 + n;
        v4u o; o.x = pk2(s[0 * 33], s[1 * 33]); o.y = pk2(s[2 * 33], s[3 * 33]); o.z = pk2(s[4 * 33], s[5 * 33]); o.w = pk2(s[6 * 33], s[7 * 33]);
        *(v4u*)(WT + (size_t)(n0 + n) * K + k0 + 8 * c) = o; }
    LDS_WAIT();
}


__device__ __forceinline__ void s5_tables(const Args& a, LAS unsigned char* lds, int tid) {
    const int bid = blockIdx.x; if (bid >= 192) return;
    const int g = bid % NG, q = bid / NG;
    const float* lam_re = a.in[4]; const float* lam_im = a.in[5]; const float* b_re = a.in[6]; const float* b_im = a.in[7]; const float* c_re = a.in[8]; const float* c_im = a.in[9]; const float* log_dt = a.in[11];
    LAS float* LPr = (LAS float*)(lds + 69632); LAS float* LPi = LPr + 17 * 64; LAS float* BBr = LPi + 17 * 64; LAS float* BBi = BBr + 1024;
    LAS float* Cr = BBi + 1024; LAS float* Ci = Cr + 1024; LAS float* KT = Ci + 1024;
    if (tid < 64) {
        const int p = tid, i = g * NP + p;
        const double dt = exp((double)log_dt[g]);
        const double lr = lam_re[i], li = lam_im[i];
        const double er = exp(lr * dt), ang = li * dt;
        const double lbr = er * cos(ang), lbi = er * sin(ang);
        const double nr = lbr - 1.0, ni = lbi, den = lr * lr + li * li;
        const double qr = (nr * lr + ni * li) / den, qi = (ni * lr - nr * li) / den;
        for (int h = 0; h < GH; ++h) { const double br = b_re[i * GH + h], bi = b_im[i * GH + h];
            BBr[p * 16 + h] = (float)(qr * br - qi * bi); BBi[p * 16 + h] = (float)(qr * bi + qi * br); }
        double pr = 1.0, pi = 0.0;
        for (int t = 0; t < 16; ++t) { LPr[t * 64 + p] = (float)pr; LPi[t * 64 + p] = (float)pi; const double nr2 = pr * lbr - pi * lbi, ni2 = pr * lbi + pi * lbr; pr = nr2; pi = ni2; }
        LPr[16 * 64 + p] = (float)pr; LPi[16 * 64 + p] = (float)pi;
        double tr = pr, ti = pi;
        if (q == 0) { float* LAMT = (float*)(a.ws + WS_LAMT); LAMT[2 * i] = (float)tr; LAMT[2 * i + 1] = (float)ti; }
        for (int k = 0; k < 5; ++k) { const double nr2 = tr * tr - ti * ti, ni2 = 2.0 * tr * ti; tr = nr2; ti = ni2; }
        if (q == 0) { float* L512 = (float*)(a.ws + WS_LAM512); L512[2 * i] = (float)tr; L512[2 * i + 1] = (float)ti; }
    }
    for (int i = tid; i < 1024; i += 512) { Cr[i] = c_re[g * 1024 + i]; Ci[i] = c_im[g * 1024 + i]; }
    __syncthreads();
    { const int tau = tid >> 5, hol = (tid >> 4) & 1, hi = tid & 15, ho = 2 * q + hol; float sacc = 0.f;
#pragma unroll 4
      for (int p = 0; p < 64; ++p) { const float lpr = LPr[tau * 64 + p], lpi = LPi[tau * 64 + p], br = BBr[p * 16 + hi], bi = BBi[p * 16 + hi];
          const float wr_ = lpr * br - lpi * bi, wi_ = lpr * bi + lpi * br; sacc += Cr[ho * 64 + p] * wr_ - Ci[ho * 64 + p] * wi_; }
      KT[tid] = sacc; }
    __syncthreads();
    bf16_t* WSb = (bf16_t*)(a.ws + WS_WS); bf16_t* WYb = (bf16_t*)(a.ws + WS_WY);
#pragma unroll
    for (int kk = 0; kk < 2; ++kk) { const int ch = tid + 512 * kk, n = 32 * q + (ch >> 5), k0 = (ch & 31) * 8, p = n & 63, isim = (n >> 6) & 1;
        float v[8];
#pragma unroll
        for (int j = 0; j < 8; ++j) { const int k = k0 + j, t = k >> 4, h = k & 15, tau = 15 - t; const float lpr = LPr[tau * 64 + p], lpi = LPi[tau * 64 + p], br = BBr[p * 16 + h], bi = BBi[p * 16 + h];
            const float val = isim ? (lpr * bi + lpi * br) : (lpr * br - lpi * bi); v[j] = n < 128 ? val : 0.f; }
        v4u o; o.x = pk2(v[0], v[1]); o.y = pk2(v[2], v[3]); o.z = pk2(v[4], v[5]); o.w = pk2(v[6], v[7]);
        *(v4u*)(WSb + ((size_t)(g * 256 + n)) * 256 + k0) = o; }
#pragma unroll
    for (int kk = 0; kk < 4; ++kk) { const int ch = tid + 512 * kk, rr = ch >> 6, to = rr >> 1, hol = rr & 1, ho = 2 * q + hol, n = to * 16 + ho, k0 = (ch & 63) * 8;
        float v[8];
#pragma unroll
        for (int j = 0; j < 8; ++j) { const int k = k0 + j; float val;
            if (k < 256) { const int ti = k >> 4, hi = k & 15; val = ti <= to ? KT[((to - ti) * 2 + hol) * 16 + hi] : 0.f; }
            else { const int jj = (k - 256) & 127, p = jj & 63, isim = jj >> 6; const float lpr = LPr[(to + 1) * 64 + p], lpi = LPi[(to + 1) * 64 + p], cr = Cr[ho * 64 + p], ci = Ci[ho * 64 + p];
                val = isim ? -(cr * lpi + ci * lpr) : (cr * lpr - ci * lpi); }
            v[j] = val; }
        v4u o; o.x = pk2(v[0], v[1]); o.y = pk2(v[2], v[3]); o.z = pk2(v[4], v[5]); o.w = pk2(v[6], v[7]);
        *(v4u*)(WYb + ((size_t)(g * 256 + n)) * 512 + k0) = o; }
}

__device__ __forceinline__ void rms_rows2_to_bf16(const float* x0, const float* x1, bf16_t* o0, bf16_t* o1, const float* gain, int lane, float* rinv = nullptr) {
    const f32x4* xr0 = (const f32x4*)x0 + lane; const f32x4* xr1 = (const f32x4*)x1 + lane;
    f32x4 v[4], w[4]; float s0 = 0.f, s1 = 0.f;
#pragma unroll
    for (int j = 0; j < 4; ++j) { v[j] = __builtin_nontemporal_load(xr0 + 64 * j); w[j] = __builtin_nontemporal_load(xr1 + 64 * j); }
#pragma unroll
    for (int j = 0; j < 4; ++j) { s0 += (v[j].x * v[j].x + v[j].y * v[j].y) + (v[j].z * v[j].z + v[j].w * v[j].w); s1 += (w[j].x * w[j].x + w[j].y * w[j].y) + (w[j].z * w[j].z + w[j].w * w[j].w); }
#pragma unroll
    for (int o = 1; o < 64; o <<= 1) { s0 += __shfl_xor(s0, o); s1 += __shfl_xor(s1, o); }
    const float q0 = sqrtf(s0 * (1.0f / DM) + NORM_EPS), q1 = sqrtf(s1 * (1.0f / DM) + NORM_EPS);
    const float r0 = 1.0f / q0, r1 = 1.0f / q1;
    if (rinv && lane == 0) { rinv[0] = q0; rinv[1] = q1; }
    unsigned long long* p0 = (unsigned long long*)o0 + lane; unsigned long long* p1 = (unsigned long long*)o1 + lane;
#pragma unroll
    for (int j = 0; j < 4; ++j) {
        const f32x4 g = gain ? ((const f32x4*)gain)[lane + 64 * j] : (f32x4){1.f, 1.f, 1.f, 1.f};
        p0[64 * j] = (unsigned long long)pk2(v[j].x * r0 * g.x, v[j].y * r0 * g.y) | ((unsigned long long)pk2(v[j].z * r0 * g.z, v[j].w * r0 * g.w) << 32);
        p1[64 * j] = (unsigned long long)pk2(w[j].x * r1 * g.x, w[j].y * r1 * g.y) | ((unsigned long long)pk2(w[j].z * r1 * g.z, w[j].w * r1 * g.w) << 32);
    }
}
__device__ __forceinline__ int win_dest_col(int n) {
    if (n < 768 || n >= 2304) return n;
    const int q = (n - 768) / 384, ch = (n - 768) % 384, base = (q == 0 || q == 2) ? 768 : 1536, half = (q >= 2) ? 128 : 0;
    return base + 256 * (ch >> 7) + half + (ch & 127);
}
__device__ __forceinline__ void transpose_item4(const float* W, int K, int N, bf16_t* WT, const float* ks, LAS float* scr, int item, int lane, bool winmap = false) {
    const int nblk = N / 32, kb = item / nblk, nb = item % nblk, k0 = 64 * kb, n0 = 32 * nb, d0 = winmap ? win_dest_col(n0) : n0;
    f32x4 w[8];
#pragma unroll
    for (int i = 0; i < 8; ++i) { const int kk = 8 * i + (lane >> 3); w[i] = __builtin_nontemporal_load((const f32x4*)(W + (size_t)(k0 + kk) * N + n0 + 4 * (lane & 7))); }
#pragma unroll
    for (int i = 0; i < 8; ++i) { const int kk = 8 * i + (lane >> 3); const float sc = ks ? ks[k0 + kk] : 1.0f; LAS float* d = scr + kk * 33 + 4 * (lane & 7);
        d[0] = w[i].x * sc; d[1] = w[i].y * sc; d[2] = w[i].z * sc; d[3] = w[i].w * sc; }
    LDS_WAIT();
    const int c = lane & 7;
#pragma unroll
    for (int j = 0; j < 4; ++j) { const int n = (lane >> 3) + 8 * j; const LAS float* sp = scr + (8 * c) * 33 + n;
        v4u o; o.x = pk2(sp[0 * 33], sp[1 * 33]); o.y = pk2(sp[2 * 33], sp[3 * 33]); o.z = pk2(sp[4 * 33], sp[5 * 33]); o.w = pk2(sp[6 * 33], sp[7 * 33]);
        *(v4u*)(WT + (size_t)(d0 + n) * K + k0 + 8 * c) = o; }
    LDS_WAIT();
}

__device__ __forceinline__ void phase0(const Args& a, LAS unsigned char* lds) {
    const int tid = otid(), lane = tid & 63, wave = tid >> 6;
    const int gw = blockIdx.x * 8 + wave, NGW = gridDim.x * 8;
    s5_tables(a, lds, tid);
    const float* x = a.in[0]; const float* mem = a.in[1]; const float* norm_g = a.in[2]; const float* w_in = a.in[3];
    const float* w_glu = a.in[12]; const float* mem_norm_g = a.in[16]; const float* w_mem_kv = a.in[17]; const float* w_out = a.in[18];
    bf16_t* XB = (bf16_t*)(a.ws + WS_XB); bf16_t* MEMN = (bf16_t*)(a.ws + WS_MEMN);
    bf16_t* WINT = (bf16_t*)(a.ws + WS_WINT); bf16_t* WKVT = (bf16_t*)(a.ws + WS_WKVT); bf16_t* WOUTT = (bf16_t*)(a.ws + WS_WOUTT); bf16_t* WGLUT = (bf16_t*)(a.ws + WS_WGLUT);
    for (int rnd = 0; rnd < 5; ++rnd) { const int r2 = rnd < 4 ? rnd * NGW + gw : 4 * NGW + (gw - 1536); if (rnd == 4 && (gw < 1536 || r2 >= (NTOK + NB * NMEM) / 2)) break; const int r = 2 * r2;
        if (r < NTOK) rms_rows2_to_bf16(x + (size_t)r * DM, x + (size_t)(r + 1) * DM, XB + (size_t)r * DM, XB + (size_t)(r + 1) * DM, nullptr, lane, (float*)(a.ws + WS_RINV) + r);
        else { const int m = r - NTOK; rms_rows2_to_bf16(mem + (size_t)m * DM, mem + (size_t)(m + 1) * DM, MEMN + (size_t)m * DM, MEMN + (size_t)(m + 1) * DM, mem_norm_g, lane); }
    }
    LAS float* scr = (LAS float*)(lds + wave * 8448);
    constexpr int I_IN = (DM / 64) * (DIN / 32), I_KV = (DM / 64) * (512 / 32), I_OUT = (DM / 64) * (DM / 32), I_GLU = (WSSM / 64) * (WSSM / 32);
    for (int rnd = 0; rnd < 2; ++rnd) { const int it = rnd == 0 ? gw : NGW + (gw - 1536); if (rnd == 1 && (gw < 1536 || it >= I_IN + I_KV + I_OUT + I_GLU)) break;
        int r = it;
        if (r < I_IN) { transpose_item4(w_in, DM, DIN, WINT, norm_g, scr, r, lane, true); continue; } r -= I_IN;
        if (r < I_KV) { transpose_item4(w_mem_kv, DM, 512, WKVT, nullptr, scr, r, lane); continue; } r -= I_KV;
        if (r < I_OUT) { transpose_item4(w_out, DM, DM, WOUTT, nullptr, scr, r, lane); continue; } r -= I_OUT;
        transpose_item4(w_glu, WSSM, WSSM, WGLUT, nullptr, scr, r, lane);
    }
    const int gt = blockIdx.x * 512 + tid, NT = gridDim.x * 512;
    for (int i = gt; i < 128 * 384 / 2; i += NT) ((unsigned*)(WGLUT + 384 * 384))[i] = 0u;
}

template <class Epi>
__device__ __forceinline__ void gemm_naive(const bf16_t* A, int lda, const bf16_t* Bt, int ldb, int M, int N, int K, LAS unsigned char* lds, int tile0, int ntile_total, const Epi& epi) {
    LAS float* As = (LAS float*)lds;
    LAS float* Bs = As + 32 * 132;
    const int tid = threadIdx.x, ty = tid >> 4, tx = tid & 15;
    const int ntn = N / 64, nt = (M / 128) * ntn;
    (void)ntile_total;
    for (int tile = blockIdx.x - tile0; tile < nt; tile += gridDim.x) {
        if (tile < 0) continue;
        const int tm = tile / ntn, tn = tile % ntn;
        float acc[4][4];
#pragma unroll
        for (int i = 0; i < 4; ++i)
#pragma unroll
            for (int j = 0; j < 4; ++j) acc[i][j] = 0.f;
        for (int k0 = 0; k0 < K; k0 += 32) {
            __syncthreads();
            { const int r = tid >> 2, kc = (tid & 3) * 8; const v4u v = *(const v4u*)(A + (size_t)(tm * 128 + r) * lda + k0 + kc);
              As[(kc + 0) * 132 + r] = bflo(v.x); As[(kc + 1) * 132 + r] = bfhi(v.x); As[(kc + 2) * 132 + r] = bflo(v.y); As[(kc + 3) * 132 + r] = bfhi(v.y);
              As[(kc + 4) * 132 + r] = bflo(v.z); As[(kc + 5) * 132 + r] = bfhi(v.z); As[(kc + 6) * 132 + r] = bflo(v.w); As[(kc + 7) * 132 + r] = bfhi(v.w); }
            if (tid < 256) { const int r = tid >> 2, kc = (tid & 3) * 8; const v4u v = *(const v4u*)(Bt + (size_t)(tn * 64 + r) * ldb + k0 + kc);
              Bs[(kc + 0) * 68 + r] = bflo(v.x); Bs[(kc + 1) * 68 + r] = bfhi(v.x); Bs[(kc + 2) * 68 + r] = bflo(v.y); Bs[(kc + 3) * 68 + r] = bfhi(v.y);
              Bs[(kc + 4) * 68 + r] = bflo(v.z); Bs[(kc + 5) * 68 + r] = bfhi(v.z); Bs[(kc + 6) * 68 + r] = bflo(v.w); Bs[(kc + 7) * 68 + r] = bfhi(v.w); }
            __syncthreads();
#pragma unroll 8
            for (int k = 0; k < 32; ++k) {
                const f32x4 av = *(const LAS f32x4*)(As + k * 132 + ty * 4), bv = *(const LAS f32x4*)(Bs + k * 68 + tx * 4);
#pragma unroll
                for (int i = 0; i < 4; ++i)
#pragma unroll
                    for (int j = 0; j < 4; ++j) acc[i][j] += av[i] * bv[j];
            }
        }
#pragma unroll
        for (int i = 0; i < 4; ++i)
#pragma unroll
            for (int j = 0; j < 4; ++j) epi(tm * 128 + ty * 4 + i, tn * 64 + tx * 4 + j, acc[i][j]);
    }
}

struct EpiStoreBf16 { bf16_t* O; int ldo; __device__ __forceinline__ void operator()(int r, int c, float v) const { O[(size_t)r * ldo + c] = (bf16_t)f2bf(v); } };
struct EpiGlu { const bf16_t* GB; const bf16_t* PROJ; const float* b_glu; bf16_t* YCAT;
    __device__ __forceinline__ void operator()(int r, int c, float v) const {
        const float g = bf2f(GB[(size_t)r * WSSM + c]); const float gate = bf2f(PROJ[(size_t)r * DIN + C_AGATE + c]);
        YCAT[(size_t)r * DM + c] = (bf16_t)f2bf(g * sigmoid_f(v + b_glu[c]) * silu_f(gate)); } };
struct EpiOut { const float* x; float* out; __device__ __forceinline__ void operator()(int r, int c, float v) const { out[(size_t)r * DM + c] = x[(size_t)r * DM + c] + v; } };


namespace pg8 {
typedef short bf16x8 __attribute__((ext_vector_type(8)));
typedef unsigned u32x4 __attribute__((ext_vector_type(4)));
constexpr int BM = 256, BK = 64, HALF = 128, HTB = HALF * BK * 2, STAGE_BYTES = 8 * HTB, NXCD = 8, WGM = 8;
__host__ __device__ __forceinline__ int lds_byte(int r, int c) { const int st = (r >> 4) * 2 + (c >> 5), rr = r & 15, cc = c & 31, ob = rr * 64 + cc * 2; return st * 1024 + (ob ^ (((ob >> 9) & 1) << 5)); }
__host__ __device__ __forceinline__ void stage_rc(int b, int& R, int& C) { const int st = b / 1024, sb = b % 1024, swz = sb ^ (((sb >> 9) & 1) << 5); R = (st >> 1) * 16 + swz / 64; C = (st & 1) * 32 + (swz % 64) / 2; }
__host__ __device__ __forceinline__ int perm32(int rho) { const int n = rho >> 4, i = rho & 15; return 8 * (i >> 2) + 4 * n + (i & 3); }
struct Unit { int pm, pn, z; };
struct Gemm { const bf16_t* A; const bf16_t* Bt; int lda, ldb, K; size_t sAz, sBz; };
struct Order {
    int nM, nN, per, total, G, c;
    __device__ void init(int nM_, int nN_, int nZ_, int G_, int c_) { nM = nM_; nN = nN_; per = nM_ * nN_; total = per * nZ_; G = G_; c = c_; }
    __device__ bool next(int i, Unit& u) const {
        const long L = (long)i * G + c; if (L >= total) return false;
        u.z = (int)(L / per); int wgid = (int)(L % per); const int nwg = per;
        { const int q = nwg / NXCD, r = nwg % NXCD, xcd = wgid % NXCD, off = wgid / NXCD; wgid = (xcd < r ? xcd * (q + 1) : r * (q + 1) + (xcd - r) * q) + off; }
        const int nig = WGM * nN, gid = wgid / nig, fm = gid * WGM, gsz = (nM - fm) < WGM ? (nM - fm) : WGM;
        u.pm = fm + ((wgid % nig) % gsz); u.pn = (wgid % nig) / gsz; return true;
    }
};
typedef __bf16 bf2v_t __attribute__((ext_vector_type(2))); typedef float f2v_t __attribute__((ext_vector_type(2)));
__device__ __forceinline__ unsigned cvt_pk_bf16(float lo, float hi) { const f2v_t v = {lo, hi}; return __builtin_bit_cast(unsigned, __builtin_convertvector(v, bf2v_t)); }

template <bool ALIGN_EPI = false, bool SP2 = false, class Epi>
__device__ __forceinline__ void gemm_phase(LAS unsigned char* lds, const Gemm g, const Order& S, const Epi& E) {
    int tid = threadIdx.x; asm volatile("" : "+v"(tid));
    const int wid = __builtin_amdgcn_readfirstlane(tid >> 6), lane = tid & 63, wr = wid >> 2, wc = wid & 3, fr = lane & 15, fq = lane >> 4;
    int K = g.K; asm volatile("" : "+s"(K));
    const int nt = K / BK;
    unsigned voffA[2], voffB[2];
#pragma unroll
    for (int i = 0; i < 2; ++i) { int R, C; stage_rc(tid * 16 + i * 8192, R, C); const int Rb = Epi::PERM ? ((R & ~31) + perm32(R & 31)) : R;
        voffA[i] = (unsigned)(R * g.lda + C) * 2u; voffB[i] = (unsigned)(Rb * g.ldb + C) * 2u; }
    const size_t kstep = (size_t)(BK * 2);
    const size_t hstepA = (size_t)HALF * g.lda * 2, hstepB = (size_t)HALF * g.ldb * 2;
    const size_t tstepA = 2 * hstepA, tstepB = 2 * hstepB;
    const unsigned ldsw = (unsigned)wid * 1024u;
    const int aoff = lds_byte(wr * 64 + fr, fq * 8), boff = lds_byte(wc * 32 + fr, fq * 8);
#define PG8_SA(b, h) (((b) * 2 + (h)) * HTB)
#define PG8_SB(b, h) ((4 + (b) * 2 + (h)) * HTB)
#define PG8_STAGE(bufoff, gbase, voff) do { _Pragma("unroll") for (int _i = 0; _i < 2; ++_i) \
        __builtin_amdgcn_global_load_lds((const unsigned*)((const char*)(gbase) + (voff)[_i]), (LAS unsigned*)(lds + (bufoff) + ldsw + _i * 8192), 16, 0, 0); } while (0)
#define PG8_LDA(dst, b, h) do { _Pragma("unroll") for (int m = 0; m < 4; ++m) _Pragma("unroll") for (int k = 0; k < 2; ++k) dst[m][k] = *(const LAS bf16x8*)(lds + PG8_SA(b, h) + aoff + m * 2048 + k * 1024); } while (0)
#define PG8_LDB(dst, b, h) do { _Pragma("unroll") for (int n = 0; n < 2; ++n) _Pragma("unroll") for (int k = 0; k < 2; ++k) dst[n][k] = *(const LAS bf16x8*)(lds + PG8_SB(b, h) + boff + n * 2048 + k * 1024); } while (0)
#define PG8_MMA(ai, bj, At, Bt) do { __builtin_amdgcn_s_setprio(1); _Pragma("unroll") for (int m = 0; m < 4; ++m) _Pragma("unroll") for (int n = 0; n < 2; ++n) _Pragma("unroll") for (int k = 0; k < 2; ++k) \
        acc[ai][bj][m][n] = __builtin_amdgcn_mfma_f32_16x16x32_bf16(Bt[n][k], At[m][k], acc[ai][bj][m][n], 0, 0, 0); __builtin_amdgcn_s_setprio(0); } while (0)
#define PG8_WAIT_V(n) asm volatile("s_waitcnt vmcnt(" #n ")" ::: "memory")
#define PG8_WAIT_L(n) asm volatile("s_waitcnt lgkmcnt(" #n ")" ::: "memory")
#define PG8_BAR __builtin_amdgcn_s_barrier()
#define PG8_SCHED __builtin_amdgcn_sched_barrier(0)
    Unit cur, nxt; int ui = 0;
    if (!S.next(0, cur)) return;
    f32x4 acc[2][2][4][2];
#pragma unroll
    for (int a = 0; a < 2; ++a)
#pragma unroll
        for (int b = 0; b < 2; ++b)
#pragma unroll
            for (int m = 0; m < 4; ++m)
#pragma unroll
                for (int n = 0; n < 2; ++n) acc[a][b][m][n] = (f32x4){0.f, 0.f, 0.f, 0.f};
    bf16x8 At[4][2], B0[2][2], B1[2][2];
    const char* cA = (const char*)(g.A + (size_t)cur.z * g.sAz) + (size_t)cur.pm * tstepA; const char* cB = (const char*)(g.Bt + (size_t)cur.z * g.sBz) + (size_t)cur.pn * tstepB;
    if constexpr (SP2) {
        PG8_STAGE(PG8_SB(0, 0), cB, voffB); PG8_STAGE(PG8_SB(0, 1), cB + hstepB, voffB); PG8_STAGE(PG8_SA(0, 0), cA, voffA); PG8_STAGE(PG8_SA(0, 1), cA + hstepA, voffA);
        if (wr == 1) PG8_BAR;
        PG8_WAIT_V(2); PG8_BAR;
        PG8_STAGE(PG8_SB(1, 0), cB + kstep, voffB); PG8_STAGE(PG8_SA(1, 0), cA + kstep, voffA); PG8_STAGE(PG8_SB(1, 1), cB + hstepB + kstep, voffB);
        PG8_WAIT_V(6); PG8_BAR;
    } else {
    PG8_STAGE(PG8_SB(0, 0), cB, voffB); PG8_STAGE(PG8_SA(0, 0), cA, voffA); PG8_STAGE(PG8_SB(0, 1), cB + hstepB, voffB); PG8_STAGE(PG8_SA(0, 1), cA + hstepA, voffA);
    if (wr == 1) PG8_BAR;
    PG8_WAIT_V(4); PG8_BAR;
    PG8_STAGE(PG8_SB(1, 0), cB + kstep, voffB); PG8_STAGE(PG8_SA(1, 0), cA + kstep, voffA); PG8_STAGE(PG8_SB(1, 1), cB + hstepB + kstep, voffB);
    PG8_WAIT_V(6); PG8_BAR;
    }
    for (;;) {
        const bool has_next = S.next(ui + 1, nxt);
        const char* nA = has_next ? (const char*)(g.A + (size_t)nxt.z * g.sAz) + (size_t)nxt.pm * tstepA : cA; const char* nB = has_next ? (const char*)(g.Bt + (size_t)nxt.z * g.sBz) + (size_t)nxt.pn * tstepB : cB;
        for (int t = 0; t < nt; t += 2) {
            const bool last = (t == nt - 2);
            const char* a1 = cA + (size_t)(t + 1) * kstep;
            const char* a2 = last ? nA : cA + (size_t)(t + 2) * kstep; const char* b2 = last ? nB : cB + (size_t)(t + 2) * kstep;
            const char* a3 = a2 + kstep; const char* b3 = b2 + kstep;
            if constexpr (SP2) {
            PG8_LDB(B0, 0, 0); PG8_LDB(B1, 0, 1); PG8_SCHED; PG8_LDA(At, 0, 0); PG8_STAGE(PG8_SA(1, 1), a1 + hstepA, voffA);
            PG8_WAIT_V(8); PG8_WAIT_L(0); PG8_BAR; PG8_MMA(0, 0, At, B0); PG8_MMA(0, 1, At, B1); PG8_BAR; PG8_SCHED;
            PG8_LDA(At, 0, 1); PG8_STAGE(PG8_SB(0, 0), b2, voffB); PG8_STAGE(PG8_SB(0, 1), b2 + hstepB, voffB); PG8_STAGE(PG8_SA(0, 0), a2, voffA);
            PG8_WAIT_V(8); PG8_WAIT_L(0); PG8_BAR; PG8_MMA(1, 0, At, B0); PG8_MMA(1, 1, At, B1); PG8_BAR; PG8_SCHED;
            PG8_LDB(B0, 1, 0); PG8_LDB(B1, 1, 1); PG8_SCHED; PG8_LDA(At, 1, 0); PG8_STAGE(PG8_SA(0, 1), a2 + hstepA, voffA);
            PG8_WAIT_V(8); PG8_WAIT_L(0); PG8_BAR; PG8_MMA(0, 0, At, B0); PG8_MMA(0, 1, At, B1); PG8_BAR; PG8_SCHED;
            PG8_LDA(At, 1, 1); PG8_STAGE(PG8_SB(1, 0), b3, voffB); PG8_STAGE(PG8_SB(1, 1), b3 + hstepB, voffB); PG8_STAGE(PG8_SA(1, 0), a3, voffA);
            PG8_WAIT_V(8); PG8_WAIT_L(0); PG8_BAR; PG8_MMA(1, 0, At, B0); PG8_MMA(1, 1, At, B1); PG8_BAR; PG8_SCHED;
            } else {
            PG8_LDB(B0, 0, 0); PG8_SCHED; PG8_LDA(At, 0, 0); PG8_STAGE(PG8_SA(1, 1), a1 + hstepA, voffA);
            PG8_WAIT_L(8); PG8_BAR; PG8_WAIT_L(0); PG8_MMA(0, 0, At, B0); PG8_BAR; PG8_SCHED;
            PG8_LDB(B1, 0, 1); PG8_STAGE(PG8_SB(0, 0), b2, voffB);
            PG8_BAR; PG8_WAIT_L(0); PG8_MMA(0, 1, At, B1); PG8_BAR;
            PG8_LDA(At, 0, 1); PG8_STAGE(PG8_SA(0, 0), a2, voffA);
            PG8_BAR; PG8_WAIT_L(0); PG8_MMA(1, 0, At, B0); PG8_BAR; PG8_SCHED;
            PG8_STAGE(PG8_SB(0, 1), b2 + hstepB, voffB);
            PG8_WAIT_V(6); PG8_BAR; PG8_MMA(1, 1, At, B1); PG8_BAR;
            PG8_LDB(B0, 1, 0); PG8_SCHED; PG8_LDA(At, 1, 0); PG8_STAGE(PG8_SA(0, 1), a2 + hstepA, voffA);
            PG8_WAIT_L(8); PG8_BAR; PG8_WAIT_L(0); PG8_MMA(0, 0, At, B0); PG8_BAR; PG8_SCHED;
            PG8_LDB(B1, 1, 1); PG8_STAGE(PG8_SB(1, 0), b3, voffB);
            PG8_BAR; PG8_WAIT_L(0); PG8_MMA(0, 1, At, B1); PG8_BAR;
            PG8_LDA(At, 1, 1); PG8_STAGE(PG8_SA(1, 0), a3, voffA);
            PG8_BAR; PG8_WAIT_L(0); PG8_MMA(1, 0, At, B0); PG8_BAR; PG8_SCHED;
            PG8_STAGE(PG8_SB(1, 1), b3 + hstepB, voffB);
            PG8_WAIT_V(6); PG8_BAR; PG8_MMA(1, 1, At, B1); PG8_BAR;
            }
        }
        if constexpr (ALIGN_EPI) { if (wr == 0) PG8_BAR; }
        if constexpr (!Epi::AFTER_DRAIN) { E(acc, cur, wr, wc, fr, fq); }
        if (!has_next) break;
#pragma unroll
        for (int a = 0; a < 2; ++a)
#pragma unroll
            for (int b = 0; b < 2; ++b)
#pragma unroll
                for (int m = 0; m < 4; ++m)
#pragma unroll
                    for (int n = 0; n < 2; ++n) acc[a][b][m][n] = (f32x4){0.f, 0.f, 0.f, 0.f};
        cur = nxt; cA = nA; cB = nB; ++ui;
        if constexpr (ALIGN_EPI) { if (wr == 1) PG8_BAR; }
    }
    PG8_WAIT_V(0);
    if constexpr (!ALIGN_EPI) { if (wr == 0) PG8_BAR; }
    PG8_BAR;
    if constexpr (Epi::AFTER_DRAIN) { E.fused(acc, cur, wr, wc, fr, fq, lds, wid, lane); }
#undef PG8_SA
#undef PG8_SB
#undef PG8_STAGE
#undef PG8_LDA
#undef PG8_LDB
#undef PG8_MMA
#undef PG8_WAIT_V
#undef PG8_WAIT_L
#undef PG8_BAR
#undef PG8_SCHED
}

struct EpiBf16Store {
    static constexpr bool PERM = true, AFTER_DRAIN = false;
    bf16_t* O; int ldc;
    __device__ __forceinline__ void operator()(const f32x4 (&acc)[2][2][4][2], const Unit& u, int wr, int wc, int fr, int fq) const {
        const int row0 = u.pm * BM + wr * 64 + fr, col0 = u.pn * BM + wc * 32 + 8 * fq;
#pragma unroll
        for (int ai = 0; ai < 2; ++ai)
#pragma unroll
            for (int m = 0; m < 4; ++m) { bf16_t* rowp = O + (size_t)(row0 + ai * HALF + m * 16) * ldc + col0;
#pragma unroll
                for (int bj = 0; bj < 2; ++bj) { const f32x4 v0 = acc[ai][bj][m][0], v1 = acc[ai][bj][m][1];
                    u32x4 w; w.x = cvt_pk_bf16(v0[0], v0[1]); w.y = cvt_pk_bf16(v0[2], v0[3]); w.z = cvt_pk_bf16(v1[0], v1[1]); w.w = cvt_pk_bf16(v1[2], v1[3]);
                    *(u32x4*)(rowp + bj * HALF) = w; } }
    }
};

struct EpiProjAY {
    static constexpr bool PERM = true, AFTER_DRAIN = false;
    bf16_t* PROJ; bf16_t* AY;
    __device__ __forceinline__ void operator()(const f32x4 (&acc)[2][2][4][2], const Unit& u, int wr, int wc, int fr, int fq) const {
        const int rowb = u.pm * BM + wr * 64, col0 = u.pn * BM + wc * 32 + 8 * fq;
        if (u.pn >= 3 && u.pn <= 8) {
            const bool gate = u.pn >= 6; const int colo = (gate ? C_W + (u.pn - 6) * HALF : C_U + (u.pn - 3) * HALF) + wc * 32 + 8 * fq;
#pragma unroll
            for (int ai = 0; ai < 2; ++ai)
#pragma unroll
                for (int m = 0; m < 4; ++m) { const int rb = rowb + ai * HALF + m * 16;
                    const f32x4 a0 = acc[ai][0][m][0], a1 = acc[ai][0][m][1], b0 = acc[ai][1][m][0], b1 = acc[ai][1][m][1];
                    f32x4 p0, p1;
                    if (gate) { p0 = (f32x4){a0[0] * silu_f(b0[0]), a0[1] * silu_f(b0[1]), a0[2] * silu_f(b0[2]), a0[3] * silu_f(b0[3])}; p1 = (f32x4){a1[0] * silu_f(b1[0]), a1[1] * silu_f(b1[1]), a1[2] * silu_f(b1[2]), a1[3] * silu_f(b1[3])}; }
                    else { p0 = a0 * b0; p1 = a1 * b1; }
                    u32x4 w; w.x = cvt_pk_bf16(p0[0], p0[1]); w.y = cvt_pk_bf16(p0[2], p0[3]); w.z = cvt_pk_bf16(p1[0], p1[1]); w.w = cvt_pk_bf16(p1[2], p1[3]);
                    *(u32x4*)(PROJ + (size_t)(rb + fr) * DIN + colo) = w; }
            return; }
#pragma unroll
        for (int bj = 0; bj < 2; ++bj) { const int col = col0 + bj * HALF; const bool ay = col < WSSM, sg = col >= C_AGATE && col < C_AGATE + WSSM;
#pragma unroll
            for (int ai = 0; ai < 2; ++ai)
#pragma unroll
                for (int m = 0; m < 4; ++m) { const int rb = rowb + ai * HALF + m * 16;
                    bf16_t* dst = ay ? AY + ((size_t)((col >> 4) * 1024 + (rb >> 4)) * 512 + fr * 16 + (col & 15)) : PROJ + (size_t)(rb + fr) * DIN + col;
                    f32x4 v0 = acc[ai][bj][m][0], v1 = acc[ai][bj][m][1];
                    if (sg) { v0 = (f32x4){silu_f(v0[0]), silu_f(v0[1]), silu_f(v0[2]), silu_f(v0[3])}; v1 = (f32x4){silu_f(v1[0]), silu_f(v1[1]), silu_f(v1[2]), silu_f(v1[3])}; }
                    u32x4 w; w.x = cvt_pk_bf16(v0[0], v0[1]); w.y = cvt_pk_bf16(v0[2], v0[3]); w.z = cvt_pk_bf16(v1[0], v1[1]); w.w = cvt_pk_bf16(v1[2], v1[3]);
                    *(u32x4*)dst = w; } }
    }
};
struct EpiSend {
    static constexpr bool PERM = false, AFTER_DRAIN = true;
    bf16_t* AY; const float* LAMT; const float* LAM512;
    __device__ __forceinline__ void fused(const f32x4 (&acc)[2][2][4][2], const Unit& u, int wr, int wc, int fr, int fq, LAS unsigned char* lds, int wid, int lane) const {
        LAS float* S = (LAS float*)lds;
        LAS float* E = (LAS float*)(lds + 131072);
#pragma unroll
        for (int ai = 0; ai < 2; ++ai)
#pragma unroll
            for (int m = 0; m < 4; ++m)
#pragma unroll
                for (int n = 0; n < 2; ++n) { const int r = ai * HALF + wr * 64 + m * 16 + fr, c = wc * 32 + n * 16 + 4 * fq; *(LAS f32x4*)(S + r * 128 + c) = acc[ai][0][m][n]; }
        __syncthreads();
        const int g = u.z, b = u.pm, p = lane, seg = wid;
        const float tr = LAMT[(g * NP + p) * 2], ti = LAMT[(g * NP + p) * 2 + 1], hr = LAM512[(g * NP + p) * 2], hi = LAM512[(g * NP + p) * 2 + 1];
        float sr = 0.f, si = 0.f;
        for (int i = 0; i < 32; ++i) { const int row = seg * 32 + i; const float xr = S[row * 128 + p], xi = S[row * 128 + 64 + p];
            const float nr = tr * sr - ti * si + xr, ni = tr * si + ti * sr + xi; sr = nr; si = ni; }
        E[seg * 128 + p] = sr; E[seg * 128 + 64 + p] = si;
        __syncthreads();
        sr = 0.f; si = 0.f;
        for (int s2 = 0; s2 < seg; ++s2) { const float xr = E[s2 * 128 + p], xi = E[s2 * 128 + 64 + p]; const float nr = hr * sr - hi * si + xr, ni = hr * si + hi * sr + xi; sr = nr; si = ni; }
        bf16_t* base = AY + ((size_t)(g * 1024 + b * 256 + seg * 32)) * 512 + 256 + p;
        for (int i = 0; i < 32; ++i) { const int row = seg * 32 + i;
            bf16_t* o = base + (size_t)i * 512;
            o[0] = (bf16_t)f2bf(sr); o[64] = (bf16_t)f2bf(si);
            const float xr = S[row * 128 + p], xi = S[row * 128 + 64 + p];
            const float nr = tr * sr - ti * si + xr, ni = tr * si + ti * sr + xi; sr = nr; si = ni; }
    }
};
struct EpiY {
    static constexpr bool PERM = true, AFTER_DRAIN = false;
    const bf16_t* AY; const float* ssm_d; bf16_t* GB;
    __device__ __forceinline__ void operator()(const f32x4 (&acc)[2][2][4][2], const Unit& u, int wr, int wc, int fr, int fq) const {
        const int g = u.z, b = u.pm;
#pragma unroll
        for (int bj = 0; bj < 2; ++bj) { const int col = bj * HALF + wc * 32 + 8 * fq, t = col >> 4, h0 = col & 15;
            const f32x4 d0 = *(const f32x4*)(ssm_d + g * GH + h0), d1 = *(const f32x4*)(ssm_d + g * GH + h0 + 4);
            u32x4 u8[2][4];
#pragma unroll
            for (int ai = 0; ai < 2; ++ai)
#pragma unroll
                for (int m = 0; m < 4; ++m) { const int crow = ai * HALF + wr * 64 + m * 16 + fr; u8[ai][m] = *(const u32x4*)(AY + ((size_t)(g * 1024 + b * 256 + crow)) * 512 + col); }
#pragma unroll
            for (int ai = 0; ai < 2; ++ai)
#pragma unroll
                for (int m = 0; m < 4; ++m) { const int crow = ai * HALF + wr * 64 + m * 16 + fr;
                    const u32x4 uu = u8[ai][m]; const f32x4 v0 = acc[ai][bj][m][0], v1 = acc[ai][bj][m][1];
                    u32x4 w;
                    w.x = cvt_pk_bf16(gelu_tanh(v0[0] + d0[0] * bflo(uu.x)), gelu_tanh(v0[1] + d0[1] * bfhi(uu.x)));
                    w.y = cvt_pk_bf16(gelu_tanh(v0[2] + d0[2] * bflo(uu.y)), gelu_tanh(v0[3] + d0[3] * bfhi(uu.y)));
                    w.z = cvt_pk_bf16(gelu_tanh(v1[0] + d1[0] * bflo(uu.z)), gelu_tanh(v1[1] + d1[1] * bfhi(uu.z)));
                    w.w = cvt_pk_bf16(gelu_tanh(v1[2] + d1[2] * bflo(uu.w)), gelu_tanh(v1[3] + d1[3] * bfhi(uu.w)));
                    *(u32x4*)(GB + ((size_t)(b * SEQ + crow * 16 + t)) * WSSM + g * GH + h0) = w; }
            asm volatile("" ::: "memory"); }
    }
};
struct EpiGluP {
    static constexpr bool PERM = true, AFTER_DRAIN = false;
    const bf16_t* GB; const bf16_t* PROJ; const float* b_glu; bf16_t* YCAT;
    __device__ __forceinline__ void operator()(const f32x4 (&acc)[2][2][4][2], const Unit& u, int wr, int wc, int fr, int fq) const {
        const int row0 = u.pm * BM + wr * 64 + fr, col0 = u.pn * BM + wc * 32 + 8 * fq;
#pragma unroll
        for (int bj = 0; bj < 2; ++bj) { const int col = col0 + bj * HALF; if (col >= WSSM) continue;
            const f32x4 b0 = *(const f32x4*)(b_glu + col), b1 = *(const f32x4*)(b_glu + col + 4);
#pragma unroll
            for (int ai = 0; ai < 2; ++ai) { if (ai != u.z) continue;
                u32x4 g8[4], a8[4];
#pragma unroll
                for (int m = 0; m < 4; ++m) { const size_t row = (size_t)(row0 + ai * HALF + m * 16); g8[m] = *(const u32x4*)(GB + row * WSSM + col); a8[m] = *(const u32x4*)(PROJ + row * DIN + C_AGATE + col); }
#pragma unroll
                for (int m = 0; m < 4; ++m) { const size_t row = (size_t)(row0 + ai * HALF + m * 16);
                    const f32x4 v0 = acc[ai][bj][m][0] + b0, v1 = acc[ai][bj][m][1] + b1;
                    u32x4 w;
                    w.x = cvt_pk_bf16(bflo(g8[m].x) * sigmoid_f(v0[0]) * bflo(a8[m].x), bfhi(g8[m].x) * sigmoid_f(v0[1]) * bfhi(a8[m].x));
                    w.y = cvt_pk_bf16(bflo(g8[m].y) * sigmoid_f(v0[2]) * bflo(a8[m].y), bfhi(g8[m].y) * sigmoid_f(v0[3]) * bfhi(a8[m].y));
                    w.z = cvt_pk_bf16(bflo(g8[m].z) * sigmoid_f(v1[0]) * bflo(a8[m].z), bfhi(g8[m].z) * sigmoid_f(v1[1]) * bfhi(a8[m].z));
                    w.w = cvt_pk_bf16(bflo(g8[m].w) * sigmoid_f(v1[2]) * bflo(a8[m].w), bfhi(g8[m].w) * sigmoid_f(v1[3]) * bfhi(a8[m].w));
                    *(u32x4*)(YCAT + row * DM + col) = w; }
                asm volatile("" ::: "memory"); } }
    }
};
struct EpiResF32 {
    static constexpr bool PERM = false, AFTER_DRAIN = false;
    const float* x; float* out;
    __device__ __forceinline__ void operator()(const f32x4 (&acc)[2][2][4][2], const Unit& u, int wr, int wc, int fr, int fq) const {
        const int row0 = u.pm * BM + wr * 64 + fr, col0 = u.pn * BM + wc * 32 + 4 * fq;
#pragma unroll
        for (int ai = 0; ai < 2; ++ai)
#pragma unroll
            for (int m = 0; m < 4; ++m) { const size_t off = (size_t)(row0 + ai * HALF + m * 16) * DM + col0;
#pragma unroll
                for (int bj = 0; bj < 2; ++bj)
#pragma unroll
                    for (int n = 0; n < 2; ++n) { const f32x4 xv = *(const f32x4*)(x + off + bj * HALF + n * 16); *(f32x4*)(out + off + bj * HALF + n * 16) = xv + acc[ai][bj][m][n]; }
                asm volatile("" ::: "memory"); }
    }
};

struct EpiOutNorm {
    static constexpr bool PERM = false, AFTER_DRAIN = true;
    const bf16_t* xb; const float* rinv; const float* fg; float* out; float* xch; unsigned* cnt;
    __device__ __forceinline__ void fused(f32x4 (&acc)[2][2][4][2], const Unit& u, int wr, int wc, int fr, int fq, LAS unsigned char* lds, int wid, int lane) const {
        LAS float* P = (LAS float*)lds;
        LAS float* S = (LAS float*)(lds + 8192);
        const int row0 = u.pm * BM + wr * 64 + fr, col0 = u.pn * BM + wc * 32 + 4 * fq;
        typedef unsigned u32x2v __attribute__((ext_vector_type(2)));
        u32x2v xv[2][4][2][2]; float ri[2][4];
#pragma unroll
        for (int ai = 0; ai < 2; ++ai)
#pragma unroll
            for (int m = 0; m < 4; ++m) { const size_t off = (size_t)(row0 + ai * HALF + m * 16) * DM + col0; ri[ai][m] = rinv[row0 + ai * HALF + m * 16];
#pragma unroll
                for (int bj = 0; bj < 2; ++bj)
#pragma unroll
                    for (int n = 0; n < 2; ++n) xv[ai][m][bj][n] = *(const u32x2v*)(xb + off + bj * HALF + n * 16); }
#pragma unroll
        for (int ai = 0; ai < 2; ++ai)
#pragma unroll
            for (int m = 0; m < 4; ++m) { float sq = 0.f; const float rv = ri[ai][m];
#pragma unroll
                for (int bj = 0; bj < 2; ++bj)
#pragma unroll
                    for (int n = 0; n < 2; ++n) { const u32x2v w = xv[ai][m][bj][n]; const f32x4 xf = {bflo(w.x) * rv, bfhi(w.x) * rv, bflo(w.y) * rv, bfhi(w.y) * rv};
                        const f32x4 hv = acc[ai][bj][m][n] + xf; acc[ai][bj][m][n] = hv; sq += (hv[0] * hv[0] + hv[1] * hv[1]) + (hv[2] * hv[2] + hv[3] * hv[3]); }
                sq += __shfl_xor(sq, 16); sq += __shfl_xor(sq, 32);
                if (fq == 0) P[(ai * HALF + wr * 64 + m * 16 + fr) * 4 + wc] = sq; }
        asm volatile("s_waitcnt lgkmcnt(0)" ::: "memory"); __builtin_amdgcn_s_barrier(); asm volatile("" ::: "memory");
        const int row = wid * 32 + (lane & 31);
        if (lane < 32) { const f32x4 pv = *(const LAS f32x4*)(P + row * 4); const float t = (pv[0] + pv[1]) + (pv[2] + pv[3]);
            __hip_atomic_store(xch + ((size_t)(u.pm * BM + row) * 4 + u.pn), t, __ATOMIC_RELAXED, __HIP_MEMORY_SCOPE_AGENT); }
        asm volatile("s_waitcnt vmcnt(0)" ::: "memory");
        if (lane == 0) __hip_atomic_fetch_add(cnt + 64 * u.pm, 1u, __ATOMIC_RELAXED, __HIP_MEMORY_SCOPE_AGENT);
        if (wid == 0) { unsigned sp = 0;
            while ((unsigned)__builtin_amdgcn_readfirstlane(__hip_atomic_load(cnt + 64 * u.pm, __ATOMIC_RELAXED, __HIP_MEMORY_SCOPE_AGENT)) < 32u) { __builtin_amdgcn_s_sleep(2); if (++sp > (1u << 22)) break; }
            __builtin_amdgcn_fence(__ATOMIC_ACQUIRE, "agent"); }
        asm volatile("s_waitcnt vmcnt(0) lgkmcnt(0)" ::: "memory"); __builtin_amdgcn_s_barrier(); asm volatile("" ::: "memory");
        if (lane < 32) { const float* slot = xch + (size_t)(u.pm * BM + row) * 4; float t = 0.f;
#pragma unroll
            for (int q = 0; q < 4; ++q) t += __hip_atomic_load(slot + q, __ATOMIC_RELAXED, __HIP_MEMORY_SCOPE_AGENT);
            S[row] = 1.0f / sqrtf(t * (1.0f / DM) + NORM_EPS); }
        asm volatile("s_waitcnt lgkmcnt(0)" ::: "memory"); __builtin_amdgcn_s_barrier(); asm volatile("" ::: "memory");
        f32x4 gv[2][2];
#pragma unroll
        for (int bj = 0; bj < 2; ++bj)
#pragma unroll
            for (int n = 0; n < 2; ++n) gv[bj][n] = *(const f32x4*)(fg + col0 + bj * HALF + n * 16);
#pragma unroll
        for (int ai = 0; ai < 2; ++ai)
#pragma unroll
            for (int m = 0; m < 4; ++m) { const int r = ai * HALF + wr * 64 + m * 16 + fr; const float rs = S[r]; const size_t off = (size_t)(u.pm * BM + r) * DM + col0;
#pragma unroll
                for (int bj = 0; bj < 2; ++bj)
#pragma unroll
                    for (int n = 0; n < 2; ++n) *(f32x4*)(out + off + bj * HALF + n * 16) = acc[ai][bj][m][n] * rs * gv[bj][n]; }
    }
};
}

__device__ __forceinline__ void s5_naive(const Args& a, int b, int g, int lane) {
    const bf16_t* PROJ = (const bf16_t*)(a.ws + WS_PROJ); bf16_t* GB = (bf16_t*)(a.ws + WS_GB);
    const float* LAMB = (const float*)(a.ws + WS_LAMB); const float* BBAR = (const float*)(a.ws + WS_BBAR);
    const float* c_re = a.in[8]; const float* c_im = a.in[9]; const float* ssm_d = a.in[10];
    const int p = lane, h = lane & 15, pg = lane >> 4;
    const float lr = LAMB[(g * NP + p) * 2], li = LAMB[(g * NP + p) * 2 + 1];
    float bre[16], bim[16], cre[16], cim[16];
#pragma unroll
    for (int j = 0; j < 16; ++j) { bre[j] = BBAR[((g * NP + p) * GH + j) * 2]; bim[j] = BBAR[((g * NP + p) * GH + j) * 2 + 1];
        cre[j] = c_re[(g * GH + h) * NP + pg * 16 + j]; cim[j] = c_im[(g * GH + h) * NP + pg * 16 + j]; }
    const float dd = ssm_d[g * GH + h];
    float sr = 0.f, si = 0.f;
    for (int t = 0; t < SEQ; ++t) {
        const bf16_t* up = PROJ + (size_t)(b * SEQ + t) * DIN + C_AIN + g * GH;
        const v4u u0 = *(const v4u*)up, u1 = *(const v4u*)(up + 8);
        float u[16];
        u[0] = bflo(u0.x); u[1] = bfhi(u0.x); u[2] = bflo(u0.y); u[3] = bfhi(u0.y); u[4] = bflo(u0.z); u[5] = bfhi(u0.z); u[6] = bflo(u0.w); u[7] = bfhi(u0.w);
        u[8] = bflo(u1.x); u[9] = bfhi(u1.x); u[10] = bflo(u1.y); u[11] = bfhi(u1.y); u[12] = bflo(u1.z); u[13] = bfhi(u1.z); u[14] = bflo(u1.w); u[15] = bfhi(u1.w);
        const float uh = bf2f(up[h]);
        float bur = 0.f, bui = 0.f;
#pragma unroll
        for (int j = 0; j < 16; ++j) { bur += bre[j] * u[j]; bui += bim[j] * u[j]; }
        const float nsr = lr * sr - li * si + bur, nsi = lr * si + li * sr + bui;
        sr = nsr; si = nsi;
        float part = 0.f;
#pragma unroll
        for (int j = 0; j < 16; ++j) { const float xr = __shfl(sr, pg * 16 + j), xi = __shfl(si, pg * 16 + j); part += cre[j] * xr - cim[j] * xi; }
        part += __shfl_xor(part, 16); part += __shfl_xor(part, 32);
        const float y = part + dd * uh;
        if (lane < 16) GB[(size_t)(b * SEQ + t) * WSSM + g * GH + h] = (bf16_t)f2bf(gelu_tanh(y));
    }
}

__device__ __forceinline__ void conv_naive(const Args& a, int vb, int nvb) {
    const bf16_t* PROJ = (const bf16_t*)(a.ws + WS_PROJ); bf16_t* YCAT = (bf16_t*)(a.ws + WS_YCAT);
    const float* conv_w = a.in[14]; const float* conv_b = a.in[15];
    const int gt = vb * 512 + otid(), NT = nvb * 512;
    for (int idx = gt; idx < NTOK * WSSM; idx += NT) {
        const int tok = idx / WSSM, c = idx % WSSM, t = tok % SEQ;
        const bf16_t* row = PROJ + (size_t)tok * DIN;
        float acc = conv_b[c];
#pragma unroll
        for (int k = 0; k < 3; ++k) { const int tt = t - 2 + k; if (tt >= 0) { const bf16_t* r2 = PROJ + (size_t)(tok - 2 + k) * DIN; acc += conv_w[k * WSSM + c] * (bf2f(r2[C_CC + c]) * bf2f(r2[C_CIN + c])); } }
        const float y = bf2f(row[C_CB + c]) * acc * silu_f(bf2f(row[C_CGATE + c]));
        YCAT[(size_t)tok * DM + WSSM + c] = (bf16_t)f2bf(y);
    }
}
__device__ __forceinline__ void attn_naive(const Args& a, int vb, int nvb) {
    const bf16_t* PROJ = (const bf16_t*)(a.ws + WS_PROJ); bf16_t* YCAT = (bf16_t*)(a.ws + WS_YCAT); const bf16_t* KV = (const bf16_t*)(a.ws + WS_KV);
    const int gt = vb * 512 + otid(), NT = nvb * 512;
    for (int item = gt; item < NB * 4 * SEQ; item += NT) {
        const int t = item % SEQ, hh = (item / SEQ) % 4, b = item / (4 * SEQ), tok = b * SEQ + t;
        const v4u* qp = (const v4u*)(PROJ + (size_t)tok * DIN + C_Q + hh * 64);
        float q[64], o[64];
#pragma unroll
        for (int i = 0; i < 8; ++i) { const v4u v = qp[i]; q[8 * i] = bflo(v.x); q[8 * i + 1] = bfhi(v.x); q[8 * i + 2] = bflo(v.y); q[8 * i + 3] = bfhi(v.y); q[8 * i + 4] = bflo(v.z); q[8 * i + 5] = bfhi(v.z); q[8 * i + 6] = bflo(v.w); q[8 * i + 7] = bfhi(v.w); }
#pragma unroll
        for (int d = 0; d < 64; ++d) o[d] = 0.f;
        float m = -1e30f, l = 0.f;
        for (int mm = 0; mm < NMEM; ++mm) {
            const v4u* kp = (const v4u*)(KV + (size_t)(b * NMEM + mm) * 512 + hh * 64);
            const v4u* vp = (const v4u*)(KV + (size_t)(b * NMEM + mm) * 512 + 256 + hh * 64);
            float s = 0.f;
#pragma unroll
            for (int i = 0; i < 8; ++i) { const v4u v = kp[i];
                s += q[8 * i] * bflo(v.x) + q[8 * i + 1] * bfhi(v.x) + q[8 * i + 2] * bflo(v.y) + q[8 * i + 3] * bfhi(v.y) + q[8 * i + 4] * bflo(v.z) + q[8 * i + 5] * bfhi(v.z) + q[8 * i + 6] * bflo(v.w) + q[8 * i + 7] * bfhi(v.w); }
            s *= 0.125f;
            const float mn = fmaxf(m, s), sc = __expf(m - mn), pp = __expf(s - mn);
            l = l * sc + pp; m = mn;
#pragma unroll
            for (int i = 0; i < 8; ++i) { const v4u v = vp[i];
                o[8 * i] = o[8 * i] * sc + pp * bflo(v.x); o[8 * i + 1] = o[8 * i + 1] * sc + pp * bfhi(v.x); o[8 * i + 2] = o[8 * i + 2] * sc + pp * bflo(v.y); o[8 * i + 3] = o[8 * i + 3] * sc + pp * bfhi(v.y);
                o[8 * i + 4] = o[8 * i + 4] * sc + pp * bflo(v.z); o[8 * i + 5] = o[8 * i + 5] * sc + pp * bfhi(v.z); o[8 * i + 6] = o[8 * i + 6] * sc + pp * bflo(v.w); o[8 * i + 7] = o[8 * i + 7] * sc + pp * bfhi(v.w); }
        }
        const float inv = 1.0f / l;
        const v4u* gp = (const v4u*)(PROJ + (size_t)tok * DIN + C_QGATE + hh * 64);
        v4u* op = (v4u*)(YCAT + (size_t)tok * DM + 768 + hh * 64);
#pragma unroll
        for (int i = 0; i < 8; ++i) { const v4u gv = gp[i]; v4u w;
            w.x = pk2(o[8 * i] * inv * silu_f(bflo(gv.x)), o[8 * i + 1] * inv * silu_f(bfhi(gv.x)));
            w.y = pk2(o[8 * i + 2] * inv * silu_f(bflo(gv.y)), o[8 * i + 3] * inv * silu_f(bfhi(gv.y)));
            w.z = pk2(o[8 * i + 4] * inv * silu_f(bflo(gv.z)), o[8 * i + 5] * inv * silu_f(bfhi(gv.z)));
            w.w = pk2(o[8 * i + 6] * inv * silu_f(bflo(gv.w)), o[8 * i + 7] * inv * silu_f(bfhi(gv.w)));
            op[i] = w; }
    }
}

typedef short bf16x8_t __attribute__((ext_vector_type(8)));
typedef short s16x4_t __attribute__((ext_vector_type(4)));
typedef float f32x16 __attribute__((ext_vector_type(16)));
typedef __bf16 bf2_t __attribute__((ext_vector_type(2)));
typedef float f2_t __attribute__((ext_vector_type(2)));
typedef unsigned u32x2_t __attribute__((ext_vector_type(2)));
__device__ __forceinline__ unsigned cvt2(float lo, float hi) { const f2_t v = {lo, hi}; return __builtin_bit_cast(unsigned, __builtin_convertvector(v, bf2_t)); }
__device__ __forceinline__ void attn_mfma(const Args& a, LAS unsigned char* lds, int vb, int nvb) {
    const int nj = nvb / 16; if (nj < 1 || vb >= nj * 16) return;
    const int tid = otid(), lane = tid & 63, wave = tid >> 6, r = lane & 31, h = lane >> 5;
    const int bh = vb % 16, j = vb / 16, b = bh >> 2, head = bh & 3;
    const bf16_t* PROJ = (const bf16_t*)(a.ws + WS_PROJ); bf16_t* YCAT = (bf16_t*)(a.ws + WS_YCAT); const bf16_t* KV = (const bf16_t*)(a.ws + WS_KV);
    LAS unsigned char* Kl = lds;
    LAS unsigned char* Vl = lds + 36864;
    for (int c = tid; c < 2048; c += 512) { const int key = c >> 3, dch = c & 7;
        const bf16_t* src = KV + (size_t)(b * NMEM + key) * 512 + head * 64 + dch * 8;
        const v4u kv = *(const v4u*)src, vv = *(const v4u*)(src + 256);
        *(LAS v4u*)(Kl + key * 144 + dch * 16) = kv;
        LAS bf16_t* vd = (LAS bf16_t*)(Vl + (dch * 8) * 520 + key * 2);
        vd[0 * 260] = (bf16_t)(vv.x & 0xffff); vd[1 * 260] = (bf16_t)(vv.x >> 16); vd[2 * 260] = (bf16_t)(vv.y & 0xffff); vd[3 * 260] = (bf16_t)(vv.y >> 16);
        vd[4 * 260] = (bf16_t)(vv.z & 0xffff); vd[5 * 260] = (bf16_t)(vv.z >> 16); vd[6 * 260] = (bf16_t)(vv.w & 0xffff); vd[7 * 260] = (bf16_t)(vv.w >> 16); }
    __syncthreads();
    for (int tile = j * 8 + wave; tile < SEQ / 32; tile += nj * 8) {
        const size_t tok = (size_t)b * SEQ + tile * 32 + r;
        bf16x8_t qf[4];
#pragma unroll
        for (int s4 = 0; s4 < 4; ++s4) qf[s4] = *(const bf16x8_t*)(PROJ + tok * DIN + C_Q + head * 64 + 16 * s4 + 8 * h);
        const float sc = 0.125f * 1.4426950408889634f;
        float mx = -3.0e38f, l = 0.f;
        f32x16 o0, o1;
#pragma unroll
        for (int i = 0; i < 16; ++i) { o0[i] = 0.f; o1[i] = 0.f; }
#pragma unroll 2
        for (int kt = 0; kt < 8; ++kt) {
            f32x16 st;
#pragma unroll
            for (int i = 0; i < 16; ++i) st[i] = 0.f;
#pragma unroll
            for (int s4 = 0; s4 < 4; ++s4) { const bf16x8_t kf = *(const LAS bf16x8_t*)(Kl + (kt * 32 + r) * 144 + (16 * s4 + 8 * h) * 2);
                st = __builtin_amdgcn_mfma_f32_32x32x16_bf16(kf, qf[s4], st, 0, 0, 0); }
            float tm = st[0];
#pragma unroll
            for (int i = 1; i < 16; ++i) tm = fmaxf(tm, st[i]);
            tm = fmaxf(tm, __shfl_xor(tm, 32));
            const float mn = fmaxf(mx, tm), alpha = __builtin_amdgcn_exp2f((mx - mn) * sc), mb = mn * sc;
            mx = mn; l *= alpha;
#pragma unroll
            for (int i = 0; i < 16; ++i) { o0[i] *= alpha; o1[i] *= alpha; }
#pragma unroll
            for (int i = 0; i < 16; ++i) { const float p = __builtin_amdgcn_exp2f(st[i] * sc - mb); st[i] = p; l += p; }
#pragma unroll
            for (int s2 = 0; s2 < 2; ++s2) {
                v4u pw; pw.x = cvt2(st[8 * s2 + 0], st[8 * s2 + 1]); pw.y = cvt2(st[8 * s2 + 2], st[8 * s2 + 3]);
                pw.z = cvt2(st[8 * s2 + 4], st[8 * s2 + 5]); pw.w = cvt2(st[8 * s2 + 6], st[8 * s2 + 7]);
                const bf16x8_t pf = __builtin_bit_cast(bf16x8_t, pw);
                const int koff = (kt * 32 + 16 * s2 + 4 * h) * 2;
                { const s16x4_t lo = *(const LAS s16x4_t*)(Vl + r * 520 + koff), hi = *(const LAS s16x4_t*)(Vl + r * 520 + koff + 16);
                  const bf16x8_t vf = __builtin_shufflevector(lo, hi, 0, 1, 2, 3, 4, 5, 6, 7); o0 = __builtin_amdgcn_mfma_f32_32x32x16_bf16(vf, pf, o0, 0, 0, 0); }
                { const s16x4_t lo = *(const LAS s16x4_t*)(Vl + (32 + r) * 520 + koff), hi = *(const LAS s16x4_t*)(Vl + (32 + r) * 520 + koff + 16);
                  const bf16x8_t vf = __builtin_shufflevector(lo, hi, 0, 1, 2, 3, 4, 5, 6, 7); o1 = __builtin_amdgcn_mfma_f32_32x32x16_bf16(vf, pf, o1, 0, 0, 0); }
            }
        }
        l += __shfl_xor(l, 32);
        const float inv = 1.0f / l;
        const bf16_t* gp = PROJ + tok * DIN + C_QGATE + head * 64; bf16_t* op = YCAT + tok * DM + 768 + head * 64;
#pragma unroll
        for (int q4 = 0; q4 < 4; ++q4) {
            { const int d = 8 * q4 + 4 * h; const u32x2_t gv = *(const u32x2_t*)(gp + d); u32x2_t w;
              w.x = cvt2(o0[4 * q4 + 0] * inv * silu_f(bflo(gv.x)), o0[4 * q4 + 1] * inv * silu_f(bfhi(gv.x))); w.y = cvt2(o0[4 * q4 + 2] * inv * silu_f(bflo(gv.y)), o0[4 * q4 + 3] * inv * silu_f(bfhi(gv.y)));
              *(u32x2_t*)(op + d) = w; }
            { const int d = 32 + 8 * q4 + 4 * h; const u32x2_t gv = *(const u32x2_t*)(gp + d); u32x2_t w;
              w.x = cvt2(o1[4 * q4 + 0] * inv * silu_f(bflo(gv.x)), o1[4 * q4 + 1] * inv * silu_f(bfhi(gv.x))); w.y = cvt2(o1[4 * q4 + 2] * inv * silu_f(bflo(gv.y)), o1[4 * q4 + 3] * inv * silu_f(bfhi(gv.y)));
              *(u32x2_t*)(op + d) = w; }
        }
    }
}
__device__ __forceinline__ void conv_vec(const Args& a, int vb, int nvb) {
    const bf16_t* PROJ = (const bf16_t*)(a.ws + WS_PROJ); bf16_t* YCAT = (bf16_t*)(a.ws + WS_YCAT);
    const float* conv_w = a.in[14]; const float* conv_b = a.in[15];
    const int gt = vb * 512 + otid(), NT = nvb * 512;
    for (int it = gt; it < (NTOK / 4) * 48; it += NT) {
        const int tg = it / 48, c0 = (it % 48) * 8, tok0 = tg * 4, t0 = tok0 % SEQ;
        const bf16_t* row0 = PROJ + (size_t)tok0 * DIN;
        v4u uu[6], ww[4];
#pragma unroll
        for (int r = 0; r < 6; ++r) { const bool ok = (t0 + r - 2) >= 0; const bf16_t* rp = row0 + (ptrdiff_t)(r - 2) * DIN; uu[r] = ok ? *(const v4u*)(rp + C_U + c0) : (v4u){0u, 0u, 0u, 0u}; }
#pragma unroll
        for (int j = 0; j < 4; ++j) ww[j] = *(const v4u*)(row0 + (size_t)j * DIN + C_W + c0);
        float w[3][8], bb[8];
#pragma unroll
        for (int k = 0; k < 3; ++k) { const f32x4 w0 = *(const f32x4*)(conv_w + k * WSSM + c0), w1 = *(const f32x4*)(conv_w + k * WSSM + c0 + 4);
            w[k][0] = w0.x; w[k][1] = w0.y; w[k][2] = w0.z; w[k][3] = w0.w; w[k][4] = w1.x; w[k][5] = w1.y; w[k][6] = w1.z; w[k][7] = w1.w; }
        { const f32x4 b0 = *(const f32x4*)(conv_b + c0), b1 = *(const f32x4*)(conv_b + c0 + 4); bb[0] = b0.x; bb[1] = b0.y; bb[2] = b0.z; bb[3] = b0.w; bb[4] = b1.x; bb[5] = b1.y; bb[6] = b1.z; bb[7] = b1.w; }
        float u[6][8];
#pragma unroll
        for (int r = 0; r < 6; ++r) { u[r][0] = bflo(uu[r].x); u[r][1] = bfhi(uu[r].x); u[r][2] = bflo(uu[r].y); u[r][3] = bfhi(uu[r].y); u[r][4] = bflo(uu[r].z); u[r][5] = bfhi(uu[r].z); u[r][6] = bflo(uu[r].w); u[r][7] = bfhi(uu[r].w); }
#pragma unroll
        for (int j = 0; j < 4; ++j) { float y[8];
#pragma unroll
            for (int e = 0; e < 8; ++e) y[e] = bb[e] + w[0][e] * u[j][e] + w[1][e] * u[j + 1][e] + w[2][e] * u[j + 2][e];
            v4u o;
            o.x = cvt2(bflo(ww[j].x) * y[0], bfhi(ww[j].x) * y[1]); o.y = cvt2(bflo(ww[j].y) * y[2], bfhi(ww[j].y) * y[3]);
            o.z = cvt2(bflo(ww[j].z) * y[4], bfhi(ww[j].z) * y[5]); o.w = cvt2(bflo(ww[j].w) * y[6], bfhi(ww[j].w) * y[7]);
            *(v4u*)(YCAT + (size_t)(tok0 + j) * DM + WSSM + c0) = o; }
    }
}
__device__ __forceinline__ void final_norm(const Args& a) {
    const int tid = otid(), lane = tid & 63, gw = blockIdx.x * 8 + (tid >> 6), NGW = gridDim.x * 8;
    const float* fg = a.in[19];
    for (int r = gw; r < NTOK; r += NGW) {
        f32x4* xr = (f32x4*)(a.out + (size_t)r * DM) + lane;
        f32x4 v[4]; float s = 0.f;
#pragma unroll
        for (int j = 0; j < 4; ++j) { v[j] = xr[64 * j]; s += (v[j].x * v[j].x + v[j].y * v[j].y) + (v[j].z * v[j].z + v[j].w * v[j].w); }
        const float rstd = 1.0f / sqrtf(wave_sum(s) * (1.0f / DM) + NORM_EPS);
#pragma unroll
        for (int j = 0; j < 4; ++j) { const f32x4 g = ((const f32x4*)fg)[lane + 64 * j]; xr[64 * j] = v[j] * rstd * g; }
    }
}

__global__ void __launch_bounds__(512, 2) mega(Args a) {
    extern __shared__ __attribute__((aligned(16))) unsigned char smem_raw[];
    LAS unsigned char* lds = (LAS unsigned char*)smem_raw;
    cg::grid_group grid = cg::this_grid();
    volatile LAS unsigned* xst = (volatile LAS unsigned*)(lds + 139264);
    if (threadIdx.x == 0) { xst[0] = 0u; xst[1] = 0u; }
    { unsigned* ctl = (unsigned*)(a.ws + WS_CTL); unsigned* flag = ctl + CTL_FLAG_WORD;
      if (blockIdx.x == 0) { for (int i = threadIdx.x; i < 8192; i += 512) __hip_atomic_store(ctl + i, 0u, __ATOMIC_RELAXED, __HIP_MEMORY_SCOPE_AGENT);
          asm volatile("s_waitcnt vmcnt(0)" ::: "memory"); __syncthreads();
          if (threadIdx.x == 0) { __builtin_amdgcn_fence(__ATOMIC_RELEASE, "agent"); __hip_atomic_store(flag, CTL_TOKEN, __ATOMIC_RELAXED, __HIP_MEMORY_SCOPE_AGENT); } }
      if (threadIdx.x == 0) { unsigned sp = 0; while (__hip_atomic_load(flag, __ATOMIC_RELAXED, __HIP_MEMORY_SCOPE_AGENT) != CTL_TOKEN) { __builtin_amdgcn_s_sleep(1); if (++sp > (1u << 22)) break; }
          __builtin_amdgcn_fence(__ATOMIC_ACQUIRE, "agent"); } }
    __syncthreads();
    const XcdBarrier xbar = xcd_barrier_post((unsigned*)(a.ws + WS_CTL), xst);
    const int bid = blockIdx.x, G = gridDim.x;
    bf16_t* XB = (bf16_t*)(a.ws + WS_XB); bf16_t* MEMN = (bf16_t*)(a.ws + WS_MEMN);
    bf16_t* WINT = (bf16_t*)(a.ws + WS_WINT); bf16_t* WKVT = (bf16_t*)(a.ws + WS_WKVT); bf16_t* WOUTT = (bf16_t*)(a.ws + WS_WOUTT); bf16_t* WGLUT = (bf16_t*)(a.ws + WS_WGLUT);
    bf16_t* PROJ = (bf16_t*)(a.ws + WS_PROJ); bf16_t* KV = (bf16_t*)(a.ws + WS_KV); bf16_t* GB = (bf16_t*)(a.ws + WS_GB); bf16_t* YCAT = (bf16_t*)(a.ws + WS_YCAT);
    bf16_t* AY = (bf16_t*)(a.ws + WS_AY); bf16_t* WSb = (bf16_t*)(a.ws + WS_WS); bf16_t* WYb = (bf16_t*)(a.ws + WS_WY);

#ifndef PROBE_DUP
#define PROBE_DUP -1
#endif
#define REPS(k) for (int rep_ = 0; rep_ < ((PROBE_DUP == (k)) ? 2 : 1); ++rep_)
#ifndef PROBE_SUB
#define PROBE_SUB -1
#endif
    if (a.out == nullptr) grid.sync();
    REPS(0) { phase0(a, lds);
    xcd_barrier(xbar); }
    REPS(1) {
    { pg8::Order S; S.init(NTOK / 256, DIN / 256, 1, G, bid);
      pg8::gemm_phase<true, true>(lds, pg8::Gemm{XB, WINT, DM, DM, DM, 0, 0}, S, pg8::EpiProjAY{PROJ, AY}); }
    { pg8::Order S; S.init(NB * NMEM / 256, 512 / 256, 1, G, (bid + G - ((NTOK / 256) * (DIN / 256)) % G) % G);
      pg8::gemm_phase<false, true>(lds, pg8::Gemm{MEMN, WKVT, DM, DM, DM, 0, 0}, S, pg8::EpiBf16Store{KV, 512}); }
    xcd_barrier(xbar); }
    REPS(2) {
    if (bid < NB * NG) { pg8::Order S; S.init(NB, 1, NG, G, bid);
      pg8::gemm_phase<false, true>(lds, pg8::Gemm{AY, WSb, 512, 256, 256, (size_t)1024 * 512, (size_t)256 * 256}, S, pg8::EpiSend{AY, (const float*)(a.ws + WS_LAMT), (const float*)(a.ws + WS_LAM512)});
      asm volatile("s_waitcnt vmcnt(0)" ::: "memory"); __syncthreads();
      pg8::gemm_phase<false, true>(lds, pg8::Gemm{AY, WYb, 512, 512, 384, (size_t)1024 * 512, (size_t)256 * 512}, S, pg8::EpiY{AY, a.in[10], GB}); }
    else { attn_mfma(a, lds, bid - NB * NG, G - NB * NG); conv_vec(a, bid - NB * NG, G - NB * NG); }
    xcd_barrier(xbar); }
    REPS(4) {
    { pg8::Order S; S.init(NTOK / 256, 2, 2, G, bid);
      pg8::gemm_phase<false, true>(lds, pg8::Gemm{GB, WGLUT, WSSM, WSSM, WSSM, 0, 0}, S, pg8::EpiGluP{GB, PROJ, a.in[13], YCAT}); }
    xcd_barrier(xbar); }
    REPS(5) {
    { pg8::Order S; S.init(NTOK / 256, DM / 256, 1, G, bid);
      pg8::gemm_phase<false, true>(lds, pg8::Gemm{YCAT, WOUTT, DM, DM, DM, 0, 0}, S, pg8::EpiOutNorm{XB, (const float*)(a.ws + WS_RINV), a.in[19], a.out, (float*)(a.ws + WS_XCH), (unsigned*)(a.ws + WS_CTL + CTL_PANEL)}); }
    }
    __syncthreads();
    if (threadIdx.x == 0) { unsigned* ctl = (unsigned*)(a.ws + WS_CTL);
        const unsigned old_ = __hip_atomic_fetch_add(ctl + CTL_EXIT_WORD, 1u, __ATOMIC_RELAXED, __HIP_MEMORY_SCOPE_AGENT);
        if (old_ == (unsigned)G - 1u) __hip_atomic_store(ctl + CTL_FLAG_WORD, CTL_RESET, __ATOMIC_RELAXED, __HIP_MEMORY_SCOPE_AGENT); }
}

extern "C" void kernel_launch(void* const* d_in, const int* in_sizes, int n_in, void* d_out, int out_size, void* d_ws, size_t ws_size, hipStream_t stream) {
    static int grid = 0;
    if (grid == 0) {
        if (n_in != 20 || out_size != NTOK * DM || ws_size < WS_END) { fprintf(stderr, "kernel_launch: unexpected shapes n_in %d out %d ws %zu\n", n_in, out_size, ws_size); grid = -1; return; }
        int dev = 0, cus = 0, per_cu = 0;
        hipGetDevice(&dev);
        hipDeviceGetAttribute(&cus, hipDeviceAttributeMultiprocessorCount, dev);
        if (hipFuncSetAttribute((const void*)mega, hipFuncAttributeMaxDynamicSharedMemorySize, LDS_BYTES) != hipSuccess) { fprintf(stderr, "kernel_launch: hipFuncSetAttribute failed\n"); grid = -1; return; }
        if (hipOccupancyMaxActiveBlocksPerMultiprocessor(&per_cu, (const void*)mega, 512, LDS_BYTES) != hipSuccess || per_cu < 1) { fprintf(stderr, "kernel_launch: occupancy query says %d\n", per_cu); per_cu = 1; }
        (void)hipGetLastError();
        grid = cus;
        if (grid != 256) { fprintf(stderr, "kernel_launch: built for 256 CUs (one workgroup each), device has %d\n", grid); grid = -1; return; }
        if (grid < NB * NG) { fprintf(stderr, "kernel_launch: grid %d too small\n", grid); grid = -1; return; }
    }
    if (grid < 0) return;
    Args a{};
    for (int i = 0; i < 20; ++i) a.in[i] = (const float*)d_in[i];
    a.out = (float*)d_out; a.ws = (unsigned char*)d_ws;
    void* args[] = {&a};
    hipError_t e = hipLaunchCooperativeKernel((const void*)mega, dim3(grid), dim3(512), args, LDS_BYTES, stream);
    if (e != hipSuccess) fprintf(stderr, "cooperative launch failed: %s (grid %d)\n", hipGetErrorString(e), grid);
}
```

```cpp
#include <hip/hip_runtime.h>
#include <hip/hip_cooperative_groups.h>
#include <cstdio>
#include <cstdint>
namespace cg = cooperative_groups;

#define LAS __attribute__((address_space(3)))
typedef unsigned short bf16_t;
typedef unsigned v4u __attribute__((ext_vector_type(4)));
typedef float f32x4 __attribute__((ext_vector_type(4)));

constexpr int NB = 4, SEQ = 4096, DM = 1024, NTOK = NB * SEQ, DIN = 2816, WSSM = 384, NG = 24, GH = 16, NP = 64, NMEM = 256;
constexpr int C_AIN = 0, C_AGATE = 384, C_CIN = 768, C_CB = 1152, C_CC = 1536, C_CGATE = 1920, C_Q = 2304, C_QGATE = 2560;
constexpr int C_U = 768, C_W = 1152;
constexpr float NORM_EPS = 1e-6f;

constexpr size_t MiB = 1u << 20;
constexpr size_t WS_CTL = 0;
constexpr size_t WS_XB = 1 * MiB;
constexpr size_t WS_WINT = 33 * MiB;
constexpr size_t WS_WKVT = 39 * MiB;
constexpr size_t WS_WOUTT = 40 * MiB;
constexpr size_t WS_WGLUT = 42 * MiB;
constexpr size_t WS_MEMN = 43 * MiB;
constexpr size_t WS_KV = 45 * MiB;
constexpr size_t WS_LAMB = 46 * MiB;
constexpr size_t WS_BBAR = 46 * MiB + 65536;
constexpr size_t WS_GB = 47 * MiB;
constexpr size_t WS_PROJ = 59 * MiB;
constexpr size_t WS_YCAT = 147 * MiB;
constexpr size_t WS_AY = 179 * MiB;
constexpr size_t WS_WS = 203 * MiB;
constexpr size_t WS_WY = 206 * MiB;
constexpr size_t WS_LAMT = 212 * MiB;
constexpr size_t WS_LAM512 = 212 * MiB + 65536;
constexpr size_t WS_XCH = 213 * MiB;
constexpr size_t WS_RINV = 214 * MiB;
constexpr size_t WS_END = 215 * MiB;
constexpr size_t CTL_PANEL = 16384;
constexpr size_t CTL_BYTES = 32768;
constexpr int CTL_EXIT_WORD = 3968, CTL_FLAG_WORD = 8192 + 64;
constexpr unsigned CTL_TOKEN = 0x600DF00Du, CTL_RESET = 0x0BADF00Du;

constexpr int LDS_BYTES = 147456;

struct Args {
    const float* in[20];
    float* out;
    unsigned char* ws;
};

__device__ __forceinline__ unsigned f2bf(float f) { unsigned u = __builtin_bit_cast(unsigned, f); return (u + 0x7fffu + ((u >> 16) & 1u)) >> 16; }
__device__ __forceinline__ unsigned pk2(float lo, float hi) { return f2bf(lo) | (f2bf(hi) << 16); }
__device__ __forceinline__ float bf2f(unsigned short b) { return __builtin_bit_cast(float, ((unsigned)b) << 16); }
__device__ __forceinline__ float bflo(unsigned w) { return __builtin_bit_cast(float, w << 16); }
__device__ __forceinline__ float bfhi(unsigned w) { return __builtin_bit_cast(float, w & 0xffff0000u); }
__device__ __forceinline__ float wave_sum(float v) {
#pragma unroll
    for (int o = 1; o < 64; o <<= 1) v += __shfl_xor(v, o);
    return v;
}
__device__ __forceinline__ float silu_f(float v) { return v * __builtin_amdgcn_rcpf(1.0f + __builtin_amdgcn_exp2f(-1.4426950408889634f * v)); }
__device__ __forceinline__ float sigmoid_f(float v) { return __builtin_amdgcn_rcpf(1.0f + __builtin_amdgcn_exp2f(-1.4426950408889634f * v)); }
__device__ __forceinline__ float gelu_tanh(float v) { const float w = __builtin_fmaf(v * v, -0.10294324f, -2.3022082f); return v * __builtin_amdgcn_rcpf(1.0f + __builtin_amdgcn_exp2f(v * w)); }
#define LDS_WAIT() asm volatile("s_waitcnt lgkmcnt(0)" ::: "memory")
__device__ __forceinline__ int otid() { int t = threadIdx.x; asm volatile("" : "+v"(t)); return t; }

#define XB_TMO      128
#define XB_XCNT(j)  (256  + 64 * (j))
#define XB_XSUB(j)  (1280 + 64 * (j))
#define XB_XGEN(j)  (2304 + 64 * (j))
#define XB_TOP      3328
#define XB_TOPGEN   3392
#define XCD_BAR_WORDS 3456
#define XB_SPIN_CAP (1u << 18)

__device__ __forceinline__ unsigned xb_ld(unsigned* p)              { return __hip_atomic_load(p, __ATOMIC_RELAXED, __HIP_MEMORY_SCOPE_AGENT); }
__device__ __forceinline__ unsigned xb_add(unsigned* p, unsigned v) { return __hip_atomic_fetch_add(p, v, __ATOMIC_RELAXED, __HIP_MEMORY_SCOPE_AGENT); }
__device__ __forceinline__ unsigned xb_xcc_id() { return (unsigned)__builtin_amdgcn_s_getreg((3 << 11) | 20) & 0xFu; }
#define XB_SPIN(cond, bar) do { unsigned _sp = 0; while (cond) { __builtin_amdgcn_s_sleep(1); \
    if ((++_sp & 255u) == 0u) { if (xb_ld(&(bar)[XB_TMO])) break; if (_sp > XB_SPIN_CAP) { atomicAdd(&(bar)[XB_TMO], 1u); break; } } } } while (0)

struct XcdBarrier {
    unsigned* bar; unsigned x;
    volatile LAS unsigned* st;
};

__device__ __forceinline__ XcdBarrier xcd_barrier_post(unsigned* bar, volatile LAS unsigned* st) {
    XcdBarrier b; b.bar = bar; b.x = xb_xcc_id(); b.st = st;
    if (threadIdx.x == 0) (void)xb_add(&bar[XB_XCNT(b.x)], 1u);
    return b;
}
__device__ __forceinline__ void xcd_barrier_complete(unsigned* bar, unsigned x, unsigned& nloc, unsigned& nx) {
    const unsigned G = gridDim.x * gridDim.y * gridDim.z;
    unsigned sum, cnt, mine, sp = 0u;
    for (;;) {
        sum = 0u; cnt = 0u; mine = 0u;
#pragma unroll
        for (unsigned j = 0; j < 16; ++j) { const unsigned c = xb_ld(&bar[XB_XCNT(j)]); sum += c; cnt += (c > 0u) ? 1u : 0u; mine = (j == x) ? c : mine; }
        if (sum == G) break;
        __builtin_amdgcn_s_sleep(1);
        if ((++sp & 255u) == 0u) { if (xb_ld(&bar[XB_TMO])) break; if (sp > XB_SPIN_CAP) { atomicAdd(&bar[XB_TMO], 1u); break; } }
    }
    nloc = mine > 0u ? mine : 1u; nx = cnt > 0u ? cnt : 1u;
}

__device__ __forceinline__ void xcd_barrier(const XcdBarrier& b) {
    asm volatile("s_waitcnt vmcnt(0)" ::: "memory");
    __syncthreads();
    if (threadIdx.x == 0) {
        unsigned* bar = b.bar;
        __builtin_amdgcn_s_waitcnt(0);
        unsigned nloc = b.st[0], nx = b.st[1];
        if (nloc == 0u) { xcd_barrier_complete(bar, b.x, nloc, nx); b.st[0] = nloc; b.st[1] = nx; }
        const unsigned old = xb_add(&bar[XB_XSUB(b.x)], 1u);
        const unsigned gen = old / nloc;
        if (old + 1u == (gen + 1u) * nloc) {
            __builtin_amdgcn_fence(__ATOMIC_RELEASE, "agent");
            asm volatile("s_waitcnt vmcnt(0)" ::: "memory");
            const unsigned og = xb_add(&bar[XB_TOP], 1u);
            const unsigned tg = og / nx;
            if (og + 1u == (tg + 1u) * nx) xb_add(&bar[XB_TOPGEN], 1u);
            else XB_SPIN(xb_ld(&bar[XB_TOPGEN]) == tg, bar);
            __builtin_amdgcn_fence(__ATOMIC_ACQUIRE, "agent");
            xb_add(&bar[XB_XGEN(b.x)], 1u);
            asm volatile("s_waitcnt vmcnt(0)" ::: "memory");
        } else {
            XB_SPIN(xb_ld(&bar[XB_XGEN(b.x)]) == gen, bar);
            __builtin_amdgcn_fence(__ATOMIC_ACQUIRE, "agent");
            asm volatile("s_waitcnt vmcnt(0)" ::: "memory");
        }
    }
    __syncthreads();
}

__device__ __forceinline__ void rms_row_to_bf16(const float* xrow, bf16_t* orow, const float* gain, int lane) {
    const f32x4* xr = (const f32x4*)xrow + lane;
    f32x4 v[4]; float s = 0.f;
#pragma unroll
    for (int j = 0; j < 4; ++j) { v[j] = xr[64 * j]; s += (v[j].x * v[j].x + v[j].y * v[j].y) + (v[j].z * v[j].z + v[j].w * v[j].w); }
    const float rstd = 1.0f / sqrtf(wave_sum(s) * (1.0f / DM) + NORM_EPS);
    unsigned long long* o8 = (unsigned long long*)orow + lane;
#pragma unroll
    for (int j = 0; j < 4; ++j) {
        f32x4 g = gain ? ((const f32x4*)gain)[lane + 64 * j] : (f32x4){1.f, 1.f, 1.f, 1.f};
        o8[64 * j] = (unsigned long long)pk2(v[j].x * rstd * g.x, v[j].y * rstd * g.y) | ((unsigned long long)pk2(v[j].z * rstd * g.z, v[j].w * rstd * g.w) << 32);
    }
}
__device__ __forceinline__ void transpose_item(const float* W, int K, int N, bf16_t* WT, const float* ks, LAS float* scr, int item, int lane) {
    const int nblk = N / 32, kb = item / nblk, nb = item % nblk, k0 = 64 * kb, n0 = 32 * nb;
#pragma unroll 8
    for (int i = 0; i < 32; ++i) { const int kk = 2 * i + (lane >> 5); float w = W[(size_t)(k0 + kk) * N + n0 + (lane & 31)]; if (ks) w *= ks[k0 + kk]; scr[kk * 33 + (lane & 31)] = w; }
    LDS_WAIT();
    const int c = lane & 7;
#pragma unroll
    for (int j = 0; j < 4; ++j) { const int n = (lane >> 3) + 8 * j; const LAS float* s = scr + (8 * c) * 33 + n;
        v4u o; o.x = pk2(s[0 * 33], s[1 * 33]); o.y = pk2(s[2 * 33], s[3 * 33]); o.z = pk2(s[4 * 33], s[5 * 33]); o.w = pk2(s[6 * 33], s[7 * 33]);
        *(v4u*)(WT + (size_t)(n0 + n) * K + k0 + 8 * c) = o; }
    LDS_WAIT();
}


__device__ __forceinline__ void s5_tables(const Args& a, LAS unsigned char* lds, int tid) {
    const int bid = blockIdx.x; if (bid >= 192) return;
    const int g = bid % NG, q = bid / NG;
    const float* lam_re = a.in[4]; const float* lam_im = a.in[5]; const float* b_re = a.in[6]; const float* b_im = a.in[7]; const float* c_re = a.in[8]; const float* c_im = a.in[9]; const float* log_dt = a.in[11];
    LAS float* LPr = (LAS float*)(lds + 69632); LAS float* LPi = LPr + 17 * 64; LAS float* BBr = LPi + 17 * 64; LAS float* BBi = BBr + 1024;
    LAS float* Cr = BBi + 1024; LAS float* Ci = Cr + 1024; LAS float* KT = Ci + 1024;
    if (tid < 64) {
        const int p = tid, i = g * NP + p;
        const double dt = exp((double)log_dt[g]);
        const double lr = lam_re[i], li = lam_im[i];
        const double er = exp(lr * dt), ang = li * dt;
        const double lbr = er * cos(ang), lbi = er * sin(ang);
        const double nr = lbr - 1.0, ni = lbi, den = lr * lr + li * li;
        const double qr = (nr * lr + ni * li) / den, qi = (ni * lr - nr * li) / den;
        for (int h = 0; h < GH; ++h) { const double br = b_re[i * GH + h], bi = b_im[i * GH + h];
            BBr[p * 16 + h] = (float)(qr * br - qi * bi); BBi[p * 16 + h] = (float)(qr * bi + qi * br); }
        double pr = 1.0, pi = 0.0;
        for (int t = 0; t < 16; ++t) { LPr[t * 64 + p] = (float)pr; LPi[t * 64 + p] = (float)pi; const double nr2 = pr * lbr - pi * lbi, ni2 = pr * lbi + pi * lbr; pr = nr2; pi = ni2; }
        LPr[16 * 64 + p] = (float)pr; LPi[16 * 64 + p] = (float)pi;
        double tr = pr, ti = pi;
        if (q == 0) { float* LAMT = (float*)(a.ws + WS_LAMT); LAMT[2 * i] = (float)tr; LAMT[2 * i + 1] = (float)ti; }
        for (int k = 0; k < 5; ++k) { const double nr2 = tr * tr - ti * ti, ni2 = 2.0 * tr * ti; tr = nr2; ti = ni2; }
        if (q == 0) { float* L512 = (float*)(a.ws + WS_LAM512); L512[2 * i] = (float)tr; L512[2 * i + 1] = (float)ti; }
    }
    for (int i = tid; i < 1024; i += 512) { Cr[i] = c_re[g * 1024 + i]; Ci[i] = c_im[g * 1024 + i]; }
    __syncthreads();
    { const int tau = tid >> 5, hol = (tid >> 4) & 1, hi = tid & 15, ho = 2 * q + hol; float sacc = 0.f;
#pragma unroll 4
      for (int p = 0; p < 64; ++p) { const float lpr = LPr[tau * 64 + p], lpi = LPi[tau * 64 + p], br = BBr[p * 16 + hi], bi = BBi[p * 16 + hi];
          const float wr_ = lpr * br - lpi * bi, wi_ = lpr * bi + lpi * br; sacc += Cr[ho * 64 + p] * wr_ - Ci[ho * 64 + p] * wi_; }
      KT[tid] = sacc; }
    __syncthreads();
    bf16_t* WSb = (bf16_t*)(a.ws + WS_WS); bf16_t* WYb = (bf16_t*)(a.ws + WS_WY);
#pragma unroll
    for (int kk = 0; kk < 2; ++kk) { const int ch = tid + 512 * kk, n = 32 * q + (ch >> 5), k0 = (ch & 31) * 8, p = n & 63, isim = (n >> 6) & 1;
        float v[8];
#pragma unroll
        for (int j = 0; j < 8; ++j) { const int k = k0 + j, t = k >> 4, h = k & 15, tau = 15 - t; const float lpr = LPr[tau * 64 + p], lpi = LPi[tau * 64 + p], br = BBr[p * 16 + h], bi = BBi[p * 16 + h];
            const float val = isim ? (lpr * bi + lpi * br) : (lpr * br - lpi * bi); v[j] = n < 128 ? val : 0.f; }
        v4u o; o.x = pk2(v[0], v[1]); o.y = pk2(v[2], v[3]); o.z = pk2(v[4], v[5]); o.w = pk2(v[6], v[7]);
        *(v4u*)(WSb + ((size_t)(g * 256 + n)) * 256 + k0) = o; }
#pragma unroll
    for (int kk = 0; kk < 4; ++kk) { const int ch = tid + 512 * kk, rr = ch >> 6, to = rr >> 1, hol = rr & 1, ho = 2 * q + hol, n = to * 16 + ho, k0 = (ch & 63) * 8;
        float v[8];
#pragma unroll
        for (int j = 0; j < 8; ++j) { const int k = k0 + j; float val;
            if (k < 256) { const int ti = k >> 4, hi = k & 15; val = ti <= to ? KT[((to - ti) * 2 + hol) * 16 + hi] : 0.f; if (ti == to && hi == ho) val += a.in[10][g * GH + ho]; }
            else { const int jj = (k - 256) & 127, p = jj & 63, isim = jj >> 6; const float lpr = LPr[(to + 1) * 64 + p], lpi = LPi[(to + 1) * 64 + p], cr = Cr[ho * 64 + p], ci = Ci[ho * 64 + p];
                val = isim ? -(cr * lpi + ci * lpr) : (cr * lpr - ci * lpi); }
            v[j] = val; }
        v4u o; o.x = pk2(v[0], v[1]); o.y = pk2(v[2], v[3]); o.z = pk2(v[4], v[5]); o.w = pk2(v[6], v[7]);
        *(v4u*)(WYb + ((size_t)(g * 256 + n)) * 512 + k0) = o; }
}

__device__ __forceinline__ void rms_rows2_to_bf16(const float* x0, const float* x1, bf16_t* o0, bf16_t* o1, const float* gain, int lane, float* rinv = nullptr) {
    const f32x4* xr0 = (const f32x4*)x0 + lane; const f32x4* xr1 = (const f32x4*)x1 + lane;
    f32x4 v[4], w[4]; float s0 = 0.f, s1 = 0.f;
#pragma unroll
    for (int j = 0; j < 4; ++j) { v[j] = __builtin_nontemporal_load(xr0 + 64 * j); w[j] = __builtin_nontemporal_load(xr1 + 64 * j); }
#pragma unroll
    for (int j = 0; j < 4; ++j) { s0 += (v[j].x * v[j].x + v[j].y * v[j].y) + (v[j].z * v[j].z + v[j].w * v[j].w); s1 += (w[j].x * w[j].x + w[j].y * w[j].y) + (w[j].z * w[j].z + w[j].w * w[j].w); }
#pragma unroll
    for (int o = 1; o < 64; o <<= 1) { s0 += __shfl_xor(s0, o); s1 += __shfl_xor(s1, o); }
    const float q0 = sqrtf(s0 * (1.0f / DM) + NORM_EPS), q1 = sqrtf(s1 * (1.0f / DM) + NORM_EPS);
    const float r0 = 1.0f / q0, r1 = 1.0f / q1;
    if (rinv && lane == 0) { rinv[0] = q0; rinv[1] = q1; }
    unsigned long long* p0 = (unsigned long long*)o0 + lane; unsigned long long* p1 = (unsigned long long*)o1 + lane;
#pragma unroll
    for (int j = 0; j < 4; ++j) {
        const f32x4 g = gain ? ((const f32x4*)gain)[lane + 64 * j] : (f32x4){1.f, 1.f, 1.f, 1.f};
        p0[64 * j] = (unsigned long long)pk2(v[j].x * r0 * g.x, v[j].y * r0 * g.y) | ((unsigned long long)pk2(v[j].z * r0 * g.z, v[j].w * r0 * g.w) << 32);
        p1[64 * j] = (unsigned long long)pk2(w[j].x * r1 * g.x, w[j].y * r1 * g.y) | ((unsigned long long)pk2(w[j].z * r1 * g.z, w[j].w * r1 * g.w) << 32);
    }
}
__device__ __forceinline__ int win_dest_col(int n) {
    if (n < 768 || n >= 2304) return n;
    const int q = (n - 768) / 384, ch = (n - 768) % 384, base = (q == 0 || q == 2) ? 768 : 1536, half = (q >= 2) ? 128 : 0;
    return base + 256 * (ch >> 7) + half + (ch & 127);
}
__device__ __forceinline__ void transpose_item4(const float* W, int K, int N, bf16_t* WT, const float* ks, LAS float* scr, int item, int lane, bool winmap = false) {
    const int nblk = N / 32, kb = item / nblk, nb = item % nblk, k0 = 64 * kb, n0 = 32 * nb, d0 = winmap ? win_dest_col(n0) : n0;
    f32x4 w[8];
#pragma unroll
    for (int i = 0; i < 8; ++i) { const int kk = 8 * i + (lane >> 3); w[i] = __builtin_nontemporal_load((const f32x4*)(W + (size_t)(k0 + kk) * N + n0 + 4 * (lane & 7))); }
#pragma unroll
    for (int i = 0; i < 8; ++i) { const int kk = 8 * i + (lane >> 3); const float sc = ks ? ks[k0 + kk] : 1.0f; LAS float* d = scr + kk * 33 + 4 * (lane & 7);
        d[0] = w[i].x * sc; d[1] = w[i].y * sc; d[2] = w[i].z * sc; d[3] = w[i].w * sc; }
    LDS_WAIT();
    const int c = lane & 7;
#pragma unroll
    for (int j = 0; j < 4; ++j) { const int n = (lane >> 3) + 8 * j; const LAS float* sp = scr + (8 * c) * 33 + n;
        v4u o; o.x = pk2(sp[0 * 33], sp[1 * 33]); o.y = pk2(sp[2 * 33], sp[3 * 33]); o.z = pk2(sp[4 * 33], sp[5 * 33]); o.w = pk2(sp[6 * 33], sp[7 * 33]);
        *(v4u*)(WT + (size_t)(d0 + n) * K + k0 + 8 * c) = o; }
    LDS_WAIT();
}

__device__ __forceinline__ void phase0(const Args& a, LAS unsigned char* lds) {
    const int tid = otid(), lane = tid & 63, wave = tid >> 6;
    const int gw = blockIdx.x * 8 + wave, NGW = gridDim.x * 8;
    s5_tables(a, lds, tid);
    const float* x = a.in[0]; const float* mem = a.in[1]; const float* norm_g = a.in[2]; const float* w_in = a.in[3];
    const float* w_glu = a.in[12]; const float* mem_norm_g = a.in[16]; const float* w_mem_kv = a.in[17]; const float* w_out = a.in[18];
    bf16_t* XB = (bf16_t*)(a.ws + WS_XB); bf16_t* MEMN = (bf16_t*)(a.ws + WS_MEMN);
    bf16_t* WINT = (bf16_t*)(a.ws + WS_WINT); bf16_t* WKVT = (bf16_t*)(a.ws + WS_WKVT); bf16_t* WOUTT = (bf16_t*)(a.ws + WS_WOUTT); bf16_t* WGLUT = (bf16_t*)(a.ws + WS_WGLUT);
    for (int rnd = 0; rnd < 5; ++rnd) { const int r2 = rnd < 4 ? rnd * NGW + gw : 4 * NGW + (gw - 1536); if (rnd == 4 && (gw < 1536 || r2 >= (NTOK + NB * NMEM) / 2)) break; const int r = 2 * r2;
        if (r < NTOK) rms_rows2_to_bf16(x + (size_t)r * DM, x + (size_t)(r + 1) * DM, XB + (size_t)r * DM, XB + (size_t)(r + 1) * DM, nullptr, lane, (float*)(a.ws + WS_RINV) + r);
        else { const int m = r - NTOK; rms_rows2_to_bf16(mem + (size_t)m * DM, mem + (size_t)(m + 1) * DM, MEMN + (size_t)m * DM, MEMN + (size_t)(m + 1) * DM, mem_norm_g, lane); }
    }
    LAS float* scr = (LAS float*)(lds + wave * 8448);
    constexpr int I_IN = (DM / 64) * (DIN / 32), I_KV = (DM / 64) * (512 / 32), I_OUT = (DM / 64) * (DM / 32), I_GLU = (WSSM / 64) * (WSSM / 32);
    for (int rnd = 0; rnd < 2; ++rnd) { const int it = rnd == 0 ? gw : NGW + (gw - 1536); if (rnd == 1 && (gw < 1536 || it >= I_IN + I_KV + I_OUT + I_GLU)) break;
        int r = it;
        if (r < I_IN) { transpose_item4(w_in, DM, DIN, WINT, norm_g, scr, r, lane, true); continue; } r -= I_IN;
        if (r < I_KV) { transpose_item4(w_mem_kv, DM, 512, WKVT, nullptr, scr, r, lane); continue; } r -= I_KV;
        if (r < I_OUT) { transpose_item4(w_out, DM, DM, WOUTT, nullptr, scr, r, lane); continue; } r -= I_OUT;
        transpose_item4(w_glu, WSSM, WSSM, WGLUT, nullptr, scr, r, lane);
    }
    const int gt = blockIdx.x * 512 + tid, NT = gridDim.x * 512;
    for (int i = gt; i < 128 * 384 / 2; i += NT) ((unsigned*)(WGLUT + 384 * 384))[i] = 0u;
}

template <class Epi>
__device__ __forceinline__ void gemm_naive(const bf16_t* A, int lda, const bf16_t* Bt, int ldb, int M, int N, int K, LAS unsigned char* lds, int tile0, int ntile_total, const Epi& epi) {
    LAS float* As = (LAS float*)lds;
    LAS float* Bs = As + 32 * 132;
    const int tid = threadIdx.x, ty = tid >> 4, tx = tid & 15;
    const int ntn = N / 64, nt = (M / 128) * ntn;
    (void)ntile_total;
    for (int tile = blockIdx.x - tile0; tile < nt; tile += gridDim.x) {
        if (tile < 0) continue;
        const int tm = tile / ntn, tn = tile % ntn;
        float acc[4][4];
#pragma unroll
        for (int i = 0; i < 4; ++i)
#pragma unroll
            for (int j = 0; j < 4; ++j) acc[i][j] = 0.f;
        for (int k0 = 0; k0 < K; k0 += 32) {
            __syncthreads();
            { const int r = tid >> 2, kc = (tid & 3) * 8; const v4u v = *(const v4u*)(A + (size_t)(tm * 128 + r) * lda + k0 + kc);
              As[(kc + 0) * 132 + r] = bflo(v.x); As[(kc + 1) * 132 + r] = bfhi(v.x); As[(kc + 2) * 132 + r] = bflo(v.y); As[(kc + 3) * 132 + r] = bfhi(v.y);
              As[(kc + 4) * 132 + r] = bflo(v.z); As[(kc + 5) * 132 + r] = bfhi(v.z); As[(kc + 6) * 132 + r] = bflo(v.w); As[(kc + 7) * 132 + r] = bfhi(v.w); }
            if (tid < 256) { const int r = tid >> 2, kc = (tid & 3) * 8; const v4u v = *(const v4u*)(Bt + (size_t)(tn * 64 + r) * ldb + k0 + kc);
              Bs[(kc + 0) * 68 + r] = bflo(v.x); Bs[(kc + 1) * 68 + r] = bfhi(v.x); Bs[(kc + 2) * 68 + r] = bflo(v.y); Bs[(kc + 3) * 68 + r] = bfhi(v.y);
              Bs[(kc + 4) * 68 + r] = bflo(v.z); Bs[(kc + 5) * 68 + r] = bfhi(v.z); Bs[(kc + 6) * 68 + r] = bflo(v.w); Bs[(kc + 7) * 68 + r] = bfhi(v.w); }
            __syncthreads();
#pragma unroll 8
            for (int k = 0; k < 32; ++k) {
                const f32x4 av = *(const LAS f32x4*)(As + k * 132 + ty * 4), bv = *(const LAS f32x4*)(Bs + k * 68 + tx * 4);
#pragma unroll
                for (int i = 0; i < 4; ++i)
#pragma unroll
                    for (int j = 0; j < 4; ++j) acc[i][j] += av[i] * bv[j];
            }
        }
#pragma unroll
        for (int i = 0; i < 4; ++i)
#pragma unroll
            for (int j = 0; j < 4; ++j) epi(tm * 128 + ty * 4 + i, tn * 64 + tx * 4 + j, acc[i][j]);
    }
}

struct EpiStoreBf16 { bf16_t* O; int ldo; __device__ __forceinline__ void operator()(int r, int c, float v) const { O[(size_t)r * ldo + c] = (bf16_t)f2bf(v); } };
struct EpiGlu { const bf16_t* GB; const bf16_t* PROJ; const float* b_glu; bf16_t* YCAT;
    __device__ __forceinline__ void operator()(int r, int c, float v) const {
        const float g = bf2f(GB[(size_t)r * WSSM + c]); const float gate = bf2f(PROJ[(size_t)r * DIN + C_AGATE + c]);
        YCAT[(size_t)r * DM + c] = (bf16_t)f2bf(g * sigmoid_f(v + b_glu[c]) * silu_f(gate)); } };
struct EpiOut { const float* x; float* out; __device__ __forceinline__ void operator()(int r, int c, float v) const { out[(size_t)r * DM + c] = x[(size_t)r * DM + c] + v; } };


namespace pg8 {
typedef short bf16x8 __attribute__((ext_vector_type(8)));
typedef unsigned u32x4 __attribute__((ext_vector_type(4)));
constexpr int BM = 256, BK = 64, HALF = 128, HTB = HALF * BK * 2, STAGE_BYTES = 8 * HTB, NXCD = 8, WGM = 8;
__host__ __device__ __forceinline__ int lds_byte(int r, int c) { const int st = (r >> 4) * 2 + (c >> 5), rr = r & 15, cc = c & 31, ob = rr * 64 + cc * 2; return st * 1024 + (ob ^ (((ob >> 9) & 1) << 5)); }
__host__ __device__ __forceinline__ void stage_rc(int b, int& R, int& C) { const int st = b / 1024, sb = b % 1024, swz = sb ^ (((sb >> 9) & 1) << 5); R = (st >> 1) * 16 + swz / 64; C = (st & 1) * 32 + (swz % 64) / 2; }
__host__ __device__ __forceinline__ int perm32(int rho) { const int n = rho >> 4, i = rho & 15; return 8 * (i >> 2) + 4 * n + (i & 3); }
struct Unit { int pm, pn, z; };
struct Gemm { const bf16_t* A; const bf16_t* Bt; int lda, ldb, K; size_t sAz, sBz; };
struct Order {
    int nM, nN, per, total, G, c;
    __device__ void init(int nM_, int nN_, int nZ_, int G_, int c_) { nM = nM_; nN = nN_; per = nM_ * nN_; total = per * nZ_; G = G_; c = c_; }
    __device__ bool next(int i, Unit& u) const {
        const long L = (long)i * G + c; if (L >= total) return false;
        u.z = (int)(L / per); int wgid = (int)(L % per); const int nwg = per;
        { const int q = nwg / NXCD, r = nwg % NXCD, xcd = wgid % NXCD, off = wgid / NXCD; wgid = (xcd < r ? xcd * (q + 1) : r * (q + 1) + (xcd - r) * q) + off; }
        const int nig = WGM * nN, gid = wgid / nig, fm = gid * WGM, gsz = (nM - fm) < WGM ? (nM - fm) : WGM;
        u.pm = fm + ((wgid % nig) % gsz); u.pn = (wgid % nig) / gsz; return true;
    }
};
typedef __bf16 bf2v_t __attribute__((ext_vector_type(2))); typedef float f2v_t __attribute__((ext_vector_type(2)));
__device__ __forceinline__ unsigned cvt_pk_bf16(float lo, float hi) { const f2v_t v = {lo, hi}; return __builtin_bit_cast(unsigned, __builtin_convertvector(v, bf2v_t)); }

template <bool ALIGN_EPI = false, bool SP2 = false, class Epi>
__device__ __forceinline__ void gemm_phase(LAS unsigned char* lds, const Gemm g, const Order& S, const Epi& E) {
    int tid = threadIdx.x; asm volatile("" : "+v"(tid));
    const int wid = __builtin_amdgcn_readfirstlane(tid >> 6), lane = tid & 63, wr = wid >> 2, wc = wid & 3, fr = lane & 15, fq = lane >> 4;
    int K = g.K; asm volatile("" : "+s"(K));
    const int nt = K / BK;
    unsigned voffA[2], voffB[2];
#pragma unroll
    for (int i = 0; i < 2; ++i) { int R, C; stage_rc(tid * 16 + i * 8192, R, C); const int Rb = Epi::PERM ? ((R & ~31) + perm32(R & 31)) : R;
        voffA[i] = (unsigned)(R * g.lda + C) * 2u; voffB[i] = (unsigned)(Rb * g.ldb + C) * 2u; }
    const size_t kstep = (size_t)(BK * 2);
    const size_t hstepA = (size_t)HALF * g.lda * 2, hstepB = (size_t)HALF * g.ldb * 2;
    const size_t tstepA = 2 * hstepA, tstepB = 2 * hstepB;
    const unsigned ldsw = (unsigned)wid * 1024u;
    const int aoff = lds_byte(wr * 64 + fr, fq * 8), boff = lds_byte(wc * 32 + fr, fq * 8);
#define PG8_SA(b, h) (((b) * 2 + (h)) * HTB)
#define PG8_SB(b, h) ((4 + (b) * 2 + (h)) * HTB)
#define PG8_STAGE(bufoff, gbase, voff) do { _Pragma("unroll") for (int _i = 0; _i < 2; ++_i) \
        __builtin_amdgcn_global_load_lds((const unsigned*)((const char*)(gbase) + (voff)[_i]), (LAS unsigned*)(lds + (bufoff) + ldsw + _i * 8192), 16, 0, 0); } while (0)
#define PG8_LDA(dst, b, h) do { _Pragma("unroll") for (int m = 0; m < 4; ++m) _Pragma("unroll") for (int k = 0; k < 2; ++k) dst[m][k] = *(const LAS bf16x8*)(lds + PG8_SA(b, h) + aoff + m * 2048 + k * 1024); } while (0)
#define PG8_LDB(dst, b, h) do { _Pragma("unroll") for (int n = 0; n < 2; ++n) _Pragma("unroll") for (int k = 0; k < 2; ++k) dst[n][k] = *(const LAS bf16x8*)(lds + PG8_SB(b, h) + boff + n * 2048 + k * 1024); } while (0)
#define PG8_MMA(ai, bj, At, Bt) do { __builtin_amdgcn_s_setprio(1); _Pragma("unroll") for (int m = 0; m < 4; ++m) _Pragma("unroll") for (int n = 0; n < 2; ++n) _Pragma("unroll") for (int k = 0; k < 2; ++k) \
        acc[ai][bj][m][n] = __builtin_amdgcn_mfma_f32_16x16x32_bf16(Bt[n][k], At[m][k], acc[ai][bj][m][n], 0, 0, 0); __builtin_amdgcn_s_setprio(0); } while (0)
#define PG8_WAIT_V(n) asm volatile("s_waitcnt vmcnt(" #n ")" ::: "memory")
#define PG8_WAIT_L(n) asm volatile("s_waitcnt lgkmcnt(" #n ")" ::: "memory")
#define PG8_BAR __builtin_amdgcn_s_barrier()
#define PG8_SCHED __builtin_amdgcn_sched_barrier(0)
    Unit cur, nxt; int ui = 0;
    if (!S.next(0, cur)) return;
    f32x4 acc[2][2][4][2];
#pragma unroll
    for (int a = 0; a < 2; ++a)
#pragma unroll
        for (int b = 0; b < 2; ++b)
#pragma unroll
            for (int m = 0; m < 4; ++m)
#pragma unroll
                for (int n = 0; n < 2; ++n) acc[a][b][m][n] = (f32x4){0.f, 0.f, 0.f, 0.f};
    bf16x8 At[4][2], B0[2][2], B1[2][2];
    const char* cA = (const char*)(g.A + (size_t)cur.z * g.sAz) + (size_t)cur.pm * tstepA; const char* cB = (const char*)(g.Bt + (size_t)cur.z * g.sBz) + (size_t)cur.pn * tstepB;
    if constexpr (SP2) {
        PG8_STAGE(PG8_SB(0, 0), cB, voffB); PG8_STAGE(PG8_SB(0, 1), cB + hstepB, voffB); PG8_STAGE(PG8_SA(0, 0), cA, voffA); PG8_STAGE(PG8_SA(0, 1), cA + hstepA, voffA);
        if (wr == 1) PG8_BAR;
        PG8_WAIT_V(2); PG8_BAR;
        PG8_STAGE(PG8_SB(1, 0), cB + kstep, voffB); PG8_STAGE(PG8_SA(1, 0), cA + kstep, voffA); PG8_STAGE(PG8_SB(1, 1), cB + hstepB + kstep, voffB);
        PG8_WAIT_V(6); PG8_BAR;
    } else {
    PG8_STAGE(PG8_SB(0, 0), cB, voffB); PG8_STAGE(PG8_SA(0, 0), cA, voffA); PG8_STAGE(PG8_SB(0, 1), cB + hstepB, voffB); PG8_STAGE(PG8_SA(0, 1), cA + hstepA, voffA);
    if (wr == 1) PG8_BAR;
    PG8_WAIT_V(4); PG8_BAR;
    PG8_STAGE(PG8_SB(1, 0), cB + kstep, voffB); PG8_STAGE(PG8_SA(1, 0), cA + kstep, voffA); PG8_STAGE(PG8_SB(1, 1), cB + hstepB + kstep, voffB);
    PG8_WAIT_V(6); PG8_BAR;
    }
    for (;;) {
        const bool has_next = S.next(ui + 1, nxt);
        const char* nA = has_next ? (const char*)(g.A + (size_t)nxt.z * g.sAz) + (size_t)nxt.pm * tstepA : cA; const char* nB = has_next ? (const char*)(g.Bt + (size_t)nxt.z * g.sBz) + (size_t)nxt.pn * tstepB : cB;
        for (int t = 0; t < nt; t += 2) {
            const bool last = (t == nt - 2);
            const char* a1 = cA + (size_t)(t + 1) * kstep;
            const char* a2 = last ? nA : cA + (size_t)(t + 2) * kstep; const char* b2 = last ? nB : cB + (size_t)(t + 2) * kstep;
            const char* a3 = a2 + kstep; const char* b3 = b2 + kstep;
            if constexpr (SP2) {
            PG8_LDB(B0, 0, 0); PG8_LDB(B1, 0, 1); PG8_SCHED; PG8_LDA(At, 0, 0); PG8_STAGE(PG8_SA(1, 1), a1 + hstepA, voffA);
            PG8_WAIT_V(8); PG8_WAIT_L(0); PG8_BAR; PG8_MMA(0, 0, At, B0); PG8_MMA(0, 1, At, B1); PG8_BAR; PG8_SCHED;
            PG8_LDA(At, 0, 1); PG8_STAGE(PG8_SB(0, 0), b2, voffB); PG8_STAGE(PG8_SB(0, 1), b2 + hstepB, voffB); PG8_STAGE(PG8_SA(0, 0), a2, voffA);
            PG8_WAIT_V(8); PG8_WAIT_L(0); PG8_BAR; PG8_MMA(1, 0, At, B0); PG8_MMA(1, 1, At, B1); PG8_BAR; PG8_SCHED;
            PG8_LDB(B0, 1, 0); PG8_LDB(B1, 1, 1); PG8_SCHED; PG8_LDA(At, 1, 0); PG8_STAGE(PG8_SA(0, 1), a2 + hstepA, voffA);
            PG8_WAIT_V(8); PG8_WAIT_L(0); PG8_BAR; PG8_MMA(0, 0, At, B0); PG8_MMA(0, 1, At, B1); PG8_BAR; PG8_SCHED;
            PG8_LDA(At, 1, 1); PG8_STAGE(PG8_SB(1, 0), b3, voffB); PG8_STAGE(PG8_SB(1, 1), b3 + hstepB, voffB); PG8_STAGE(PG8_SA(1, 0), a3, voffA);
            PG8_WAIT_V(8); PG8_WAIT_L(0); PG8_BAR; PG8_MMA(1, 0, At, B0); PG8_MMA(1, 1, At, B1); PG8_BAR; PG8_SCHED;
            } else {
            PG8_LDB(B0, 0, 0); PG8_SCHED; PG8_LDA(At, 0, 0); PG8_STAGE(PG8_SA(1, 1), a1 + hstepA, voffA);
            PG8_WAIT_L(8); PG8_BAR; PG8_WAIT_L(0); PG8_MMA(0, 0, At, B0); PG8_BAR; PG8_SCHED;
            PG8_LDB(B1, 0, 1); PG8_STAGE(PG8_SB(0, 0), b2, voffB);
            PG8_BAR; PG8_WAIT_L(0); PG8_MMA(0, 1, At, B1); PG8_BAR;
            PG8_LDA(At, 0, 1); PG8_STAGE(PG8_SA(0, 0), a2, voffA);
            PG8_BAR; PG8_WAIT_L(0); PG8_MMA(1, 0, At, B0); PG8_BAR; PG8_SCHED;
            PG8_STAGE(PG8_SB(0, 1), b2 + hstepB, voffB);
            PG8_WAIT_V(6); PG8_BAR; PG8_MMA(1, 1, At, B1); PG8_BAR;
            PG8_LDB(B0, 1, 0); PG8_SCHED; PG8_LDA(At, 1, 0); PG8_STAGE(PG8_SA(0, 1), a2 + hstepA, voffA);
            PG8_WAIT_L(8); PG8_BAR; PG8_WAIT_L(0); PG8_MMA(0, 0, At, B0); PG8_BAR; PG8_SCHED;
            PG8_LDB(B1, 1, 1); PG8_STAGE(PG8_SB(1, 0), b3, voffB);
            PG8_BAR; PG8_WAIT_L(0); PG8_MMA(0, 1, At, B1); PG8_BAR;
            PG8_LDA(At, 1, 1); PG8_STAGE(PG8_SA(1, 0), a3, voffA);
            PG8_BAR; PG8_WAIT_L(0); PG8_MMA(1, 0, At, B0); PG8_BAR; PG8_SCHED;
            PG8_STAGE(PG8_SB(1, 1), b3 + hstepB, voffB);
            PG8_WAIT_V(6); PG8_BAR; PG8_MMA(1, 1, At, B1); PG8_BAR;
            }
        }
        if constexpr (ALIGN_EPI) { if (wr == 0) PG8_BAR; }
        if constexpr (!Epi::AFTER_DRAIN) { E(acc, cur, wr, wc, fr, fq); }
        if (!has_next) break;
#pragma unroll
        for (int a = 0; a < 2; ++a)
#pragma unroll
            for (int b = 0; b < 2; ++b)
#pragma unroll
                for (int m = 0; m < 4; ++m)
#pragma unroll
                    for (int n = 0; n < 2; ++n) acc[a][b][m][n] = (f32x4){0.f, 0.f, 0.f, 0.f};
        cur = nxt; cA = nA; cB = nB; ++ui;
        if constexpr (ALIGN_EPI) { if (wr == 1) PG8_BAR; }
    }
    PG8_WAIT_V(0);
    if constexpr (!ALIGN_EPI) { if (wr == 0) PG8_BAR; }
    PG8_BAR;
    if constexpr (Epi::AFTER_DRAIN) { E.fused(acc, cur, wr, wc, fr, fq, lds, wid, lane); }
#undef PG8_SA
#undef PG8_SB
#undef PG8_STAGE
#undef PG8_LDA
#undef PG8_LDB
#undef PG8_MMA
#undef PG8_WAIT_V
#undef PG8_WAIT_L
#undef PG8_BAR
#undef PG8_SCHED
}

struct EpiBf16Store {
    static constexpr bool PERM = true, AFTER_DRAIN = false;
    bf16_t* O; int ldc;
    __device__ __forceinline__ void operator()(const f32x4 (&acc)[2][2][4][2], const Unit& u, int wr, int wc, int fr, int fq) const {
        const int row0 = u.pm * BM + wr * 64 + fr, col0 = u.pn * BM + wc * 32 + 8 * fq;
#pragma unroll
        for (int ai = 0; ai < 2; ++ai)
#pragma unroll
            for (int m = 0; m < 4; ++m) { bf16_t* rowp = O + (size_t)(row0 + ai * HALF + m * 16) * ldc + col0;
#pragma unroll
                for (int bj = 0; bj < 2; ++bj) { const f32x4 v0 = acc[ai][bj][m][0], v1 = acc[ai][bj][m][1];
                    u32x4 w; w.x = cvt_pk_bf16(v0[0], v0[1]); w.y = cvt_pk_bf16(v0[2], v0[3]); w.z = cvt_pk_bf16(v1[0], v1[1]); w.w = cvt_pk_bf16(v1[2], v1[3]);
                    *(u32x4*)(rowp + bj * HALF) = w; } }
    }
};

struct EpiProjAY {
    static constexpr bool PERM = true, AFTER_DRAIN = false;
    bf16_t* PROJ; bf16_t* AY;
    __device__ __forceinline__ void operator()(const f32x4 (&acc)[2][2][4][2], const Unit& u, int wr, int wc, int fr, int fq) const {
        const int rowb = u.pm * BM + wr * 64, col0 = u.pn * BM + wc * 32 + 8 * fq;
        if (u.pn >= 3 && u.pn <= 8) {
            const bool gate = u.pn >= 6; const int colo = (gate ? C_W + (u.pn - 6) * HALF : C_U + (u.pn - 3) * HALF) + wc * 32 + 8 * fq;
#pragma unroll
            for (int ai = 0; ai < 2; ++ai)
#pragma unroll
                for (int m = 0; m < 4; ++m) { const int rb = rowb + ai * HALF + m * 16;
                    const f32x4 a0 = acc[ai][0][m][0], a1 = acc[ai][0][m][1], b0 = acc[ai][1][m][0], b1 = acc[ai][1][m][1];
                    f32x4 p0, p1;
                    if (gate) { p0 = (f32x4){a0[0] * silu_f(b0[0]), a0[1] * silu_f(b0[1]), a0[2] * silu_f(b0[2]), a0[3] * silu_f(b0[3])}; p1 = (f32x4){a1[0] * silu_f(b1[0]), a1[1] * silu_f(b1[1]), a1[2] * silu_f(b1[2]), a1[3] * silu_f(b1[3])}; }
                    else { p0 = a0 * b0; p1 = a1 * b1; }
                    u32x4 w; w.x = cvt_pk_bf16(p0[0], p0[1]); w.y = cvt_pk_bf16(p0[2], p0[3]); w.z = cvt_pk_bf16(p1[0], p1[1]); w.w = cvt_pk_bf16(p1[2], p1[3]);
                    *(u32x4*)(PROJ + (size_t)(rb + fr) * DIN + colo) = w; }
            return; }
#pragma unroll
        for (int bj = 0; bj < 2; ++bj) { const int col = col0 + bj * HALF; const bool ay = col < WSSM, sg = col >= C_AGATE && col < C_AGATE + WSSM;
#pragma unroll
            for (int ai = 0; ai < 2; ++ai)
#pragma unroll
                for (int m = 0; m < 4; ++m) { const int rb = rowb + ai * HALF + m * 16;
                    bf16_t* dst = ay ? AY + ((size_t)((col >> 4) * 1024 + (rb >> 4)) * 512 + fr * 16 + (col & 15)) : PROJ + (size_t)(rb + fr) * DIN + col;
                    f32x4 v0 = acc[ai][bj][m][0], v1 = acc[ai][bj][m][1];
                    if (sg) { v0 = (f32x4){silu_f(v0[0]), silu_f(v0[1]), silu_f(v0[2]), silu_f(v0[3])}; v1 = (f32x4){silu_f(v1[0]), silu_f(v1[1]), silu_f(v1[2]), silu_f(v1[3])}; }
                    u32x4 w; w.x = cvt_pk_bf16(v0[0], v0[1]); w.y = cvt_pk_bf16(v0[2], v0[3]); w.z = cvt_pk_bf16(v1[0], v1[1]); w.w = cvt_pk_bf16(v1[2], v1[3]);
                    *(u32x4*)dst = w; } }
    }
};
struct EpiSend {
    static constexpr bool PERM = false, AFTER_DRAIN = true;
    bf16_t* AY; const float* LAMT; const float* LAM512;
    __device__ __forceinline__ void fused(const f32x4 (&acc)[2][2][4][2], const Unit& u, int wr, int wc, int fr, int fq, LAS unsigned char* lds, int wid, int lane) const {
        LAS float* S = (LAS float*)lds;
        LAS float* E = (LAS float*)(lds + 131072);
#pragma unroll
        for (int ai = 0; ai < 2; ++ai)
#pragma unroll
            for (int m = 0; m < 4; ++m)
#pragma unroll
                for (int n = 0; n < 2; ++n) { const int r = ai * HALF + wr * 64 + m * 16 + fr, c = wc * 32 + n * 16 + 4 * fq; *(LAS f32x4*)(S + r * 128 + c) = acc[ai][0][m][n]; }
        __syncthreads();
        const int g = u.z, b = u.pm, p = lane, seg = wid;
        const float tr = LAMT[(g * NP + p) * 2], ti = LAMT[(g * NP + p) * 2 + 1], hr = LAM512[(g * NP + p) * 2], hi = LAM512[(g * NP + p) * 2 + 1];
        float sr = 0.f, si = 0.f;
        for (int i = 0; i < 32; ++i) { const int row = seg * 32 + i; const float xr = S[row * 128 + p], xi = S[row * 128 + 64 + p];
            const float nr = tr * sr - ti * si + xr, ni = tr * si + ti * sr + xi; sr = nr; si = ni; }
        E[seg * 128 + p] = sr; E[seg * 128 + 64 + p] = si;
        __syncthreads();
        sr = 0.f; si = 0.f;
        for (int s2 = 0; s2 < seg; ++s2) { const float xr = E[s2 * 128 + p], xi = E[s2 * 128 + 64 + p]; const float nr = hr * sr - hi * si + xr, ni = hr * si + hi * sr + xi; sr = nr; si = ni; }
        bf16_t* base = AY + ((size_t)(g * 1024 + b * 256 + seg * 32)) * 512 + 256 + p;
        for (int i = 0; i < 32; ++i) { const int row = seg * 32 + i;
            bf16_t* o = base + (size_t)i * 512;
            o[0] = (bf16_t)f2bf(sr); o[64] = (bf16_t)f2bf(si);
            const float xr = S[row * 128 + p], xi = S[row * 128 + 64 + p];
            const float nr = tr * sr - ti * si + xr, ni = tr * si + ti * sr + xi; sr = nr; si = ni; }
    }
};
struct EpiY {
    static constexpr bool PERM = true, AFTER_DRAIN = false;
    const bf16_t* AY; const float* ssm_d; bf16_t* GB;
    __device__ __forceinline__ void operator()(const f32x4 (&acc)[2][2][4][2], const Unit& u, int wr, int wc, int fr, int fq) const {
        const int g = u.z, b = u.pm;
#pragma unroll
        for (int bj = 0; bj < 2; ++bj) { const int col = bj * HALF + wc * 32 + 8 * fq, t = col >> 4, h0 = col & 15;
#pragma unroll
            for (int ai = 0; ai < 2; ++ai)
#pragma unroll
                for (int m = 0; m < 4; ++m) { const int crow = ai * HALF + wr * 64 + m * 16 + fr;
                    const f32x4 v0 = acc[ai][bj][m][0], v1 = acc[ai][bj][m][1];
                    u32x4 w;
                    w.x = cvt_pk_bf16(gelu_tanh(v0[0]), gelu_tanh(v0[1])); w.y = cvt_pk_bf16(gelu_tanh(v0[2]), gelu_tanh(v0[3]));
                    w.z = cvt_pk_bf16(gelu_tanh(v1[0]), gelu_tanh(v1[1])); w.w = cvt_pk_bf16(gelu_tanh(v1[2]), gelu_tanh(v1[3]));
                    *(u32x4*)(GB + ((size_t)(b * SEQ + crow * 16 + t)) * WSSM + g * GH + h0) = w; } }
    }
};
struct EpiGluP {
    static constexpr bool PERM = true, AFTER_DRAIN = false;
    const bf16_t* GB; const bf16_t* PROJ; const float* b_glu; bf16_t* YCAT;
    __device__ __forceinline__ void operator()(const f32x4 (&acc)[2][2][4][2], const Unit& u, int wr, int wc, int fr, int fq) const {
        const int row0 = u.pm * BM + wr * 64 + fr, col0 = u.pn * BM + wc * 32 + 8 * fq;
#pragma unroll
        for (int bj = 0; bj < 2; ++bj) { const int col = col0 + bj * HALF; if (col >= WSSM) continue;
            const f32x4 b0 = *(const f32x4*)(b_glu + col), b1 = *(const f32x4*)(b_glu + col + 4);
#pragma unroll
            for (int ai = 0; ai < 2; ++ai) { if (ai != u.z) continue;
                u32x4 g8[4], a8[4];
#pragma unroll
                for (int m = 0; m < 4; ++m) { const size_t row = (size_t)(row0 + ai * HALF + m * 16); g8[m] = *(const u32x4*)(GB + row * WSSM + col); a8[m] = *(const u32x4*)(PROJ + row * DIN + C_AGATE + col); }
#pragma unroll
                for (int m = 0; m < 4; ++m) { const size_t row = (size_t)(row0 + ai * HALF + m * 16);
                    const f32x4 v0 = acc[ai][bj][m][0] + b0, v1 = acc[ai][bj][m][1] + b1;
                    u32x4 w;
                    w.x = cvt_pk_bf16(bflo(g8[m].x) * sigmoid_f(v0[0]) * bflo(a8[m].x), bfhi(g8[m].x) * sigmoid_f(v0[1]) * bfhi(a8[m].x));
                    w.y = cvt_pk_bf16(bflo(g8[m].y) * sigmoid_f(v0[2]) * bflo(a8[m].y), bfhi(g8[m].y) * sigmoid_f(v0[3]) * bfhi(a8[m].y));
                    w.z = cvt_pk_bf16(bflo(g8[m].z) * sigmoid_f(v1[0]) * bflo(a8[m].z), bfhi(g8[m].z) * sigmoid_f(v1[1]) * bfhi(a8[m].z));
                    w.w = cvt_pk_bf16(bflo(g8[m].w) * sigmoid_f(v1[2]) * bflo(a8[m].w), bfhi(g8[m].w) * sigmoid_f(v1[3]) * bfhi(a8[m].w));
                    *(u32x4*)(YCAT + row * DM + col) = w; }
                asm volatile("" ::: "memory"); } }
    }
};
struct EpiResF32 {
    static constexpr bool PERM = false, AFTER_DRAIN = false;
    const float* x; float* out;
    __device__ __forceinline__ void operator()(const f32x4 (&acc)[2][2][4][2], const Unit& u, int wr, int wc, int fr, int fq) const {
        const int row0 = u.pm * BM + wr * 64 + fr, col0 = u.pn * BM + wc * 32 + 4 * fq;
#pragma unroll
        for (int ai = 0; ai < 2; ++ai)
#pragma unroll
            for (int m = 0; m < 4; ++m) { const size_t off = (size_t)(row0 + ai * HALF + m * 16) * DM + col0;
#pragma unroll
                for (int bj = 0; bj < 2; ++bj)
#pragma unroll
                    for (int n = 0; n < 2; ++n) { const f32x4 xv = *(const f32x4*)(x + off + bj * HALF + n * 16); *(f32x4*)(out + off + bj * HALF + n * 16) = xv + acc[ai][bj][m][n]; }
                asm volatile("" ::: "memory"); }
    }
};

struct EpiOutNorm {
    static constexpr bool PERM = false, AFTER_DRAIN = true;
    const bf16_t* xb; const float* rinv; const float* fg; float* out; float* xch; unsigned* cnt;
    __device__ __forceinline__ void fused(f32x4 (&acc)[2][2][4][2], const Unit& u, int wr, int wc, int fr, int fq, LAS unsigned char* lds, int wid, int lane) const {
        LAS float* P = (LAS float*)lds;
        LAS float* S = (LAS float*)(lds + 8192);
        const int row0 = u.pm * BM + wr * 64 + fr, col0 = u.pn * BM + wc * 32 + 4 * fq;
        typedef unsigned u32x2v __attribute__((ext_vector_type(2)));
        u32x2v xv[2][4][2][2]; float ri[2][4];
#pragma unroll
        for (int ai = 0; ai < 2; ++ai)
#pragma unroll
            for (int m = 0; m < 4; ++m) { const size_t off = (size_t)(row0 + ai * HALF + m * 16) * DM + col0; ri[ai][m] = rinv[row0 + ai * HALF + m * 16];
#pragma unroll
                for (int bj = 0; bj < 2; ++bj)
#pragma unroll
                    for (int n = 0; n < 2; ++n) xv[ai][m][bj][n] = *(const u32x2v*)(xb + off + bj * HALF + n * 16); }
#pragma unroll
        for (int ai = 0; ai < 2; ++ai)
#pragma unroll
            for (int m = 0; m < 4; ++m) { float sq = 0.f; const float rv = ri[ai][m];
#pragma unroll
                for (int bj = 0; bj < 2; ++bj)
#pragma unroll
                    for (int n = 0; n < 2; ++n) { const u32x2v w = xv[ai][m][bj][n]; const f32x4 xf = {bflo(w.x) * rv, bfhi(w.x) * rv, bflo(w.y) * rv, bfhi(w.y) * rv};
                        const f32x4 hv = acc[ai][bj][m][n] + xf; acc[ai][bj][m][n] = hv; sq += (hv[0] * hv[0] + hv[1] * hv[1]) + (hv[2] * hv[2] + hv[3] * hv[3]); }
                sq += __shfl_xor(sq, 16); sq += __shfl_xor(sq, 32);
                if (fq == 0) P[(ai * HALF + wr * 64 + m * 16 + fr) * 4 + wc] = sq; }
        asm volatile("s_waitcnt lgkmcnt(0)" ::: "memory"); __builtin_amdgcn_s_barrier(); asm volatile("" ::: "memory");
        const int row = wid * 32 + (lane & 31);
        if (lane < 32) { const f32x4 pv = *(const LAS f32x4*)(P + row * 4); const float t = (pv[0] + pv[1]) + (pv[2] + pv[3]);
            __hip_atomic_store(xch + ((size_t)(u.pm * BM + row) * 4 + u.pn), t, __ATOMIC_RELAXED, __HIP_MEMORY_SCOPE_AGENT); }
        asm volatile("s_waitcnt vmcnt(0)" ::: "memory");
        if (lane == 0) __hip_atomic_fetch_add(cnt + 64 * u.pm, 1u, __ATOMIC_RELAXED, __HIP_MEMORY_SCOPE_AGENT);
        if (wid == 0) { unsigned sp = 0;
            while ((unsigned)__builtin_amdgcn_readfirstlane(__hip_atomic_load(cnt + 64 * u.pm, __ATOMIC_RELAXED, __HIP_MEMORY_SCOPE_AGENT)) < 32u) { __builtin_amdgcn_s_sleep(2); if (++sp > (1u << 22)) break; }
            __builtin_amdgcn_fence(__ATOMIC_ACQUIRE, "agent"); }
        asm volatile("s_waitcnt vmcnt(0) lgkmcnt(0)" ::: "memory"); __builtin_amdgcn_s_barrier(); asm volatile("" ::: "memory");
        if (lane < 32) { const float* slot = xch + (size_t)(u.pm * BM + row) * 4; float t = 0.f;
#pragma unroll
            for (int q = 0; q < 4; ++q) t += __hip_atomic_load(slot + q, __ATOMIC_RELAXED, __HIP_MEMORY_SCOPE_AGENT);
            S[row] = 1.0f / sqrtf(t * (1.0f / DM) + NORM_EPS); }
        asm volatile("s_waitcnt lgkmcnt(0)" ::: "memory"); __builtin_amdgcn_s_barrier(); asm volatile("" ::: "memory");
        f32x4 gv[2][2];
#pragma unroll
        for (int bj = 0; bj < 2; ++bj)
#pragma unroll
            for (int n = 0; n < 2; ++n) gv[bj][n] = *(const f32x4*)(fg + col0 + bj * HALF + n * 16);
#pragma unroll
        for (int ai = 0; ai < 2; ++ai)
#pragma unroll
            for (int m = 0; m < 4; ++m) { const int r = ai * HALF + wr * 64 + m * 16 + fr; const float rs = S[r]; const size_t off = (size_t)(u.pm * BM + r) * DM + col0;
#pragma unroll
                for (int bj = 0; bj < 2; ++bj)
#pragma unroll
                    for (int n = 0; n < 2; ++n) *(f32x4*)(out + off + bj * HALF + n * 16) = acc[ai][bj][m][n] * rs * gv[bj][n]; }
    }
};
}

__device__ __forceinline__ void s5_naive(const Args& a, int b, int g, int lane) {
    const bf16_t* PROJ = (const bf16_t*)(a.ws + WS_PROJ); bf16_t* GB = (bf16_t*)(a.ws + WS_GB);
    const float* LAMB = (const float*)(a.ws + WS_LAMB); const float* BBAR = (const float*)(a.ws + WS_BBAR);
    const float* c_re = a.in[8]; const float* c_im = a.in[9]; const float* ssm_d = a.in[10];
    const int p = lane, h = lane & 15, pg = lane >> 4;
    const float lr = LAMB[(g * NP + p) * 2], li = LAMB[(g * NP + p) * 2 + 1];
    float bre[16], bim[16], cre[16], cim[16];
#pragma unroll
    for (int j = 0; j < 16; ++j) { bre[j] = BBAR[((g * NP + p) * GH + j) * 2]; bim[j] = BBAR[((g * NP + p) * GH + j) * 2 + 1];
        cre[j] = c_re[(g * GH + h) * NP + pg * 16 + j]; cim[j] = c_im[(g * GH + h) * NP + pg * 16 + j]; }
    const float dd = ssm_d[g * GH + h];
    float sr = 0.f, si = 0.f;
    for (int t = 0; t < SEQ; ++t) {
        const bf16_t* up = PROJ + (size_t)(b * SEQ + t) * DIN + C_AIN + g * GH;
        const v4u u0 = *(const v4u*)up, u1 = *(const v4u*)(up + 8);
        float u[16];
        u[0] = bflo(u0.x); u[1] = bfhi(u0.x); u[2] = bflo(u0.y); u[3] = bfhi(u0.y); u[4] = bflo(u0.z); u[5] = bfhi(u0.z); u[6] = bflo(u0.w); u[7] = bfhi(u0.w);
        u[8] = bflo(u1.x); u[9] = bfhi(u1.x); u[10] = bflo(u1.y); u[11] = bfhi(u1.y); u[12] = bflo(u1.z); u[13] = bfhi(u1.z); u[14] = bflo(u1.w); u[15] = bfhi(u1.w);
        const float uh = bf2f(up[h]);
        float bur = 0.f, bui = 0.f;
#pragma unroll
        for (int j = 0; j < 16; ++j) { bur += bre[j] * u[j]; bui += bim[j] * u[j]; }
        const float nsr = lr * sr - li * si + bur, nsi = lr * si + li * sr + bui;
        sr = nsr; si = nsi;
        float part = 0.f;
#pragma unroll
        for (int j = 0; j < 16; ++j) { const float xr = __shfl(sr, pg * 16 + j), xi = __shfl(si, pg * 16 + j); part += cre[j] * xr - cim[j] * xi; }
        part += __shfl_xor(part, 16); part += __shfl_xor(part, 32);
        const float y = part + dd * uh;
        if (lane < 16) GB[(size_t)(b * SEQ + t) * WSSM + g * GH + h] = (bf16_t)f2bf(gelu_tanh(y));
    }
}

__device__ __forceinline__ void conv_naive(const Args& a, int vb, int nvb) {
    const bf16_t* PROJ = (const bf16_t*)(a.ws + WS_PROJ); bf16_t* YCAT = (bf16_t*)(a.ws + WS_YCAT);
    const float* conv_w = a.in[14]; const float* conv_b = a.in[15];
    const int gt = vb * 512 + otid(), NT = nvb * 512;
    for (int idx = gt; idx < NTOK * WSSM; idx += NT) {
        const int tok = idx / WSSM, c = idx % WSSM, t = tok % SEQ;
        const bf16_t* row = PROJ + (size_t)tok * DIN;
        float acc = conv_b[c];
#pragma unroll
        for (int k = 0; k < 3; ++k) { const int tt = t - 2 + k; if (tt >= 0) { const bf16_t* r2 = PROJ + (size_t)(tok - 2 + k) * DIN; acc += conv_w[k * WSSM + c] * (bf2f(r2[C_CC + c]) * bf2f(r2[C_CIN + c])); } }
        const float y = bf2f(row[C_CB + c]) * acc * silu_f(bf2f(row[C_CGATE + c]));
        YCAT[(size_t)tok * DM + WSSM + c] = (bf16_t)f2bf(y);
    }
}
__device__ __forceinline__ void attn_naive(const Args& a, int vb, int nvb) {
    const bf16_t* PROJ = (const bf16_t*)(a.ws + WS_PROJ); bf16_t* YCAT = (bf16_t*)(a.ws + WS_YCAT); const bf16_t* KV = (const bf16_t*)(a.ws + WS_KV);
    const int gt = vb * 512 + otid(), NT = nvb * 512;
    for (int item = gt; item < NB * 4 * SEQ; item += NT) {
        const int t = item % SEQ, hh = (item / SEQ) % 4, b = item / (4 * SEQ), tok = b * SEQ + t;
        const v4u* qp = (const v4u*)(PROJ + (size_t)tok * DIN + C_Q + hh * 64);
        float q[64], o[64];
#pragma unroll
        for (int i = 0; i < 8; ++i) { const v4u v = qp[i]; q[8 * i] = bflo(v.x); q[8 * i + 1] = bfhi(v.x); q[8 * i + 2] = bflo(v.y); q[8 * i + 3] = bfhi(v.y); q[8 * i + 4] = bflo(v.z); q[8 * i + 5] = bfhi(v.z); q[8 * i + 6] = bflo(v.w); q[8 * i + 7] = bfhi(v.w); }
#pragma unroll
        for (int d = 0; d < 64; ++d) o[d] = 0.f;
        float m = -1e30f, l = 0.f;
        for (int mm = 0; mm < NMEM; ++mm) {
            const v4u* kp = (const v4u*)(KV + (size_t)(b * NMEM + mm) * 512 + hh * 64);
            const v4u* vp = (const v4u*)(KV + (size_t)(b * NMEM + mm) * 512 + 256 + hh * 64);
            float s = 0.f;
#pragma unroll
            for (int i = 0; i < 8; ++i) { const v4u v = kp[i];
                s += q[8 * i] * bflo(v.x) + q[8 * i + 1] * bfhi(v.x) + q[8 * i + 2] * bflo(v.y) + q[8 * i + 3] * bfhi(v.y) + q[8 * i + 4] * bflo(v.z) + q[8 * i + 5] * bfhi(v.z) + q[8 * i + 6] * bflo(v.w) + q[8 * i + 7] * bfhi(v.w); }
            s *= 0.125f;
            const float mn = fmaxf(m, s), sc = __expf(m - mn), pp = __expf(s - mn);
            l = l * sc + pp; m = mn;
#pragma unroll
            for (int i = 0; i < 8; ++i) { const v4u v = vp[i];
                o[8 * i] = o[8 * i] * sc + pp * bflo(v.x); o[8 * i + 1] = o[8 * i + 1] * sc + pp * bfhi(v.x); o[8 * i + 2] = o[8 * i + 2] * sc + pp * bflo(v.y); o[8 * i + 3] = o[8 * i + 3] * sc + pp * bfhi(v.y);
                o[8 * i + 4] = o[8 * i + 4] * sc + pp * bflo(v.z); o[8 * i + 5] = o[8 * i + 5] * sc + pp * bfhi(v.z); o[8 * i + 6] = o[8 * i + 6] * sc + pp * bflo(v.w); o[8 * i + 7] = o[8 * i + 7] * sc + pp * bfhi(v.w); }
        }
        const float inv = 1.0f / l;
        const v4u* gp = (const v4u*)(PROJ + (size_t)tok * DIN + C_QGATE + hh * 64);
        v4u* op = (v4u*)(YCAT + (size_t)tok * DM + 768 + hh * 64);
#pragma unroll
        for (int i = 0; i < 8; ++i) { const v4u gv = gp[i]; v4u w;
            w.x = pk2(o[8 * i] * inv * silu_f(bflo(gv.x)), o[8 * i + 1] * inv * silu_f(bfhi(gv.x)));
            w.y = pk2(o[8 * i + 2] * inv * silu_f(bflo(gv.y)), o[8 * i + 3] * inv * silu_f(bfhi(gv.y)));
            w.z = pk2(o[8 * i + 4] * inv * silu_f(bflo(gv.z)), o[8 * i + 5] * inv * silu_f(bfhi(gv.z)));
            w.w = pk2(o[8 * i + 6] * inv * silu_f(bflo(gv.w)), o[8 * i + 7] * inv * silu_f(bfhi(gv.w)));
            op[i] = w; }
    }
}

typedef short bf16x8_t __attribute__((ext_vector_type(8)));
typedef short s16x4_t __attribute__((ext_vector_type(4)));
typedef float f32x16 __attribute__((ext_vector_type(16)));
typedef __bf16 bf2_t __attribute__((ext_vector_type(2)));
typedef float f2_t __attribute__((ext_vector_type(2)));
typedef unsigned u32x2_t __attribute__((ext_vector_type(2)));
__device__ __forceinline__ unsigned cvt2(float lo, float hi) { const f2_t v = {lo, hi}; return __builtin_bit_cast(unsigned, __builtin_convertvector(v, bf2_t)); }
__device__ __forceinline__ void attn_mfma(const Args& a, LAS unsigned char* lds, int vb, int nvb) {
    const int nj = nvb / 16; if (nj < 1 || vb >= nj * 16) return;
    const int tid = otid(), lane = tid & 63, wave = tid >> 6, r = lane & 31, h = lane >> 5;
    const int bh = vb % 16, j = vb / 16, b = bh >> 2, head = bh & 3;
    const bf16_t* PROJ = (const bf16_t*)(a.ws + WS_PROJ); bf16_t* YCAT = (bf16_t*)(a.ws + WS_YCAT); const bf16_t* KV = (const bf16_t*)(a.ws + WS_KV);
    LAS unsigned char* Kl = lds;
    LAS unsigned char* Vl = lds + 36864;
    for (int c = tid; c < 2048; c += 512) { const int key = c >> 3, dch = c & 7;
        const bf16_t* src = KV + (size_t)(b * NMEM + key) * 512 + head * 64 + dch * 8;
        const v4u kv = *(const v4u*)src, vv = *(const v4u*)(src + 256);
        *(LAS v4u*)(Kl + key * 144 + dch * 16) = kv;
        LAS bf16_t* vd = (LAS bf16_t*)(Vl + (dch * 8) * 520 + key * 2);
        vd[0 * 260] = (bf16_t)(vv.x & 0xffff); vd[1 * 260] = (bf16_t)(vv.x >> 16); vd[2 * 260] = (bf16_t)(vv.y & 0xffff); vd[3 * 260] = (bf16_t)(vv.y >> 16);
        vd[4 * 260] = (bf16_t)(vv.z & 0xffff); vd[5 * 260] = (bf16_t)(vv.z >> 16); vd[6 * 260] = (bf16_t)(vv.w & 0xffff); vd[7 * 260] = (bf16_t)(vv.w >> 16); }
    __syncthreads();
    for (int tile = j * 8 + wave; tile < SEQ / 32; tile += nj * 8) {
        const size_t tok = (size_t)b * SEQ + tile * 32 + r;
        bf16x8_t qf[4];
#pragma unroll
        for (int s4 = 0; s4 < 4; ++s4) qf[s4] = *(const bf16x8_t*)(PROJ + tok * DIN + C_Q + head * 64 + 16 * s4 + 8 * h);
        const float sc = 0.125f * 1.4426950408889634f;
        float mx = -3.0e38f, l = 0.f;
        f32x16 o0, o1;
#pragma unroll
        for (int i = 0; i < 16; ++i) { o0[i] = 0.f; o1[i] = 0.f; }
#pragma unroll 2
        for (int kt = 0; kt < 8; ++kt) {
            f32x16 st;
#pragma unroll
            for (int i = 0; i < 16; ++i) st[i] = 0.f;
#pragma unroll
            for (int s4 = 0; s4 < 4; ++s4) { const bf16x8_t kf = *(const LAS bf16x8_t*)(Kl + (kt * 32 + r) * 144 + (16 * s4 + 8 * h) * 2);
                st = __builtin_amdgcn_mfma_f32_32x32x16_bf16(kf, qf[s4], st, 0, 0, 0); }
            float tm = st[0];
#pragma unroll
            for (int i = 1; i < 16; ++i) tm = fmaxf(tm, st[i]);
            tm = fmaxf(tm, __shfl_xor(tm, 32));
            const float mn = fmaxf(mx, tm), alpha = __builtin_amdgcn_exp2f((mx - mn) * sc), mb = mn * sc;
            mx = mn; l *= alpha;
#pragma unroll
            for (int i = 0; i < 16; ++i) { o0[i] *= alpha; o1[i] *= alpha; }
#pragma unroll
            for (int i = 0; i < 16; ++i) { const float p = __builtin_amdgcn_exp2f(st[i] * sc - mb); st[i] = p; l += p; }
#pragma unroll
            for (int s2 = 0; s2 < 2; ++s2) {
                v4u pw; pw.x = cvt2(st[8 * s2 + 0], st[8 * s2 + 1]); pw.y = cvt2(st[8 * s2 + 2], st[8 * s2 + 3]);
                pw.z = cvt2(st[8 * s2 + 4], st[8 * s2 + 5]); pw.w = cvt2(st[8 * s2 + 6], st[8 * s2 + 7]);
                const bf16x8_t pf = __builtin_bit_cast(bf16x8_t, pw);
                const int koff = (kt * 32 + 16 * s2 + 4 * h) * 2;
                { const s16x4_t lo = *(const LAS s16x4_t*)(Vl + r * 520 + koff), hi = *(const LAS s16x4_t*)(Vl + r * 520 + koff + 16);
                  const bf16x8_t vf = __builtin_shufflevector(lo, hi, 0, 1, 2, 3, 4, 5, 6, 7); o0 = __builtin_amdgcn_mfma_f32_32x32x16_bf16(vf, pf, o0, 0, 0, 0); }
                { const s16x4_t lo = *(const LAS s16x4_t*)(Vl + (32 + r) * 520 + koff), hi = *(const LAS s16x4_t*)(Vl + (32 + r) * 520 + koff + 16);
                  const bf16x8_t vf = __builtin_shufflevector(lo, hi, 0, 1, 2, 3, 4, 5, 6, 7); o1 = __builtin_amdgcn_mfma_f32_32x32x16_bf16(vf, pf, o1, 0, 0, 0); }
            }
        }
        l += __shfl_xor(l, 32);
        const float inv = 1.0f / l;
        const bf16_t* gp = PROJ + tok * DIN + C_QGATE + head * 64; bf16_t* op = YCAT + tok * DM + 768 + head * 64;
#pragma unroll
        for (int q4 = 0; q4 < 4; ++q4) {
            { const int d = 8 * q4 + 4 * h; const u32x2_t gv = *(const u32x2_t*)(gp + d); u32x2_t w;
              w.x = cvt2(o0[4 * q4 + 0] * inv * silu_f(bflo(gv.x)), o0[4 * q4 + 1] * inv * silu_f(bfhi(gv.x))); w.y = cvt2(o0[4 * q4 + 2] * inv * silu_f(bflo(gv.y)), o0[4 * q4 + 3] * inv * silu_f(bfhi(gv.y)));
              *(u32x2_t*)(op + d) = w; }
            { const int d = 32 + 8 * q4 + 4 * h; const u32x2_t gv = *(const u32x2_t*)(gp + d); u32x2_t w;
              w.x = cvt2(o1[4 * q4 + 0] * inv * silu_f(bflo(gv.x)), o1[4 * q4 + 1] * inv * silu_f(bfhi(gv.x))); w.y = cvt2(o1[4 * q4 + 2] * inv * silu_f(bflo(gv.y)), o1[4 * q4 + 3] * inv * silu_f(bfhi(gv.y)));
              *(u32x2_t*)(op + d) = w; }
        }
    }
}
__device__ __forceinline__ void conv_vec(const Args& a, int vb, int nvb) {
    const bf16_t* PROJ = (const bf16_t*)(a.ws + WS_PROJ); bf16_t* YCAT = (bf16_t*)(a.ws + WS_YCAT);
    const float* conv_w = a.in[14]; const float* conv_b = a.in[15];
    const int gt = vb * 512 + otid(), NT = nvb * 512;
    for (int it = gt; it < (NTOK / 4) * 48; it += NT) {
        const int tg = it / 48, c0 = (it % 48) * 8, tok0 = tg * 4, t0 = tok0 % SEQ;
        const bf16_t* row0 = PROJ + (size_t)tok0 * DIN;
        v4u uu[6], ww[4];
#pragma unroll
        for (int r = 0; r < 6; ++r) { const bool ok = (t0 + r - 2) >= 0; const bf16_t* rp = row0 + (ptrdiff_t)(r - 2) * DIN; uu[r] = ok ? *(const v4u*)(rp + C_U + c0) : (v4u){0u, 0u, 0u, 0u}; }
#pragma unroll
        for (int j = 0; j < 4; ++j) ww[j] = *(const v4u*)(row0 + (size_t)j * DIN + C_W + c0);
        float w[3][8], bb[8];
#pragma unroll
        for (int k = 0; k < 3; ++k) { const f32x4 w0 = *(const f32x4*)(conv_w + k * WSSM + c0), w1 = *(const f32x4*)(conv_w + k * WSSM + c0 + 4);
            w[k][0] = w0.x; w[k][1] = w0.y; w[k][2] = w0.z; w[k][3] = w0.w; w[k][4] = w1.x; w[k][5] = w1.y; w[k][6] = w1.z; w[k][7] = w1.w; }
        { const f32x4 b0 = *(const f32x4*)(conv_b + c0), b1 = *(const f32x4*)(conv_b + c0 + 4); bb[0] = b0.x; bb[1] = b0.y; bb[2] = b0.z; bb[3] = b0.w; bb[4] = b1.x; bb[5] = b1.y; bb[6] = b1.z; bb[7] = b1.w; }
        float u[6][8];
#pragma unroll
        for (int r = 0; r < 6; ++r) { u[r][0] = bflo(uu[r].x); u[r][1] = bfhi(uu[r].x); u[r][2] = bflo(uu[r].y); u[r][3] = bfhi(uu[r].y); u[r][4] = bflo(uu[r].z); u[r][5] = bfhi(uu[r].z); u[r][6] = bflo(uu[r].w); u[r][7] = bfhi(uu[r].w); }
#pragma unroll
        for (int j = 0; j < 4; ++j) { float y[8];
#pragma unroll
            for (int e = 0; e < 8; ++e) y[e] = bb[e] + w[0][e] * u[j][e] + w[1][e] * u[j + 1][e] + w[2][e] * u[j + 2][e];
            v4u o;
            o.x = cvt2(bflo(ww[j].x) * y[0], bfhi(ww[j].x) * y[1]); o.y = cvt2(bflo(ww[j].y) * y[2], bfhi(ww[j].y) * y[3]);
            o.z = cvt2(bflo(ww[j].z) * y[4], bfhi(ww[j].z) * y[5]); o.w = cvt2(bflo(ww[j].w) * y[6], bfhi(ww[j].w) * y[7]);
            *(v4u*)(YCAT + (size_t)(tok0 + j) * DM + WSSM + c0) = o; }
    }
}
__device__ __forceinline__ void final_norm(const Args& a) {
    const int tid = otid(), lane = tid & 63, gw = blockIdx.x * 8 + (tid >> 6), NGW = gridDim.x * 8;
    const float* fg = a.in[19];
    for (int r = gw; r < NTOK; r += NGW) {
        f32x4* xr = (f32x4*)(a.out + (size_t)r * DM) + lane;
        f32x4 v[4]; float s = 0.f;
#pragma unroll
        for (int j = 0; j < 4; ++j) { v[j] = xr[64 * j]; s += (v[j].x * v[j].x + v[j].y * v[j].y) + (v[j].z * v[j].z + v[j].w * v[j].w); }
        const float rstd = 1.0f / sqrtf(wave_sum(s) * (1.0f / DM) + NORM_EPS);
#pragma unroll
        for (int j = 0; j < 4; ++j) { const f32x4 g = ((const f32x4*)fg)[lane + 64 * j]; xr[64 * j] = v[j] * rstd * g; }
    }
}

__global__ void __launch_bounds__(512, 2) mega(Args a) {
    extern __shared__ __attribute__((aligned(16))) unsigned char smem_raw[];
    LAS unsigned char* lds = (LAS unsigned char*)smem_raw;
    cg::grid_group grid = cg::this_grid();
    volatile LAS unsigned* xst = (volatile LAS unsigned*)(lds + 139264);
    if (threadIdx.x == 0) { xst[0] = 0u; xst[1] = 0u; }
    { unsigned* ctl = (unsigned*)(a.ws + WS_CTL); unsigned* flag = ctl + CTL_FLAG_WORD;
      if (blockIdx.x == 0) { for (int i = threadIdx.x; i < 8192; i += 512) __hip_atomic_store(ctl + i, 0u, __ATOMIC_RELAXED, __HIP_MEMORY_SCOPE_AGENT);
          asm volatile("s_waitcnt vmcnt(0)" ::: "memory"); __syncthreads();
          if (threadIdx.x == 0) { __builtin_amdgcn_fence(__ATOMIC_RELEASE, "agent"); __hip_atomic_store(flag, CTL_TOKEN, __ATOMIC_RELAXED, __HIP_MEMORY_SCOPE_AGENT); } }
      if (threadIdx.x == 0) { unsigned sp = 0; while (__hip_atomic_load(flag, __ATOMIC_RELAXED, __HIP_MEMORY_SCOPE_AGENT) != CTL_TOKEN) { __builtin_amdgcn_s_sleep(1); if (++sp > (1u << 22)) break; }
          __builtin_amdgcn_fence(__ATOMIC_ACQUIRE, "agent"); } }
    __syncthreads();
    const XcdBarrier xbar = xcd_barrier_post((unsigned*)(a.ws + WS_CTL), xst);
    const int bid = blockIdx.x, G = gridDim.x;
    bf16_t* XB = (bf16_t*)(a.ws + WS_XB); bf16_t* MEMN = (bf16_t*)(a.ws + WS_MEMN);
    bf16_t* WINT = (bf16_t*)(a.ws + WS_WINT); bf16_t* WKVT = (bf16_t*)(a.ws + WS_WKVT); bf16_t* WOUTT = (bf16_t*)(a.ws + WS_WOUTT); bf16_t* WGLUT = (bf16_t*)(a.ws + WS_WGLUT);
    bf16_t* PROJ = (bf16_t*)(a.ws + WS_PROJ); bf16_t* KV = (bf16_t*)(a.ws + WS_KV); bf16_t* GB = (bf16_t*)(a.ws + WS_GB); bf16_t* YCAT = (bf16_t*)(a.ws + WS_YCAT);
    bf16_t* AY = (bf16_t*)(a.ws + WS_AY); bf16_t* WSb = (bf16_t*)(a.ws + WS_WS); bf16_t* WYb = (bf16_t*)(a.ws + WS_WY);

#ifndef PROBE_DUP
#define PROBE_DUP -1
#endif
#define REPS(k) for (int rep_ = 0; rep_ < ((PROBE_DUP == (k)) ? 2 : 1); ++rep_)
#ifndef PROBE_SUB
#define PROBE_SUB -1
#endif
    if (a.out == nullptr) grid.sync();
    REPS(0) { phase0(a, lds);
    xcd_barrier(xbar); }
    REPS(1) {
    { pg8::Order S; S.init(NTOK / 256, DIN / 256, 1, G, bid);
      pg8::gemm_phase<true, true>(lds, pg8::Gemm{XB, WINT, DM, DM, DM, 0, 0}, S, pg8::EpiProjAY{PROJ, AY}); }
    { pg8::Order S; S.init(NB * NMEM / 256, 512 / 256, 1, G, (bid + G - ((NTOK / 256) * (DIN / 256)) % G) % G);
      pg8::gemm_phase<false, true>(lds, pg8::Gemm{MEMN, WKVT, DM, DM, DM, 0, 0}, S, pg8::EpiBf16Store{KV, 512}); }
    xcd_barrier(xbar); }
    REPS(2) {
    if (bid < NB * NG) { pg8::Order S; S.init(NB, 1, NG, G, bid);
      pg8::gemm_phase<false, true>(lds, pg8::Gemm{AY, WSb, 512, 256, 256, (size_t)1024 * 512, (size_t)256 * 256}, S, pg8::EpiSend{AY, (const float*)(a.ws + WS_LAMT), (const float*)(a.ws + WS_LAM512)});
      asm volatile("s_waitcnt vmcnt(0)" ::: "memory"); __syncthreads();
      pg8::gemm_phase<false, true>(lds, pg8::Gemm{AY, WYb, 512, 512, 384, (size_t)1024 * 512, (size_t)256 * 512}, S, pg8::EpiY{AY, a.in[10], GB}); }
    else { attn_mfma(a, lds, bid - NB * NG, G - NB * NG); conv_vec(a, bid - NB * NG, G - NB * NG); }
    xcd_barrier(xbar); }
    REPS(4) {
    { pg8::Order S; S.init(NTOK / 256, 2, 2, G, bid);
      pg8::gemm_phase<false, true>(lds, pg8::Gemm{GB, WGLUT, WSSM, WSSM, WSSM, 0, 0}, S, pg8::EpiGluP{GB, PROJ, a.in[13], YCAT}); }
    xcd_barrier(xbar); }
    REPS(5) {
    { pg8::Order S; S.init(NTOK / 256, DM / 256, 1, G, bid);
      pg8::gemm_phase<false, true>(lds, pg8::Gemm{YCAT, WOUTT, DM, DM, DM, 0, 0}, S, pg8::EpiOutNorm{XB, (const float*)(a.ws + WS_RINV), a.in[19], a.out, (float*)(a.ws + WS_XCH), (unsigned*)(a.ws + WS_CTL + CTL_PANEL)}); }
    }
    __syncthreads();
    if (threadIdx.x == 0) { unsigned* ctl = (unsigned*)(a.ws + WS_CTL);
        const unsigned old_ = __hip_atomic_fetch_add(ctl + CTL_EXIT_WORD, 1u, __ATOMIC_RELAXED, __HIP_MEMORY_SCOPE_AGENT);
        if (old_ == (unsigned)G - 1u) __hip_atomic_store(ctl + CTL_FLAG_WORD, CTL_RESET, __ATOMIC_RELAXED, __HIP_MEMORY_SCOPE_AGENT); }
}

extern "C" void kernel_launch(void* const* d_in, const int* in_sizes, int n_in, void* d_out, int out_size, void* d_ws, size_t ws_size, hipStream_t stream) {
    static int grid = 0;
    if (grid == 0) {
        if (n_in != 20 || out_size != NTOK * DM || ws_size < WS_END) { fprintf(stderr, "kernel_launch: unexpected shapes n_in %d out %d ws %zu\n", n_in, out_size, ws_size); grid = -1; return; }
        int dev = 0, cus = 0, per_cu = 0;
        hipGetDevice(&dev);
        hipDeviceGetAttribute(&cus, hipDeviceAttributeMultiprocessorCount, dev);
        if (hipFuncSetAttribute((const void*)mega, hipFuncAttributeMaxDynamicSharedMemorySize, LDS_BYTES) != hipSuccess) { fprintf(stderr, "kernel_launch: hipFuncSetAttribute failed\n"); grid = -1; return; }
        if (hipOccupancyMaxActiveBlocksPerMultiprocessor(&per_cu, (const void*)mega, 512, LDS_BYTES) != hipSuccess || per_cu < 1) { fprintf(stderr, "kernel_launch: occupancy query says %d\n", per_cu); per_cu = 1; }
        (void)hipGetLastError();
        grid = cus;
        if (grid != 256) { fprintf(stderr, "kernel_launch: built for 256 CUs (one workgroup each), device has %d\n", grid); grid = -1; return; }
        if (grid < NB * NG) { fprintf(stderr, "kernel_launch: grid %d too small\n", grid); grid = -1; return; }
    }
    if (grid < 0) return;
    Args a{};
    for (int i = 0; i < 20; ++i) a.in[i] = (const float*)d_in[i];
    a.out = (float*)d_out; a.ws = (unsigned char*)d_ws;
    void* args[] = {&a};
    hipError_t e = hipLaunchCooperativeKernel((const void*)mega, dim3(grid), dim3(512), args, LDS_BYTES, stream);
    if (e != hipSuccess) fprintf(stderr, "cooperative launch failed: %s (grid %d)\n", hipGetErrorString(e), grid);
}
```
